# Optimizing an MI355X kernel written in HIP

```python
import math
import jax
import jax.numpy as jnp
from jax import lax
import numpy as np

D_MODEL = 1024
BATCH = 1
SEQ = 16384
DEPTH = 2

GRID_W = 64
CTX_LEN = 256

HG_HEADS = 4
HG_DK = 128
HG_DV = 128
HG_WIDTH = HG_HEADS * HG_DK
HG_VWIDTH = HG_HEADS * HG_DV
F_MIN = 1e-30

RET_HEADS = 4
RET_DK = 128
RET_DV = 256
RET_QK = RET_HEADS * RET_DK
RET_V = RET_HEADS * RET_DV
ROPE_BASE = 10000.0

CHUNK = 64

N_GROUPS = 4
EXPERTS_PER_GROUP = 8
N_EXPERTS = N_GROUPS * EXPERTS_PER_GROUP
TOP_K = 2
D_EXPERT = 256
MOE_BLOCK = 128

N_MOD = 6
EPS = 1e-6

IN_SIZES = (HG_WIDTH, HG_WIDTH, HG_WIDTH, HG_VWIDTH, HG_VWIDTH, RET_QK, RET_QK, RET_V, RET_V, D_MODEL, D_MODEL)
D_IN = sum(IN_SIZES)
IN_SPLITS = tuple(int(s) for s in np.cumsum(IN_SIZES)[:-1])

kernel_name = 'hybrid_hgrn2_retention_hmoe_block'


def rms_norm(a, w):
    a32 = a.astype(jnp.float32)
    out = a32 * lax.rsqrt(jnp.mean(a32 * a32, axis=-1, keepdims=True) + EPS) * w.astype(jnp.float32)
    return out.astype(a.dtype)


def modulate(h, shift, scale):
    return h * (1 + scale) + shift


def heads(a, n_heads):
    b, l, w = a.shape
    return a.reshape(b, l, n_heads, w // n_heads).transpose(0, 2, 1, 3)


def merge_heads(o):
    b, h, l, dh = o.shape
    return o.transpose(0, 2, 1, 3).reshape(b, l, h * dh)


def rope_1d(x, pos):
    d = x.shape[-1]
    inv = ROPE_BASE ** (-jnp.arange(0, d, 2, dtype=jnp.float32) / d)
    ang = pos.astype(jnp.float32)[:, None] * inv
    cos, sin = jnp.cos(ang), jnp.sin(ang)
    x1, x2 = jnp.split(x.astype(jnp.float32), 2, axis=-1)
    return jnp.concatenate([x1 * cos - x2 * sin, x1 * sin + x2 * cos], axis=-1).astype(x.dtype)


def rope_2d(x, row_pos, col_pos):
    xr, xc = jnp.split(x, 2, axis=-1)
    return jnp.concatenate([rope_1d(xr, row_pos), rope_1d(xc, col_pos)], axis=-1)


def chunk_recurrence(q, k, v, log_f, s0):
    b_, h_, t_, _ = q.shape
    dv = v.shape[-1]
    dg = log_f.shape[-1]
    n = t_ // CHUNK

    def blocks(a):
        return jnp.moveaxis(a.astype(jnp.float32).reshape(b_, h_, n, CHUNK, a.shape[-1]), 2, 0)

    mask = jnp.tril(jnp.ones((CHUNK, CHUNK), dtype=bool))[:, :, None]

    def step(s, xs):
        qc, kc, vc, gc = xs
        b = jnp.cumsum(gc, axis=2)
        b_last = b[:, :, -1:, :]
        o_inter = jnp.einsum('bhtd,bhde->bhte', qc * jnp.exp(b), s)
        diff = b[:, :, :, None, :] - b[:, :, None, :, :]
        rel = jnp.where(mask, jnp.exp(jnp.minimum(diff, 0.0)), 0.0)
        if dg == 1:
            scores = jnp.einsum('bhtd,bhsd->bhts', qc, kc) * rel[..., 0]
        else:
            scores = jnp.einsum('bhtd,bhsd,bhtsd->bhts', qc, kc, rel)
        o = o_inter + jnp.einsum('bhts,bhse->bhte', scores, vc)
        s_new = s * jnp.exp(b_last[:, :, 0, :])[..., None] + jnp.einsum('bhsd,bhse->bhde', kc * jnp.exp(b_last - b), vc)
        return s_new, o

    s_fin, o = lax.scan(step, s0, (blocks(q), blocks(k), blocks(v), blocks(log_f)))
    return jnp.moveaxis(o, 0, 2).reshape(b_, h_, t_, dv), s_fin


def flip_seq(a):
    return jnp.flip(a, axis=2)


def two_way(ctx_in, lat_in):
    qc, kfc, kbc, vc, gfc, gbc = ctx_in
    ql, kfl, kbl, vl, gfl, gbl = lat_in
    b_, h_, _, dk = qc.shape
    s0 = jnp.zeros((b_, h_, dk, vc.shape[-1]), jnp.float32)
    oc_f, sc_f = chunk_recurrence(qc, kfc, vc, gfc, s0)
    oc_b, sc_b = chunk_recurrence(flip_seq(qc), flip_seq(kbc), flip_seq(vc), flip_seq(gbc), s0)
    ol_f, _ = chunk_recurrence(ql, kfl, vl, gfl, sc_f)
    ol_b, _ = chunk_recurrence(flip_seq(ql), flip_seq(kbl), flip_seq(vl), flip_seq(gbl), sc_b)
    return oc_f + flip_seq(oc_b), ol_f + flip_seq(ol_b)


def hgrn_lower_bounds(logits):
    p = jax.nn.softmax(logits.astype(jnp.float32), axis=0)
    return jnp.clip(jnp.cumsum(p, axis=0) - p[0], 0.0, 1.0 - 1e-6)


def hgrn_forget(z, lb):
    z = z.astype(jnp.float32)
    sig = jax.nn.sigmoid(z)
    f = lb + (1 - lb) * sig
    log_f = jnp.log(jnp.maximum(f, F_MIN))
    k = (1 - lb) * (1 - sig)
    return heads(k, HG_HEADS), heads(log_f, HG_HEADS)


def token_mixer(h, lc, row_pos, col_pos, w_in, lb_f, lb_b, hg_norm_w, ret_logit, ret_gn_w, w_o_hg, w_o_ret, w_out):
    b_, l_, _ = h.shape
    t_ = l_ - lc
    proj = h @ w_in
    hq, hf_f, hf_b, hi, hg, rq, rk, rv, rg, ga, gb = jnp.split(proj, IN_SPLITS, axis=-1)

    q_hg = heads(jax.nn.silu(hq), HG_HEADS) * (HG_DK ** -0.5)
    i_hg = heads(hi, HG_HEADS)
    k_f, lf_f = hgrn_forget(hf_f, lb_f)
    k_b, lf_b = hgrn_forget(hf_b, lb_b)
    parts = (q_hg, k_f, k_b, i_hg, lf_f, lf_b)
    o_hg_c, o_hg_l = two_way([p[:, :, :lc] for p in parts], [p[:, :, lc:] for p in parts])
    o_hg = jnp.concatenate([o_hg_c, o_hg_l], axis=2)
    o_hg = o_hg * lax.rsqrt(jnp.mean(o_hg * o_hg, axis=-1, keepdims=True) + EPS)
    o_hg = merge_heads(o_hg) * hg_norm_w.astype(jnp.float32) * jax.nn.silu(hg.astype(jnp.float32))
    y_hg = o_hg.astype(h.dtype) @ w_o_hg

    q_r = heads(rq, RET_HEADS) * (RET_DK ** -0.5)
    k_r = heads(rk, RET_HEADS)
    v_r = heads(rv, RET_HEADS)
    q_c, q_l = q_r[:, :, :lc], rope_2d(q_r[:, :, lc:], row_pos, col_pos)
    k_c, k_l = k_r[:, :, :lc], rope_2d(k_r[:, :, lc:], row_pos, col_pos)
    log_gamma = jax.nn.log_sigmoid(ret_logit.astype(jnp.float32))

    def decay(direction, length):
        return jnp.broadcast_to(log_gamma[direction][None, :, None, None], (b_, RET_HEADS, length, 1))

    o_r_c, o_r_l = two_way([q_c, k_c, k_c, v_r[:, :, :lc], decay(0, lc), decay(1, lc)],
                           [q_l, k_l, k_l, v_r[:, :, lc:], decay(0, t_), decay(1, t_)])
    o_r = jnp.concatenate([o_r_c, o_r_l], axis=2)
    mu = jnp.mean(o_r, axis=-1, keepdims=True)
    var = jnp.mean(jnp.square(o_r - mu), axis=-1, keepdims=True)
    o_r = merge_heads((o_r - mu) * lax.rsqrt(var + EPS)) * ret_gn_w.astype(jnp.float32)
    o_r = o_r * jax.nn.silu(rg.astype(jnp.float32))
    y_ret = o_r.astype(h.dtype) @ w_o_ret

    y = (jax.nn.sigmoid(ga) * y_hg + jax.nn.sigmoid(gb) * y_ret) @ w_out
    return y[:, :lc], y[:, lc:]


def hierarchical_moe(h, wg, bg, we, be, w_gate, w_up, w_down):
    n_tok, d = h.shape
    h32 = h.astype(jnp.float32)
    g_logits = h32 @ wg.astype(jnp.float32) + bg.astype(jnp.float32)
    g_prob = jax.nn.softmax(g_logits, axis=-1)
    grp = jnp.argmax(g_logits, axis=-1)
    g_val = jnp.take_along_axis(g_prob, grp[:, None], axis=1)
    e_logits = (h32 @ we.astype(jnp.float32) + be.astype(jnp.float32)).reshape(n_tok, N_GROUPS, EXPERTS_PER_GROUP)
    e_in_grp = jnp.take_along_axis(e_logits, grp[:, None, None], axis=1)[:, 0]
    top_val, top_idx = lax.top_k(e_in_grp, TOP_K)
    weights = g_val * jax.nn.softmax(top_val, axis=-1)
    expert = grp[:, None] * EXPERTS_PER_GROUP + top_idx

    n_assign = n_tok * TOP_K
    flat_e = expert.reshape(-1)
    flat_tok = jnp.repeat(jnp.arange(n_tok), TOP_K)
    flat_w = weights.reshape(-1)
    order = jnp.argsort(flat_e)
    e_sorted = flat_e[order]
    tok_sorted = flat_tok[order]
    counts = jnp.bincount(flat_e, length=N_EXPERTS)
    padded = ((counts + MOE_BLOCK - 1) // MOE_BLOCK) * MOE_BLOCK
    seg_start = jnp.cumsum(counts) - counts
    pad_end = jnp.cumsum(padded)
    pad_start = pad_end - padded
    dest = pad_start[e_sorted] + (jnp.arange(n_assign) - seg_start[e_sorted])
    n_blocks = (n_assign + N_EXPERTS * (MOE_BLOCK - 1) + MOE_BLOCK - 1) // MOE_BLOCK
    buf_tok = jnp.full((n_blocks * MOE_BLOCK,), n_tok, jnp.int32).at[dest].set(tok_sorted.astype(jnp.int32))
    block_expert = jnp.minimum(jnp.searchsorted(pad_end, jnp.arange(n_blocks) * MOE_BLOCK, side='right'), N_EXPERTS - 1)
    h_pad = jnp.concatenate([h, jnp.zeros((1, d), h.dtype)], axis=0)
    x_blocks = h_pad[buf_tok].reshape(n_blocks, MOE_BLOCK, d)

    def expert_block(args):
        xb, e = args
        return (jax.nn.silu(xb @ w_gate[e]) * (xb @ w_up[e])) @ w_down[e]

    y_buf = lax.map(expert_block, (x_blocks, block_expert)).reshape(n_blocks * MOE_BLOCK, d)
    y_assign = y_buf[dest] * flat_w[order][:, None].astype(h.dtype)
    return jax.ops.segment_sum(y_assign, tok_sorted, num_segments=n_tok)


def setup_inputs(seed: int = 0) -> dict:
    key = jax.random.key(seed)
    ks = jax.random.split(key, 26)
    f32 = jnp.float32
    d = D_MODEL

    def nrm(k, shape, scale):
        return jax.random.normal(k, shape, f32) * scale

    base_decay_logit = jnp.asarray(np.log(2.0 ** (5 + np.arange(RET_HEADS)) - 1.0), f32)
    return {
        'x': nrm(ks[0], (BATCH, SEQ, d), 1.0),
        'c': nrm(ks[1], (BATCH, d), 1.0),
        'ctx': nrm(ks[2], (BATCH, CTX_LEN, d), 1.0),
        'c_ctx': nrm(ks[3], (d,), 1.0),
        'w_mod': nrm(ks[4], (DEPTH, d, N_MOD * d), 0.5 * d ** -0.5),
        'b_mod': nrm(ks[5], (DEPTH, N_MOD * d), 0.02),
        'norm_mix_w': 1.0 + nrm(ks[6], (DEPTH, d), 0.05),
        'norm_ffn_w': 1.0 + nrm(ks[7], (DEPTH, d), 0.05),
        'w_in': nrm(ks[8], (DEPTH, d, D_IN), d ** -0.5),
        'hgrn_lb_logits': nrm(ks[9], (2, DEPTH, HG_WIDTH), 1.0),
        'hgrn_norm_w': 1.0 + nrm(ks[10], (DEPTH, HG_VWIDTH), 0.05),
        'ret_decay_logit': base_decay_logit + nrm(ks[11], (DEPTH, 2, RET_HEADS), 0.1),
        'ret_gn_w': 1.0 + nrm(ks[12], (DEPTH, RET_V), 0.05),
        'w_o_hgrn': nrm(ks[13], (DEPTH, HG_VWIDTH, d), HG_VWIDTH ** -0.5),
        'w_o_ret': nrm(ks[14], (DEPTH, RET_V, d), RET_V ** -0.5),
        'w_out': nrm(ks[15], (DEPTH, d, d), d ** -0.5),
        'router_group_w': nrm(ks[16], (DEPTH, d, N_GROUPS), d ** -0.5),
        'router_group_b': nrm(ks[17], (DEPTH, N_GROUPS), 0.01),
        'router_expert_w': nrm(ks[18], (DEPTH, d, N_EXPERTS), d ** -0.5),
        'router_expert_b': nrm(ks[19], (DEPTH, N_EXPERTS), 0.01),
        'expert_w_gate': nrm(ks[20], (DEPTH, N_EXPERTS, d, D_EXPERT), d ** -0.5),
        'expert_w_up': nrm(ks[21], (DEPTH, N_EXPERTS, d, D_EXPERT), d ** -0.5),
        'expert_w_down': nrm(ks[22], (DEPTH, N_EXPERTS, D_EXPERT, d), D_EXPERT ** -0.5),
        'final_norm_w': 1.0 + nrm(ks[23], (d,), 0.05),
    }


def reference(x, c, ctx, c_ctx, w_mod, b_mod, norm_mix_w, norm_ffn_w, w_in, hgrn_lb_logits, hgrn_norm_w,
              ret_decay_logit, ret_gn_w, w_o_hgrn, w_o_ret, w_out, router_group_w, router_group_b,
              router_expert_w, router_expert_b, expert_w_gate, expert_w_up, expert_w_down, final_norm_w):
    b_, t_, d = x.shape
    lc = ctx.shape[1]
    ROWS = t_ // GRID_W
    row_pos = jnp.repeat(jnp.arange(ROWS), GRID_W)
    col_pos = jnp.tile(jnp.arange(GRID_W), ROWS)
    lb_fwd = hgrn_lower_bounds(hgrn_lb_logits[0])
    lb_bwd = hgrn_lower_bounds(hgrn_lb_logits[1])
    silu_c = jax.nn.silu(c)
    silu_cc = jax.nn.silu(c_ctx)

    for layer in range(DEPTH):
        mod_x = (silu_c @ w_mod[layer] + b_mod[layer])[:, None, :]
        mod_c = (silu_cc @ w_mod[layer] + b_mod[layer])[None, None, :]
        sh1x, sc1x, g1x, sh2x, sc2x, g2x = jnp.split(mod_x, N_MOD, axis=-1)
        sh1c, sc1c, g1c, sh2c, sc2c, g2c = jnp.split(mod_c, N_MOD, axis=-1)

        h = jnp.concatenate([modulate(rms_norm(ctx, norm_mix_w[layer]), sh1c, sc1c),
                             modulate(rms_norm(x, norm_mix_w[layer]), sh1x, sc1x)], axis=1)
        y_c, y_x = token_mixer(h, lc, row_pos, col_pos, w_in[layer], lb_fwd[layer], lb_bwd[layer],
                               hgrn_norm_w[layer], ret_decay_logit[layer], ret_gn_w[layer],
                               w_o_hgrn[layer], w_o_ret[layer], w_out[layer])
        x = x + g1x * y_x

        moe_args = (router_group_w[layer], router_group_b[layer], router_expert_w[layer], router_expert_b[layer],
                    expert_w_gate[layer], expert_w_up[layer], expert_w_down[layer])
        h_x = modulate(rms_norm(x, norm_ffn_w[layer]), sh2x, sc2x)
        if layer < DEPTH - 1:
            ctx = ctx + g1c * y_c
            h_c = modulate(rms_norm(ctx, norm_ffn_w[layer]), sh2c, sc2c)
            tokens = jnp.concatenate([h_c, h_x], axis=1).reshape(-1, d)
            y = hierarchical_moe(tokens, *moe_args).reshape(b_, lc + t_, d)
            ctx = ctx + g2c * y[:, :lc]
            x = x + g2x * y[:, lc:]
        else:
            y = hierarchical_moe(h_x.reshape(-1, d), *moe_args).reshape(b_, t_, d)
            x = x + g2x * y

    return rms_norm(x, final_norm_w)
```

```cpp
#include <hip/hip_runtime.h>
#include <cstdio>
#include <cstdint>
__device__ __forceinline__ int tid_fresh() { int t = (int)threadIdx.x; asm volatile("" : "+v"(t)); return t; }
namespace pg8 {
#define PG8_LAS __attribute__((address_space(3)))
typedef unsigned short bf16_t;
typedef short bf16x8 __attribute__((ext_vector_type(8)));
typedef float f32x4 __attribute__((ext_vector_type(4)));
typedef unsigned u32x4 __attribute__((ext_vector_type(4)));
constexpr int BM = 256, BK = 64, HALF = 128, HTB = HALF * BK * 2  , STAGE_BYTES = 8 * HTB, NXCD = 8, WGM = 8;

__host__ __device__ __forceinline__ int lds_byte(int r, int c) { const int st = (r >> 4) * 2 + (c >> 5), rr = r & 15, cc = c & 31, ob = rr * 64 + cc * 2; return st * 1024 + (ob ^ (((ob >> 9) & 1) << 5)); }
__host__ __device__ __forceinline__ void stage_rc(int b, int& R, int& C) { const int st = b / 1024, sb = b % 1024, swz = sb ^ (((sb >> 9) & 1) << 5); R = (st >> 1) * 16 + swz / 64; C = (st & 1) * 32 + (swz % 64) / 2; }
__host__ __device__ __forceinline__ int perm32(int rho) { const int n = rho >> 4, i = rho & 15; return 8 * (i >> 2) + 4 * n + (i & 3); }

struct Unit { int pm, pn, be; };
struct Gemm { const bf16_t* A; const bf16_t* Bt; int M, N, K; size_t bstride; };

struct StaticOrder {
    int nM, nN, nwg, G, c;
    __host__ __device__ void init(int M, int N, int G_, int c_) { nM = M / BM; nN = N / BM; nwg = nM * nN; G = G_; c = c_; }
    __host__ __device__ bool next(int i, Unit& u) const {
        const long L = (long)i * G + c; if (L >= nwg) return false;
        int wgid = (int)L; { const int q = nwg / NXCD, r = nwg % NXCD, xcd = wgid % NXCD, off = wgid / NXCD; wgid = (xcd < r ? xcd * (q + 1) : r * (q + 1) + (xcd - r) * q) + off; }
        const int nig = WGM * nN, gid = wgid / nig, fm = gid * WGM, gsz = (nM - fm) < WGM ? (nM - fm) : WGM;
        u.pm = fm + ((wgid % nig) % gsz); u.pn = (wgid % nig) / gsz; u.be = 0; return true;
    }
    __device__ __forceinline__ void a_ready(const Unit&) const {}
    __device__ __forceinline__ void done(const Unit&) const {}
};

__device__ __forceinline__ unsigned cvt_pk_bf16(float lo, float hi) { unsigned r; asm volatile("v_cvt_pk_bf16_f32 %0, %1, %2" : "=v"(r) : "v"(lo), "v"(hi)); return r; }
template <class Epi, class Sched, bool STAMP = false>
__device__ __forceinline__ void gemm_phase(PG8_LAS unsigned char* lds, const Gemm g, const Sched& S, const Epi& E, unsigned long long* stamps) {
    const int tid = tid_fresh(), wid = __builtin_amdgcn_readfirstlane(tid >> 6), lane = tid & 63, wr = wid >> 2, wc = wid & 3, fr = lane & 15, fq = lane >> 4;
    const int K = g.K, nt = K / BK;
    int ts_lo = 0, ts_hi = 0, nts = 0; const unsigned long long rt_entry = STAMP ? (unsigned long long)wall_clock64() : 0ull;
#define PG8_STAMP() do { if (STAMP && wid == 0 && nts < 64) { const unsigned long long _c = (unsigned long long)clock64(); \
        ts_lo = (lane == nts) ? (int)(unsigned)_c : ts_lo; ts_hi = (lane == nts) ? (int)(unsigned)(_c >> 32) : ts_hi; ++nts; } } while (0)
    PG8_STAMP();
    unsigned voffA[2], voffB[2];
#pragma unroll
    for (int i = 0; i < 2; ++i) { int R, C; stage_rc(tid * 16 + i * 8192, R, C); const int Rb = Epi::PERM ? ((R & ~31) + perm32(R & 31)) : R;
        voffA[i] = (unsigned)(R * K + C) * 2u; voffB[i] = (unsigned)(Rb * K + C) * 2u; }
    const size_t kstep = (size_t)(BK * 2);
    const size_t hstep = (size_t)HALF * K * 2;
    const size_t tstep = 2 * hstep;
    const unsigned ldsw = (unsigned)wid * 1024u;
    const int aoff = lds_byte(wr * 64 + fr, fq * 8), boff = lds_byte(wc * 32 + fr, fq * 8);
#define PG8_SA(b, h) (((b) * 2 + (h)) * HTB)
#define PG8_SB(b, h) ((4 + (b) * 2 + (h)) * HTB)
#define PG8_STAGE(bufoff, gbase, voff) do { _Pragma("unroll") for (int _i = 0; _i < 2; ++_i) \
        __builtin_amdgcn_global_load_lds((const unsigned*)((const char*)(gbase) + (voff)[_i]), (PG8_LAS unsigned*)(lds + (bufoff) + ldsw + _i * 8192), 16, 0, 0); } while (0)
#define PG8_LDA(dst, b, h) do { _Pragma("unroll") for (int m = 0; m < 4; ++m) _Pragma("unroll") for (int k = 0; k < 2; ++k) dst[m][k] = *(const PG8_LAS bf16x8*)(lds + PG8_SA(b, h) + aoff + m * 2048 + k * 1024); } while (0)
#define PG8_LDB(dst, b, h) do { _Pragma("unroll") for (int n = 0; n < 2; ++n) _Pragma("unroll") for (int k = 0; k < 2; ++k) dst[n][k] = *(const PG8_LAS bf16x8*)(lds + PG8_SB(b, h) + boff + n * 2048 + k * 1024); } while (0)
#define PG8_MMA(ai, bj, At, Bt) do { __builtin_amdgcn_s_setprio(1); _Pragma("unroll") for (int m = 0; m < 4; ++m) _Pragma("unroll") for (int n = 0; n < 2; ++n) _Pragma("unroll") for (int k = 0; k < 2; ++k) \
        acc[ai][bj][m][n] = __builtin_amdgcn_mfma_f32_16x16x32_bf16(Bt[n][k], At[m][k], acc[ai][bj][m][n], 0, 0, 0); __builtin_amdgcn_s_setprio(0); } while (0)
#define PG8_WAIT_V(n) asm volatile("s_waitcnt vmcnt(" #n ")" ::: "memory")
#define PG8_WAIT_L(n) asm volatile("s_waitcnt lgkmcnt(" #n ")" ::: "memory")
#define PG8_BAR __builtin_amdgcn_s_barrier()
#define PG8_SCHED __builtin_amdgcn_sched_barrier(0)
    Unit cur, nxt; int ui = 0;
    if (!S.next(0, cur)) return;
    f32x4 acc[2][2][4][2];
#pragma unroll
    for (int a = 0; a < 2; ++a)
#pragma unroll
        for (int b = 0; b < 2; ++b)
#pragma unroll
            for (int m = 0; m < 4; ++m)
#pragma unroll
                for (int n = 0; n < 2; ++n) acc[a][b][m][n] = (f32x4){0.f, 0.f, 0.f, 0.f};
    bf16x8 At[4][2], B0[2][2], B1[2][2];
    const char* cA = (const char*)g.A + (size_t)cur.pm * tstep; const char* cB = (const char*)g.Bt + (size_t)cur.be * g.bstride + (size_t)cur.pn * tstep;
    S.a_ready(cur);
    PG8_STAGE(PG8_SB(0, 0), cB, voffB); PG8_STAGE(PG8_SA(0, 0), cA, voffA); PG8_STAGE(PG8_SB(0, 1), cB + hstep, voffB); PG8_STAGE(PG8_SA(0, 1), cA + hstep, voffA);
    if (wr == 1) PG8_BAR;
    PG8_WAIT_V(4); PG8_BAR;
    PG8_STAGE(PG8_SB(1, 0), cB + kstep, voffB); PG8_STAGE(PG8_SA(1, 0), cA + kstep, voffA); PG8_STAGE(PG8_SB(1, 1), cB + hstep + kstep, voffB);
    PG8_WAIT_V(6); PG8_BAR;
    PG8_STAMP();
    for (;;) {
        const bool has_next = S.next(ui + 1, nxt);
        const char* nA = has_next ? (const char*)g.A + (size_t)nxt.pm * tstep : cA; const char* nB = has_next ? (const char*)g.Bt + (size_t)nxt.be * g.bstride + (size_t)nxt.pn * tstep : cB;
        for (int t = 0; t < nt; t += 2) {
            const bool last = (t == nt - 2);
            const char* a1 = cA + (size_t)(t + 1) * kstep;
            const char* a2 = last ? nA : cA + (size_t)(t + 2) * kstep; const char* b2 = last ? nB : cB + (size_t)(t + 2) * kstep;
            const char* a3 = a2 + kstep; const char* b3 = b2 + kstep;
            if (last && has_next) S.a_ready(nxt);
            PG8_LDB(B0, 0, 0); PG8_SCHED; PG8_LDA(At, 0, 0); PG8_STAGE(PG8_SA(1, 1), a1 + hstep, voffA);
            PG8_WAIT_L(8); PG8_BAR; PG8_WAIT_L(0); PG8_MMA(0, 0, At, B0); PG8_BAR; PG8_SCHED;
            PG8_LDB(B1, 0, 1); PG8_STAGE(PG8_SB(0, 0), b2, voffB);
            PG8_BAR; PG8_WAIT_L(0); PG8_MMA(0, 1, At, B1); PG8_BAR;
            PG8_LDA(At, 0, 1); PG8_STAGE(PG8_SA(0, 0), a2, voffA);
            PG8_BAR; PG8_WAIT_L(0); PG8_MMA(1, 0, At, B0); PG8_BAR; PG8_SCHED;
            PG8_STAGE(PG8_SB(0, 1), b2 + hstep, voffB);
            PG8_WAIT_V(6); PG8_BAR; PG8_MMA(1, 1, At, B1); PG8_BAR;
            PG8_LDB(B0, 1, 0); PG8_SCHED; PG8_LDA(At, 1, 0); PG8_STAGE(PG8_SA(0, 1), a2 + hstep, voffA);
            PG8_WAIT_L(8); PG8_BAR; PG8_WAIT_L(0); PG8_MMA(0, 0, At, B0); PG8_BAR; PG8_SCHED;
            PG8_LDB(B1, 1, 1); PG8_STAGE(PG8_SB(1, 0), b3, voffB);
            PG8_BAR; PG8_WAIT_L(0); PG8_MMA(0, 1, At, B1); PG8_BAR;
            PG8_LDA(At, 1, 1); PG8_STAGE(PG8_SA(1, 0), a3, voffA);
            PG8_BAR; PG8_WAIT_L(0); PG8_MMA(1, 0, At, B0); PG8_BAR; PG8_SCHED;
            PG8_STAGE(PG8_SB(1, 1), b3 + hstep, voffB);
            PG8_WAIT_V(6); PG8_BAR; PG8_MMA(1, 1, At, B1); PG8_BAR;
        }
        PG8_STAMP();
        if constexpr (!Epi::AFTER_DRAIN) { E(acc, cur, wr, wc, fr, fq); S.done(cur); }
        PG8_STAMP();
        if (!has_next) break;
#pragma unroll
        for (int a = 0; a < 2; ++a)
#pragma unroll
            for (int b = 0; b < 2; ++b)
#pragma unroll
                for (int m = 0; m < 4; ++m)
#pragma unroll
                    for (int n = 0; n < 2; ++n) acc[a][b][m][n] = (f32x4){0.f, 0.f, 0.f, 0.f};
        cur = nxt; cA = nA; cB = nB; ++ui;
    }
    PG8_WAIT_V(0);
    if (wr == 0) PG8_BAR;
    PG8_BAR;
    if constexpr (Epi::AFTER_DRAIN) { E.fused(acc, cur, wr, wc, fr, fq, lds, wid, lane); S.done(cur); }
    PG8_STAMP();
    if (STAMP && wid == 0) { stamps[lane] = lane < nts ? (((unsigned long long)(unsigned)ts_hi << 32) | (unsigned)ts_lo) : 0ull;
        if (lane == 62) stamps[62] = rt_entry; if (lane == 63) stamps[63] = (unsigned long long)wall_clock64(); }
#undef PG8_STAMP
#undef PG8_SA
#undef PG8_SB
#undef PG8_STAGE
#undef PG8_LDA
#undef PG8_LDB
#undef PG8_MMA
#undef PG8_WAIT_V
#undef PG8_WAIT_L
#undef PG8_BAR
#undef PG8_SCHED
}
}


#define XB_TMO      128
#define XB_XCNT(j)  (256  + 64 * (j))
#define XB_XSUB(j)  (1280 + 64 * (j))
#define XB_XGEN(j)  (2304 + 64 * (j))
#define XB_TOP      3328
#define XB_TOPGEN   3392
#define XCD_BAR_WORDS 3456
#define XB_SPIN_CAP (1u << 18)
#define LAS __attribute__((address_space(3)))

__device__ __forceinline__ unsigned xb_ld(unsigned* p)              { return __hip_atomic_load(p, __ATOMIC_RELAXED, __HIP_MEMORY_SCOPE_AGENT); }
__device__ __forceinline__ unsigned xb_add(unsigned* p, unsigned v) { return __hip_atomic_fetch_add(p, v, __ATOMIC_RELAXED, __HIP_MEMORY_SCOPE_AGENT); }
__device__ __forceinline__ unsigned xb_xcc_id() { return (unsigned)__builtin_amdgcn_s_getreg((3 << 11) | 20) & 0xFu; }
#define XB_SPIN(cond, bar) do { unsigned _sp = 0; while (cond) { __builtin_amdgcn_s_sleep(1); \
    if ((++_sp & 255u) == 0u) { if (xb_ld(&(bar)[XB_TMO])) break; if (_sp > XB_SPIN_CAP) { atomicAdd(&(bar)[XB_TMO], 1u); break; } } } } while (0)

struct XcdBarrier {
    unsigned* bar; unsigned x;
    volatile LAS unsigned* st;
};

__device__ __forceinline__ XcdBarrier xcd_barrier_post(unsigned* bar, volatile LAS unsigned* st) {
    XcdBarrier b; b.bar = bar; b.x = xb_xcc_id(); b.st = st;
    if (threadIdx.x == 0) (void)xb_add(&bar[XB_XCNT(b.x)], 1u);
    return b;
}
__device__ __forceinline__ void xcd_barrier_complete(unsigned* bar, unsigned x, unsigned& nloc, unsigned& nx) {
    const unsigned G = gridDim.x * gridDim.y * gridDim.z;
    unsigned sum, cnt, mine, sp = 0u;
    for (;;) {
        sum = 0u; cnt = 0u; mine = 0u;
#pragma unroll
        for (unsigned j = 0; j < 16; ++j) { const unsigned c = xb_ld(&bar[XB_XCNT(j)]); sum += c; cnt += (c > 0u) ? 1u : 0u; mine = (j == x) ? c : mine; }
        if (sum == G) break;
        __builtin_amdgcn_s_sleep(1);
        if ((++sp & 255u) == 0u) { if (xb_ld(&bar[XB_TMO])) break; if (sp > XB_SPIN_CAP) { atomicAdd(&bar[XB_TMO], 1u); break; } }
    }
    nloc = mine > 0u ? mine : 1u; nx = cnt > 0u ? cnt : 1u;
}

__device__ __forceinline__ void xcd_barrier(const XcdBarrier& b) {
    asm volatile("s_waitcnt vmcnt(0)" ::: "memory");
    __syncthreads();
    if (threadIdx.x == 0) {
        unsigned* bar = b.bar;
        __builtin_amdgcn_s_waitcnt(0);
        unsigned nloc = b.st[0], nx = b.st[1];
        if (nloc == 0u) { xcd_barrier_complete(bar, b.x, nloc, nx); b.st[0] = nloc; b.st[1] = nx; }
        const unsigned old = xb_add(&bar[XB_XSUB(b.x)], 1u);
        const unsigned gen = old / nloc;
        if (old + 1u == (gen + 1u) * nloc) {
            __builtin_amdgcn_fence(__ATOMIC_RELEASE, "agent");
            asm volatile("s_waitcnt vmcnt(0)" ::: "memory");
            const unsigned og = xb_add(&bar[XB_TOP], 1u);
            const unsigned tg = og / nx;
            if (og + 1u == (tg + 1u) * nx) xb_add(&bar[XB_TOPGEN], 1u);
            else XB_SPIN(xb_ld(&bar[XB_TOPGEN]) == tg, bar);
            __builtin_amdgcn_fence(__ATOMIC_ACQUIRE, "agent");
            xb_add(&bar[XB_XGEN(b.x)], 1u);
            asm volatile("s_waitcnt vmcnt(0)" ::: "memory");
        } else {
            XB_SPIN(xb_ld(&bar[XB_XGEN(b.x)]) == gen, bar);
            __builtin_amdgcn_fence(__ATOMIC_ACQUIRE, "agent");
            asm volatile("s_waitcnt vmcnt(0)" ::: "memory");
        }
    }
    __syncthreads();
}


namespace mk {
using pg8::bf16_t; using pg8::f32x4; using pg8::u32x4; using pg8::cvt_pk_bf16;
#define MKLAS __attribute__((address_space(3)))
typedef unsigned u32x2 __attribute__((ext_vector_type(2)));

constexpr int D = 1024, T = 16384, LC = 256, L = T + LC, DEPTH = 2;
constexpr int NA = 4096, NB = 3584;
constexpr int NE = 32, DE = 256;
constexpr float EPS = 1e-6f;
constexpr int NT = 512, NW = 8;

constexpr size_t MiB = 1u << 20, QMiB = 1u << 18;
constexpr size_t WS_CTL = 0, CTL_BYTES = 1 * MiB;
constexpr size_t WS_MOD = 1 * MiB, WS_LB = WS_MOD + 128 * 1024, WS_ROPE = WS_MOD + 192 * 1024, WS_LGAM = WS_MOD + 256 * 1024;
constexpr size_t WS_AE = 2 * MiB, WS_AW = WS_AE + 256 * 1024, WS_APOS = WS_AE + 512 * 1024, WS_ROWW = WS_AE + 768 * 1024;
constexpr size_t WS_CTX = 4 * MiB;
constexpr size_t WS_WIN = 5 * MiB, WS_WOHG = 20 * MiB, WS_WORET = 21 * MiB, WS_WOUT = 23 * MiB;
constexpr size_t WS_H = 25 * MiB;
constexpr size_t WS_QH = 58 * MiB, WS_VH = WS_QH + 65 * QMiB, WS_RQ = WS_VH + 65 * QMiB, WS_RK = WS_RQ + 65 * QMiB;
constexpr size_t WS_RV = 123 * MiB;
constexpr size_t WS_LF = WS_RV + 130 * QMiB;
constexpr size_t WS_OHG = WS_LF + 260 * QMiB;
constexpr size_t WS_ORT = WS_OHG + 65 * QMiB;
constexpr size_t WS_OF = WS_ORT + 130 * QMiB;
constexpr size_t WS_END = WS_OF + 390 * QMiB;
constexpr size_t WS_GA = WS_QH, WS_GB = WS_QH + 130 * QMiB;
constexpr size_t WS_M1 = WS_LF;
constexpr size_t WS_MB = WS_RV;
constexpr int CW_BAR = 4096, CW_CNT = 8192;

struct P { const float* in[24]; float* out; unsigned char* ws; int ph_lo, ph_hi; };
#define WSP(type, off) ((type*)(p.ws + (off)))

__device__ __forceinline__ float bf2f(bf16_t b) { return __uint_as_float(((unsigned)b) << 16); }
__device__ __forceinline__ bf16_t f2bf(float f) { return (bf16_t)(cvt_pk_bf16(f, 0.f) & 0xffffu); }
__device__ __forceinline__ float siluf(float x) { return x / (1.f + __expf(-x)); }
__device__ __forceinline__ float sigmf(float x) { return 1.f / (1.f + __expf(-x)); }
__device__ __forceinline__ float wave_sum(float v) {
#pragma unroll
    for (int o = 1; o < 64; o <<= 1) v += __shfl_xor(v, o);
    return v;
}
__device__ __forceinline__ const float* xrow_in(const P& p, int l, int r) {
    if (l == 0) return r < LC ? p.in[2] + (size_t)r * D : p.in[0] + (size_t)(r - LC) * D;
    return r < LC ? WSP(float, WS_CTX) + (size_t)r * D : p.out + (size_t)(r - LC) * D;
}
__device__ __forceinline__ float* xrow_st(const P& p, int r) { return r < LC ? WSP(float, WS_CTX) + (size_t)r * D : p.out + (size_t)(r - LC) * D; }
__device__ __forceinline__ int seq_row(int dir, int i) { return dir == 0 ? i : (i < LC ? LC - 1 - i : L + LC - 1 - i); }

__device__ __forceinline__ void tr_item(const float* W, int K, int N, bf16_t* WT, int k0, int n0, int outrow0, MKLAS float* tile) {
    const int tid = tid_fresh(), r = tid >> 6, c = tid & 63;
#pragma unroll
    for (int i = 0; i < 8; ++i) tile[(r + 8 * i) * 65 + c] = W[(size_t)(k0 + r + 8 * i) * N + n0 + c];
    __syncthreads();
    const int nn = tid >> 3, kc = tid & 7;
    const MKLAS float* s = tile + (kc * 8) * 65 + nn;
    u32x4 o; o.x = cvt_pk_bf16(s[0], s[65]); o.y = cvt_pk_bf16(s[130], s[195]); o.z = cvt_pk_bf16(s[260], s[325]); o.w = cvt_pk_bf16(s[390], s[455]);
    *(u32x4*)(WT + (size_t)(outrow0 + nn) * K + k0 + kc * 8) = o;
    __syncthreads();
}
__device__ __forceinline__ int win_perm(int n) { return n < 2048 ? n : (n < 2560 ? 4096 + (n - 2048) : (n < 4608 ? 2048 + (n - 2560) : n)); }
__device__ __forceinline__ void convert_mixer_weights(const P& p, int l, MKLAS unsigned char* lds) {
    MKLAS float* tile = (MKLAS float*)lds;
    constexpr int I_IN = 16 * 120, I_OHG = 8 * 16, I_ORT = 16 * 16, I_OUT = 16 * 16;
    for (int it = blockIdx.x; it < I_IN + I_OHG + I_ORT + I_OUT; it += gridDim.x) {
        int r = it;
        if (r < I_IN) { const int kb = r / 120, nb = r % 120; tr_item(p.in[8] + (size_t)l * D * 7680, D, 7680, WSP(bf16_t, WS_WIN), kb * 64, nb * 64, win_perm(nb * 64), tile); continue; } r -= I_IN;
        if (r < I_OHG) { const int kb = r / 16, nb = r % 16; tr_item(p.in[13] + (size_t)l * 512 * D, 512, D, WSP(bf16_t, WS_WOHG), kb * 64, nb * 64, nb * 64, tile); continue; } r -= I_OHG;
        if (r < I_ORT) { const int kb = r / 16, nb = r % 16; tr_item(p.in[14] + (size_t)l * D * D, D, D, WSP(bf16_t, WS_WORET), kb * 64, nb * 64, nb * 64, tile); continue; } r -= I_ORT;
        { const int kb = r / 16, nb = r % 16; tr_item(p.in[15] + (size_t)l * D * D, D, D, WSP(bf16_t, WS_WOUT), kb * 64, nb * 64, nb * 64, tile); }
    }
}

__device__ __forceinline__ void ph_prologue(const P& p, MKLAS unsigned char* lds) {
    const int tid = tid_fresh(), b = blockIdx.x, G = gridDim.x;
    MKLAS float* s0 = (MKLAS float*)lds;
    MKLAS float* red = s0 + 2048;
    for (int i = tid; i < 1024; i += NT) { s0[i] = siluf(p.in[1][i]); s0[1024 + i] = siluf(p.in[3][i]); }
    __syncthreads();
    float* MOD = WSP(float, WS_MOD);
    for (int u = b; u < DEPTH * 96; u += G) {
        const int l = u / 96, n0 = (u % 96) * 64, c = tid & 63, ks = tid >> 6;
        const float* W = p.in[4] + (size_t)l * 1024 * 6144 + n0 + c;
        float a0 = 0.f, a1 = 0.f;
#pragma unroll 8
        for (int i = 0; i < 128; ++i) { const int k = ks * 128 + i; const float w = W[(size_t)k * 6144]; a0 += s0[k] * w; a1 += s0[1024 + k] * w; }
        red[(ks * 64 + c) * 2] = a0; red[(ks * 64 + c) * 2 + 1] = a1;
        __syncthreads();
        if (tid < 128) { const int cc = tid & 63, w = tid >> 6; float s = 0.f;
#pragma unroll
            for (int k2 = 0; k2 < 8; ++k2) s += red[(k2 * 64 + cc) * 2 + w];
            MOD[(l * 2 + w) * 6144 + n0 + cc] = s + p.in[5][l * 6144 + n0 + cc]; }
        __syncthreads();
    }
    if (b == G - 1) {
        float* LB = WSP(float, WS_LB);
        for (int idx = tid; idx < 2 * 512; idx += NT) { const int dir = idx >> 9, ch = idx & 511;
            float x[DEPTH], m = -3.0e38f;
#pragma unroll
            for (int l = 0; l < DEPTH; ++l) { x[l] = p.in[9][(dir * DEPTH + l) * 512 + ch]; m = fmaxf(m, x[l]); }
            float s = 0.f;
#pragma unroll
            for (int l = 0; l < DEPTH; ++l) { x[l] = expf(x[l] - m); s += x[l]; }
            float cum = 0.f; const float p0 = x[0] / s;
#pragma unroll
            for (int l = 0; l < DEPTH; ++l) { cum += x[l] / s; LB[(dir * DEPTH + l) * 512 + ch] = fminf(fmaxf(cum - p0, 0.f), 1.0f - 1e-6f); } }
    }
    if (b == (G > 1 ? G - 2 : 0)) {
        float* RT = WSP(float, WS_ROPE);
        for (int idx = tid; idx < 256 * 32; idx += NT) { const int pos = idx >> 5, i = idx & 31;
            double bp = 1.0; for (int q = 0; q < i; ++q) bp *= 0.7498942093324559;
            const float inv = (float)bp; const float ang = (float)pos * inv;
            const double a = (double)ang, n = rint(a * 0.15915494309189535), r = a - n * 6.283185307179586, r2 = r * r;
            double ts = r, tc = 1.0, sn = r, cs = 1.0;
            for (int k = 1; k <= 14; ++k) { tc *= -r2 / (double)((2 * k - 1) * (2 * k)); cs += tc; ts *= -r2 / (double)((2 * k) * (2 * k + 1)); sn += ts; }
            RT[idx * 2] = (float)cs; RT[idx * 2 + 1] = (float)sn; }
    }
    if (b == (G > 2 ? G - 3 : 0)) {
        float* LG = WSP(float, WS_LGAM);
        if (tid < DEPTH * 2 * 4) LG[tid] = -log1pf(expf(-p.in[11][tid]));
    }
    convert_mixer_weights(p, 0, lds);
}

__device__ __forceinline__ void ph_hnorm(const P& p, int l) {
    const int tid_ = tid_fresh(), lane = tid_ & 63, wave = tid_ >> 6;
    const float* MOD = WSP(float, WS_MOD); bf16_t* H = WSP(bf16_t, WS_H);
    const float* nw = p.in[6] + l * D;
    for (int r = blockIdx.x * NW + wave; r < L; r += gridDim.x * NW) {
        const f32x4* xr = (const f32x4*)xrow_in(p, l, r) + lane;
        const float* mod = MOD + (l * 2 + (r < LC ? 1 : 0)) * 6144;
        f32x4 v[4]; float ss = 0.f;
#pragma unroll
        for (int j = 0; j < 4; ++j) { v[j] = xr[64 * j]; ss += (v[j].x * v[j].x + v[j].y * v[j].y) + (v[j].z * v[j].z + v[j].w * v[j].w); }
        const float rinv = 1.0f / sqrtf(wave_sum(ss) * (1.f / D) + EPS);
        u32x2* o = (u32x2*)(H + (size_t)r * D) + lane;
#pragma unroll
        for (int j = 0; j < 4; ++j) { const int c = 4 * (lane + 64 * j);
            const f32x4 w = *(const f32x4*)(nw + c), sh = *(const f32x4*)(mod + c), sc = *(const f32x4*)(mod + 1024 + c);
            const f32x4 h = v[j] * rinv * w * (sc + 1.0f) + sh;
            u32x2 q; q.x = cvt_pk_bf16(h.x, h.y); q.y = cvt_pk_bf16(h.z, h.w); o[64 * j] = q; }
    }
}

template <class F> struct EpiGen {
    static constexpr bool PERM = false, AFTER_DRAIN = false;
    F f;
    __device__ __forceinline__ void operator()(const f32x4 (&acc)[2][2][4][2], const pg8::Unit& u, int wr, int wc, int fr, int fq) const {
        const int row0 = u.pm * 256 + wr * 64 + fr, col0 = u.pn * 256 + wc * 32 + 4 * fq;
#pragma unroll
        for (int ai = 0; ai < 2; ++ai)
#pragma unroll
            for (int m = 0; m < 4; ++m) {
#pragma unroll
                for (int bj = 0; bj < 2; ++bj)
#pragma unroll
                    for (int n = 0; n < 2; ++n) f(row0 + ai * 128 + m * 16, col0 + bj * 128 + n * 16, acc[ai][bj][m][n], u);
                asm volatile("" ::: "memory");
            }
    }
};
__device__ __forceinline__ void st_bf4(bf16_t* dst, f32x4 v) { u32x2 q; q.x = cvt_pk_bf16(v.x, v.y); q.y = cvt_pk_bf16(v.z, v.w); *(u32x2*)dst = q; }
__device__ __forceinline__ f32x4 ld_bf4(const bf16_t* src) { const u32x2 q = *(const u32x2*)src; f32x4 v; v.x = __uint_as_float(q.x << 16); v.y = __uint_as_float(q.x & 0xffff0000u); v.z = __uint_as_float(q.y << 16); v.w = __uint_as_float(q.y & 0xffff0000u); return v; }

struct FnA {
    bf16_t *QH, *VH, *RQ, *RK, *RV; float* LF; const float* LB;
    __device__ __forceinline__ void operator()(int row, int col, f32x4 v, const pg8::Unit& u) const {
        const int seg = u.pn >> 1;
        if (seg == 0) { f32x4 o; o.x = siluf(v.x); o.y = siluf(v.y); o.z = siluf(v.z); o.w = siluf(v.w); st_bf4(QH + (size_t)row * 512 + col, o * 0.08838834764831845f); }
        else if (seg == 1 || seg == 2) { const int dir = seg - 1, ch = col - seg * 512; const f32x4 lb = *(const f32x4*)(LB + dir * DEPTH * 512 + ch); f32x4 o;
#pragma unroll
            for (int j = 0; j < 4; ++j) { const float f = lb[j] + (1.f - lb[j]) * sigmf(v[j]); o[j] = logf(fmaxf(f, 1e-30f)); }
            *(f32x4*)(LF + (size_t)row * 1024 + dir * 512 + ch) = o; }
        else if (seg == 3) st_bf4(VH + (size_t)row * 512 + (col - 1536), v);
        else if (seg == 4) st_bf4(RQ + (size_t)row * 512 + (col - 2048), v * 0.08838834764831845f);
        else if (seg == 5) st_bf4(RK + (size_t)row * 512 + (col - 2560), v);
        else st_bf4(RV + (size_t)row * 1024 + (col - 3072), v);
    }
};
struct FnB {
    bf16_t *OHG, *ORT, *GA, *GB;
    __device__ __forceinline__ void operator()(int row, int col, f32x4 v, const pg8::Unit& u) const {
        const int pn = u.pn;
        if (pn < 6) { bf16_t* o = pn < 2 ? OHG + (size_t)row * 512 + col : ORT + (size_t)row * 1024 + (col - 512);
            f32x4 s; s.x = siluf(v.x); s.y = siluf(v.y); s.z = siluf(v.z); s.w = siluf(v.w); st_bf4(o, ld_bf4(o) * s); }
        else { bf16_t* o = pn < 10 ? GA + (size_t)row * 1024 + (col - 1536) : GB + (size_t)row * 1024 + (col - 2560);
            f32x4 s; s.x = sigmf(v.x); s.y = sigmf(v.y); s.z = sigmf(v.z); s.w = sigmf(v.w); st_bf4(o, s); }
    }
};
struct FnM1 { const bf16_t* GA; float* M1;
    __device__ __forceinline__ void operator()(int row, int col, f32x4 v, const pg8::Unit&) const { *(f32x4*)(M1 + (size_t)row * D + col) = ld_bf4(GA + (size_t)row * D + col) * v; } };
struct FnM2 { const bf16_t* GB; const float* M1; bf16_t* MB;
    __device__ __forceinline__ void operator()(int row, int col, f32x4 v, const pg8::Unit&) const { st_bf4(MB + (size_t)row * D + col, *(const f32x4*)(M1 + (size_t)row * D + col) + ld_bf4(GB + (size_t)row * D + col) * v); } };
struct FnX { const float *xc_in, *xl_in; float *xc_out, *xl_out; const float* MODL;
    __device__ __forceinline__ void operator()(int row, int col, f32x4 v, const pg8::Unit&) const {
        const bool isc = row < LC;
        const f32x4 g = *(const f32x4*)(MODL + (isc ? 6144 : 0) + 2 * 1024 + col);
        const size_t off = (size_t)(isc ? row : row - LC) * D + col;
        const f32x4 x = *(const f32x4*)((isc ? xc_in : xl_in) + off);
        *(f32x4*)((isc ? xc_out : xl_out) + off) = x + g * v; } };

__device__ __forceinline__ void ph_scan_naive(const P& p, int l, MKLAS unsigned char* lds) {
    const int tid = tid_fresh(), lane = tid & 63, wave = tid >> 6;
    MKLAS float* part = (MKLAS float*)lds;
    const bf16_t *QH = WSP(bf16_t, WS_QH), *VH = WSP(bf16_t, WS_VH), *RQ = WSP(bf16_t, WS_RQ), *RK = WSP(bf16_t, WS_RK), *RV = WSP(bf16_t, WS_RV);
    const float *LF = WSP(float, WS_LF), *RT = WSP(float, WS_ROPE), *LG = WSP(float, WS_LGAM);
    float* OF = WSP(float, WS_OF);
    for (int u = blockIdx.x; u < 192; u += gridDim.x) {
        const bool ret = u >= 64; const int h = ret ? (u - 64) / 32 : u / 16, es = ret ? (u - 64) % 32 : u % 16;
        const int d = tid & 127, eg = tid >> 7, e0 = es * 8 + eg * 2;
        const int obase = ret ? 512 + h * 256 + es * 8 : h * 128 + es * 8;
        const bool lower = (d & 63) < 32; const int dp = d ^ 32, ri = d & 31, half = d >> 6;
        for (int dir = 0; dir < 2; ++dir) {
            float S0 = 0.f, S1 = 0.f;
            const float gam = ret ? expf(LG[(l * 2 + dir) * 4 + h]) : 0.f;
            for (int i0 = 0; i0 < L; i0 += 8) {
                float qv[8], kv[8], fv[8], v0[8], v1[8];
#pragma unroll
                for (int s = 0; s < 8; ++s) { const int r = seq_row(dir, i0 + s);
                    if (!ret) { qv[s] = bf2f(QH[(size_t)r * 512 + h * 128 + d]); const float f = __expf(LF[(size_t)r * 1024 + dir * 512 + h * 128 + d]); fv[s] = f; kv[s] = 1.f - f;
                        const unsigned vv = *(const unsigned*)(VH + (size_t)r * 512 + h * 128 + e0); v0[s] = __uint_as_float(vv << 16); v1[s] = __uint_as_float(vv & 0xffff0000u); }
                    else { float q = bf2f(RQ[(size_t)r * 512 + h * 128 + d]), k = bf2f(RK[(size_t)r * 512 + h * 128 + d]);
                        if (r >= LC) { const int t = r - LC, pos = half ? (t & 63) : (t >> 6); const float cs = RT[(pos * 32 + ri) * 2], sn = RT[(pos * 32 + ri) * 2 + 1];
                            const float qp = bf2f(RQ[(size_t)r * 512 + h * 128 + dp]), kp = bf2f(RK[(size_t)r * 512 + h * 128 + dp]);
                            q = q * cs + (lower ? -qp : qp) * sn; k = k * cs + (lower ? -kp : kp) * sn; }
                        qv[s] = q; kv[s] = k; fv[s] = gam;
                        const unsigned vv = *(const unsigned*)(RV + (size_t)r * 1024 + h * 256 + e0); v0[s] = __uint_as_float(vv << 16); v1[s] = __uint_as_float(vv & 0xffff0000u); }
                }
#pragma unroll
                for (int s = 0; s < 8; ++s) { S0 = fv[s] * S0 + kv[s] * v0[s]; S1 = fv[s] * S1 + kv[s] * v1[s];
                    const float p0 = wave_sum(S0 * qv[s]), p1 = wave_sum(S1 * qv[s]);
                    if (lane == 0) { part[(s * 8 + wave) * 2] = p0; part[(s * 8 + wave) * 2 + 1] = p1; } }
                __syncthreads();
                if (tid < 64) { const int s = tid >> 3, egg = (tid >> 1) & 3, j = tid & 1;
                    const float val = part[(s * 8 + 2 * egg) * 2 + j] + part[(s * 8 + 2 * egg + 1) * 2 + j];
                    float* o = OF + (size_t)seq_row(dir, i0 + s) * 1536 + obase + egg * 2 + j;
                    if (dir == 0) *o = val; else *o += val; }
                __syncthreads();
            }
        }
    }
}
__device__ __forceinline__ void ph_onorm(const P& p, int l) {
    const int tid_ = tid_fresh(), lane = tid_ & 63, wave = tid_ >> 6;
    const float* OF = WSP(float, WS_OF); bf16_t *OHG = WSP(bf16_t, WS_OHG), *ORT = WSP(bf16_t, WS_ORT);
    const float *hw = p.in[10] + l * 512, *gw = p.in[12] + l * 1024;
    for (int r = blockIdx.x * NW + wave; r < L; r += gridDim.x * NW) {
        const float* o = OF + (size_t)r * 1536;
#pragma unroll
        for (int h = 0; h < 4; ++h) { const int c = h * 128 + lane * 2; const float a = o[c], b = o[c + 1];
            const float rinv = 1.0f / sqrtf(wave_sum(a * a + b * b) * (1.f / 128.f) + EPS);
            *(unsigned*)(OHG + (size_t)r * 512 + c) = cvt_pk_bf16(a * rinv * hw[c], b * rinv * hw[c + 1]); }
#pragma unroll
        for (int h = 0; h < 4; ++h) { const int c = h * 256 + lane * 4; f32x4 v = *(const f32x4*)(o + 512 + c);
            const float mu = wave_sum((v.x + v.y) + (v.z + v.w)) * (1.f / 256.f); v = v - mu;
            const float rinv = 1.0f / sqrtf(wave_sum((v.x * v.x + v.y * v.y) + (v.z * v.z + v.w * v.w)) * (1.f / 256.f) + EPS);
            st_bf4(ORT + (size_t)r * 1024 + c, v * rinv * *(const f32x4*)(gw + c)); }
    }
}

__device__ __forceinline__ void ph_router(const P& p, int l, MKLAS unsigned char* lds) {
    const int tid_ = tid_fresh(), lane = tid_ & 63, wave = tid_ >> 6;
    MKLAS float* hrow = (MKLAS float*)lds + wave * 1024;
    const float* MOD = WSP(float, WS_MOD); bf16_t* H = WSP(bf16_t, WS_H);
    int* AE = WSP(int, WS_AE); float* AW = WSP(float, WS_AW);
    const float* nw = p.in[7] + l * D;
    const float *wg = p.in[16] + (size_t)l * D * 4, *bg = p.in[17] + l * 4, *we = p.in[18] + (size_t)l * D * NE, *be = p.in[19] + l * NE;
    const int r_lo = (l == DEPTH - 1) ? LC : 0;
    for (int r = r_lo + blockIdx.x * NW + wave; r < L; r += gridDim.x * NW) {
        const f32x4* xr = (const f32x4*)xrow_st(p, r) + lane;
        const float* mod = MOD + (l * 2 + (r < LC ? 1 : 0)) * 6144;
        f32x4 v[4]; float ss = 0.f;
#pragma unroll
        for (int j = 0; j < 4; ++j) { v[j] = xr[64 * j]; ss += (v[j].x * v[j].x + v[j].y * v[j].y) + (v[j].z * v[j].z + v[j].w * v[j].w); }
        const float rinv = 1.0f / sqrtf(wave_sum(ss) * (1.f / D) + EPS);
        u32x2* o = (u32x2*)(H + (size_t)r * D) + lane;
#pragma unroll
        for (int j = 0; j < 4; ++j) { const int c = 4 * (lane + 64 * j);
            const f32x4 w = *(const f32x4*)(nw + c), sh = *(const f32x4*)(mod + 3 * 1024 + c), sc = *(const f32x4*)(mod + 4 * 1024 + c);
            const f32x4 h = v[j] * rinv * w * (sc + 1.0f) + sh;
            u32x2 q; q.x = cvt_pk_bf16(h.x, h.y); q.y = cvt_pk_bf16(h.z, h.w); o[64 * j] = q;
            *(MKLAS f32x4*)(hrow + c) = h; }
        float ea = 0.f, ga = 0.f;
        { const int c = lane & 31, k0 = (lane >> 5) * 512;
#pragma unroll 8
            for (int k = 0; k < 512; ++k) ea += hrow[k0 + k] * we[(size_t)(k0 + k) * NE + c]; }
        { const int c = lane & 3, k0 = (lane >> 2) * 64;
#pragma unroll 8
            for (int k = 0; k < 64; ++k) ga += hrow[k0 + k] * wg[(size_t)(k0 + k) * 4 + c]; }
        ea += __shfl_xor(ea, 32);
        ga += __shfl_xor(ga, 4); ga += __shfl_xor(ga, 8); ga += __shfl_xor(ga, 16); ga += __shfl_xor(ga, 32);
        float gl[4];
#pragma unroll
        for (int g = 0; g < 4; ++g) gl[g] = __shfl(ga, g) + bg[g];
        int grp = 0; float gm = gl[0];
#pragma unroll
        for (int g = 1; g < 4; ++g) if (gl[g] > gm) { gm = gl[g]; grp = g; }
        float gs = 0.f;
#pragma unroll
        for (int g = 0; g < 4; ++g) gs += expf(gl[g] - gm);
        const float gval = 1.0f / gs;
        float el[8];
#pragma unroll
        for (int j = 0; j < 8; ++j) el[j] = __shfl(ea, grp * 8 + j) + be[grp * 8 + j];
        int i1 = 0; float v1 = el[0];
#pragma unroll
        for (int j = 1; j < 8; ++j) if (el[j] > v1) { v1 = el[j]; i1 = j; }
        int i2 = -1; float v2 = -3.0e38f;
#pragma unroll
        for (int j = 0; j < 8; ++j) if (j != i1 && el[j] > v2) { v2 = el[j]; i2 = j; }
        const float e2 = expf(v2 - v1), w1 = 1.0f / (1.0f + e2), w2 = e2 / (1.0f + e2);
        if (lane == 0) { AE[2 * r] = grp * 8 + i1; AE[2 * r + 1] = grp * 8 + i2; AW[2 * r] = gval * w1; AW[2 * r + 1] = gval * w2; }
    }
}
__device__ __forceinline__ void ph_moe_naive(const P& p, int l, MKLAS unsigned char* lds) {
    const int tid = tid_fresh();
    MKLAS float* hs = (MKLAS float*)lds; MKLAS float* gu = hs + 1024; MKLAS float* act = gu + 512;
    const float* MOD = WSP(float, WS_MOD); const bf16_t* H = WSP(bf16_t, WS_H);
    const int* AE = WSP(int, WS_AE); const float* AW = WSP(float, WS_AW);
    const int r_lo = (l == DEPTH - 1) ? LC : 0;
    for (int r = r_lo + blockIdx.x; r < L; r += gridDim.x) {
        for (int i = tid; i < 1024; i += NT) hs[i] = bf2f(H[(size_t)r * D + i]);
        __syncthreads();
        float y0 = 0.f, y1 = 0.f;
        for (int k = 0; k < 2; ++k) {
            const int e = AE[2 * r + k]; const float w = AW[2 * r + k];
            const float* Wx = (tid < 256 ? p.in[20] : p.in[21]) + ((size_t)l * NE + e) * D * DE + (tid & 255);
            float a = 0.f;
#pragma unroll 8
            for (int dd = 0; dd < D; ++dd) a += hs[dd] * Wx[(size_t)dd * DE];
            gu[tid] = a;
            __syncthreads();
            if (tid < 256) act[tid] = siluf(gu[tid]) * gu[256 + tid];
            __syncthreads();
            const float* Wd = p.in[22] + ((size_t)l * NE + e) * DE * D + tid;
            float b0 = 0.f, b1 = 0.f;
#pragma unroll 8
            for (int j = 0; j < DE; ++j) { const float a2 = act[j]; b0 += a2 * Wd[(size_t)j * D]; b1 += a2 * Wd[(size_t)j * D + 512]; }
            y0 += w * b0; y1 += w * b1;
            __syncthreads();
        }
        const float* g2 = MOD + (l * 2 + (r < LC ? 1 : 0)) * 6144 + 5 * 1024;
        float* xo = xrow_st(p, r);
        xo[tid] += g2[tid] * y0; xo[tid + 512] += g2[tid + 512] * y1;
    }
}
__device__ __forceinline__ void ph_final(const P& p) {
    const int tid_ = tid_fresh(), lane = tid_ & 63, wave = tid_ >> 6;
    const float* nw = p.in[23];
    for (int r = blockIdx.x * NW + wave; r < T; r += gridDim.x * NW) {
        f32x4* xr = (f32x4*)(p.out + (size_t)r * D) + lane;
        f32x4 v[4]; float ss = 0.f;
#pragma unroll
        for (int j = 0; j < 4; ++j) { v[j] = xr[64 * j]; ss += (v[j].x * v[j].x + v[j].y * v[j].y) + (v[j].z * v[j].z + v[j].w * v[j].w); }
        const float rinv = 1.0f / sqrtf(wave_sum(ss) * (1.f / D) + EPS);
#pragma unroll
        for (int j = 0; j < 4; ++j) xr[64 * j] = v[j] * rinv * *(const f32x4*)(nw + 4 * (lane + 64 * j));
    }
}

constexpr int LDS_BYTES = 147456, LDS_CTL = 131072;
constexpr int NPH_LAYER = 10, NPH = 1 + DEPTH * NPH_LAYER + 1;

template <class F> __device__ __forceinline__ void run_gemm(MKLAS unsigned char* lds, const bf16_t* A, const bf16_t* Bt, int M, int N, int K, const F& f) {
    pg8::Gemm g{A, Bt, M, N, K, 0}; pg8::StaticOrder S; S.init(M, N, (int)gridDim.x, (int)blockIdx.x);
    EpiGen<F> E{f};
    pg8::gemm_phase<EpiGen<F>, pg8::StaticOrder, false>(lds, g, S, E, nullptr);
}

__global__ void __launch_bounds__(NT, 2) fwd(P p) {
    extern __shared__ __attribute__((aligned(16))) unsigned char lds_raw[];
    MKLAS unsigned char* lds = (MKLAS unsigned char*)lds_raw;
    volatile MKLAS unsigned* lctl = (volatile MKLAS unsigned*)(lds + LDS_CTL);
    if (threadIdx.x < 4) lctl[threadIdx.x] = 0u;
    __syncthreads();
    const int lo = p.ph_lo, hi = p.ph_hi;
    const bool multi = (hi - lo) > 1;
    XcdBarrier bar; bar.bar = (unsigned*)(p.ws + WS_CTL) + CW_BAR; bar.x = 0; bar.st = nullptr;
    if (multi) bar = xcd_barrier_post((unsigned*)(p.ws + WS_CTL) + CW_BAR, lctl);
#ifndef MK_MASK
#define MK_MASK 0xfffff
#endif
#define KON(j) ((MK_MASK >> (j)) & 1)
#define IN(k) (lo <= (k) && (k) < hi)
#define SEAM(k) do { if (IN(k) && IN((k) + 1)) xcd_barrier(bar); } while (0)
    if (KON(0) && IN(0)) { ph_prologue(p, lds); } SEAM(0);
    for (int l = 0; l < DEPTH; ++l) {
        const int b = 1 + l * NPH_LAYER;
        if (KON(1) && IN(b + 0)) { ph_hnorm(p, l); } SEAM(b + 0);
        if (KON(2) && IN(b + 1)) { FnA f{WSP(bf16_t, WS_QH), WSP(bf16_t, WS_VH), WSP(bf16_t, WS_RQ), WSP(bf16_t, WS_RK), WSP(bf16_t, WS_RV), WSP(float, WS_LF), WSP(float, WS_LB) + l * 512};
            run_gemm(lds, WSP(bf16_t, WS_H), WSP(bf16_t, WS_WIN), L, NA, D, f); } SEAM(b + 1);
        if (KON(3) && IN(b + 2)) { ph_scan_naive(p, l, lds); } SEAM(b + 2);
        if (KON(4) && IN(b + 3)) { ph_onorm(p, l); } SEAM(b + 3);
        if (KON(5) && IN(b + 4)) { FnB f{WSP(bf16_t, WS_OHG), WSP(bf16_t, WS_ORT), WSP(bf16_t, WS_GA), WSP(bf16_t, WS_GB)};
            run_gemm(lds, WSP(bf16_t, WS_H), WSP(bf16_t, WS_WIN) + (size_t)NA * D, L, NB, D, f); } SEAM(b + 4);
        if (KON(6) && IN(b + 5)) { FnM1 f{WSP(bf16_t, WS_GA), WSP(float, WS_M1)}; run_gemm(lds, WSP(bf16_t, WS_OHG), WSP(bf16_t, WS_WOHG), L, D, 512, f); } SEAM(b + 5);
        if (KON(7) && IN(b + 6)) { FnM2 f{WSP(bf16_t, WS_GB), WSP(float, WS_M1), WSP(bf16_t, WS_MB)}; run_gemm(lds, WSP(bf16_t, WS_ORT), WSP(bf16_t, WS_WORET), L, D, D, f); } SEAM(b + 6);
        if (KON(8) && IN(b + 7)) { FnX f{l == 0 ? p.in[2] : WSP(float, WS_CTX), l == 0 ? p.in[0] : p.out, WSP(float, WS_CTX), p.out, WSP(float, WS_MOD) + l * 2 * 6144}; run_gemm(lds, WSP(bf16_t, WS_MB), WSP(bf16_t, WS_WOUT), L, D, D, f); } SEAM(b + 7);
        if (KON(9) && IN(b + 8)) { ph_router(p, l, lds); if (l + 1 < DEPTH) { __syncthreads(); convert_mixer_weights(p, l + 1, lds); } } SEAM(b + 8);
        if (KON(10) && IN(b + 9)) { ph_moe_naive(p, l, lds); } SEAM(b + 9);
    }
    if (KON(11) && IN(NPH - 1)) ph_final(p);
#undef IN
#undef SEAM
}
}

#ifndef MK_ONE_LAUNCH
#define MK_ONE_LAUNCH 1
#endif
extern "C" void kernel_launch(void* const* d_in, const int* in_sizes, int n_in, void* d_out, int out_size, void* d_ws, size_t ws_size, hipStream_t stream) {
    using namespace mk;
    static int grid = 0;
    if (grid == 0) {
        if (n_in != 24 || in_sizes[0] != T * D || out_size != T * D || ws_size < WS_END) { fprintf(stderr, "kernel_launch: unexpected shapes / workspace (n_in %d, ws %zu, need %zu); nothing launched\n", n_in, ws_size, (size_t)WS_END); grid = -1; return; }
        int dev = 0, cus = 0, per_cu = 0;
        if (hipGetDevice(&dev) != hipSuccess || hipDeviceGetAttribute(&cus, hipDeviceAttributeMultiprocessorCount, dev) != hipSuccess) { grid = -1; return; }
        if (hipFuncSetAttribute((const void*)fwd, hipFuncAttributeMaxDynamicSharedMemorySize, LDS_BYTES) != hipSuccess) { fprintf(stderr, "kernel_launch: hipFuncSetAttribute failed\n"); grid = -1; return; }
        if (hipOccupancyMaxActiveBlocksPerMultiprocessor(&per_cu, (const void*)fwd, NT, LDS_BYTES) != hipSuccess || per_cu < 1) { fprintf(stderr, "kernel_launch: occupancy query says %d\n", per_cu); (void)hipGetLastError(); per_cu = 1; }
        grid = cus;
    }
    if (grid < 0) return;
    if (hipMemsetAsync((char*)d_ws + WS_CTL, 0, CTL_BYTES, stream) != hipSuccess) return;
    P p{};
    for (int i = 0; i < 24; ++i) p.in[i] = (const float*)d_in[i];
    p.out = (float*)d_out; p.ws = (unsigned char*)d_ws;
#if MK_ONE_LAUNCH
    p.ph_lo = 0; p.ph_hi = NPH;
    hipLaunchKernelGGL(fwd, dim3(grid), dim3(NT), LDS_BYTES, stream, p);
#else
    for (int ph = 0; ph < NPH; ++ph) { p.ph_lo = ph; p.ph_hi = ph + 1; hipLaunchKernelGGL(fwd, dim3(grid), dim3(NT), LDS_BYTES, stream, p); }
#endif
}
```

```cpp
#include <hip/hip_runtime.h>
#include <cstdio>
#include <cstdint>
__device__ __forceinline__ int tid_fresh() { int t = (int)threadIdx.x; asm volatile("" : "+v"(t)); return t; }
namespace pg8 {
#define PG8_LAS __attribute__((address_space(3)))
typedef unsigned short bf16_t;
typedef short bf16x8 __attribute__((ext_vector_type(8)));
typedef float f32x4 __attribute__((ext_vector_type(4)));
typedef unsigned u32x4 __attribute__((ext_vector_type(4)));
constexpr int BM = 256, BK = 64, HALF = 128, HTB = HALF * BK * 2  , STAGE_BYTES = 8 * HTB, NXCD = 8, WGM = 8;

__host__ __device__ __forceinline__ int lds_byte(int r, int c) { const int st = (r >> 4) * 2 + (c >> 5), rr = r & 15, cc = c & 31, ob = rr * 64 + cc * 2; return st * 1024 + (ob ^ (((ob >> 9) & 1) << 5)); }
__host__ __device__ __forceinline__ void stage_rc(int b, int& R, int& C) { const int st = b / 1024, sb = b % 1024, swz = sb ^ (((sb >> 9) & 1) << 5); R = (st >> 1) * 16 + swz / 64; C = (st & 1) * 32 + (swz % 64) / 2; }
__host__ __device__ __forceinline__ int perm32(int rho) { const int n = rho >> 4, i = rho & 15; return 8 * (i >> 2) + 4 * n + (i & 3); }

struct Unit { int pm, pn, be; };
struct Gemm { const bf16_t* A; const bf16_t* Bt; int M, N, K; size_t bstride; };

struct StaticOrder {
    int nM, nN, nwg, G, c;
    __host__ __device__ void init(int M, int N, int G_, int c_) { nM = M / BM; nN = N / BM; nwg = nM * nN; G = G_; c = c_; }
    __host__ __device__ bool next(int i, Unit& u) const {
        const long L = (long)i * G + c; if (L >= nwg) return false;
        int wgid = (int)L; { const int q = nwg / NXCD, r = nwg % NXCD, xcd = wgid % NXCD, off = wgid / NXCD; wgid = (xcd < r ? xcd * (q + 1) : r * (q + 1) + (xcd - r) * q) + off; }
        const int nig = WGM * nN, gid = wgid / nig, fm = gid * WGM, gsz = (nM - fm) < WGM ? (nM - fm) : WGM;
        u.pm = fm + ((wgid % nig) % gsz); u.pn = (wgid % nig) / gsz; u.be = 0; return true;
    }
    __device__ __forceinline__ void a_ready(const Unit&) const {}
    __device__ __forceinline__ void done(const Unit&) const {}
};

__device__ __forceinline__ unsigned cvt_pk_bf16(float lo, float hi) { unsigned r; asm volatile("v_cvt_pk_bf16_f32 %0, %1, %2" : "=v"(r) : "v"(lo), "v"(hi)); return r; }
template <class Epi, class Sched, bool STAMP = false>
__device__ __forceinline__ void gemm_phase(PG8_LAS unsigned char* lds, const Gemm g, const Sched& S, const Epi& E, unsigned long long* stamps) {
    const int tid = tid_fresh(), wid = __builtin_amdgcn_readfirstlane(tid >> 6), lane = tid & 63, wr = wid >> 2, wc = wid & 3, fr = lane & 15, fq = lane >> 4;
    const int K = g.K, nt = K / BK;
    int ts_lo = 0, ts_hi = 0, nts = 0; const unsigned long long rt_entry = STAMP ? (unsigned long long)wall_clock64() : 0ull;
#define PG8_STAMP() do { if (STAMP && wid == 0 && nts < 64) { const unsigned long long _c = (unsigned long long)clock64(); \
        ts_lo = (lane == nts) ? (int)(unsigned)_c : ts_lo; ts_hi = (lane == nts) ? (int)(unsigned)(_c >> 32) : ts_hi; ++nts; } } while (0)
    PG8_STAMP();
    unsigned voffA[2], voffB[2];
#pragma unroll
    for (int i = 0; i < 2; ++i) { int R, C; stage_rc(tid * 16 + i * 8192, R, C); const int Rb = Epi::PERM ? ((R & ~31) + perm32(R & 31)) : R;
        voffA[i] = (unsigned)(R * K + C) * 2u; voffB[i] = (unsigned)(Rb * K + C) * 2u; }
    const size_t kstep = (size_t)(BK * 2);
    const size_t hstep = (size_t)HALF * K * 2;
    const size_t tstep = 2 * hstep;
    const unsigned ldsw = (unsigned)wid * 1024u;
    const int aoff = lds_byte(wr * 64 + fr, fq * 8), boff = lds_byte(wc * 32 + fr, fq * 8);
#define PG8_SA(b, h) (((b) * 2 + (h)) * HTB)
#define PG8_SB(b, h) ((4 + (b) * 2 + (h)) * HTB)
#define PG8_STAGE(bufoff, gbase, voff) do { _Pragma("unroll") for (int _i = 0; _i < 2; ++_i) \
        __builtin_amdgcn_global_load_lds((const unsigned*)((const char*)(gbase) + (voff)[_i]), (PG8_LAS unsigned*)(lds + (bufoff) + ldsw + _i * 8192), 16, 0, 0); } while (0)
#define PG8_LDA(dst, b, h) do { _Pragma("unroll") for (int m = 0; m < 4; ++m) _Pragma("unroll") for (int k = 0; k < 2; ++k) dst[m][k] = *(const PG8_LAS bf16x8*)(lds + PG8_SA(b, h) + aoff + m * 2048 + k * 1024); } while (0)
#define PG8_LDB(dst, b, h) do { _Pragma("unroll") for (int n = 0; n < 2; ++n) _Pragma("unroll") for (int k = 0; k < 2; ++k) dst[n][k] = *(const PG8_LAS bf16x8*)(lds + PG8_SB(b, h) + boff + n * 2048 + k * 1024); } while (0)
#define PG8_MMA(ai, bj, At, Bt) do { __builtin_amdgcn_s_setprio(1); _Pragma("unroll") for (int m = 0; m < 4; ++m) _Pragma("unroll") for (int n = 0; n < 2; ++n) _Pragma("unroll") for (int k = 0; k < 2; ++k) \
        acc[ai][bj][m][n] = __builtin_amdgcn_mfma_f32_16x16x32_bf16(Bt[n][k], At[m][k], acc[ai][bj][m][n], 0, 0, 0); __builtin_amdgcn_s_setprio(0); } while (0)
#define PG8_WAIT_V(n) asm volatile("s_waitcnt vmcnt(" #n ")" ::: "memory")
#define PG8_WAIT_L(n) asm volatile("s_waitcnt lgkmcnt(" #n ")" ::: "memory")
#define PG8_BAR __builtin_amdgcn_s_barrier()
#define PG8_SCHED __builtin_amdgcn_sched_barrier(0)
    Unit cur, nxt; int ui = 0;
    if (!S.next(0, cur)) return;
    f32x4 acc[2][2][4][2];
#pragma unroll
    for (int a = 0; a < 2; ++a)
#pragma unroll
        for (int b = 0; b < 2; ++b)
#pragma unroll
            for (int m = 0; m < 4; ++m)
#pragma unroll
                for (int n = 0; n < 2; ++n) acc[a][b][m][n] = (f32x4){0.f, 0.f, 0.f, 0.f};
    bf16x8 At[4][2], B0[2][2], B1[2][2];
    const char* cA = (const char*)g.A + (size_t)cur.pm * tstep; const char* cB = (const char*)g.Bt + (size_t)cur.be * g.bstride + (size_t)cur.pn * tstep;
    S.a_ready(cur);
    PG8_STAGE(PG8_SB(0, 0), cB, voffB); PG8_STAGE(PG8_SA(0, 0), cA, voffA); PG8_STAGE(PG8_SB(0, 1), cB + hstep, voffB); PG8_STAGE(PG8_SA(0, 1), cA + hstep, voffA);
    if (wr == 1) PG8_BAR;
    PG8_WAIT_V(4); PG8_BAR;
    PG8_STAGE(PG8_SB(1, 0), cB + kstep, voffB); PG8_STAGE(PG8_SA(1, 0), cA + kstep, voffA); PG8_STAGE(PG8_SB(1, 1), cB + hstep + kstep, voffB);
    PG8_WAIT_V(6); PG8_BAR;
    PG8_STAMP();
    for (;;) {
        const bool has_next = S.next(ui + 1, nxt);
        const char* nA = has_next ? (const char*)g.A + (size_t)nxt.pm * tstep : cA; const char* nB = has_next ? (const char*)g.Bt + (size_t)nxt.be * g.bstride + (size_t)nxt.pn * tstep : cB;
        for (int t = 0; t < nt; t += 2) {
            const bool last = (t == nt - 2);
            const char* a1 = cA + (size_t)(t + 1) * kstep;
            const char* a2 = last ? nA : cA + (size_t)(t + 2) * kstep; const char* b2 = last ? nB : cB + (size_t)(t + 2) * kstep;
            const char* a3 = a2 + kstep; const char* b3 = b2 + kstep;
            if (last && has_next) S.a_ready(nxt);
            PG8_LDB(B0, 0, 0); PG8_SCHED; PG8_LDA(At, 0, 0); PG8_STAGE(PG8_SA(1, 1), a1 + hstep, voffA);
            PG8_WAIT_L(8); PG8_BAR; PG8_WAIT_L(0); PG8_MMA(0, 0, At, B0); PG8_BAR; PG8_SCHED;
            PG8_LDB(B1, 0, 1); PG8_STAGE(PG8_SB(0, 0), b2, voffB);
            PG8_BAR; PG8_WAIT_L(0); PG8_MMA(0, 1, At, B1); PG8_BAR;
            PG8_LDA(At, 0, 1); PG8_STAGE(PG8_SA(0, 0), a2, voffA);
            PG8_BAR; PG8_WAIT_L(0); PG8_MMA(1, 0, At, B0); PG8_BAR; PG8_SCHED;
            PG8_STAGE(PG8_SB(0, 1), b2 + hstep, voffB);
            PG8_WAIT_V(6); PG8_BAR; PG8_MMA(1, 1, At, B1); PG8_BAR;
            PG8_LDB(B0, 1, 0); PG8_SCHED; PG8_LDA(At, 1, 0); PG8_STAGE(PG8_SA(0, 1), a2 + hstep, voffA);
            PG8_WAIT_L(8); PG8_BAR; PG8_WAIT_L(0); PG8_MMA(0, 0, At, B0); PG8_BAR; PG8_SCHED;
            PG8_LDB(B1, 1, 1); PG8_STAGE(PG8_SB(1, 0), b3, voffB);
            PG8_BAR; PG8_WAIT_L(0); PG8_MMA(0, 1, At, B1); PG8_BAR;
            PG8_LDA(At, 1, 1); PG8_STAGE(PG8_SA(1, 0), a3, voffA);
            PG8_BAR; PG8_WAIT_L(0); PG8_MMA(1, 0, At, B0); PG8_BAR; PG8_SCHED;
            PG8_STAGE(PG8_SB(1, 1), b3 + hstep, voffB);
            PG8_WAIT_V(6); PG8_BAR; PG8_MMA(1, 1, At, B1); PG8_BAR;
        }
        PG8_STAMP();
        if constexpr (!Epi::AFTER_DRAIN) { E(acc, cur, wr, wc, fr, fq); S.done(cur); }
        PG8_STAMP();
        if (!has_next) break;
#pragma unroll
        for (int a = 0; a < 2; ++a)
#pragma unroll
            for (int b = 0; b < 2; ++b)
#pragma unroll
                for (int m = 0; m < 4; ++m)
#pragma unroll
                    for (int n = 0; n < 2; ++n) acc[a][b][m][n] = (f32x4){0.f, 0.f, 0.f, 0.f};
        cur = nxt; cA = nA; cB = nB; ++ui;
    }
    PG8_WAIT_V(0);
    if (wr == 0) PG8_BAR;
    PG8_BAR;
    if constexpr (Epi::AFTER_DRAIN) { E.fused(acc, cur, wr, wc, fr, fq, lds, wid, lane); S.done(cur); }
    PG8_STAMP();
    if (STAMP && wid == 0) { stamps[lane] = lane < nts ? (((unsigned long long)(unsigned)ts_hi << 32) | (unsigned)ts_lo) : 0ull;
        if (lane == 62) stamps[62] = rt_entry; if (lane == 63) stamps[63] = (unsigned long long)wall_clock64(); }
#undef PG8_STAMP
#undef PG8_SA
#undef PG8_SB
#undef PG8_STAGE
#undef PG8_LDA
#undef PG8_LDB
#undef PG8_MMA
#undef PG8_WAIT_V
#undef PG8_WAIT_L
#undef PG8_BAR
#undef PG8_SCHED
}
}


#define XB_TMO      128
#define XB_XCNT(j)  (256  + 64 * (j))
#define XB_XSUB(j)  (1280 + 64 * (j))
#define XB_XGEN(j)  (2304 + 64 * (j))
#define XB_TOP      3328
#define XB_TOPGEN   3392
#define XCD_BAR_WORDS 3456
#define XB_SPIN_CAP (1u << 18)
#define LAS __attribute__((address_space(3)))

__device__ __forceinline__ unsigned xb_ld(unsigned* p)              { return __hip_atomic_load(p, __ATOMIC_RELAXED, __HIP_MEMORY_SCOPE_AGENT); }
__device__ __forceinline__ unsigned xb_add(unsigned* p, unsigned v) { return __hip_atomic_fetch_add(p, v, __ATOMIC_RELAXED, __HIP_MEMORY_SCOPE_AGENT); }
__device__ __forceinline__ unsigned xb_xcc_id() { return (unsigned)__builtin_amdgcn_s_getreg((3 << 11) | 20) & 0xFu; }
#define XB_SPIN(cond, bar) do { unsigned _sp = 0; while (cond) { __builtin_amdgcn_s_sleep(1); \
    if ((++_sp & 255u) == 0u) { if (xb_ld(&(bar)[XB_TMO])) break; if (_sp > XB_SPIN_CAP) { atomicAdd(&(bar)[XB_TMO], 1u); break; } } } } while (0)

struct XcdBarrier {
    unsigned* bar; unsigned x;
    volatile LAS unsigned* st;
};

__device__ __forceinline__ XcdBarrier xcd_barrier_post(unsigned* bar, volatile LAS unsigned* st) {
    XcdBarrier b; b.bar = bar; b.x = xb_xcc_id(); b.st = st;
    if (threadIdx.x == 0) (void)xb_add(&bar[XB_XCNT(b.x)], 1u);
    return b;
}
__device__ __forceinline__ void xcd_barrier_complete(unsigned* bar, unsigned x, unsigned& nloc, unsigned& nx) {
    const unsigned G = gridDim.x * gridDim.y * gridDim.z;
    unsigned sum, cnt, mine, sp = 0u;
    for (;;) {
        sum = 0u; cnt = 0u; mine = 0u;
#pragma unroll
        for (unsigned j = 0; j < 16; ++j) { const unsigned c = xb_ld(&bar[XB_XCNT(j)]); sum += c; cnt += (c > 0u) ? 1u : 0u; mine = (j == x) ? c : mine; }
        if (sum == G) break;
        __builtin_amdgcn_s_sleep(1);
        if ((++sp & 255u) == 0u) { if (xb_ld(&bar[XB_TMO])) break; if (sp > XB_SPIN_CAP) { atomicAdd(&bar[XB_TMO], 1u); break; } }
    }
    nloc = mine > 0u ? mine : 1u; nx = cnt > 0u ? cnt : 1u;
}

__device__ __forceinline__ void xcd_barrier(const XcdBarrier& b) {
    asm volatile("s_waitcnt vmcnt(0)" ::: "memory");
    __syncthreads();
    if (threadIdx.x == 0) {
        unsigned* bar = b.bar;
        __builtin_amdgcn_s_waitcnt(0);
        unsigned nloc = b.st[0], nx = b.st[1];
        if (nloc == 0u) { xcd_barrier_complete(bar, b.x, nloc, nx); b.st[0] = nloc; b.st[1] = nx; }
        const unsigned old = xb_add(&bar[XB_XSUB(b.x)], 1u);
        const unsigned gen = old / nloc;
        if (old + 1u == (gen + 1u) * nloc) {
            __builtin_amdgcn_fence(__ATOMIC_RELEASE, "agent");
            asm volatile("s_waitcnt vmcnt(0)" ::: "memory");
            const unsigned og = xb_add(&bar[XB_TOP], 1u);
            const unsigned tg = og / nx;
            if (og + 1u == (tg + 1u) * nx) xb_add(&bar[XB_TOPGEN], 1u);
            else XB_SPIN(xb_ld(&bar[XB_TOPGEN]) == tg, bar);
            __builtin_amdgcn_fence(__ATOMIC_ACQUIRE, "agent");
            xb_add(&bar[XB_XGEN(b.x)], 1u);
            asm volatile("s_waitcnt vmcnt(0)" ::: "memory");
        } else {
            XB_SPIN(xb_ld(&bar[XB_XGEN(b.x)]) == gen, bar);
            __builtin_amdgcn_fence(__ATOMIC_ACQUIRE, "agent");
            asm volatile("s_waitcnt vmcnt(0)" ::: "memory");
        }
    }
    __syncthreads();
}


namespace mk {
using pg8::bf16_t; using pg8::f32x4; using pg8::u32x4; using pg8::cvt_pk_bf16;
#define MKLAS __attribute__((address_space(3)))
typedef unsigned u32x2 __attribute__((ext_vector_type(2)));

constexpr int D = 1024, T = 16384, LC = 256, L = T + LC, DEPTH = 2;
constexpr int NA = 4096, NB = 3584;
constexpr int NE = 32, DE = 256;
constexpr float EPS = 1e-6f;
constexpr int NT = 512, NW = 8;

constexpr size_t MiB = 1u << 20, QMiB = 1u << 18;
constexpr size_t WS_CTL = 0, CTL_BYTES = 1 * MiB;
constexpr size_t WS_MOD = 1 * MiB, WS_LB = WS_MOD + 128 * 1024, WS_ROPE = WS_MOD + 192 * 1024, WS_LGAM = WS_MOD + 256 * 1024;
constexpr size_t WS_AE = 2 * MiB, WS_AW = WS_AE + 256 * 1024, WS_APOS = WS_AE + 512 * 1024, WS_ROWW = WS_AE + 768 * 1024, WS_TILEE = WS_AE + 1024 * 1024, WS_ASLOT = WS_AE + 1280 * 1024;
constexpr size_t WS_CTX = 4 * MiB;
constexpr size_t WS_WIN = 5 * MiB, WS_WOHG = 20 * MiB, WS_WORET = 21 * MiB, WS_WOUT = 23 * MiB;
constexpr size_t WS_H = 25 * MiB;
constexpr size_t WS_QH = 58 * MiB, WS_VH = WS_QH + 65 * QMiB, WS_RQ = WS_VH + 65 * QMiB, WS_RK = WS_RQ + 65 * QMiB;
constexpr size_t WS_RV = 123 * MiB;
constexpr size_t WS_LF = WS_RV + 130 * QMiB;
constexpr size_t WS_OHG = WS_LF + 260 * QMiB;
constexpr size_t WS_ORT = WS_OHG + 65 * QMiB;
constexpr size_t WS_OF = WS_ORT + 130 * QMiB;
constexpr size_t WS_END = WS_OF + 390 * QMiB;
constexpr size_t WS_GA = WS_QH, WS_GB = WS_QH + 130 * QMiB;
constexpr size_t WS_M1 = WS_LF;
constexpr size_t WS_MB = WS_RV;
constexpr int CW_BAR = 4096, CW_CNT = 8192, CW_ECNT = 12288;

struct P { const float* in[24]; float* out; unsigned char* ws; int ph_lo, ph_hi; };
__device__ __forceinline__ unsigned char* ws_fresh(unsigned char* w) { asm volatile("" : "+s"(w)); return w; }
#define WSP(type, off) ((type*)(p.ws + (off)))

__device__ __forceinline__ float bf2f(bf16_t b) { return __uint_as_float(((unsigned)b) << 16); }
__device__ __forceinline__ bf16_t f2bf(float f) { return (bf16_t)(cvt_pk_bf16(f, 0.f) & 0xffffu); }
__device__ __forceinline__ float siluf(float x) { return x / (1.f + __expf(-x)); }
__device__ __forceinline__ float sigmf(float x) { return 1.f / (1.f + __expf(-x)); }
__device__ __forceinline__ float wave_sum(float v) {
#pragma unroll
    for (int o = 1; o < 64; o <<= 1) v += __shfl_xor(v, o);
    return v;
}
__device__ __forceinline__ const float* xrow_in(const P& p, int l, int r) {
    if (l == 0) return r < LC ? p.in[2] + (size_t)r * D : p.in[0] + (size_t)(r - LC) * D;
    return r < LC ? WSP(float, WS_CTX) + (size_t)r * D : p.out + (size_t)(r - LC) * D;
}
__device__ __forceinline__ float* xrow_st(const P& p, int r) { return r < LC ? WSP(float, WS_CTX) + (size_t)r * D : p.out + (size_t)(r - LC) * D; }
__device__ __forceinline__ int seq_row(int dir, int i) { return dir == 0 ? i : (i < LC ? LC - 1 - i : L + LC - 1 - i); }

__device__ __forceinline__ void tr_item(const float* W, int K, int N, bf16_t* WT, int k0, int n0, int outrow0, MKLAS float* tile) {
    const int tid = tid_fresh(), r = tid >> 6, c = tid & 63;
#pragma unroll
    for (int i = 0; i < 8; ++i) tile[(r + 8 * i) * 65 + c] = W[(size_t)(k0 + r + 8 * i) * N + n0 + c];
    __syncthreads();
    const int nn = tid >> 3, kc = tid & 7;
    const MKLAS float* s = tile + (kc * 8) * 65 + nn;
    u32x4 o; o.x = cvt_pk_bf16(s[0], s[65]); o.y = cvt_pk_bf16(s[130], s[195]); o.z = cvt_pk_bf16(s[260], s[325]); o.w = cvt_pk_bf16(s[390], s[455]);
    *(u32x4*)(WT + (size_t)(outrow0 + nn) * K + k0 + kc * 8) = o;
    __syncthreads();
}
__device__ __forceinline__ int win_perm(int n) { return n < 2048 ? n : (n < 2560 ? 4096 + (n - 2048) : (n < 4608 ? 2048 + (n - 2560) : n)); }
__device__ __forceinline__ void convert_mixer_weights(const P& p, int l, MKLAS unsigned char* lds) {
    MKLAS float* tile = (MKLAS float*)lds;
    constexpr int I_IN = 16 * 120, I_OHG = 8 * 16, I_ORT = 16 * 16, I_OUT = 16 * 16;
    for (int it = blockIdx.x; it < I_IN + I_OHG + I_ORT + I_OUT; it += gridDim.x) {
        int r = it;
        if (r < I_IN) { const int kb = r / 120, nb = r % 120; tr_item(p.in[8] + (size_t)l * D * 7680, D, 7680, WSP(bf16_t, WS_WIN), kb * 64, nb * 64, win_perm(nb * 64), tile); continue; } r -= I_IN;
        if (r < I_OHG) { const int kb = r / 16, nb = r % 16; tr_item(p.in[13] + (size_t)l * 512 * D, 512, D, WSP(bf16_t, WS_WOHG), kb * 64, nb * 64, nb * 64, tile); continue; } r -= I_OHG;
        if (r < I_ORT) { const int kb = r / 16, nb = r % 16; tr_item(p.in[14] + (size_t)l * D * D, D, D, WSP(bf16_t, WS_WORET), kb * 64, nb * 64, nb * 64, tile); continue; } r -= I_ORT;
        { const int kb = r / 16, nb = r % 16; tr_item(p.in[15] + (size_t)l * D * D, D, D, WSP(bf16_t, WS_WOUT), kb * 64, nb * 64, nb * 64, tile); }
    }
}

__device__ __forceinline__ void ph_prologue(const P& p, MKLAS unsigned char* lds) {
    const int tid = tid_fresh(), b = blockIdx.x, G = gridDim.x;
    MKLAS float* s0 = (MKLAS float*)lds;
    MKLAS float* red = s0 + 2048;
    for (int i = tid; i < 1024; i += NT) { s0[i] = siluf(p.in[1][i]); s0[1024 + i] = siluf(p.in[3][i]); }
    __syncthreads();
    float* MOD = WSP(float, WS_MOD);
    for (int u = b; u < DEPTH * 96; u += G) {
        const int l = u / 96, n0 = (u % 96) * 64, c = tid & 63, ks = tid >> 6;
        const float* W = p.in[4] + (size_t)l * 1024 * 6144 + n0 + c;
        float a0 = 0.f, a1 = 0.f;
#pragma unroll 8
        for (int i = 0; i < 128; ++i) { const int k = ks * 128 + i; const float w = W[(size_t)k * 6144]; a0 += s0[k] * w; a1 += s0[1024 + k] * w; }
        red[(ks * 64 + c) * 2] = a0; red[(ks * 64 + c) * 2 + 1] = a1;
        __syncthreads();
        if (tid < 128) { const int cc = tid & 63, w = tid >> 6; float s = 0.f;
#pragma unroll
            for (int k2 = 0; k2 < 8; ++k2) s += red[(k2 * 64 + cc) * 2 + w];
            MOD[(l * 2 + w) * 6144 + n0 + cc] = s + p.in[5][l * 6144 + n0 + cc]; }
        __syncthreads();
    }
    if (b == G - 1) {
        float* LB = WSP(float, WS_LB);
        for (int idx = tid; idx < 2 * 512; idx += NT) { const int dir = idx >> 9, ch = idx & 511;
            float x[DEPTH], m = -3.0e38f;
#pragma unroll
            for (int l = 0; l < DEPTH; ++l) { x[l] = p.in[9][(dir * DEPTH + l) * 512 + ch]; m = fmaxf(m, x[l]); }
            float s = 0.f;
#pragma unroll
            for (int l = 0; l < DEPTH; ++l) { x[l] = expf(x[l] - m); s += x[l]; }
            float cum = 0.f; const float p0 = x[0] / s;
#pragma unroll
            for (int l = 0; l < DEPTH; ++l) { cum += x[l] / s; LB[(dir * DEPTH + l) * 512 + ch] = fminf(fmaxf(cum - p0, 0.f), 1.0f - 1e-6f); } }
    }
    if (b == (G > 1 ? G - 2 : 0)) {
        float* RT = WSP(float, WS_ROPE);
        for (int idx = tid; idx < 256 * 32; idx += NT) { const int pos = idx >> 5, i = idx & 31;
            double bp = 1.0; for (int q = 0; q < i; ++q) bp *= 0.7498942093324559;
            const float inv = (float)bp; const float ang = (float)pos * inv;
            const double a = (double)ang, n = rint(a * 0.15915494309189535), r = a - n * 6.283185307179586, r2 = r * r;
            double ts = r, tc = 1.0, sn = r, cs = 1.0;
            for (int k = 1; k <= 14; ++k) { tc *= -r2 / (double)((2 * k - 1) * (2 * k)); cs += tc; ts *= -r2 / (double)((2 * k) * (2 * k + 1)); sn += ts; }
            RT[idx * 2] = (float)cs; RT[idx * 2 + 1] = (float)sn; }
    }
    if (b == (G > 2 ? G - 3 : 0)) {
        float* LG = WSP(float, WS_LGAM);
        if (tid < DEPTH * 2 * 4) LG[tid] = -log1pf(expf(-p.in[11][tid]));
    }
    convert_mixer_weights(p, 0, lds);
}

__device__ __forceinline__ void ph_hnorm(const P& p, int l) {
    const int tid_ = tid_fresh(), lane = tid_ & 63, wave = tid_ >> 6;
    const float* MOD = WSP(float, WS_MOD); bf16_t* H = WSP(bf16_t, WS_H);
    const float* nw = p.in[6] + l * D;
    for (int r = blockIdx.x * NW + wave; r < L; r += gridDim.x * NW) {
        const f32x4* xr = (const f32x4*)xrow_in(p, l, r) + lane;
        const float* mod = MOD + (l * 2 + (r < LC ? 1 : 0)) * 6144;
        f32x4 v[4]; float ss = 0.f;
#pragma unroll
        for (int j = 0; j < 4; ++j) { v[j] = xr[64 * j]; ss += (v[j].x * v[j].x + v[j].y * v[j].y) + (v[j].z * v[j].z + v[j].w * v[j].w); }
        const float rinv = 1.0f / sqrtf(wave_sum(ss) * (1.f / D) + EPS);
        u32x2* o = (u32x2*)(H + (size_t)r * D) + lane;
#pragma unroll
        for (int j = 0; j < 4; ++j) { const int c = 4 * (lane + 64 * j);
            const f32x4 w = *(const f32x4*)(nw + c), sh = *(const f32x4*)(mod + c), sc = *(const f32x4*)(mod + 1024 + c);
            const f32x4 h = v[j] * rinv * w * (sc + 1.0f) + sh;
            u32x2 q; q.x = cvt_pk_bf16(h.x, h.y); q.y = cvt_pk_bf16(h.z, h.w); o[64 * j] = q; }
    }
}

template <class F> struct EpiGen {
    static constexpr bool PERM = false, AFTER_DRAIN = false;
    F f;
    __device__ __forceinline__ void operator()(const f32x4 (&acc)[2][2][4][2], const pg8::Unit& u, int wr, int wc, int fr, int fq) const {
        const int row0 = u.pm * 256 + wr * 64 + fr, col0 = u.pn * 256 + wc * 32 + 4 * fq;
#pragma unroll
        for (int ai = 0; ai < 2; ++ai)
#pragma unroll
            for (int m = 0; m < 4; ++m) {
#pragma unroll
                for (int bj = 0; bj < 2; ++bj)
#pragma unroll
                    for (int n = 0; n < 2; ++n) f(row0 + ai * 128 + m * 16, col0 + bj * 128 + n * 16, acc[ai][bj][m][n], u);
                asm volatile("" ::: "memory");
            }
    }
};
__device__ __forceinline__ void st_bf4(bf16_t* dst, f32x4 v) { u32x2 q; q.x = cvt_pk_bf16(v.x, v.y); q.y = cvt_pk_bf16(v.z, v.w); *(u32x2*)dst = q; }
__device__ __forceinline__ f32x4 ld_bf4(const bf16_t* src) { const u32x2 q = *(const u32x2*)src; f32x4 v; v.x = __uint_as_float(q.x << 16); v.y = __uint_as_float(q.x & 0xffff0000u); v.z = __uint_as_float(q.y << 16); v.w = __uint_as_float(q.y & 0xffff0000u); return v; }

struct FnA {
    bf16_t *QH, *VH, *RQ, *RK, *RV; float* LF; const float* LB;
    __device__ __forceinline__ void operator()(int row, int col, f32x4 v, const pg8::Unit& u) const {
        const int seg = u.pn >> 1;
        if (seg == 0) { f32x4 o; o.x = siluf(v.x); o.y = siluf(v.y); o.z = siluf(v.z); o.w = siluf(v.w); st_bf4(QH + (size_t)row * 512 + col, o * 0.08838834764831845f); }
        else if (seg == 1 || seg == 2) { const int dir = seg - 1, ch = col - seg * 512; const f32x4 lb = *(const f32x4*)(LB + dir * DEPTH * 512 + ch); f32x4 o;
#pragma unroll
            for (int j = 0; j < 4; ++j) { const float f = lb[j] + (1.f - lb[j]) * sigmf(v[j]); o[j] = logf(fmaxf(f, 1e-30f)); }
            *(f32x4*)(LF + (size_t)row * 1024 + dir * 512 + ch) = o; }
        else if (seg == 3) st_bf4(VH + (size_t)row * 512 + (col - 1536), v);
        else if (seg == 4) st_bf4(RQ + (size_t)row * 512 + (col - 2048), v * 0.08838834764831845f);
        else if (seg == 5) st_bf4(RK + (size_t)row * 512 + (col - 2560), v);
        else st_bf4(RV + (size_t)row * 1024 + (col - 3072), v);
    }
};
struct FnB {
    bf16_t *OHG, *ORT, *GA, *GB;
    __device__ __forceinline__ void operator()(int row, int col, f32x4 v, const pg8::Unit& u) const {
        const int pn = u.pn;
        if (pn < 6) { bf16_t* o = pn < 2 ? OHG + (size_t)row * 512 + col : ORT + (size_t)row * 1024 + (col - 512);
            f32x4 s; s.x = siluf(v.x); s.y = siluf(v.y); s.z = siluf(v.z); s.w = siluf(v.w); st_bf4(o, ld_bf4(o) * s); }
        else { bf16_t* o = pn < 10 ? GA + (size_t)row * 1024 + (col - 1536) : GB + (size_t)row * 1024 + (col - 2560);
            f32x4 s; s.x = sigmf(v.x); s.y = sigmf(v.y); s.z = sigmf(v.z); s.w = sigmf(v.w); st_bf4(o, s); }
    }
};
struct FnM1 { const bf16_t* GA; float* M1;
    __device__ __forceinline__ void operator()(int row, int col, f32x4 v, const pg8::Unit&) const { *(f32x4*)(M1 + (size_t)row * D + col) = ld_bf4(GA + (size_t)row * D + col) * v; } };
struct FnM2 { const bf16_t* GB; const float* M1; bf16_t* MB;
    __device__ __forceinline__ void operator()(int row, int col, f32x4 v, const pg8::Unit&) const { st_bf4(MB + (size_t)row * D + col, *(const f32x4*)(M1 + (size_t)row * D + col) + ld_bf4(GB + (size_t)row * D + col) * v); } };
struct FnX { const float *xc_in, *xl_in; float *xc_out, *xl_out; const float* MODL;
    __device__ __forceinline__ void operator()(int row, int col, f32x4 v, const pg8::Unit&) const {
        const bool isc = row < LC;
        const f32x4 g = *(const f32x4*)(MODL + (isc ? 6144 : 0) + 2 * 1024 + col);
        const size_t off = (size_t)(isc ? row : row - LC) * D + col;
        const f32x4 x = *(const f32x4*)((isc ? xc_in : xl_in) + off);
        *(f32x4*)((isc ? xc_out : xl_out) + off) = x + g * v; } };

__device__ __forceinline__ void ph_scan_naive(const P& p, int l, MKLAS unsigned char* lds) {
    const int tid = tid_fresh(), lane = tid & 63, wave = tid >> 6;
    MKLAS float* part = (MKLAS float*)lds;
    const bf16_t *QH = WSP(bf16_t, WS_QH), *VH = WSP(bf16_t, WS_VH), *RQ = WSP(bf16_t, WS_RQ), *RK = WSP(bf16_t, WS_RK), *RV = WSP(bf16_t, WS_RV);
    const float *LF = WSP(float, WS_LF), *RT = WSP(float, WS_ROPE), *LG = WSP(float, WS_LGAM);
    float* OF = WSP(float, WS_OF);
    for (int u = blockIdx.x; u < 192; u += gridDim.x) {
        const bool ret = u >= 64; const int h = ret ? (u - 64) / 32 : u / 16, es = ret ? (u - 64) % 32 : u % 16;
        const int d = tid & 127, eg = tid >> 7, e0 = es * 8 + eg * 2;
        const int obase = ret ? 512 + h * 256 + es * 8 : h * 128 + es * 8;
        const bool lower = (d & 63) < 32; const int dp = d ^ 32, ri = d & 31, half = d >> 6;
        for (int dir = 0; dir < 2; ++dir) {
            float S0 = 0.f, S1 = 0.f;
            const float gam = ret ? expf(LG[(l * 2 + dir) * 4 + h]) : 0.f;
            for (int i0 = 0; i0 < L; i0 += 8) {
                float qv[8], kv[8], fv[8], v0[8], v1[8];
#pragma unroll
                for (int s = 0; s < 8; ++s) { const int r = seq_row(dir, i0 + s);
                    if (!ret) { qv[s] = bf2f(QH[(size_t)r * 512 + h * 128 + d]); const float f = __expf(LF[(size_t)r * 1024 + dir * 512 + h * 128 + d]); fv[s] = f; kv[s] = 1.f - f;
                        const unsigned vv = *(const unsigned*)(VH + (size_t)r * 512 + h * 128 + e0); v0[s] = __uint_as_float(vv << 16); v1[s] = __uint_as_float(vv & 0xffff0000u); }
                    else { float q = bf2f(RQ[(size_t)r * 512 + h * 128 + d]), k = bf2f(RK[(size_t)r * 512 + h * 128 + d]);
                        if (r >= LC) { const int t = r - LC, pos = half ? (t & 63) : (t >> 6); const float cs = RT[(pos * 32 + ri) * 2], sn = RT[(pos * 32 + ri) * 2 + 1];
                            const float qp = bf2f(RQ[(size_t)r * 512 + h * 128 + dp]), kp = bf2f(RK[(size_t)r * 512 + h * 128 + dp]);
                            q = q * cs + (lower ? -qp : qp) * sn; k = k * cs + (lower ? -kp : kp) * sn; }
                        qv[s] = q; kv[s] = k; fv[s] = gam;
                        const unsigned vv = *(const unsigned*)(RV + (size_t)r * 1024 + h * 256 + e0); v0[s] = __uint_as_float(vv << 16); v1[s] = __uint_as_float(vv & 0xffff0000u); }
                }
#pragma unroll
                for (int s = 0; s < 8; ++s) { S0 = fv[s] * S0 + kv[s] * v0[s]; S1 = fv[s] * S1 + kv[s] * v1[s];
                    const float p0 = wave_sum(S0 * qv[s]), p1 = wave_sum(S1 * qv[s]);
                    if (lane == 0) { part[(s * 8 + wave) * 2] = p0; part[(s * 8 + wave) * 2 + 1] = p1; } }
                __syncthreads();
                if (tid < 64) { const int s = tid >> 3, egg = (tid >> 1) & 3, j = tid & 1;
                    const float val = part[(s * 8 + 2 * egg) * 2 + j] + part[(s * 8 + 2 * egg + 1) * 2 + j];
                    float* o = OF + (size_t)seq_row(dir, i0 + s) * 1536 + obase + egg * 2 + j;
                    if (dir == 0) *o = val; else *o += val; }
                __syncthreads();
            }
        }
    }
}
__device__ __forceinline__ void ph_onorm(const P& p, int l) {
    const int tid_ = tid_fresh(), lane = tid_ & 63, wave = tid_ >> 6;
    const float* OF = WSP(float, WS_OF); bf16_t *OHG = WSP(bf16_t, WS_OHG), *ORT = WSP(bf16_t, WS_ORT);
    const float *hw = p.in[10] + l * 512, *gw = p.in[12] + l * 1024;
    for (int r = blockIdx.x * NW + wave; r < L; r += gridDim.x * NW) {
        const float* o = OF + (size_t)r * 1536;
#pragma unroll
        for (int h = 0; h < 4; ++h) { const int c = h * 128 + lane * 2; const float a = o[c], b = o[c + 1];
            const float rinv = 1.0f / sqrtf(wave_sum(a * a + b * b) * (1.f / 128.f) + EPS);
            *(unsigned*)(OHG + (size_t)r * 512 + c) = cvt_pk_bf16(a * rinv * hw[c], b * rinv * hw[c + 1]); }
#pragma unroll
        for (int h = 0; h < 4; ++h) { const int c = h * 256 + lane * 4; f32x4 v = *(const f32x4*)(o + 512 + c);
            const float mu = wave_sum((v.x + v.y) + (v.z + v.w)) * (1.f / 256.f); v = v - mu;
            const float rinv = 1.0f / sqrtf(wave_sum((v.x * v.x + v.y * v.y) + (v.z * v.z + v.w * v.w)) * (1.f / 256.f) + EPS);
            st_bf4(ORT + (size_t)r * 1024 + c, v * rinv * *(const f32x4*)(gw + c)); }
    }
}


typedef short bf16x8 __attribute__((ext_vector_type(8)));
typedef short s16x4 __attribute__((ext_vector_type(4)));
#define MFMA16(a, b, c) __builtin_amdgcn_mfma_f32_16x16x32_bf16((a), (b), (c), 0, 0, 0)
constexpr size_t WS_STH = WS_OF, WS_STR = WS_OF + (size_t)8 * 65 * 16384 * 2, WS_ATOT = WS_OF + 49 * MiB;

__device__ __forceinline__ bf16x8 ld_frag_row(const MKLAS bf16_t* tile, int stride, int row0, int k0, int lane) {
    return *(const MKLAS bf16x8*)(tile + (row0 + (lane & 15)) * stride + k0 + 8 * (lane >> 4));
}
__device__ __forceinline__ bf16x8 ld_frag_tr(const MKLAS bf16_t* tile, int stride, int k0, int col0, int lane) {
    const int g = lane >> 4, q = (lane & 15) >> 2, pp = lane & 3;
    const MKLAS bf16_t* a = tile + (k0 + 8 * g + q) * stride + col0 + 4 * pp;
    const s16x4 lo = __builtin_amdgcn_ds_read_tr16_b64_v4i16((MKLAS s16x4*)a), hi = __builtin_amdgcn_ds_read_tr16_b64_v4i16((MKLAS s16x4*)(a + 4 * stride));
    return (bf16x8){lo[0], lo[1], lo[2], lo[3], hi[0], hi[1], hi[2], hi[3]};
}
__device__ __forceinline__ bf16x8 pack8(f32x4 a, f32x4 b) { u32x4 r; r.x = cvt_pk_bf16(a.x, a.y); r.y = cvt_pk_bf16(a.z, a.w); r.z = cvt_pk_bf16(b.x, b.y); r.w = cvt_pk_bf16(b.z, b.w); return __builtin_bit_cast(bf16x8, r); }
__device__ __forceinline__ float bflo(unsigned u) { return __uint_as_float(u << 16); }
__device__ __forceinline__ float bfhi(unsigned u) { return __uint_as_float(u & 0xffff0000u); }
__device__ __forceinline__ u32x4 scale_piece(u32x4 v, float s) { u32x4 r; r.x = cvt_pk_bf16(bflo(v.x) * s, bfhi(v.x) * s); r.y = cvt_pk_bf16(bflo(v.y) * s, bfhi(v.y) * s); r.z = cvt_pk_bf16(bflo(v.z) * s, bfhi(v.z) * s); r.w = cvt_pk_bf16(bflo(v.w) * s, bfhi(v.w) * s); return r; }

__device__ __forceinline__ void ph_rope(const P& p) {
    const int tid_ = tid_fresh(), lane = tid_ & 63, wave = tid_ >> 6;
    const float* RT = WSP(float, WS_ROPE);
    const int d0 = 8 * (lane & 15), half = d0 >> 6, i0 = d0 & 31; const bool lower = (d0 & 63) < 32;
    for (int r = LC + blockIdx.x * NW + wave; r < L; r += gridDim.x * NW) {
        const int t = r - LC, pos = half ? (t & 63) : (t >> 6);
        const f32x4* cs = (const f32x4*)(RT + (pos * 32 + i0) * 2);
        const f32x4 c0 = cs[0], c1 = cs[1], c2 = cs[2], c3 = cs[3];
        const float co[8] = {c0.x, c0.z, c1.x, c1.z, c2.x, c2.z, c3.x, c3.z}, si[8] = {c0.y, c0.w, c1.y, c1.w, c2.y, c2.w, c3.y, c3.w};
#pragma unroll
        for (int which = 0; which < 2; ++which) {
            u32x4* ptr = (u32x4*)((which ? WSP(bf16_t, WS_RK) : WSP(bf16_t, WS_RQ)) + (size_t)r * 512) + lane;
            const u32x4 v = *ptr; u32x4 pv;
            pv.x = __shfl_xor(v.x, 4); pv.y = __shfl_xor(v.y, 4); pv.z = __shfl_xor(v.z, 4); pv.w = __shfl_xor(v.w, 4);
            const unsigned vv[4] = {v.x, v.y, v.z, v.w}, pp[4] = {pv.x, pv.y, pv.z, pv.w}; unsigned oo[4];
#pragma unroll
            for (int k = 0; k < 4; ++k) {
                const float x0 = bflo(vv[k]), x1 = bfhi(vv[k]), q0 = bflo(pp[k]), q1 = bfhi(pp[k]);
                const float y0 = x0 * co[2 * k] + (lower ? -q0 : q0) * si[2 * k], y1 = x1 * co[2 * k + 1] + (lower ? -q1 : q1) * si[2 * k + 1];
                oo[k] = cvt_pk_bf16(y0, y1); }
            u32x4 o; o.x = oo[0]; o.y = oo[1]; o.z = oo[2]; o.w = oo[3]; *ptr = o;
        }
    }
}

template <bool RET, int MODE>
__device__ __forceinline__ void scan_unit(const P& p, int l, int h, int c, int dir, MKLAS unsigned char* lds) {
    constexpr int C = RET ? 64 : 32, NCH = 256 / C, NET = RET ? 2 : 1, DV = RET ? 256 : 128, QS = 136, VS = DV + 8, PS = C + 8, NTT = C / 16, NKS2 = C / 32;
    const int tid = tid_fresh(), lane = tid & 63, w = __builtin_amdgcn_readfirstlane(tid >> 6), r16 = lane & 15, quad = lane >> 4;
    MKLAS bf16_t* Qn = (MKLAS bf16_t*)lds; MKLAS bf16_t* Kn = Qn + C * QS; MKLAS bf16_t* Vn = Kn + C * QS; MKLAS bf16_t* Pm = Vn + C * VS;
    MKLAS float* TOT = (MKLAS float*)(Pm + C * PS); MKLAS float* E12 = TOT + 512; MKLAS float* RED = E12 + 256; MKLAS float* DQK = RED + 1024;
    const int e0 = 16 * NET * w, row0 = 256 * c, chain = dir * 4 + h;
    const bf16_t* Qg = RET ? WSP(bf16_t, WS_RQ) + h * 128 : WSP(bf16_t, WS_QH) + h * 128;
    const bf16_t* Kg = WSP(bf16_t, WS_RK) + h * 128;
    const bf16_t* Vg = RET ? WSP(bf16_t, WS_RV) + h * 256 : WSP(bf16_t, WS_VH) + h * 128;
    const float* LFg = WSP(float, WS_LF) + dir * 512 + h * 128;
    bf16_t* ST = RET ? WSP(bf16_t, WS_STR) + (((size_t)chain * 65 + c) << 15) : WSP(bf16_t, WS_STH) + (((size_t)chain * 65 + c) << 14);
    const float lg = RET ? WSP(float, WS_LGAM)[(l * 2 + dir) * 4 + h] : 0.f;
    if (RET && tid < 64) { DQK[2 * tid] = __expf((float)(tid + 1) * lg); DQK[2 * tid + 1] = __expf(-(float)(tid + 1) * lg); }
    const float e2s = RET ? __expf((float)C * lg) : 1.f;

    f32x4 Sacc[8][NET];
#pragma unroll
    for (int i = 0; i < 8; ++i)
#pragma unroll
        for (int n = 0; n < NET; ++n) {
            if (MODE == 0) Sacc[i][n] = (f32x4){0.f, 0.f, 0.f, 0.f};
            else { const u32x2 q = *(const u32x2*)(ST + (size_t)(e0 + 16 * n + r16) * 128 + 16 * i + 4 * quad); Sacc[i][n] = (f32x4){bflo(q.x), bfhi(q.x), bflo(q.y), bfhi(q.y)}; }
        }
    float btot = 0.f;
    float lfv[8]; unsigned short qv[8]; u32x4 hv = {0, 0, 0, 0};
    u32x4 qp[2], kp[2], vp[4];
    const int hd = tid & 127, hseg = tid >> 7;
#define TOKROW(pos) (row0 + (dir ? 255 - (pos) : (pos)))
#define LOAD_CHUNK(j) do { \
        if (!RET) { _Pragma("unroll") for (int ii = 0; ii < 8; ++ii) { const size_t rr = (size_t)TOKROW(C * (j) + 8 * hseg + ii); lfv[ii] = LFg[rr * 1024 + hd]; if (MODE != 0) qv[ii] = Qg[rr * 512 + hd]; } \
            { const size_t rr = (size_t)TOKROW(C * (j) + (tid >> 4)); hv = *(const u32x4*)(Vg + rr * 512 + 8 * (tid & 15)); } } \
        else { _Pragma("unroll") for (int m = 0; m < 2; ++m) { const int pc = tid + 512 * m; const size_t rr = (size_t)TOKROW(C * (j) + (pc >> 4)); \
                if (MODE != 0) qp[m] = *(const u32x4*)(Qg + rr * 512 + 8 * (pc & 15)); kp[m] = *(const u32x4*)(Kg + rr * 512 + 8 * (pc & 15)); } \
            _Pragma("unroll") for (int m = 0; m < 4; ++m) { const int pc = tid + 512 * m; const size_t rr = (size_t)TOKROW(C * (j) + (pc >> 5)); vp[m] = *(const u32x4*)(Vg + rr * 1024 + 8 * (pc & 31)); } } \
    } while (0)
    LOAD_CHUNK(0);
    if (MODE != 0) { for (int i = tid; i < C * PS / 8; i += NT) ((MKLAS u32x4*)Pm)[i] = (u32x4){0u, 0u, 0u, 0u}; }
    __syncthreads();
    for (int j = 0; j < NCH; ++j) {
        if (!RET) {
            float pl[8]; float run = 0.f;
#pragma unroll
            for (int ii = 0; ii < 8; ++ii) { run += lfv[ii]; pl[ii] = run; }
            TOT[hseg * 128 + hd] = run;
            __syncthreads();
            const float t0 = TOT[hd], t1 = TOT[128 + hd], t2 = TOT[256 + hd], t3 = TOT[384 + hd];
            const float off = hseg == 0 ? 0.f : (hseg == 1 ? t0 : (hseg == 2 ? t0 + t1 : t0 + t1 + t2));
            const float rref = t0 + t1, blast = (t0 + t1) + (t2 + t3);
#pragma unroll
            for (int ii = 0; ii < 8; ++ii) { const int pos = 8 * hseg + ii; const float b = off + pl[ii];
                const float kk = 1.f - __expf(lfv[ii]);
                Kn[pos * QS + hd] = f2bf(kk * __expf(fminf(rref - b, 60.f)));
                if (MODE != 0) Qn[pos * QS + hd] = f2bf(bf2f(qv[ii]) * __expf(fminf(b - rref, 60.f))); }
            if (hseg == 0) { E12[hd] = __expf(rref); E12[128 + hd] = __expf(blast - rref); btot += blast; }
            *(MKLAS u32x4*)(Vn + (tid >> 4) * VS + 8 * (tid & 15)) = hv;
        } else {
#pragma unroll
            for (int m = 0; m < 2; ++m) { const int pc = tid + 512 * m, pos = pc >> 4;
                *(MKLAS u32x4*)(Kn + pos * QS + 8 * (pc & 15)) = scale_piece(kp[m], DQK[2 * pos + 1]);
                if (MODE != 0) *(MKLAS u32x4*)(Qn + pos * QS + 8 * (pc & 15)) = scale_piece(qp[m], DQK[2 * pos]); }
#pragma unroll
            for (int m = 0; m < 4; ++m) { const int pc = tid + 512 * m; *(MKLAS u32x4*)(Vn + (pc >> 5) * VS + 8 * (pc & 31)) = vp[m]; }
        }
        if (j + 1 < NCH) LOAD_CHUNK(j + 1);
        __syncthreads();
        if (MODE != 0) {
            constexpr int NTILE = NTT * (NTT + 1) / 2;
#pragma unroll
            for (int rep = 0; rep < (NTILE + 7) / 8; ++rep) {
                const int q = w + 8 * rep;
                if (q < NTILE) {
                    int tt = 0, st = q;
#pragma unroll
                    for (int z = 1; z < NTT; ++z) if (q >= z * (z + 1) / 2) { tt = z; st = q - z * (z + 1) / 2; }
                    f32x4 sc = {0.f, 0.f, 0.f, 0.f};
#pragma unroll
                    for (int ks = 0; ks < 4; ++ks) sc = MFMA16(ld_frag_row(Qn, QS, 16 * tt, 32 * ks, lane), ld_frag_row(Kn, QS, 16 * st, 32 * ks, lane), sc);
#pragma unroll
                    for (int jj = 0; jj < 4; ++jj) { const bool keep = (st < tt) || (r16 <= 4 * quad + jj); Pm[(16 * tt + 4 * quad + jj) * PS + 16 * st + r16] = f2bf(keep ? sc[jj] : 0.f); }
                }
            }
            __syncthreads();
        }
        bf16x8 Vf[NKS2][NET];
#pragma unroll
        for (int k2 = 0; k2 < NKS2; ++k2)
#pragma unroll
            for (int n = 0; n < NET; ++n) Vf[k2][n] = ld_frag_tr(Vn, VS, 32 * k2, e0 + 16 * n, lane);
        if (!RET) {
#pragma unroll
            for (int i = 0; i < 8; ++i) { const f32x4 e1 = *(const MKLAS f32x4*)(E12 + 16 * i + 4 * quad);
#pragma unroll
                for (int n = 0; n < NET; ++n) Sacc[i][n] = Sacc[i][n] * e1; }
        }
        f32x4 oacc[NTT][NET];
        if (MODE != 0) {
#pragma unroll
            for (int tt = 0; tt < NTT; ++tt)
#pragma unroll
                for (int n = 0; n < NET; ++n) oacc[tt][n] = (f32x4){0.f, 0.f, 0.f, 0.f};
#pragma unroll
            for (int ks = 0; ks < 4; ++ks) {
                bf16x8 Bf[NET];
#pragma unroll
                for (int n = 0; n < NET; ++n) Bf[n] = pack8(Sacc[2 * ks][n], Sacc[2 * ks + 1][n]);
#pragma unroll
                for (int tt = 0; tt < NTT; ++tt) {
                    const MKLAS bf16_t* qa = Qn + (16 * tt + r16) * QS + 32 * ks + 4 * quad;
                    const s16x4 a0 = *(const MKLAS s16x4*)qa, a1 = *(const MKLAS s16x4*)(qa + 16);
                    const bf16x8 Af = (bf16x8){a0[0], a0[1], a0[2], a0[3], a1[0], a1[1], a1[2], a1[3]};
#pragma unroll
                    for (int n = 0; n < NET; ++n) oacc[tt][n] = MFMA16(Af, Bf[n], oacc[tt][n]);
                }
            }
#pragma unroll
            for (int k2 = 0; k2 < NKS2; ++k2)
#pragma unroll
                for (int tt = 0; tt < NTT; ++tt) {
                    if (32 * k2 > 16 * tt + 15) continue;
                    const bf16x8 Af = ld_frag_row(Pm, PS, 16 * tt, 32 * k2, lane);
#pragma unroll
                    for (int n = 0; n < NET; ++n) oacc[tt][n] = MFMA16(Af, Vf[k2][n], oacc[tt][n]);
                }
        }
#pragma unroll
        for (int i = 0; i < 8; ++i)
#pragma unroll
            for (int k2 = 0; k2 < NKS2; ++k2) { const bf16x8 Af = ld_frag_tr(Kn, QS, 32 * k2, 16 * i, lane);
#pragma unroll
                for (int n = 0; n < NET; ++n) Sacc[i][n] = MFMA16(Af, Vf[k2][n], Sacc[i][n]); }
#pragma unroll
        for (int i = 0; i < 8; ++i) { f32x4 e2; if (!RET) e2 = *(const MKLAS f32x4*)(E12 + 128 + 16 * i + 4 * quad); else e2 = (f32x4){e2s, e2s, e2s, e2s};
#pragma unroll
            for (int n = 0; n < NET; ++n) Sacc[i][n] = Sacc[i][n] * e2; }
        if (MODE != 0) {
            bf16_t* Og = RET ? WSP(bf16_t, WS_ORT) + h * 256 : WSP(bf16_t, WS_OHG) + h * 128;
            constexpr int OS = RET ? 1024 : 512;
            if (MODE == 1) {
#pragma unroll
                for (int tt = 0; tt < NTT; ++tt)
#pragma unroll
                    for (int jj = 0; jj < 4; ++jj) { const size_t rr = (size_t)TOKROW(C * j + 16 * tt + 4 * quad + jj);
#pragma unroll
                        for (int n = 0; n < NET; ++n) Og[rr * OS + e0 + 16 * n + r16] = f2bf(oacc[tt][n][jj]); }
            } else {
#pragma unroll
                for (int tt = 0; tt < NTT; ++tt)
#pragma unroll
                    for (int jj = 0; jj < 4; ++jj) { const size_t rr = (size_t)TOKROW(C * j + 16 * tt + 4 * quad + jj); float s1 = 0.f, s2 = 0.f;
#pragma unroll
                        for (int n = 0; n < NET; ++n) { const float v = oacc[tt][n][jj] + bf2f(Og[rr * OS + e0 + 16 * n + r16]); oacc[tt][n][jj] = v; s1 += v; s2 += v * v; }
#pragma unroll
                        for (int o = 1; o < 16; o <<= 1) { s1 += __shfl_xor(s1, o); s2 += __shfl_xor(s2, o); }
                        if (r16 == 0) { RED[(w * 64 + 16 * tt + 4 * quad + jj) * 2] = s1; RED[(w * 64 + 16 * tt + 4 * quad + jj) * 2 + 1] = s2; } }
                __syncthreads();
                const float* nw = RET ? p.in[12] + l * 1024 + h * 256 : p.in[10] + l * 512 + h * 128;
                float nwv[NET];
#pragma unroll
                for (int n = 0; n < NET; ++n) nwv[n] = nw[e0 + 16 * n + r16];
#pragma unroll
                for (int tt = 0; tt < NTT; ++tt)
#pragma unroll
                    for (int jj = 0; jj < 4; ++jj) { const int tpos = 16 * tt + 4 * quad + jj; const size_t rr = (size_t)TOKROW(C * j + tpos); float s1 = 0.f, s2 = 0.f;
#pragma unroll
                        for (int ww = 0; ww < 8; ++ww) { s1 += RED[(ww * 64 + tpos) * 2]; s2 += RED[(ww * 64 + tpos) * 2 + 1]; }
                        const float mean = RET ? s1 * (1.f / 256.f) : 0.f;
                        const float var = RET ? fmaxf(s2 * (1.f / 256.f) - mean * mean, 0.f) : s2 * (1.f / 128.f);
                        const float rinv = 1.0f / sqrtf(var + EPS);
#pragma unroll
                        for (int n = 0; n < NET; ++n) Og[rr * OS + e0 + 16 * n + r16] = f2bf((oacc[tt][n][jj] - mean) * rinv * nwv[n]); }
            }
        }
        if (RET) __syncthreads();
    }
    if (MODE == 0) {
#pragma unroll
        for (int i = 0; i < 8; ++i)
#pragma unroll
            for (int n = 0; n < NET; ++n) { u32x2 q; q.x = cvt_pk_bf16(Sacc[i][n].x, Sacc[i][n].y); q.y = cvt_pk_bf16(Sacc[i][n].z, Sacc[i][n].w);
                *(u32x2*)(ST + (size_t)(e0 + 16 * n + r16) * 128 + 16 * i + 4 * quad) = q; }
        if (!RET && hseg == 0) WSP(float, WS_ATOT)[((size_t)chain * 65 + c) * 128 + hd] = __expf(btot);
    }
#undef LOAD_CHUNK
#undef TOKROW
}

__device__ __forceinline__ int next_unit(unsigned* ctr, volatile MKLAS int* slot) {
    __syncthreads();
    if (threadIdx.x == 0) *slot = (int)__hip_atomic_fetch_add(ctr, 1u, __ATOMIC_RELAXED, __HIP_MEMORY_SCOPE_AGENT);
    __syncthreads();
    return *slot;
}
__device__ __forceinline__ void ph_scan_pass1(const P& p, int l, MKLAS unsigned char* lds, unsigned* ctr, volatile MKLAS int* slot) {
    for (;;) { const int u = next_unit(ctr, slot); if (u >= 1040) break;
        const bool ret = u < 520; const int v = ret ? u : u - 520, dir = v / 260, rem = v % 260, h = rem / 65, c = rem % 65;
        if (ret) scan_unit<true, 0>(p, l, h, c, dir, lds); else scan_unit<false, 0>(p, l, h, c, dir, lds); }
}
template <int MODE> __device__ __forceinline__ void ph_scan_pass3(const P& p, int l, MKLAS unsigned char* lds, unsigned* ctr, volatile MKLAS int* slot) {
    for (;;) { const int u = next_unit(ctr, slot); if (u >= 520) break;
        const bool ret = u < 260; const int v = ret ? u : u - 260, h = v / 65, c = v % 65;
        if (ret) scan_unit<true, MODE>(p, l, h, c, MODE == 1 ? 1 : 0, lds); else scan_unit<false, MODE>(p, l, h, c, MODE == 1 ? 1 : 0, lds); }
}
__device__ __forceinline__ void ph_scan_pass2(const P& p, int l) {
    const int tid = tid_fresh();
    const float* LG = WSP(float, WS_LGAM); const float* AT = WSP(float, WS_ATOT);
    for (int item = blockIdx.x * NT + tid; item < 32768 + 65536; item += gridDim.x * NT) {
        const bool ret = item >= 32768; const int it = ret ? item - 32768 : item, per = ret ? 8192 : 4096, chain = it / per, q4 = it % per, dir = chain >> 2, h = chain & 3, dd = (q4 * 4) & 127;
        bf16_t* base = (ret ? WSP(bf16_t, WS_STR) : WSP(bf16_t, WS_STH)) + (size_t)chain * 65 * (per * 4) + (size_t)q4 * 4;
        const float ar = ret ? __expf(256.f * LG[(l * 2 + dir) * 4 + h]) : 0.f;
        f32x4 S = {0.f, 0.f, 0.f, 0.f};
        for (int b0 = 0; b0 < 65; b0 += 13) {
            u32x2 U[13]; f32x4 A[13];
#pragma unroll
            for (int s = 0; s < 13; ++s) { const int step = b0 + s, c = dir == 0 ? step : (step == 0 ? 0 : 65 - step);
                U[s] = *(const u32x2*)(base + (size_t)c * (per * 4));
                A[s] = ret ? (f32x4){ar, ar, ar, ar} : *(const f32x4*)(AT + ((size_t)chain * 65 + c) * 128 + dd); }
#pragma unroll
            for (int s = 0; s < 13; ++s) { const int step = b0 + s, c = dir == 0 ? step : (step == 0 ? 0 : 65 - step);
                u32x2 o; o.x = cvt_pk_bf16(S.x, S.y); o.y = cvt_pk_bf16(S.z, S.w); *(u32x2*)(base + (size_t)c * (per * 4)) = o;
                S = A[s] * S + (f32x4){bflo(U[s].x), bfhi(U[s].x), bflo(U[s].y), bfhi(U[s].y)}; }
        }
    }
}

__device__ __forceinline__ void ph_router(const P& p, int l, MKLAS unsigned char* lds) {
    const int tid_ = tid_fresh(), lane = tid_ & 63, wave = tid_ >> 6;
    MKLAS float* hrow = (MKLAS float*)lds + wave * 1024;
    const float* MOD = WSP(float, WS_MOD); bf16_t* H = WSP(bf16_t, WS_H);
    int* AE = WSP(int, WS_AE); float* AW = WSP(float, WS_AW); int* APOS = WSP(int, WS_APOS);
    unsigned* ecnt = (unsigned*)(p.ws + WS_CTL) + CW_ECNT + l * NE * 16;
    const float* nw = p.in[7] + l * D;
    const float *wg = p.in[16] + (size_t)l * D * 4, *bg = p.in[17] + l * 4, *we = p.in[18] + (size_t)l * D * NE, *be = p.in[19] + l * NE;
    const int r_lo = (l == DEPTH - 1) ? LC : 0;
    for (int r = r_lo + blockIdx.x * NW + wave; r < L; r += gridDim.x * NW) {
        const f32x4* xr = (const f32x4*)xrow_st(p, r) + lane;
        const float* mod = MOD + (l * 2 + (r < LC ? 1 : 0)) * 6144;
        f32x4 v[4]; float ss = 0.f;
#pragma unroll
        for (int j = 0; j < 4; ++j) { v[j] = xr[64 * j]; ss += (v[j].x * v[j].x + v[j].y * v[j].y) + (v[j].z * v[j].z + v[j].w * v[j].w); }
        const float rinv = 1.0f / sqrtf(wave_sum(ss) * (1.f / D) + EPS);
        u32x2* o = (u32x2*)(H + (size_t)r * D) + lane;
#pragma unroll
        for (int j = 0; j < 4; ++j) { const int c = 4 * (lane + 64 * j);
            const f32x4 w = *(const f32x4*)(nw + c), sh = *(const f32x4*)(mod + 3 * 1024 + c), sc = *(const f32x4*)(mod + 4 * 1024 + c);
            const f32x4 h = v[j] * rinv * w * (sc + 1.0f) + sh;
            u32x2 q; q.x = cvt_pk_bf16(h.x, h.y); q.y = cvt_pk_bf16(h.z, h.w); o[64 * j] = q;
            *(MKLAS f32x4*)(hrow + c) = h; }
        float ea = 0.f, ga = 0.f;
        { const int c = lane & 31, k0 = (lane >> 5) * 512;
#pragma unroll 8
            for (int k = 0; k < 512; ++k) ea += hrow[k0 + k] * we[(size_t)(k0 + k) * NE + c]; }
        { const int c = lane & 3, k0 = (lane >> 2) * 64;
#pragma unroll 8
            for (int k = 0; k < 64; ++k) ga += hrow[k0 + k] * wg[(size_t)(k0 + k) * 4 + c]; }
        ea += __shfl_xor(ea, 32);
        ga += __shfl_xor(ga, 4); ga += __shfl_xor(ga, 8); ga += __shfl_xor(ga, 16); ga += __shfl_xor(ga, 32);
        float gl[4];
#pragma unroll
        for (int g = 0; g < 4; ++g) gl[g] = __shfl(ga, g) + bg[g];
        int grp = 0; float gm = gl[0];
#pragma unroll
        for (int g = 1; g < 4; ++g) if (gl[g] > gm) { gm = gl[g]; grp = g; }
        float gs = 0.f;
#pragma unroll
        for (int g = 0; g < 4; ++g) gs += expf(gl[g] - gm);
        const float gval = 1.0f / gs;
        float el[8];
#pragma unroll
        for (int j = 0; j < 8; ++j) el[j] = __shfl(ea, grp * 8 + j) + be[grp * 8 + j];
        int i1 = 0; float v1 = el[0];
#pragma unroll
        for (int j = 1; j < 8; ++j) if (el[j] > v1) { v1 = el[j]; i1 = j; }
        int i2 = -1; float v2 = -3.0e38f;
#pragma unroll
        for (int j = 0; j < 8; ++j) if (j != i1 && el[j] > v2) { v2 = el[j]; i2 = j; }
        const float e2 = expf(v2 - v1), w1 = 1.0f / (1.0f + e2), w2 = e2 / (1.0f + e2);
        if (lane == 0) { const int ea0 = grp * 8 + i1, ea1 = grp * 8 + i2;
            AE[2 * r] = ea0; AE[2 * r + 1] = ea1; AW[2 * r] = gval * w1; AW[2 * r + 1] = gval * w2;
            APOS[2 * r] = (int)__hip_atomic_fetch_add(ecnt + 16 * ea0, 1u, __ATOMIC_RELAXED, __HIP_MEMORY_SCOPE_AGENT);
            APOS[2 * r + 1] = (int)__hip_atomic_fetch_add(ecnt + 16 * ea1, 1u, __ATOMIC_RELAXED, __HIP_MEMORY_SCOPE_AGENT); }
    }
}

constexpr int XG_ROWS = 41472;
constexpr size_t WS_WGU = WS_OF, WS_WD = WS_OF + 32 * MiB;
constexpr size_t WS_XG = WS_QH, WS_ACT = WS_XG + (size_t)XG_ROWS * 2048, WS_YA = 160 * MiB;
static_assert(WS_ACT + (size_t)XG_ROWS * 512 <= WS_YA && WS_YA + (size_t)XG_ROWS * 2048 <= WS_OF, "MoE overlays");
__device__ __forceinline__ void convert_expert_weights(const P& p, int l, MKLAS unsigned char* lds) {
    MKLAS float* tile = (MKLAS float*)lds;
    for (int it = blockIdx.x; it < 3 * 2048; it += gridDim.x) {
        const int which = it >> 11, r = it & 2047, e = r >> 6, q = r & 63;
        if (which < 2) { const int kb = q >> 2, nb = q & 3, n0 = nb * 64;
            tr_item(p.in[20 + which] + ((size_t)l * NE + e) * D * DE, D, DE, WSP(bf16_t, WS_WGU) + (size_t)e * 512 * D, kb * 64, n0, (n0 >> 7) * 256 + which * 128 + (n0 & 127), tile); }
        else { const int kb = q >> 4, nb = q & 15;
            tr_item(p.in[22] + ((size_t)l * NE + e) * DE * D, DE, D, WSP(bf16_t, WS_WD) + (size_t)e * D * DE, kb * 64, nb * 64, nb * 64, tile); }
    }
}
__device__ __forceinline__ void ph_moe_scatter(const P& p, int l, MKLAS unsigned char* lds) {
    const int tid = tid_fresh(), lane = tid & 63, wave = tid >> 6;
    MKLAS int* off = (MKLAS int*)lds;
    const unsigned* ecnt = (const unsigned*)(p.ws + WS_CTL) + CW_ECNT + l * NE * 16;
    if (tid == 0) { int o = 0; for (int e = 0; e < NE; ++e) { off[e] = o; o += (int)((__hip_atomic_load(ecnt + 16 * e, __ATOMIC_RELAXED, __HIP_MEMORY_SCOPE_AGENT) + 255u) & ~255u); } off[NE] = o; }
    __syncthreads();
    if (blockIdx.x == 0) { int* TE = WSP(int, WS_TILEE); const int nt = off[NE] >> 8;
        if (tid == 0) TE[255] = nt;
        for (int t = tid; t < nt; t += NT) { int e = 0; for (int k = 1; k < NE; ++k) if (t * 256 >= off[k]) e = k; TE[t] = e; } }
    const int* AE = WSP(int, WS_AE); const int* APOS = WSP(int, WS_APOS); const float* AW = WSP(float, WS_AW);
    int* ASLOT = WSP(int, WS_ASLOT); float* ROWW = WSP(float, WS_ROWW);
    const bf16_t* H = WSP(bf16_t, WS_H); bf16_t* XG = WSP(bf16_t, WS_XG);
    const int a_lo = (l == DEPTH - 1) ? 2 * LC : 0;
    for (int a = a_lo + blockIdx.x * NW + wave; a < 2 * L; a += gridDim.x * NW) {
        const int slot = off[AE[a]] + APOS[a];
        const u32x4* src = (const u32x4*)(H + (size_t)(a >> 1) * D) + lane; u32x4* dst = (u32x4*)(XG + (size_t)slot * D) + lane;
        dst[0] = src[0]; dst[64] = src[64];
        if (lane == 0) { ASLOT[a] = slot; ROWW[slot] = AW[a]; }
    }
}
struct MoeOrder { const int* tile_e; int ntiles, nN, G, c;
    __device__ __forceinline__ bool next(int i, pg8::Unit& u) const { const long Lx = (long)i * G + c; if (Lx >= (long)ntiles * nN) return false; u.pm = (int)(Lx / nN); u.pn = (int)(Lx % nN); u.be = tile_e[u.pm]; return true; }
    __device__ __forceinline__ void a_ready(const pg8::Unit&) const {}
    __device__ __forceinline__ void done(const pg8::Unit&) const {} };
struct EpiGU { static constexpr bool PERM = false, AFTER_DRAIN = false; bf16_t* ACT;
    __device__ __forceinline__ void operator()(const f32x4 (&acc)[2][2][4][2], const pg8::Unit& u, int wr, int wc, int fr, int fq) const {
        const int row0 = u.pm * 256 + wr * 64 + fr, col0 = u.pn * 128 + wc * 32 + 4 * fq;
#pragma unroll
        for (int ai = 0; ai < 2; ++ai)
#pragma unroll
            for (int m = 0; m < 4; ++m)
#pragma unroll
                for (int n = 0; n < 2; ++n) { const f32x4 g = acc[ai][0][m][n], up = acc[ai][1][m][n]; f32x4 a;
#pragma unroll
                    for (int j = 0; j < 4; ++j) a[j] = siluf(g[j]) * up[j];
                    st_bf4(ACT + (size_t)(row0 + ai * 128 + m * 16) * DE + col0 + n * 16, a); }
    } };
struct FnYA { const float* ROWW; bf16_t* YA;
    __device__ __forceinline__ void operator()(int row, int col, f32x4 v, const pg8::Unit&) const { st_bf4(YA + (size_t)row * D + col, v * ROWW[row]); } };
__device__ __forceinline__ void ph_moe_combine(const P& p, int l) {
    const int tid_ = tid_fresh(), lane = tid_ & 63, wave = tid_ >> 6;
    const float* MOD = WSP(float, WS_MOD); const bf16_t* YA = WSP(bf16_t, WS_YA); const int* ASLOT = WSP(int, WS_ASLOT); bf16_t* H = WSP(bf16_t, WS_H);
    const bool last = (l == DEPTH - 1);
    const float* nw = last ? p.in[23] : p.in[6] + (l + 1) * D;
    for (int r = (last ? LC : 0) + blockIdx.x * NW + wave; r < L; r += gridDim.x * NW) {
        const int isc = r < LC ? 1 : 0;
        const float* g2 = MOD + (l * 2 + isc) * 6144 + 5 * 1024;
        float* xo = xrow_st(p, r);
        const u32x2* ya = (const u32x2*)(YA + (size_t)ASLOT[2 * r] * D) + lane; const u32x2* yb = (const u32x2*)(YA + (size_t)ASLOT[2 * r + 1] * D) + lane;
        f32x4 v[4]; float ss = 0.f;
#pragma unroll
        for (int j = 0; j < 4; ++j) { const int c = 4 * (lane + 64 * j); const u32x2 a = ya[64 * j], b = yb[64 * j];
            const f32x4 y = (f32x4){bflo(a.x) + bflo(b.x), bfhi(a.x) + bfhi(b.x), bflo(a.y) + bflo(b.y), bfhi(a.y) + bfhi(b.y)};
            v[j] = *(const f32x4*)(xo + c) + *(const f32x4*)(g2 + c) * y;
            ss += (v[j].x * v[j].x + v[j].y * v[j].y) + (v[j].z * v[j].z + v[j].w * v[j].w); }
        const float rinv = 1.0f / sqrtf(wave_sum(ss) * (1.f / D) + EPS);
        if (last) {
#pragma unroll
            for (int j = 0; j < 4; ++j) { const int c = 4 * (lane + 64 * j); *(f32x4*)(xo + c) = v[j] * rinv * *(const f32x4*)(nw + c); }
        } else {
            const float* mod = MOD + ((l + 1) * 2 + isc) * 6144;
            u32x2* o = (u32x2*)(H + (size_t)r * D) + lane;
#pragma unroll
            for (int j = 0; j < 4; ++j) { const int c = 4 * (lane + 64 * j); *(f32x4*)(xo + c) = v[j];
                const f32x4 hh = v[j] * rinv * *(const f32x4*)(nw + c) * (*(const f32x4*)(mod + 1024 + c) + 1.0f) + *(const f32x4*)(mod + c);
                u32x2 q; q.x = cvt_pk_bf16(hh.x, hh.y); q.y = cvt_pk_bf16(hh.z, hh.w); o[64 * j] = q; }
        }
    }
}

__device__ __forceinline__ void ph_moe_naive(const P& p, int l, MKLAS unsigned char* lds) {
    const int tid = tid_fresh();
    MKLAS float* hs = (MKLAS float*)lds; MKLAS float* gu = hs + 1024; MKLAS float* act = gu + 512;
    const float* MOD = WSP(float, WS_MOD); const bf16_t* H = WSP(bf16_t, WS_H);
    const int* AE = WSP(int, WS_AE); const float* AW = WSP(float, WS_AW);
    const int r_lo = (l == DEPTH - 1) ? LC : 0;
    for (int r = r_lo + blockIdx.x; r < L; r += gridDim.x) {
        for (int i = tid; i < 1024; i += NT) hs[i] = bf2f(H[(size_t)r * D + i]);
        __syncthreads();
        float y0 = 0.f, y1 = 0.f;
        for (int k = 0; k < 2; ++k) {
            const int e = AE[2 * r + k]; const float w = AW[2 * r + k];
            const float* Wx = (tid < 256 ? p.in[20] : p.in[21]) + ((size_t)l * NE + e) * D * DE + (tid & 255);
            float a = 0.f;
#pragma unroll 8
            for (int dd = 0; dd < D; ++dd) a += hs[dd] * Wx[(size_t)dd * DE];
            gu[tid] = a;
            __syncthreads();
            if (tid < 256) act[tid] = siluf(gu[tid]) * gu[256 + tid];
            __syncthreads();
            const float* Wd = p.in[22] + ((size_t)l * NE + e) * DE * D + tid;
            float b0 = 0.f, b1 = 0.f;
#pragma unroll 8
            for (int j = 0; j < DE; ++j) { const float a2 = act[j]; b0 += a2 * Wd[(size_t)j * D]; b1 += a2 * Wd[(size_t)j * D + 512]; }
            y0 += w * b0; y1 += w * b1;
            __syncthreads();
        }
        const float* g2 = MOD + (l * 2 + (r < LC ? 1 : 0)) * 6144 + 5 * 1024;
        float* xo = xrow_st(p, r);
        xo[tid] += g2[tid] * y0; xo[tid + 512] += g2[tid + 512] * y1;
    }
}
__device__ __forceinline__ void ph_final(const P& p) {
    const int tid_ = tid_fresh(), lane = tid_ & 63, wave = tid_ >> 6;
    const float* nw = p.in[23];
    for (int r = blockIdx.x * NW + wave; r < T; r += gridDim.x * NW) {
        f32x4* xr = (f32x4*)(p.out + (size_t)r * D) + lane;
        f32x4 v[4]; float ss = 0.f;
#pragma unroll
        for (int j = 0; j < 4; ++j) { v[j] = xr[64 * j]; ss += (v[j].x * v[j].x + v[j].y * v[j].y) + (v[j].z * v[j].z + v[j].w * v[j].w); }
        const float rinv = 1.0f / sqrtf(wave_sum(ss) * (1.f / D) + EPS);
#pragma unroll
        for (int j = 0; j < 4; ++j) xr[64 * j] = v[j] * rinv * *(const f32x4*)(nw + 4 * (lane + 64 * j));
    }
}

constexpr int LDS_BYTES = 147456, LDS_CTL = 131072;
constexpr int NPH_LAYER = 16, NPH = 1 + DEPTH * NPH_LAYER;

template <class F> __device__ __forceinline__ void run_gemm(MKLAS unsigned char* lds, const bf16_t* A, const bf16_t* Bt, int M, int N, int K, const F& f) {
    pg8::Gemm g{A, Bt, M, N, K, 0}; pg8::StaticOrder S; S.init(M, N, (int)gridDim.x, (int)blockIdx.x);
    EpiGen<F> E{f};
    pg8::gemm_phase<EpiGen<F>, pg8::StaticOrder, false>(lds, g, S, E, nullptr);
}

#ifndef MK_MASK
#define MK_MASK 0xfffff
#endif
#define KON(j) ((MK_MASK >> (j)) & 1)
#define IN(k) (lo <= (k) && (k) < hi)
#define SEAM(k) do { if (IN(k) && IN((k) + 1)) xcd_barrier(bar); } while (0)
template <int l> __device__ __forceinline__ void run_layer(const P& p, MKLAS unsigned char* lds, const XcdBarrier& bar, const int lo, const int hi, volatile MKLAS unsigned* lctl) {
        const int b = 1 + l * NPH_LAYER;
        if (KON(1) && IN(b + 0)) { if (l == 0) ph_hnorm(p, l); } SEAM(b + 0);
        if (KON(2) && IN(b + 1)) { FnA f{WSP(bf16_t, WS_QH), WSP(bf16_t, WS_VH), WSP(bf16_t, WS_RQ), WSP(bf16_t, WS_RK), WSP(bf16_t, WS_RV), WSP(float, WS_LF), WSP(float, WS_LB) + l * 512};
            run_gemm(lds, WSP(bf16_t, WS_H), WSP(bf16_t, WS_WIN), L, NA, D, f); } SEAM(b + 1);
        if (KON(3) && IN(b + 2)) { ph_rope(p); } SEAM(b + 2);
        if (KON(3) && IN(b + 3)) { ph_scan_pass1(p, l, lds, (unsigned*)(p.ws + WS_CTL) + CW_CNT + 64 * (l * 4 + 0), (volatile MKLAS int*)(lctl + 2)); } SEAM(b + 3);
        if (KON(3) && IN(b + 4)) { ph_scan_pass2(p, l); } SEAM(b + 4);
        if (KON(4) && IN(b + 5)) { ph_scan_pass3<1>(p, l, lds, (unsigned*)(p.ws + WS_CTL) + CW_CNT + 64 * (l * 4 + 1), (volatile MKLAS int*)(lctl + 2)); } SEAM(b + 5);
        if (KON(4) && IN(b + 6)) { ph_scan_pass3<2>(p, l, lds, (unsigned*)(p.ws + WS_CTL) + CW_CNT + 64 * (l * 4 + 2), (volatile MKLAS int*)(lctl + 2)); } SEAM(b + 6);
        if (KON(5) && IN(b + 7)) { FnB f{WSP(bf16_t, WS_OHG), WSP(bf16_t, WS_ORT), WSP(bf16_t, WS_GA), WSP(bf16_t, WS_GB)};
            run_gemm(lds, WSP(bf16_t, WS_H), WSP(bf16_t, WS_WIN) + (size_t)NA * D, L, NB, D, f); } SEAM(b + 7);
        if (KON(6) && IN(b + 8)) { FnM1 f{WSP(bf16_t, WS_GA), WSP(float, WS_M1)}; run_gemm(lds, WSP(bf16_t, WS_OHG), WSP(bf16_t, WS_WOHG), L, D, 512, f); } SEAM(b + 8);
        if (KON(7) && IN(b + 9)) { FnM2 f{WSP(bf16_t, WS_GB), WSP(float, WS_M1), WSP(bf16_t, WS_MB)}; run_gemm(lds, WSP(bf16_t, WS_ORT), WSP(bf16_t, WS_WORET), L, D, D, f); } SEAM(b + 9);
        if (KON(8) && IN(b + 10)) { FnX f{l == 0 ? p.in[2] : WSP(float, WS_CTX), l == 0 ? p.in[0] : p.out, WSP(float, WS_CTX), p.out, WSP(float, WS_MOD) + l * 2 * 6144}; run_gemm(lds, WSP(bf16_t, WS_MB), WSP(bf16_t, WS_WOUT), L, D, D, f); } SEAM(b + 10);
        if (KON(9) && IN(b + 11)) { ph_router(p, l, lds); __syncthreads(); convert_expert_weights(p, l, lds); if (l + 1 < DEPTH) convert_mixer_weights(p, l + 1, lds); } SEAM(b + 11);
        if (KON(10) && IN(b + 12)) { ph_moe_scatter(p, l, lds); } SEAM(b + 12);
        if (KON(11) && IN(b + 13)) { const int* TE = WSP(int, WS_TILEE); MoeOrder S{TE, TE[255], 2, (int)gridDim.x, (int)blockIdx.x};
            pg8::Gemm g{WSP(bf16_t, WS_XG), WSP(bf16_t, WS_WGU), XG_ROWS, 512, D, (size_t)512 * D * 2}; EpiGU E{WSP(bf16_t, WS_ACT)};
            pg8::gemm_phase<EpiGU, MoeOrder, false>(lds, g, S, E, nullptr); } SEAM(b + 13);
        if (KON(12) && IN(b + 14)) { const int* TE = WSP(int, WS_TILEE); MoeOrder S{TE, TE[255], 4, (int)gridDim.x, (int)blockIdx.x};
            pg8::Gemm g{WSP(bf16_t, WS_ACT), WSP(bf16_t, WS_WD), XG_ROWS, D, DE, (size_t)D * DE * 2}; EpiGen<FnYA> E{FnYA{WSP(float, WS_ROWW), WSP(bf16_t, WS_YA)}};
            pg8::gemm_phase<EpiGen<FnYA>, MoeOrder, false>(lds, g, S, E, nullptr); } SEAM(b + 14);
        if (KON(13) && IN(b + 15)) { ph_moe_combine(p, l); } SEAM(b + 15);
}

__global__ void __launch_bounds__(NT, 2) fwd(P p) {
    extern __shared__ __attribute__((aligned(16))) unsigned char lds_raw[];
    MKLAS unsigned char* lds = (MKLAS unsigned char*)lds_raw;
    volatile MKLAS unsigned* lctl = (volatile MKLAS unsigned*)(lds + LDS_CTL);
    if (threadIdx.x < 4) lctl[threadIdx.x] = 0u;
    __syncthreads();
    const int lo = p.ph_lo, hi = p.ph_hi;
    const bool multi = (hi - lo) > 1;
    XcdBarrier bar; bar.bar = (unsigned*)(p.ws + WS_CTL) + CW_BAR; bar.x = 0; bar.st = nullptr;
    if (multi) bar = xcd_barrier_post((unsigned*)(p.ws + WS_CTL) + CW_BAR, lctl);
    if (KON(0) && IN(0)) { ph_prologue(p, lds); } SEAM(0);
    run_layer<0>(p, lds, bar, lo, hi, lctl);
    run_layer<1>(p, lds, bar, lo, hi, lctl);
    static_assert(DEPTH == 2, "two layers written out");
#undef IN
#undef SEAM
}
}

#ifndef MK_ONE_LAUNCH
#define MK_ONE_LAUNCH 1
#endif
extern "C" void kernel_launch(void* const* d_in, const int* in_sizes, int n_in, void* d_out, int out_size, void* d_ws, size_t ws_size, hipStream_t stream) {
    using namespace mk;
    static int grid = 0;
    if (grid == 0) {
        if (n_in != 24 || in_sizes[0] != T * D || out_size != T * D || ws_size < WS_END) { fprintf(stderr, "kernel_launch: unexpected shapes / workspace (n_in %d, ws %zu, need %zu); nothing launched\n", n_in, ws_size, (size_t)WS_END); grid = -1; return; }
        int dev = 0, cus = 0, per_cu = 0;
        if (hipGetDevice(&dev) != hipSuccess || hipDeviceGetAttribute(&cus, hipDeviceAttributeMultiprocessorCount, dev) != hipSuccess) { grid = -1; return; }
        if (hipFuncSetAttribute((const void*)fwd, hipFuncAttributeMaxDynamicSharedMemorySize, LDS_BYTES) != hipSuccess) { fprintf(stderr, "kernel_launch: hipFuncSetAttribute failed\n"); grid = -1; return; }
        if (hipOccupancyMaxActiveBlocksPerMultiprocessor(&per_cu, (const void*)fwd, NT, LDS_BYTES) != hipSuccess || per_cu < 1) { fprintf(stderr, "kernel_launch: occupancy query says %d\n", per_cu); (void)hipGetLastError(); per_cu = 1; }
        grid = cus;
    }
    if (grid < 0) return;
    if (hipMemsetAsync((char*)d_ws + WS_CTL, 0, CTL_BYTES, stream) != hipSuccess) return;
    P p{};
    for (int i = 0; i < 24; ++i) p.in[i] = (const float*)d_in[i];
    p.out = (float*)d_out; p.ws = (unsigned char*)d_ws;
#if MK_ONE_LAUNCH
    p.ph_lo = 0; p.ph_hi = NPH;
    hipLaunchKernelGGL(fwd, dim3(grid), dim3(NT), LDS_BYTES, stream, p);
#else
    for (int ph = 0; ph < NPH; ++ph) { p.ph_lo = ph; p.ph_hi = ph + 1; hipLaunchKernelGGL(fwd, dim3(grid), dim3(NT), LDS_BYTES, stream, p); }
#endif
}
```

```cpp
#include <hip/hip_runtime.h>
#include <cstdio>
#include <cstdint>
__device__ __forceinline__ int tid_fresh() { int t = (int)threadIdx.x; asm volatile("" : "+v"(t)); return t; }
namespace pg8 {
#define PG8_LAS __attribute__((address_space(3)))
typedef unsigned short bf16_t;
typedef short bf16x8 __attribute__((ext_vector_type(8)));
typedef float f32x4 __attribute__((ext_vector_type(4)));
typedef unsigned u32x4 __attribute__((ext_vector_type(4)));
constexpr int BM = 256, BK = 64, HALF = 128, HTB = HALF * BK * 2  , STAGE_BYTES = 8 * HTB, NXCD = 8, WGM = 8;

__host__ __device__ __forceinline__ int lds_byte(int r, int c) { const int st = (r >> 4) * 2 + (c >> 5), rr = r & 15, cc = c & 31, ob = rr * 64 + cc * 2; return st * 1024 + (ob ^ (((ob >> 9) & 1) << 5)); }
__host__ __device__ __forceinline__ void stage_rc(int b, int& R, int& C) { const int st = b / 1024, sb = b % 1024, swz = sb ^ (((sb >> 9) & 1) << 5); R = (st >> 1) * 16 + swz / 64; C = (st & 1) * 32 + (swz % 64) / 2; }
__host__ __device__ __forceinline__ int perm32(int rho) { const int n = rho >> 4, i = rho & 15; return 8 * (i >> 2) + 4 * n + (i & 3); }

struct Unit { int pm, pn, be; };
struct Gemm { const bf16_t* A; const bf16_t* Bt; int M, N, K; size_t bstride; };

struct StaticOrder {
    int nM, nN, nwg, G, c;
    __host__ __device__ void init(int M, int N, int G_, int c_) { nM = M / BM; nN = N / BM; nwg = nM * nN; G = G_; c = c_; }
    __host__ __device__ bool next(int i, Unit& u) const {
        const long L = (long)i * G + c; if (L >= nwg) return false;
        int wgid = (int)L; { const int q = nwg / NXCD, r = nwg % NXCD, xcd = wgid % NXCD, off = wgid / NXCD; wgid = (xcd < r ? xcd * (q + 1) : r * (q + 1) + (xcd - r) * q) + off; }
        const int nig = WGM * nN, gid = wgid / nig, fm = gid * WGM, gsz = (nM - fm) < WGM ? (nM - fm) : WGM;
        u.pm = fm + ((wgid % nig) % gsz); u.pn = (wgid % nig) / gsz; u.be = 0; return true;
    }
    __device__ __forceinline__ void a_ready(const Unit&) const {}
    __device__ __forceinline__ void done(const Unit&) const {}
};

typedef float cvt_f32x2 __attribute__((ext_vector_type(2)));
typedef __bf16 cvt_bf16x2 __attribute__((ext_vector_type(2)));
__device__ __forceinline__ unsigned cvt_pk_bf16(float lo, float hi) { const cvt_f32x2 v = {lo, hi}; return __builtin_bit_cast(unsigned, __builtin_convertvector(v, cvt_bf16x2)); }
template <class Epi, class Sched, bool STAMP = false>
__device__ __forceinline__ void gemm_phase(PG8_LAS unsigned char* lds, const Gemm g, const Sched& S, const Epi& E, unsigned long long* stamps) {
    const int tid = tid_fresh(), wid = __builtin_amdgcn_readfirstlane(tid >> 6), lane = tid & 63, wr = wid >> 2, wc = wid & 3, fr = lane & 15, fq = lane >> 4;
    const int K = g.K, nt = K / BK;
    int ts_lo = 0, ts_hi = 0, nts = 0; const unsigned long long rt_entry = STAMP ? (unsigned long long)wall_clock64() : 0ull;
#define PG8_STAMP() do { if (STAMP && wid == 0 && nts < 64) { const unsigned long long _c = (unsigned long long)clock64(); \
        ts_lo = (lane == nts) ? (int)(unsigned)_c : ts_lo; ts_hi = (lane == nts) ? (int)(unsigned)(_c >> 32) : ts_hi; ++nts; } } while (0)
    PG8_STAMP();
    unsigned voffA[2], voffB[2];
#pragma unroll
    for (int i = 0; i < 2; ++i) { int R, C; stage_rc(tid * 16 + i * 8192, R, C); const int Rb = Epi::PERM ? ((R & ~31) + perm32(R & 31)) : R;
        voffA[i] = (unsigned)(R * K + C) * 2u; voffB[i] = (unsigned)(Rb * K + C) * 2u; }
    const size_t kstep = (size_t)(BK * 2);
    const size_t hstep = (size_t)HALF * K * 2;
    const size_t tstep = 2 * hstep;
    const unsigned ldsw = (unsigned)wid * 1024u;
    const int aoff = lds_byte(wr * 64 + fr, fq * 8), boff = lds_byte(wc * 32 + fr, fq * 8);
#define PG8_SA(b, h) (((b) * 2 + (h)) * HTB)
#define PG8_SB(b, h) ((4 + (b) * 2 + (h)) * HTB)
#define PG8_STAGE(bufoff, gbase, voff) do { _Pragma("unroll") for (int _i = 0; _i < 2; ++_i) \
        __builtin_amdgcn_global_load_lds((const unsigned*)((const char*)(gbase) + (voff)[_i]), (PG8_LAS unsigned*)(lds + (bufoff) + ldsw + _i * 8192), 16, 0, 0); } while (0)
#define PG8_LDA(dst, b, h) do { _Pragma("unroll") for (int m = 0; m < 4; ++m) _Pragma("unroll") for (int k = 0; k < 2; ++k) dst[m][k] = *(const PG8_LAS bf16x8*)(lds + PG8_SA(b, h) + aoff + m * 2048 + k * 1024); } while (0)
#define PG8_LDB(dst, b, h) do { _Pragma("unroll") for (int n = 0; n < 2; ++n) _Pragma("unroll") for (int k = 0; k < 2; ++k) dst[n][k] = *(const PG8_LAS bf16x8*)(lds + PG8_SB(b, h) + boff + n * 2048 + k * 1024); } while (0)
#define PG8_MMA(ai, bj, At, Bt) do { __builtin_amdgcn_s_setprio(1); _Pragma("unroll") for (int m = 0; m < 4; ++m) _Pragma("unroll") for (int n = 0; n < 2; ++n) _Pragma("unroll") for (int k = 0; k < 2; ++k) \
        acc[ai][bj][m][n] = __builtin_amdgcn_mfma_f32_16x16x32_bf16(Bt[n][k], At[m][k], acc[ai][bj][m][n], 0, 0, 0); __builtin_amdgcn_s_setprio(0); } while (0)
#define PG8_WAIT_V(n) asm volatile("s_waitcnt vmcnt(" #n ")" ::: "memory")
#define PG8_WAIT_L(n) asm volatile("s_waitcnt lgkmcnt(" #n ")" ::: "memory")
#define PG8_BAR __builtin_amdgcn_s_barrier()
#define PG8_SCHED __builtin_amdgcn_sched_barrier(0)
    Unit cur, nxt; int ui = 0;
    if (!S.next(0, cur)) return;
    f32x4 acc[2][2][4][2];
#pragma unroll
    for (int a = 0; a < 2; ++a)
#pragma unroll
        for (int b = 0; b < 2; ++b)
#pragma unroll
            for (int m = 0; m < 4; ++m)
#pragma unroll
                for (int n = 0; n < 2; ++n) acc[a][b][m][n] = (f32x4){0.f, 0.f, 0.f, 0.f};
    bf16x8 At[4][2], B0[2][2], B1[2][2];
    const char* cA = (const char*)g.A + (size_t)cur.pm * tstep; const char* cB = (const char*)g.Bt + (size_t)cur.be * g.bstride + (size_t)cur.pn * tstep;
    S.a_ready(cur);
    PG8_STAGE(PG8_SB(0, 0), cB, voffB); PG8_STAGE(PG8_SA(0, 0), cA, voffA); PG8_STAGE(PG8_SB(0, 1), cB + hstep, voffB); PG8_STAGE(PG8_SA(0, 1), cA + hstep, voffA);
    if (wr == 1) PG8_BAR;
    PG8_WAIT_V(4); PG8_BAR;
    PG8_STAGE(PG8_SB(1, 0), cB + kstep, voffB); PG8_STAGE(PG8_SA(1, 0), cA + kstep, voffA); PG8_STAGE(PG8_SB(1, 1), cB + hstep + kstep, voffB);
    PG8_WAIT_V(6); PG8_BAR;
    PG8_STAMP();
    for (;;) {
        const bool has_next = S.next(ui + 1, nxt);
        const char* nA = has_next ? (const char*)g.A + (size_t)nxt.pm * tstep : cA; const char* nB = has_next ? (const char*)g.Bt + (size_t)nxt.be * g.bstride + (size_t)nxt.pn * tstep : cB;
        for (int t = 0; t < nt; t += 2) {
            const bool last = (t == nt - 2);
            const char* a1 = cA + (size_t)(t + 1) * kstep;
            const char* a2 = last ? nA : cA + (size_t)(t + 2) * kstep; const char* b2 = last ? nB : cB + (size_t)(t + 2) * kstep;
            const char* a3 = a2 + kstep; const char* b3 = b2 + kstep;
            if (last && has_next) S.a_ready(nxt);
            PG8_LDB(B0, 0, 0); PG8_SCHED; PG8_LDA(At, 0, 0); PG8_STAGE(PG8_SA(1, 1), a1 + hstep, voffA);
            PG8_WAIT_L(8); PG8_BAR; PG8_WAIT_L(0); PG8_MMA(0, 0, At, B0); PG8_BAR; PG8_SCHED;
            PG8_LDB(B1, 0, 1); PG8_STAGE(PG8_SB(0, 0), b2, voffB);
            PG8_BAR; PG8_WAIT_L(0); PG8_MMA(0, 1, At, B1); PG8_BAR;
            PG8_LDA(At, 0, 1); PG8_STAGE(PG8_SA(0, 0), a2, voffA);
            PG8_BAR; PG8_WAIT_L(0); PG8_MMA(1, 0, At, B0); PG8_BAR; PG8_SCHED;
            PG8_STAGE(PG8_SB(0, 1), b2 + hstep, voffB);
            PG8_WAIT_V(6); PG8_BAR; PG8_MMA(1, 1, At, B1); PG8_BAR;
            PG8_LDB(B0, 1, 0); PG8_SCHED; PG8_LDA(At, 1, 0); PG8_STAGE(PG8_SA(0, 1), a2 + hstep, voffA);
            PG8_WAIT_L(8); PG8_BAR; PG8_WAIT_L(0); PG8_MMA(0, 0, At, B0); PG8_BAR; PG8_SCHED;
            PG8_LDB(B1, 1, 1); PG8_STAGE(PG8_SB(1, 0), b3, voffB);
            PG8_BAR; PG8_WAIT_L(0); PG8_MMA(0, 1, At, B1); PG8_BAR;
            PG8_LDA(At, 1, 1); PG8_STAGE(PG8_SA(1, 0), a3, voffA);
            PG8_BAR; PG8_WAIT_L(0); PG8_MMA(1, 0, At, B0); PG8_BAR; PG8_SCHED;
            PG8_STAGE(PG8_SB(1, 1), b3 + hstep, voffB);
            PG8_WAIT_V(6); PG8_BAR; PG8_MMA(1, 1, At, B1); PG8_BAR;
        }
        PG8_STAMP();
        if constexpr (!Epi::AFTER_DRAIN) { E(acc, cur, wr, wc, fr, fq); S.done(cur); }
        PG8_STAMP();
        if (!has_next) break;
#pragma unroll
        for (int a = 0; a < 2; ++a)
#pragma unroll
            for (int b = 0; b < 2; ++b)
#pragma unroll
                for (int m = 0; m < 4; ++m)
#pragma unroll
                    for (int n = 0; n < 2; ++n) acc[a][b][m][n] = (f32x4){0.f, 0.f, 0.f, 0.f};
        cur = nxt; cA = nA; cB = nB; ++ui;
    }
    PG8_WAIT_V(0);
    if (wr == 0) PG8_BAR;
    PG8_BAR;
    if constexpr (Epi::AFTER_DRAIN) { E.fused(acc, cur, wr, wc, fr, fq, lds, wid, lane); S.done(cur); }
    PG8_STAMP();
    if (STAMP && wid == 0) { stamps[lane] = lane < nts ? (((unsigned long long)(unsigned)ts_hi << 32) | (unsigned)ts_lo) : 0ull;
        if (lane == 62) stamps[62] = rt_entry; if (lane == 63) stamps[63] = (unsigned long long)wall_clock64(); }
#undef PG8_STAMP
#undef PG8_SA
#undef PG8_SB
#undef PG8_STAGE
#undef PG8_LDA
#undef PG8_LDB
#undef PG8_MMA
#undef PG8_WAIT_V
#undef PG8_WAIT_L
#undef PG8_BAR
#undef PG8_SCHED
}
}


#define XB_TMO      128
#define XB_XCNT(j)  (256  + 64 * (j))
#define XB_XSUB(j)  (1280 + 64 * (j))
#define XB_XGEN(j)  (2304 + 64 * (j))
#define XB_TOP      3328
#define XB_TOPGEN   3392
#define XCD_BAR_WORDS 3456
#define XB_SPIN_CAP (1u << 18)
#define LAS __attribute__((address_space(3)))

__device__ __forceinline__ unsigned xb_ld(unsigned* p)              { return __hip_atomic_load(p, __ATOMIC_RELAXED, __HIP_MEMORY_SCOPE_AGENT); }
__device__ __forceinline__ unsigned xb_add(unsigned* p, unsigned v) { return __hip_atomic_fetch_add(p, v, __ATOMIC_RELAXED, __HIP_MEMORY_SCOPE_AGENT); }
__device__ __forceinline__ unsigned xb_xcc_id() { return (unsigned)__builtin_amdgcn_s_getreg((3 << 11) | 20) & 0xFu; }
#define XB_SPIN(cond, bar) do { unsigned _sp = 0; while (cond) { __builtin_amdgcn_s_sleep(1); \
    if ((++_sp & 255u) == 0u) { if (xb_ld(&(bar)[XB_TMO])) break; if (_sp > XB_SPIN_CAP) { atomicAdd(&(bar)[XB_TMO], 1u); break; } } } } while (0)

struct XcdBarrier {
    unsigned* bar; unsigned x;
    volatile LAS unsigned* st;
};

__device__ __forceinline__ XcdBarrier xcd_barrier_post(unsigned* bar, volatile LAS unsigned* st) {
    XcdBarrier b; b.bar = bar; b.x = xb_xcc_id(); b.st = st;
    if (threadIdx.x == 0) (void)xb_add(&bar[XB_XCNT(b.x)], 1u);
    return b;
}
__device__ __forceinline__ void xcd_barrier_complete(unsigned* bar, unsigned x, unsigned& nloc, unsigned& nx) {
    const unsigned G = gridDim.x * gridDim.y * gridDim.z;
    unsigned sum, cnt, mine, sp = 0u;
    for (;;) {
        sum = 0u; cnt = 0u; mine = 0u;
#pragma unroll
        for (unsigned j = 0; j < 16; ++j) { const unsigned c = xb_ld(&bar[XB_XCNT(j)]); sum += c; cnt += (c > 0u) ? 1u : 0u; mine = (j == x) ? c : mine; }
        if (sum == G) break;
        __builtin_amdgcn_s_sleep(1);
        if ((++sp & 255u) == 0u) { if (xb_ld(&bar[XB_TMO])) break; if (sp > XB_SPIN_CAP) { atomicAdd(&bar[XB_TMO], 1u); break; } }
    }
    nloc = mine > 0u ? mine : 1u; nx = cnt > 0u ? cnt : 1u;
}

__device__ __forceinline__ void xcd_barrier(const XcdBarrier& b) {
    asm volatile("s_waitcnt vmcnt(0)" ::: "memory");
    __syncthreads();
    if (threadIdx.x == 0) {
        unsigned* bar = b.bar;
        __builtin_amdgcn_s_waitcnt(0);
        unsigned nloc = b.st[0], nx = b.st[1];
        if (nloc == 0u) { xcd_barrier_complete(bar, b.x, nloc, nx); b.st[0] = nloc; b.st[1] = nx; }
        const unsigned old = xb_add(&bar[XB_XSUB(b.x)], 1u);
        const unsigned gen = old / nloc;
        if (old + 1u == (gen + 1u) * nloc) {
            __builtin_amdgcn_fence(__ATOMIC_RELEASE, "agent");
            asm volatile("s_waitcnt vmcnt(0)" ::: "memory");
            const unsigned og = xb_add(&bar[XB_TOP], 1u);
            const unsigned tg = og / nx;
            if (og + 1u == (tg + 1u) * nx) xb_add(&bar[XB_TOPGEN], 1u);
            else XB_SPIN(xb_ld(&bar[XB_TOPGEN]) == tg, bar);
            __builtin_amdgcn_fence(__ATOMIC_ACQUIRE, "agent");
            xb_add(&bar[XB_XGEN(b.x)], 1u);
            asm volatile("s_waitcnt vmcnt(0)" ::: "memory");
        } else {
            XB_SPIN(xb_ld(&bar[XB_XGEN(b.x)]) == gen, bar);
            __builtin_amdgcn_fence(__ATOMIC_ACQUIRE, "agent");
            asm volatile("s_waitcnt vmcnt(0)" ::: "memory");
        }
    }
    __syncthreads();
}


namespace mk {
using pg8::bf16_t; using pg8::f32x4; using pg8::u32x4; using pg8::cvt_pk_bf16;
#define MKLAS __attribute__((address_space(3)))
typedef unsigned u32x2 __attribute__((ext_vector_type(2)));
typedef float f32x2 __attribute__((ext_vector_type(2)));

constexpr int D = 1024, T = 16384, LC = 256, L = T + LC, DEPTH = 2;
constexpr int NA = 4096, NB = 3584;
constexpr int NE = 32, DE = 256;
constexpr float EPS = 1e-6f;
constexpr int NT = 512, NW = 8;

constexpr size_t MiB = 1u << 20, QMiB = 1u << 18;
constexpr size_t WS_CTL = 0, CTL_BYTES = 1 * MiB;
constexpr size_t WS_MOD = 1 * MiB, WS_LB = WS_MOD + 128 * 1024, WS_ROPE = WS_MOD + 192 * 1024, WS_LGAM = WS_MOD + 256 * 1024, WS_WRT = WS_MOD + 512 * 1024;
constexpr size_t WS_AE = 2 * MiB, WS_AW = WS_AE + 256 * 1024, WS_APOS = WS_AE + 512 * 1024, WS_ROWW = WS_AE + 768 * 1024, WS_TILEE = WS_AE + 1024 * 1024, WS_ASLOT = WS_AE + 1280 * 1024;
constexpr size_t WS_CTX = 4 * MiB;
constexpr size_t WS_WIN = 5 * MiB, WS_WOHG = 20 * MiB, WS_WORET = 21 * MiB, WS_WOUT = 23 * MiB;
constexpr size_t WS_H = 25 * MiB;
constexpr size_t WS_QH = 58 * MiB, WS_VH = WS_QH + 65 * QMiB, WS_RQ = WS_VH + 65 * QMiB, WS_RK = WS_RQ + 65 * QMiB;
constexpr size_t WS_RV = 123 * MiB;
constexpr size_t WS_LF = WS_RV + 130 * QMiB;
constexpr size_t WS_OHG = WS_LF + 260 * QMiB;
constexpr size_t WS_ORT = WS_OHG + 65 * QMiB;
constexpr size_t WS_OF = WS_ORT + 130 * QMiB;
constexpr size_t WS_END = WS_OF + 390 * QMiB;
constexpr size_t WS_GA = WS_QH, WS_GB = WS_QH + 130 * QMiB;
constexpr size_t WS_M1 = WS_LF;
constexpr size_t WS_MB = WS_RV;
constexpr int CW_BAR = 4096, CW_CNT = 8192, CW_ECNT = 12288;

struct P { const float* in[24]; float* out; unsigned char* ws; int ph_lo, ph_hi; };
__device__ __forceinline__ unsigned char* ws_fresh(unsigned char* w) { asm volatile("" : "+s"(w)); return w; }
#define WSP(type, off) ((type*)(p.ws + (off)))

__device__ __forceinline__ float bf2f(bf16_t b) { return __uint_as_float(((unsigned)b) << 16); }
__device__ __forceinline__ bf16_t f2bf(float f) { return (bf16_t)(cvt_pk_bf16(f, 0.f) & 0xffffu); }
__device__ __forceinline__ float siluf(float x) { return x * __builtin_amdgcn_rcpf(1.f + __expf(-x)); }
__device__ __forceinline__ float sigmf(float x) { return __builtin_amdgcn_rcpf(1.f + __expf(-x)); }
__device__ __forceinline__ float wave_sum(float v) {
#pragma unroll
    for (int o = 1; o < 64; o <<= 1) v += __shfl_xor(v, o);
    return v;
}
__device__ __forceinline__ const float* xrow_in(const P& p, int l, int r) {
    if (l == 0) return r < LC ? p.in[2] + (size_t)r * D : p.in[0] + (size_t)(r - LC) * D;
    return r < LC ? WSP(float, WS_CTX) + (size_t)r * D : p.out + (size_t)(r - LC) * D;
}
__device__ __forceinline__ float* xrow_st(const P& p, int r) { return r < LC ? WSP(float, WS_CTX) + (size_t)r * D : p.out + (size_t)(r - LC) * D; }
__device__ __forceinline__ int seq_row(int dir, int i) { return dir == 0 ? i : (i < LC ? LC - 1 - i : L + LC - 1 - i); }

__device__ __forceinline__ void tr_item(const float* W, int K, int N, bf16_t* WT, int k0, int n0, int outrow0, MKLAS float* tile) {
    const int tid = tid_fresh(), r = tid >> 6, c = tid & 63;
#pragma unroll
    for (int i = 0; i < 8; ++i) tile[(r + 8 * i) * 65 + c] = W[(size_t)(k0 + r + 8 * i) * N + n0 + c];
    __syncthreads();
    const int nn = tid >> 3, kc = tid & 7;
    const MKLAS float* s = tile + (kc * 8) * 65 + nn;
    u32x4 o; o.x = cvt_pk_bf16(s[0], s[65]); o.y = cvt_pk_bf16(s[130], s[195]); o.z = cvt_pk_bf16(s[260], s[325]); o.w = cvt_pk_bf16(s[390], s[455]);
    *(u32x4*)(WT + (size_t)(outrow0 + nn) * K + k0 + kc * 8) = o;
    __syncthreads();
}
__device__ __forceinline__ int win_perm(int n) { return n < 2048 ? n : (n < 2560 ? 4096 + (n - 2048) : (n < 4608 ? 2048 + (n - 2560) : n)); }
constexpr int MIXER_ITEMS = 16 * 120 + 8 * 16 + 16 * 16 + 16 * 16;
__device__ __forceinline__ void mixer_item(const P& p, int l, int it, MKLAS float* tile) {
    constexpr int I_IN = 16 * 120, I_OHG = 8 * 16, I_ORT = 16 * 16;
    int r = it;
    if (r < I_IN) { const int kb = r / 120, nb = r % 120; tr_item(p.in[8] + (size_t)l * D * 7680, D, 7680, WSP(bf16_t, WS_WIN), kb * 64, nb * 64, win_perm(nb * 64), tile); return; } r -= I_IN;
    if (r < I_OHG) { const int kb = r / 16, nb = r % 16; tr_item(p.in[13] + (size_t)l * 512 * D, 512, D, WSP(bf16_t, WS_WOHG), kb * 64, nb * 64, nb * 64, tile); return; } r -= I_OHG;
    if (r < I_ORT) { const int kb = r / 16, nb = r % 16; tr_item(p.in[14] + (size_t)l * D * D, D, D, WSP(bf16_t, WS_WORET), kb * 64, nb * 64, nb * 64, tile); return; } r -= I_ORT;
    { const int kb = r / 16, nb = r % 16; tr_item(p.in[15] + (size_t)l * D * D, D, D, WSP(bf16_t, WS_WOUT), kb * 64, nb * 64, nb * 64, tile); }
}
__device__ __forceinline__ void convert_mixer_weights(const P& p, int l, MKLAS unsigned char* lds) {
    for (int it = blockIdx.x; it < MIXER_ITEMS; it += gridDim.x) mixer_item(p, l, it, (MKLAS float*)lds);
}

__device__ __forceinline__ void ph_hnorm(const P& p, int l) {
    const int tid_ = tid_fresh(), lane = tid_ & 63, wave = tid_ >> 6;
    const float* MOD = WSP(float, WS_MOD); bf16_t* H = WSP(bf16_t, WS_H);
    const float* nw = p.in[6] + l * D;
    for (int r = blockIdx.x * NW + wave; r < L; r += gridDim.x * NW) {
        const f32x4* xr = (const f32x4*)xrow_in(p, l, r) + lane;
        const float* mod = MOD + (l * 2 + (r < LC ? 1 : 0)) * 6144;
        f32x4 v[4]; float ss = 0.f;
#pragma unroll
        for (int j = 0; j < 4; ++j) { v[j] = xr[64 * j]; ss += (v[j].x * v[j].x + v[j].y * v[j].y) + (v[j].z * v[j].z + v[j].w * v[j].w); }
        const float rinv = 1.0f / sqrtf(wave_sum(ss) * (1.f / D) + EPS);
        u32x2* o = (u32x2*)(H + (size_t)r * D) + lane;
#pragma unroll
        for (int j = 0; j < 4; ++j) { const int c = 4 * (lane + 64 * j);
            const f32x4 w = *(const f32x4*)(nw + c), sh = *(const f32x4*)(mod + c), sc = *(const f32x4*)(mod + 1024 + c);
            const f32x4 h = v[j] * rinv * w * (sc + 1.0f) + sh;
            u32x2 q; q.x = cvt_pk_bf16(h.x, h.y); q.y = cvt_pk_bf16(h.z, h.w); o[64 * j] = q; }
    }
}

template <class F> struct EpiGen {
    static constexpr bool PERM = false, AFTER_DRAIN = false;
    F f;
    __device__ __forceinline__ void operator()(const f32x4 (&acc)[2][2][4][2], const pg8::Unit& u, int wr, int wc, int fr, int fq) const {
        const int row0 = u.pm * 256 + wr * 64 + fr, col0 = u.pn * 256 + wc * 32 + 4 * fq;
        if constexpr (!F::HAS_LOAD) {
            const typename F::R none{};
#pragma unroll
            for (int g = 0; g < 8; ++g)
#pragma unroll
                for (int q = 0; q < 4; ++q) f.apply(row0 + (g >> 2) * 128 + (g & 3) * 16, col0 + (q >> 1) * 128 + (q & 1) * 16, acc[g >> 2][q >> 1][g & 3][q & 1], none, u);
        } else {
            typename F::R cur[4], nxt[4];
#pragma unroll
            for (int q = 0; q < 4; ++q) cur[q] = f.load(row0, col0 + (q >> 1) * 128 + (q & 1) * 16, u);
            asm volatile("" ::: "memory");
#pragma unroll
            for (int g = 0; g < 8; ++g) {
                if (g < 7) {
#pragma unroll
                    for (int q = 0; q < 4; ++q) nxt[q] = f.load(row0 + ((g + 1) >> 2) * 128 + ((g + 1) & 3) * 16, col0 + (q >> 1) * 128 + (q & 1) * 16, u);
                }
                asm volatile("" ::: "memory");
#pragma unroll
                for (int q = 0; q < 4; ++q) f.apply(row0 + (g >> 2) * 128 + (g & 3) * 16, col0 + (q >> 1) * 128 + (q & 1) * 16, acc[g >> 2][q >> 1][g & 3][q & 1], cur[q], u);
                asm volatile("" ::: "memory");
#pragma unroll
                for (int q = 0; q < 4; ++q) cur[q] = nxt[q];
            }
        }
    }
};
struct NoRegs {};
__device__ __forceinline__ void st_bf4(bf16_t* dst, f32x4 v) { u32x2 q; q.x = cvt_pk_bf16(v.x, v.y); q.y = cvt_pk_bf16(v.z, v.w); *(u32x2*)dst = q; }
__device__ __forceinline__ f32x4 ld_bf4(const bf16_t* src) { const u32x2 q = *(const u32x2*)src; f32x4 v; v.x = __uint_as_float(q.x << 16); v.y = __uint_as_float(q.x & 0xffff0000u); v.z = __uint_as_float(q.y << 16); v.w = __uint_as_float(q.y & 0xffff0000u); return v; }

struct FnA {
    bf16_t *QH, *VH, *RQ, *RK, *RV; float* LF; const float* LB;
    static constexpr bool HAS_LOAD = false; typedef NoRegs R;
    __device__ __forceinline__ void operator()(int row, int col, f32x4 v, const pg8::Unit& u) const { apply(row, col, v, R{}, u); }
    __device__ __forceinline__ void apply(int row, int col, f32x4 v, const R&, const pg8::Unit& u) const {
        const int seg = u.pn >> 1;
        if (seg == 0) { f32x4 o; o.x = siluf(v.x); o.y = siluf(v.y); o.z = siluf(v.z); o.w = siluf(v.w); st_bf4(QH + (size_t)row * 512 + col, o * 0.08838834764831845f); }
        else if (seg == 1 || seg == 2) { const int dir = seg - 1, ch = col - seg * 512; const f32x4 lb = *(const f32x4*)(LB + dir * DEPTH * 512 + ch); f32x4 o;
#pragma unroll
            for (int j = 0; j < 4; ++j) { const float e = __expf(fminf(-v[j], 69.f));
                o[j] = fmaxf(__logf(1.f + lb[j] * e) - __logf(1.f + e), -69.0775528f); }
            *(f32x4*)(LF + (size_t)row * 1024 + dir * 512 + ch) = o; }
        else if (seg == 3) st_bf4(VH + (size_t)row * 512 + (col - 1536), v);
        else if (seg == 4) st_bf4(RQ + (size_t)row * 512 + (col - 2048), v * 0.08838834764831845f);
        else if (seg == 5) st_bf4(RK + (size_t)row * 512 + (col - 2560), v);
        else st_bf4(RV + (size_t)row * 1024 + (col - 3072), v);
    }
};
struct FnB {
    bf16_t *OHG, *ORT, *GA, *GB;
    static constexpr bool HAS_LOAD = true; typedef u32x2 R;
    __device__ __forceinline__ bf16_t* optr(int row, int col, int pn) const { return pn < 2 ? OHG + (size_t)row * 512 + col : ORT + (size_t)row * 1024 + (col - 512); }
    __device__ __forceinline__ R load(int row, int col, const pg8::Unit& u) const { if (u.pn < 6) return *(const u32x2*)optr(row, col, u.pn); return (u32x2){0u, 0u}; }
    __device__ __forceinline__ void apply(int row, int col, f32x4 v, const R& r, const pg8::Unit& u) const {
        const int pn = u.pn;
        if (pn < 6) { f32x4 s; s.x = siluf(v.x); s.y = siluf(v.y); s.z = siluf(v.z); s.w = siluf(v.w);
            st_bf4(optr(row, col, pn), (f32x4){__uint_as_float(r.x << 16), __uint_as_float(r.x & 0xffff0000u), __uint_as_float(r.y << 16), __uint_as_float(r.y & 0xffff0000u)} * s); }
        else { bf16_t* o = pn < 10 ? GA + (size_t)row * 1024 + (col - 1536) : GB + (size_t)row * 1024 + (col - 2560);
            f32x4 s; s.x = sigmf(v.x); s.y = sigmf(v.y); s.z = sigmf(v.z); s.w = sigmf(v.w); st_bf4(o, s); }
    }
};
__device__ __forceinline__ f32x4 bf4_to_f32(u32x2 q) { return (f32x4){__uint_as_float(q.x << 16), __uint_as_float(q.x & 0xffff0000u), __uint_as_float(q.y << 16), __uint_as_float(q.y & 0xffff0000u)}; }
struct FnM1 { const bf16_t* GA; float* M1;
    static constexpr bool HAS_LOAD = true; typedef u32x2 R;
    __device__ __forceinline__ R load(int row, int col, const pg8::Unit&) const { return *(const u32x2*)(GA + (size_t)row * D + col); }
    __device__ __forceinline__ void apply(int row, int col, f32x4 v, const R& r, const pg8::Unit&) const { *(f32x4*)(M1 + (size_t)row * D + col) = bf4_to_f32(r) * v; }
    __device__ __forceinline__ void operator()(int row, int col, f32x4 v, const pg8::Unit& u) const { apply(row, col, v, load(row, col, u), u); } };
struct RegsM2 { f32x4 m; u32x2 g; };
struct FnM2 { const bf16_t* GB; const float* M1; bf16_t* MB;
    static constexpr bool HAS_LOAD = true; typedef RegsM2 R;
    __device__ __forceinline__ R load(int row, int col, const pg8::Unit&) const { R r; r.m = *(const f32x4*)(M1 + (size_t)row * D + col); r.g = *(const u32x2*)(GB + (size_t)row * D + col); return r; }
    __device__ __forceinline__ void apply(int row, int col, f32x4 v, const R& r, const pg8::Unit&) const { st_bf4(MB + (size_t)row * D + col, r.m + bf4_to_f32(r.g) * v); }
    __device__ __forceinline__ void operator()(int row, int col, f32x4 v, const pg8::Unit& u) const { apply(row, col, v, load(row, col, u), u); } };
struct FnX { const float *xc_in, *xl_in; float *xc_out, *xl_out; const float* MODL;
    static constexpr bool HAS_LOAD = true; typedef f32x4 R;
    __device__ __forceinline__ R load(int row, int col, const pg8::Unit&) const { const bool isc = row < LC; return *(const f32x4*)((isc ? xc_in : xl_in) + (size_t)(isc ? row : row - LC) * D + col); }
    __device__ __forceinline__ void apply(int row, int col, f32x4 v, const R& x, const pg8::Unit&) const {
        const bool isc = row < LC;
        const f32x4 g = *(const f32x4*)(MODL + (isc ? 6144 : 0) + 2 * 1024 + col);
        *(f32x4*)((isc ? xc_out : xl_out) + (size_t)(isc ? row : row - LC) * D + col) = x + g * v; }
    __device__ __forceinline__ void operator()(int row, int col, f32x4 v, const pg8::Unit& u) const { apply(row, col, v, load(row, col, u), u); } };

__device__ __forceinline__ void ph_scan_naive(const P& p, int l, MKLAS unsigned char* lds) {
    const int tid = tid_fresh(), lane = tid & 63, wave = tid >> 6;
    MKLAS float* part = (MKLAS float*)lds;
    const bf16_t *QH = WSP(bf16_t, WS_QH), *VH = WSP(bf16_t, WS_VH), *RQ = WSP(bf16_t, WS_RQ), *RK = WSP(bf16_t, WS_RK), *RV = WSP(bf16_t, WS_RV);
    const float *LF = WSP(float, WS_LF), *RT = WSP(float, WS_ROPE), *LG = WSP(float, WS_LGAM);
    float* OF = WSP(float, WS_OF);
    for (int u = blockIdx.x; u < 192; u += gridDim.x) {
        const bool ret = u >= 64; const int h = ret ? (u - 64) / 32 : u / 16, es = ret ? (u - 64) % 32 : u % 16;
        const int d = tid & 127, eg = tid >> 7, e0 = es * 8 + eg * 2;
        const int obase = ret ? 512 + h * 256 + es * 8 : h * 128 + es * 8;
        const bool lower = (d & 63) < 32; const int dp = d ^ 32, ri = d & 31, half = d >> 6;
        for (int dir = 0; dir < 2; ++dir) {
            float S0 = 0.f, S1 = 0.f;
            const float gam = ret ? expf(LG[(l * 2 + dir) * 4 + h]) : 0.f;
            for (int i0 = 0; i0 < L; i0 += 8) {
                float qv[8], kv[8], fv[8], v0[8], v1[8];
#pragma unroll
                for (int s = 0; s < 8; ++s) { const int r = seq_row(dir, i0 + s);
                    if (!ret) { qv[s] = bf2f(QH[(size_t)r * 512 + h * 128 + d]); const float f = __expf(LF[(size_t)r * 1024 + dir * 512 + h * 128 + d]); fv[s] = f; kv[s] = 1.f - f;
                        const unsigned vv = *(const unsigned*)(VH + (size_t)r * 512 + h * 128 + e0); v0[s] = __uint_as_float(vv << 16); v1[s] = __uint_as_float(vv & 0xffff0000u); }
                    else { float q = bf2f(RQ[(size_t)r * 512 + h * 128 + d]), k = bf2f(RK[(size_t)r * 512 + h * 128 + d]);
                        if (r >= LC) { const int t = r - LC, pos = half ? (t & 63) : (t >> 6); const float cs = RT[(pos * 32 + ri) * 2], sn = RT[(pos * 32 + ri) * 2 + 1];
                            const float qp = bf2f(RQ[(size_t)r * 512 + h * 128 + dp]), kp = bf2f(RK[(size_t)r * 512 + h * 128 + dp]);
                            q = q * cs + (lower ? -qp : qp) * sn; k = k * cs + (lower ? -kp : kp) * sn; }
                        qv[s] = q; kv[s] = k; fv[s] = gam;
                        const unsigned vv = *(const unsigned*)(RV + (size_t)r * 1024 + h * 256 + e0); v0[s] = __uint_as_float(vv << 16); v1[s] = __uint_as_float(vv & 0xffff0000u); }
                }
#pragma unroll
                for (int s = 0; s < 8; ++s) { S0 = fv[s] * S0 + kv[s] * v0[s]; S1 = fv[s] * S1 + kv[s] * v1[s];
                    const float p0 = wave_sum(S0 * qv[s]), p1 = wave_sum(S1 * qv[s]);
                    if (lane == 0) { part[(s * 8 + wave) * 2] = p0; part[(s * 8 + wave) * 2 + 1] = p1; } }
                __syncthreads();
                if (tid < 64) { const int s = tid >> 3, egg = (tid >> 1) & 3, j = tid & 1;
                    const float val = part[(s * 8 + 2 * egg) * 2 + j] + part[(s * 8 + 2 * egg + 1) * 2 + j];
                    float* o = OF + (size_t)seq_row(dir, i0 + s) * 1536 + obase + egg * 2 + j;
                    if (dir == 0) *o = val; else *o += val; }
                __syncthreads();
            }
        }
    }
}
__device__ __forceinline__ void ph_onorm(const P& p, int l) {
    const int tid_ = tid_fresh(), lane = tid_ & 63, wave = tid_ >> 6;
    const float* OF = WSP(float, WS_OF); bf16_t *OHG = WSP(bf16_t, WS_OHG), *ORT = WSP(bf16_t, WS_ORT);
    const float *hw = p.in[10] + l * 512, *gw = p.in[12] + l * 1024;
    for (int r = blockIdx.x * NW + wave; r < L; r += gridDim.x * NW) {
        const float* o = OF + (size_t)r * 1536;
#pragma unroll
        for (int h = 0; h < 4; ++h) { const int c = h * 128 + lane * 2; const float a = o[c], b = o[c + 1];
            const float rinv = 1.0f / sqrtf(wave_sum(a * a + b * b) * (1.f / 128.f) + EPS);
            *(unsigned*)(OHG + (size_t)r * 512 + c) = cvt_pk_bf16(a * rinv * hw[c], b * rinv * hw[c + 1]); }
#pragma unroll
        for (int h = 0; h < 4; ++h) { const int c = h * 256 + lane * 4; f32x4 v = *(const f32x4*)(o + 512 + c);
            const float mu = wave_sum((v.x + v.y) + (v.z + v.w)) * (1.f / 256.f); v = v - mu;
            const float rinv = 1.0f / sqrtf(wave_sum((v.x * v.x + v.y * v.y) + (v.z * v.z + v.w * v.w)) * (1.f / 256.f) + EPS);
            st_bf4(ORT + (size_t)r * 1024 + c, v * rinv * *(const f32x4*)(gw + c)); }
    }
}


typedef short bf16x8 __attribute__((ext_vector_type(8)));
typedef short s16x4 __attribute__((ext_vector_type(4)));
#define MFMA16(a, b, c) __builtin_amdgcn_mfma_f32_16x16x32_bf16((a), (b), (c), 0, 0, 0)
constexpr size_t WS_STH = WS_OF, WS_STR = WS_OF + (size_t)8 * 65 * 16384 * 2, WS_ATOT = WS_OF + 49 * MiB;

__device__ __forceinline__ bf16x8 ld_frag_row(const MKLAS bf16_t* tile, int stride, int row0, int k0, int lane) {
    return *(const MKLAS bf16x8*)(tile + (row0 + (lane & 15)) * stride + k0 + 8 * (lane >> 4));
}
__device__ __forceinline__ bf16x8 ld_frag_tr(const MKLAS bf16_t* tile, int stride, int k0, int col0, int lane) {
    const int g = lane >> 4, q = (lane & 15) >> 2, pp = lane & 3;
    const MKLAS bf16_t* a = tile + (k0 + 8 * g + q) * stride + col0 + 4 * pp;
    const s16x4 lo = __builtin_amdgcn_ds_read_tr16_b64_v4i16((MKLAS s16x4*)a), hi = __builtin_amdgcn_ds_read_tr16_b64_v4i16((MKLAS s16x4*)(a + 4 * stride));
    return (bf16x8){lo[0], lo[1], lo[2], lo[3], hi[0], hi[1], hi[2], hi[3]};
}
__device__ __forceinline__ bf16x8 pack8(f32x4 a, f32x4 b) { u32x4 r; r.x = cvt_pk_bf16(a.x, a.y); r.y = cvt_pk_bf16(a.z, a.w); r.z = cvt_pk_bf16(b.x, b.y); r.w = cvt_pk_bf16(b.z, b.w); return __builtin_bit_cast(bf16x8, r); }
__device__ __forceinline__ float bflo(unsigned u) { return __uint_as_float(u << 16); }
__device__ __forceinline__ float bfhi(unsigned u) { return __uint_as_float(u & 0xffff0000u); }
__device__ __forceinline__ u32x4 scale_piece(u32x4 v, float s) { u32x4 r; r.x = cvt_pk_bf16(bflo(v.x) * s, bfhi(v.x) * s); r.y = cvt_pk_bf16(bflo(v.y) * s, bfhi(v.y) * s); r.z = cvt_pk_bf16(bflo(v.z) * s, bfhi(v.z) * s); r.w = cvt_pk_bf16(bflo(v.w) * s, bfhi(v.w) * s); return r; }

__device__ __forceinline__ void ph_rope(const P& p) {
    const int tid_ = tid_fresh(), lane = tid_ & 63, wave = tid_ >> 6;
    const float* RT = WSP(float, WS_ROPE);
    const int d0 = 8 * (lane & 15), half = d0 >> 6, i0 = d0 & 31; const bool lower = (d0 & 63) < 32;
    for (int r = LC + blockIdx.x * NW + wave; r < L; r += gridDim.x * NW) {
        const int t = r - LC, pos = half ? (t & 63) : (t >> 6);
        const f32x4* cs = (const f32x4*)(RT + (pos * 32 + i0) * 2);
        const f32x4 c0 = cs[0], c1 = cs[1], c2 = cs[2], c3 = cs[3];
        const float co[8] = {c0.x, c0.z, c1.x, c1.z, c2.x, c2.z, c3.x, c3.z}, si[8] = {c0.y, c0.w, c1.y, c1.w, c2.y, c2.w, c3.y, c3.w};
#pragma unroll
        for (int which = 0; which < 2; ++which) {
            u32x4* ptr = (u32x4*)((which ? WSP(bf16_t, WS_RK) : WSP(bf16_t, WS_RQ)) + (size_t)r * 512) + lane;
            const u32x4 v = *ptr; u32x4 pv;
            pv.x = __shfl_xor(v.x, 4); pv.y = __shfl_xor(v.y, 4); pv.z = __shfl_xor(v.z, 4); pv.w = __shfl_xor(v.w, 4);
            const unsigned vv[4] = {v.x, v.y, v.z, v.w}, pp[4] = {pv.x, pv.y, pv.z, pv.w}; unsigned oo[4];
#pragma unroll
            for (int k = 0; k < 4; ++k) {
                const float x0 = bflo(vv[k]), x1 = bfhi(vv[k]), q0 = bflo(pp[k]), q1 = bfhi(pp[k]);
                const float y0 = x0 * co[2 * k] + (lower ? -q0 : q0) * si[2 * k], y1 = x1 * co[2 * k + 1] + (lower ? -q1 : q1) * si[2 * k + 1];
                oo[k] = cvt_pk_bf16(y0, y1); }
            u32x4 o; o.x = oo[0]; o.y = oo[1]; o.z = oo[2]; o.w = oo[3]; *ptr = o;
        }
    }
}

template <bool RET, int MODE>
__device__ __forceinline__ void scan_unit(const P& p, int l, int h, int c, int dir, MKLAS unsigned char* lds) {
    constexpr int C = RET ? 64 : 32, NCH = 256 / C, NET = RET ? 2 : 1, DV = RET ? 256 : 128, QS = 136, VS = DV + 8, PS = C + 8, NTT = C / 16, NKS2 = C / 32;
    const int tid = tid_fresh(), lane = tid & 63, w = __builtin_amdgcn_readfirstlane(tid >> 6), r16 = lane & 15, quad = lane >> 4;
    MKLAS bf16_t* Qn = (MKLAS bf16_t*)lds; MKLAS bf16_t* Kn = Qn + C * QS; MKLAS bf16_t* Vn = Kn + C * QS; MKLAS bf16_t* Pm = Vn + C * VS;
    MKLAS float* TOT = (MKLAS float*)(Pm + C * PS); MKLAS float* E12 = TOT + 512; MKLAS float* RED = E12 + 256; MKLAS float* DQK = RED + 1024;
    const int e0 = 16 * NET * w, row0 = 256 * c, chain = dir * 4 + h;
    const bf16_t* Qg = RET ? WSP(bf16_t, WS_RQ) + h * 128 : WSP(bf16_t, WS_QH) + h * 128;
    const bf16_t* Kg = WSP(bf16_t, WS_RK) + h * 128;
    const bf16_t* Vg = RET ? WSP(bf16_t, WS_RV) + h * 256 : WSP(bf16_t, WS_VH) + h * 128;
    const float* LFg = WSP(float, WS_LF) + dir * 512 + h * 128;
    bf16_t* ST = RET ? WSP(bf16_t, WS_STR) + (((size_t)chain * 65 + c) << 15) : WSP(bf16_t, WS_STH) + (((size_t)chain * 65 + c) << 14);
    const float lg = RET ? WSP(float, WS_LGAM)[(l * 2 + dir) * 4 + h] : 0.f;
    if (RET && tid < 64) { DQK[2 * tid] = __expf((float)(tid + 1) * lg); DQK[2 * tid + 1] = __expf(-(float)(tid + 1) * lg); }
    const float e2s = RET ? __expf((float)C * lg) : 1.f;

    f32x4 Sacc[8][NET];
#pragma unroll
    for (int i = 0; i < 8; ++i)
#pragma unroll
        for (int n = 0; n < NET; ++n) {
            if (MODE == 0) Sacc[i][n] = (f32x4){0.f, 0.f, 0.f, 0.f};
            else { const u32x2 q = *(const u32x2*)(ST + (size_t)(e0 + 16 * n + r16) * 128 + 16 * i + 4 * quad); Sacc[i][n] = (f32x4){bflo(q.x), bfhi(q.x), bflo(q.y), bfhi(q.y)}; }
        }
    float btot = 0.f;
    float lfv[8]; unsigned short qv[8]; u32x4 hv = {0, 0, 0, 0};
    u32x4 qp[2], kp[2], vp[4];
    const int hd = tid & 127, hseg = tid >> 7;
#define TOKROW(pos) (row0 + (dir ? 255 - (pos) : (pos)))
#define LOAD_CHUNK(j) do { \
        if (!RET) { _Pragma("unroll") for (int ii = 0; ii < 8; ++ii) { const size_t rr = (size_t)TOKROW(C * (j) + 8 * hseg + ii); lfv[ii] = LFg[rr * 1024 + hd]; if (MODE != 0) qv[ii] = Qg[rr * 512 + hd]; } \
            { const size_t rr = (size_t)TOKROW(C * (j) + (tid >> 4)); hv = *(const u32x4*)(Vg + rr * 512 + 8 * (tid & 15)); } } \
        else { _Pragma("unroll") for (int m = 0; m < 2; ++m) { const int pc = tid + 512 * m; const size_t rr = (size_t)TOKROW(C * (j) + (pc >> 4)); \
                if (MODE != 0) qp[m] = *(const u32x4*)(Qg + rr * 512 + 8 * (pc & 15)); kp[m] = *(const u32x4*)(Kg + rr * 512 + 8 * (pc & 15)); } \
            _Pragma("unroll") for (int m = 0; m < 4; ++m) { const int pc = tid + 512 * m; const size_t rr = (size_t)TOKROW(C * (j) + (pc >> 5)); vp[m] = *(const u32x4*)(Vg + rr * 1024 + 8 * (pc & 31)); } } \
    } while (0)
    LOAD_CHUNK(0);
    if (MODE != 0) { for (int i = tid; i < C * PS / 8; i += NT) ((MKLAS u32x4*)Pm)[i] = (u32x4){0u, 0u, 0u, 0u}; }
    __syncthreads();
    for (int j = 0; j < NCH; ++j) {
        if (!RET) {
            float pl[8]; float run = 0.f;
#pragma unroll
            for (int ii = 0; ii < 8; ++ii) { run += lfv[ii]; pl[ii] = run; }
            TOT[hseg * 128 + hd] = run;
            __syncthreads();
            const float t0 = TOT[hd], t1 = TOT[128 + hd], t2 = TOT[256 + hd], t3 = TOT[384 + hd];
            const float off = hseg == 0 ? 0.f : (hseg == 1 ? t0 : (hseg == 2 ? t0 + t1 : t0 + t1 + t2));
            const float rref = t0 + t1, blast = (t0 + t1) + (t2 + t3);
#pragma unroll
            for (int ii = 0; ii < 8; ++ii) { const int pos = 8 * hseg + ii; const float b = off + pl[ii];
                const float kk = 1.f - __expf(lfv[ii]);
                Kn[pos * QS + hd] = f2bf(kk * __expf(fminf(rref - b, 60.f)));
                if (MODE != 0) Qn[pos * QS + hd] = f2bf(bf2f(qv[ii]) * __expf(fminf(b - rref, 60.f))); }
            if (hseg == 0) { E12[hd] = __expf(rref); E12[128 + hd] = __expf(blast - rref); btot += blast; }
            *(MKLAS u32x4*)(Vn + (tid >> 4) * VS + 8 * (tid & 15)) = hv;
        } else {
#pragma unroll
            for (int m = 0; m < 2; ++m) { const int pc = tid + 512 * m, pos = pc >> 4;
                *(MKLAS u32x4*)(Kn + pos * QS + 8 * (pc & 15)) = scale_piece(kp[m], DQK[2 * pos + 1]);
                if (MODE != 0) *(MKLAS u32x4*)(Qn + pos * QS + 8 * (pc & 15)) = scale_piece(qp[m], DQK[2 * pos]); }
#pragma unroll
            for (int m = 0; m < 4; ++m) { const int pc = tid + 512 * m; *(MKLAS u32x4*)(Vn + (pc >> 5) * VS + 8 * (pc & 31)) = vp[m]; }
        }
        if (j + 1 < NCH) LOAD_CHUNK(j + 1);
        __syncthreads();
        if (MODE != 0) {
            constexpr int NTILE = NTT * (NTT + 1) / 2;
#pragma unroll
            for (int rep = 0; rep < (NTILE + 7) / 8; ++rep) {
                const int q = w + 8 * rep;
                if (q < NTILE) {
                    int tt = 0, st = q;
#pragma unroll
                    for (int z = 1; z < NTT; ++z) if (q >= z * (z + 1) / 2) { tt = z; st = q - z * (z + 1) / 2; }
                    f32x4 sc = {0.f, 0.f, 0.f, 0.f};
#pragma unroll
                    for (int ks = 0; ks < 4; ++ks) sc = MFMA16(ld_frag_row(Qn, QS, 16 * tt, 32 * ks, lane), ld_frag_row(Kn, QS, 16 * st, 32 * ks, lane), sc);
#pragma unroll
                    for (int jj = 0; jj < 4; ++jj) { const bool keep = (st < tt) || (r16 <= 4 * quad + jj); Pm[(16 * tt + 4 * quad + jj) * PS + 16 * st + r16] = f2bf(keep ? sc[jj] : 0.f); }
                }
            }
            __syncthreads();
        }
        bf16x8 Vf[NKS2][NET];
#pragma unroll
        for (int k2 = 0; k2 < NKS2; ++k2)
#pragma unroll
            for (int n = 0; n < NET; ++n) Vf[k2][n] = ld_frag_tr(Vn, VS, 32 * k2, e0 + 16 * n, lane);
        if (!RET) {
#pragma unroll
            for (int i = 0; i < 8; ++i) { const f32x4 e1 = *(const MKLAS f32x4*)(E12 + 16 * i + 4 * quad);
#pragma unroll
                for (int n = 0; n < NET; ++n) Sacc[i][n] = Sacc[i][n] * e1; }
        }
        f32x4 oacc[NTT][NET];
        if (MODE != 0) {
#pragma unroll
            for (int tt = 0; tt < NTT; ++tt)
#pragma unroll
                for (int n = 0; n < NET; ++n) oacc[tt][n] = (f32x4){0.f, 0.f, 0.f, 0.f};
#pragma unroll
            for (int ks = 0; ks < 4; ++ks) {
                bf16x8 Bf[NET];
#pragma unroll
                for (int n = 0; n < NET; ++n) Bf[n] = pack8(Sacc[2 * ks][n], Sacc[2 * ks + 1][n]);
#pragma unroll
                for (int tt = 0; tt < NTT; ++tt) {
                    const MKLAS bf16_t* qa = Qn + (16 * tt + r16) * QS + 32 * ks + 4 * quad;
                    const s16x4 a0 = *(const MKLAS s16x4*)qa, a1 = *(const MKLAS s16x4*)(qa + 16);
                    const bf16x8 Af = (bf16x8){a0[0], a0[1], a0[2], a0[3], a1[0], a1[1], a1[2], a1[3]};
#pragma unroll
                    for (int n = 0; n < NET; ++n) oacc[tt][n] = MFMA16(Bf[n], Af, oacc[tt][n]);
                }
            }
#pragma unroll
            for (int k2 = 0; k2 < NKS2; ++k2)
#pragma unroll
                for (int tt = 0; tt < NTT; ++tt) {
                    if (32 * k2 > 16 * tt + 15) continue;
                    const bf16x8 Af = ld_frag_row(Pm, PS, 16 * tt, 32 * k2, lane);
#pragma unroll
                    for (int n = 0; n < NET; ++n) oacc[tt][n] = MFMA16(Vf[k2][n], Af, oacc[tt][n]);
                }
        }
#pragma unroll
        for (int i = 0; i < 8; ++i)
#pragma unroll
            for (int k2 = 0; k2 < NKS2; ++k2) { const bf16x8 Af = ld_frag_tr(Kn, QS, 32 * k2, 16 * i, lane);
#pragma unroll
                for (int n = 0; n < NET; ++n) Sacc[i][n] = MFMA16(Af, Vf[k2][n], Sacc[i][n]); }
#pragma unroll
        for (int i = 0; i < 8; ++i) { f32x4 e2; if (!RET) e2 = *(const MKLAS f32x4*)(E12 + 128 + 16 * i + 4 * quad); else e2 = (f32x4){e2s, e2s, e2s, e2s};
#pragma unroll
            for (int n = 0; n < NET; ++n) Sacc[i][n] = Sacc[i][n] * e2; }
        if (MODE != 0) {
            bf16_t* Og = (RET ? WSP(bf16_t, WS_ORT) + h * 256 : WSP(bf16_t, WS_OHG) + h * 128) + e0 + 4 * quad;
            constexpr int OS = RET ? 1024 : 512;
            if (MODE == 1) {
#pragma unroll
                for (int tt = 0; tt < NTT; ++tt) { const size_t rr = (size_t)TOKROW(C * j + 16 * tt + r16);
#pragma unroll
                    for (int n = 0; n < NET; ++n) st_bf4(Og + rr * OS + 16 * n, oacc[tt][n]); }
            } else {
#pragma unroll
                for (int tt = 0; tt < NTT; ++tt) { float s1 = 0.f, s2 = 0.f; const size_t rb = (size_t)TOKROW(C * j + 16 * tt + r16);
#pragma unroll
                    for (int n = 0; n < NET; ++n) { const u32x2 obv = *(const u32x2*)(Og + rb * OS + 16 * n); const f32x4 v = oacc[tt][n] + (f32x4){bflo(obv.x), bfhi(obv.x), bflo(obv.y), bfhi(obv.y)}; oacc[tt][n] = v;
                        s1 += (v.x + v.y) + (v.z + v.w); s2 += (v.x * v.x + v.y * v.y) + (v.z * v.z + v.w * v.w); }
                    s1 += __shfl_xor(s1, 16); s2 += __shfl_xor(s2, 16); s1 += __shfl_xor(s1, 32); s2 += __shfl_xor(s2, 32);
                    if (quad == 0) { RED[(w * 64 + 16 * tt + r16) * 2] = s1; RED[(w * 64 + 16 * tt + r16) * 2 + 1] = s2; } }
                __syncthreads();
                const float* nw = (RET ? p.in[12] + l * 1024 + h * 256 : p.in[10] + l * 512 + h * 128) + e0 + 4 * quad;
#pragma unroll
                for (int tt = 0; tt < NTT; ++tt) { const int tpos = 16 * tt + r16; const size_t rr = (size_t)TOKROW(C * j + tpos); float s1 = 0.f, s2 = 0.f;
#pragma unroll
                    for (int ww = 0; ww < 8; ++ww) { const f32x2 q = *(const MKLAS f32x2*)(RED + (ww * 64 + tpos) * 2); s1 += q.x; s2 += q.y; }
                    const float mean = RET ? s1 * (1.f / 256.f) : 0.f;
                    const float var = RET ? fmaxf(s2 * (1.f / 256.f) - mean * mean, 0.f) : s2 * (1.f / 128.f);
                    const float rinv = 1.0f / sqrtf(var + EPS);
#pragma unroll
                    for (int n = 0; n < NET; ++n) st_bf4(Og + rr * OS + 16 * n, (oacc[tt][n] - mean) * rinv * *(const f32x4*)(nw + 16 * n)); }
            }
        }
        if (RET) __syncthreads();
    }
    if (MODE == 0) {
#pragma unroll
        for (int i = 0; i < 8; ++i)
#pragma unroll
            for (int n = 0; n < NET; ++n) { u32x2 q; q.x = cvt_pk_bf16(Sacc[i][n].x, Sacc[i][n].y); q.y = cvt_pk_bf16(Sacc[i][n].z, Sacc[i][n].w);
                *(u32x2*)(ST + (size_t)(e0 + 16 * n + r16) * 128 + 16 * i + 4 * quad) = q; }
        if (!RET && hseg == 0) WSP(float, WS_ATOT)[((size_t)chain * 65 + c) * 128 + hd] = __expf(btot);
    }
#undef LOAD_CHUNK
#undef TOKROW
}

__device__ __forceinline__ int next_unit(unsigned* ctr, volatile MKLAS int* slot) {
    __syncthreads();
    if (threadIdx.x == 0) *slot = (int)__hip_atomic_fetch_add(ctr, 1u, __ATOMIC_RELAXED, __HIP_MEMORY_SCOPE_AGENT);
    __syncthreads();
    return *slot;
}
__device__ __forceinline__ void ph_scan_pass1(const P& p, int l, MKLAS unsigned char* lds, unsigned* ctr, volatile MKLAS int* slot) {
    for (;;) { const int u = next_unit(ctr, slot); if (u >= 1040) break;
        const bool ret = u < 520; const int v = ret ? u : u - 520, dir = v / 260, rem = v % 260, h = rem / 65, c = rem % 65;
        if (ret) scan_unit<true, 0>(p, l, h, c, dir, lds); else scan_unit<false, 0>(p, l, h, c, dir, lds); }
}
template <int MODE> __device__ __forceinline__ void ph_scan_pass3(const P& p, int l, MKLAS unsigned char* lds, unsigned* ctr, volatile MKLAS int* slot) {
    const bool skipc = (l == DEPTH - 1);
    const int nc = skipc ? 64 : 65, nu = 4 * nc;
    for (;;) { const int u = next_unit(ctr, slot); if (u >= 2 * nu) break;
        const bool ret = u < nu; const int v = ret ? u : u - nu, h = v / nc, c = v % nc + (skipc ? 1 : 0);
        if (ret) scan_unit<true, MODE>(p, l, h, c, MODE == 1 ? 1 : 0, lds); else scan_unit<false, MODE>(p, l, h, c, MODE == 1 ? 1 : 0, lds); }
}
__device__ __forceinline__ void ph_scan_pass2(const P& p, int l) {
    const int tid = tid_fresh();
    const float* LG = WSP(float, WS_LGAM); const float* AT = WSP(float, WS_ATOT);
    for (int item = blockIdx.x * NT + tid; item < 32768 + 65536; item += gridDim.x * NT) {
        const bool ret = item >= 32768; const int it = ret ? item - 32768 : item, per = ret ? 8192 : 4096, chain = it / per, q4 = it % per, dir = chain >> 2, h = chain & 3, dd = (q4 * 4) & 127;
        bf16_t* base = (ret ? WSP(bf16_t, WS_STR) : WSP(bf16_t, WS_STH)) + (size_t)chain * 65 * (per * 4) + (size_t)q4 * 4;
        const float ar = ret ? __expf(256.f * LG[(l * 2 + dir) * 4 + h]) : 0.f;
        f32x4 S = {0.f, 0.f, 0.f, 0.f};
        for (int b0 = 0; b0 < 65; b0 += 13) {
            u32x2 U[13]; f32x4 A[13];
#pragma unroll
            for (int s = 0; s < 13; ++s) { const int step = b0 + s, c = dir == 0 ? step : (step == 0 ? 0 : 65 - step);
                U[s] = *(const u32x2*)(base + (size_t)c * (per * 4));
                A[s] = ret ? (f32x4){ar, ar, ar, ar} : *(const f32x4*)(AT + ((size_t)chain * 65 + c) * 128 + dd); }
#pragma unroll
            for (int s = 0; s < 13; ++s) { const int step = b0 + s, c = dir == 0 ? step : (step == 0 ? 0 : 65 - step);
                u32x2 o; o.x = cvt_pk_bf16(S.x, S.y); o.y = cvt_pk_bf16(S.z, S.w); *(u32x2*)(base + (size_t)c * (per * 4)) = o;
                S = A[s] * S + (f32x4){bflo(U[s].x), bfhi(U[s].x), bflo(U[s].y), bfhi(U[s].y)}; }
        }
    }
}

__device__ __forceinline__ void ph_router(const P& p, int l, MKLAS unsigned char* lds, unsigned* ecnt) {
    const int tid_ = tid_fresh(), lane = tid_ & 63, wave = __builtin_amdgcn_readfirstlane(tid_ >> 6), r16 = lane & 15, g = lane >> 4;
    MKLAS float* lg = (MKLAS float*)lds + wave * (16 * 52);
    const float* MOD = WSP(float, WS_MOD); bf16_t* H = WSP(bf16_t, WS_H);
    int* AE = WSP(int, WS_AE); float* AW = WSP(float, WS_AW); int* APOS = WSP(int, WS_APOS);
    const float* nw = p.in[7] + l * D + 4 * g;
    const float* WRT = WSP(float, WS_WRT) + (size_t)l * 48 * 1024 + (size_t)r16 * 1024 + 4 * g;
    const float *bg = p.in[17] + l * 4, *be = p.in[19] + l * NE;
    const int r_lo = (l == DEPTH - 1) ? LC : 0, ntile = (L - r_lo) / 16;
    for (int t = blockIdx.x + gridDim.x * wave; t < ntile; t += gridDim.x * NW) {
        const int r = r_lo + 16 * t + r16;
        const float* xr = xrow_st(p, r) + 4 * g;
        const float* mod = MOD + (l * 2 + (r < LC ? 1 : 0)) * 6144 + 4 * g;
        float ss = 0.f;
#pragma unroll 8
        for (int m = 0; m < 64; ++m) { const f32x4 x = *(const f32x4*)(xr + 16 * m); ss += (x.x * x.x + x.y * x.y) + (x.z * x.z + x.w * x.w); }
        ss += __shfl_xor(ss, 16); ss += __shfl_xor(ss, 32);
        const float rinv = 1.0f / sqrtf(ss * (1.f / D) + EPS);
        f32x4 acc[3];
#pragma unroll
        for (int nt = 0; nt < 3; ++nt) acc[nt] = (f32x4){0.f, 0.f, 0.f, 0.f};
        bf16_t* ho = H + (size_t)r * D + 4 * g;
#pragma unroll 4
        for (int m = 0; m < 64; ++m) {
            const f32x4 x = *(const f32x4*)(xr + 16 * m), w = *(const f32x4*)(nw + 16 * m), sh = *(const f32x4*)(mod + 3 * 1024 + 16 * m), sc = *(const f32x4*)(mod + 4 * 1024 + 16 * m);
            const f32x4 h = x * rinv * w * (sc + 1.0f) + sh;
            st_bf4(ho + 16 * m, h);
#pragma unroll
            for (int nt = 0; nt < 3; ++nt) { const f32x4 b = *(const f32x4*)(WRT + (size_t)nt * 16 * 1024 + 16 * m);
#pragma unroll
                for (int j = 0; j < 4; ++j) acc[nt] = __builtin_amdgcn_mfma_f32_16x16x4f32(h[j], b[j], acc[nt], 0, 0, 0); }
        }
#pragma unroll
        for (int nt = 0; nt < 3; ++nt)
#pragma unroll
            for (int j = 0; j < 4; ++j) lg[(4 * g + j) * 52 + 16 * nt + r16] = acc[nt][j];
        asm volatile("s_waitcnt lgkmcnt(0)" ::: "memory");
        if (lane < 16) {
            const MKLAS float* my = lg + lane * 52;
            float gl[4];
#pragma unroll
            for (int q = 0; q < 4; ++q) gl[q] = my[32 + q] + bg[q];
            int grp = 0; float gm = gl[0];
#pragma unroll
            for (int q = 1; q < 4; ++q) if (gl[q] > gm) { gm = gl[q]; grp = q; }
            float gs = 0.f;
#pragma unroll
            for (int q = 0; q < 4; ++q) gs += expf(gl[q] - gm);
            const float gval = 1.0f / gs;
            float el[8];
#pragma unroll
            for (int j = 0; j < 8; ++j) el[j] = my[grp * 8 + j] + be[grp * 8 + j];
            int i1 = 0; float v1 = el[0];
#pragma unroll
            for (int j = 1; j < 8; ++j) if (el[j] > v1) { v1 = el[j]; i1 = j; }
            int i2 = -1; float v2 = -3.0e38f;
#pragma unroll
            for (int j = 0; j < 8; ++j) if (j != i1 && el[j] > v2) { v2 = el[j]; i2 = j; }
            const float e2 = expf(v2 - v1), w1 = 1.0f / (1.0f + e2), w2 = e2 / (1.0f + e2);
            const int ea0 = grp * 8 + i1, ea1 = grp * 8 + i2, rr = r_lo + 16 * t + lane;
            AE[2 * rr] = ea0; AE[2 * rr + 1] = ea1; AW[2 * rr] = gval * w1; AW[2 * rr + 1] = gval * w2;
            APOS[2 * rr] = (int)__hip_atomic_fetch_add(ecnt + 16 * ea0, 1u, __ATOMIC_RELAXED, __HIP_MEMORY_SCOPE_AGENT);
            APOS[2 * rr + 1] = (int)__hip_atomic_fetch_add(ecnt + 16 * ea1, 1u, __ATOMIC_RELAXED, __HIP_MEMORY_SCOPE_AGENT);
        }
        asm volatile("s_waitcnt lgkmcnt(0)" ::: "memory");
    }
}
constexpr int XG_ROWS = 41472;
constexpr size_t WS_WGU = WS_OF, WS_WD = WS_OF + 32 * MiB;
constexpr size_t WS_XG = WS_QH, WS_ACT = WS_XG + (size_t)XG_ROWS * 2048, WS_YA = 160 * MiB;
static_assert(WS_ACT + (size_t)XG_ROWS * 512 <= WS_YA && WS_YA + (size_t)XG_ROWS * 2048 <= WS_OF, "MoE overlays");
constexpr int EXPERT_ITEMS = 3 * 2048;
__device__ __forceinline__ void expert_item(const P& p, int l, int it, MKLAS float* tile) {
    const int which = it >> 11, r = it & 2047, e = r >> 6, q = r & 63;
    if (which < 2) { const int kb = q >> 2, nb = q & 3, n0 = nb * 64;
        tr_item(p.in[20 + which] + ((size_t)l * NE + e) * D * DE, D, DE, WSP(bf16_t, WS_WGU) + (size_t)e * 512 * D, kb * 64, n0, (n0 >> 7) * 256 + which * 128 + (n0 & 127), tile); }
    else { const int kb = q >> 4, nb = q & 15;
        tr_item(p.in[22] + ((size_t)l * NE + e) * DE * D, DE, D, WSP(bf16_t, WS_WD) + (size_t)e * D * DE, kb * 64, nb * 64, nb * 64, tile); }
}
template <bool EXPERTS> __device__ __forceinline__ void fill_convert(const P& p, int l, MKLAS unsigned char* lds, unsigned* ctr, volatile MKLAS int* slot) {
    for (;;) { const int it = next_unit(ctr, slot); if (it >= (EXPERTS ? EXPERT_ITEMS : MIXER_ITEMS)) break;
        if (EXPERTS) expert_item(p, l, it, (MKLAS float*)lds); else mixer_item(p, l, it, (MKLAS float*)lds); }
}
__device__ __forceinline__ void ph_moe_scatter(const P& p, int l, MKLAS unsigned char* lds) {
    const int tid = tid_fresh(), lane = tid & 63, wave = tid >> 6;
    MKLAS int* off = (MKLAS int*)lds;
    const unsigned* ecnt = (const unsigned*)(p.ws + WS_CTL) + CW_ECNT + l * NE * 16;
    if (tid == 0) { int o = 0; for (int e = 0; e < NE; ++e) { off[e] = o; o += (int)((__hip_atomic_load(ecnt + 16 * e, __ATOMIC_RELAXED, __HIP_MEMORY_SCOPE_AGENT) + 255u) & ~255u); } off[NE] = o; }
    __syncthreads();
    if (blockIdx.x == 0) { int* TE = WSP(int, WS_TILEE); const int nt = off[NE] >> 8;
        if (tid == 0) TE[255] = nt;
        for (int t = tid; t < nt; t += NT) { int e = 0; for (int k = 1; k < NE; ++k) if (t * 256 >= off[k]) e = k; TE[t] = e; } }
    const int* AE = WSP(int, WS_AE); const int* APOS = WSP(int, WS_APOS); const float* AW = WSP(float, WS_AW);
    int* ASLOT = WSP(int, WS_ASLOT); float* ROWW = WSP(float, WS_ROWW);
    const bf16_t* H = WSP(bf16_t, WS_H); bf16_t* XG = WSP(bf16_t, WS_XG);
    const int a_lo = (l == DEPTH - 1) ? 2 * LC : 0;
    for (int a = a_lo + blockIdx.x * NW + wave; a < 2 * L; a += gridDim.x * NW) {
        const int slot = off[AE[a]] + APOS[a];
        const u32x4* src = (const u32x4*)(H + (size_t)(a >> 1) * D) + lane; u32x4* dst = (u32x4*)(XG + (size_t)slot * D) + lane;
        dst[0] = src[0]; dst[64] = src[64];
        if (lane == 0) { ASLOT[a] = slot; ROWW[slot] = AW[a]; }
    }
}
struct MoeOrder { const int* tile_e; int ntiles, nN, G, c;
    __device__ __forceinline__ bool next(int i, pg8::Unit& u) const { const long Lx = (long)i * G + c; if (Lx >= (long)ntiles * nN) return false; u.pm = (int)(Lx / nN); u.pn = (int)(Lx % nN); u.be = tile_e[u.pm]; return true; }
    __device__ __forceinline__ void a_ready(const pg8::Unit&) const {}
    __device__ __forceinline__ void done(const pg8::Unit&) const {} };
struct EpiGU { static constexpr bool PERM = false, AFTER_DRAIN = false; bf16_t* ACT;
    __device__ __forceinline__ void operator()(const f32x4 (&acc)[2][2][4][2], const pg8::Unit& u, int wr, int wc, int fr, int fq) const {
        const int row0 = u.pm * 256 + wr * 64 + fr, col0 = u.pn * 128 + wc * 32 + 4 * fq;
#pragma unroll
        for (int ai = 0; ai < 2; ++ai)
#pragma unroll
            for (int m = 0; m < 4; ++m)
#pragma unroll
                for (int n = 0; n < 2; ++n) { const f32x4 g = acc[ai][0][m][n], up = acc[ai][1][m][n]; f32x4 a;
#pragma unroll
                    for (int j = 0; j < 4; ++j) a[j] = siluf(g[j]) * up[j];
                    st_bf4(ACT + (size_t)(row0 + ai * 128 + m * 16) * DE + col0 + n * 16, a); }
    } };
struct FnYA { const float* ROWW; bf16_t* YA;
    static constexpr bool HAS_LOAD = false; typedef NoRegs R;
    __device__ __forceinline__ void apply(int row, int col, f32x4 v, const R&, const pg8::Unit&) const { st_bf4(YA + (size_t)row * D + col, v * ROWW[row]); } };
__device__ __forceinline__ void ph_moe_combine(const P& p, int l) {
    const int tid_ = tid_fresh(), lane = tid_ & 63, wave = tid_ >> 6;
    const float* MOD = WSP(float, WS_MOD); const bf16_t* YA = WSP(bf16_t, WS_YA); const int* ASLOT = WSP(int, WS_ASLOT); bf16_t* H = WSP(bf16_t, WS_H);
    const bool last = (l == DEPTH - 1);
    const float* nw = last ? p.in[23] : p.in[6] + (l + 1) * D;
    for (int r = (last ? LC : 0) + blockIdx.x * NW + wave; r < L; r += gridDim.x * NW) {
        const int isc = r < LC ? 1 : 0;
        const float* g2 = MOD + (l * 2 + isc) * 6144 + 5 * 1024;
        float* xo = xrow_st(p, r);
        const u32x2* ya = (const u32x2*)(YA + (size_t)ASLOT[2 * r] * D) + lane; const u32x2* yb = (const u32x2*)(YA + (size_t)ASLOT[2 * r + 1] * D) + lane;
        f32x4 v[4]; float ss = 0.f;
#pragma unroll
        for (int j = 0; j < 4; ++j) { const int c = 4 * (lane + 64 * j); const u32x2 a = ya[64 * j], b = yb[64 * j];
            const f32x4 y = (f32x4){bflo(a.x) + bflo(b.x), bfhi(a.x) + bfhi(b.x), bflo(a.y) + bflo(b.y), bfhi(a.y) + bfhi(b.y)};
            v[j] = *(const f32x4*)(xo + c) + *(const f32x4*)(g2 + c) * y;
            ss += (v[j].x * v[j].x + v[j].y * v[j].y) + (v[j].z * v[j].z + v[j].w * v[j].w); }
        const float rinv = 1.0f / sqrtf(wave_sum(ss) * (1.f / D) + EPS);
        if (last) {
#pragma unroll
            for (int j = 0; j < 4; ++j) { const int c = 4 * (lane + 64 * j); *(f32x4*)(xo + c) = v[j] * rinv * *(const f32x4*)(nw + c); }
        } else {
            const float* mod = MOD + ((l + 1) * 2 + isc) * 6144;
            u32x2* o = (u32x2*)(H + (size_t)r * D) + lane;
#pragma unroll
            for (int j = 0; j < 4; ++j) { const int c = 4 * (lane + 64 * j); *(f32x4*)(xo + c) = v[j];
                const f32x4 hh = v[j] * rinv * *(const f32x4*)(nw + c) * (*(const f32x4*)(mod + 1024 + c) + 1.0f) + *(const f32x4*)(mod + c);
                u32x2 q; q.x = cvt_pk_bf16(hh.x, hh.y); q.y = cvt_pk_bf16(hh.z, hh.w); o[64 * j] = q; }
        }
    }
}

__device__ __forceinline__ void ph_moe_naive(const P& p, int l, MKLAS unsigned char* lds) {
    const int tid = tid_fresh();
    MKLAS float* hs = (MKLAS float*)lds; MKLAS float* gu = hs + 1024; MKLAS float* act = gu + 512;
    const float* MOD = WSP(float, WS_MOD); const bf16_t* H = WSP(bf16_t, WS_H);
    const int* AE = WSP(int, WS_AE); const float* AW = WSP(float, WS_AW);
    const int r_lo = (l == DEPTH - 1) ? LC : 0;
    for (int r = r_lo + blockIdx.x; r < L; r += gridDim.x) {
        for (int i = tid; i < 1024; i += NT) hs[i] = bf2f(H[(size_t)r * D + i]);
        __syncthreads();
        float y0 = 0.f, y1 = 0.f;
        for (int k = 0; k < 2; ++k) {
            const int e = AE[2 * r + k]; const float w = AW[2 * r + k];
            const float* Wx = (tid < 256 ? p.in[20] : p.in[21]) + ((size_t)l * NE + e) * D * DE + (tid & 255);
            float a = 0.f;
#pragma unroll 8
            for (int dd = 0; dd < D; ++dd) a += hs[dd] * Wx[(size_t)dd * DE];
            gu[tid] = a;
            __syncthreads();
            if (tid < 256) act[tid] = siluf(gu[tid]) * gu[256 + tid];
            __syncthreads();
            const float* Wd = p.in[22] + ((size_t)l * NE + e) * DE * D + tid;
            float b0 = 0.f, b1 = 0.f;
#pragma unroll 8
            for (int j = 0; j < DE; ++j) { const float a2 = act[j]; b0 += a2 * Wd[(size_t)j * D]; b1 += a2 * Wd[(size_t)j * D + 512]; }
            y0 += w * b0; y1 += w * b1;
            __syncthreads();
        }
        const float* g2 = MOD + (l * 2 + (r < LC ? 1 : 0)) * 6144 + 5 * 1024;
        float* xo = xrow_st(p, r);
        xo[tid] += g2[tid] * y0; xo[tid + 512] += g2[tid + 512] * y1;
    }
}
__device__ __forceinline__ void ph_final(const P& p) {
    const int tid_ = tid_fresh(), lane = tid_ & 63, wave = tid_ >> 6;
    const float* nw = p.in[23];
    for (int r = blockIdx.x * NW + wave; r < T; r += gridDim.x * NW) {
        f32x4* xr = (f32x4*)(p.out + (size_t)r * D) + lane;
        f32x4 v[4]; float ss = 0.f;
#pragma unroll
        for (int j = 0; j < 4; ++j) { v[j] = xr[64 * j]; ss += (v[j].x * v[j].x + v[j].y * v[j].y) + (v[j].z * v[j].z + v[j].w * v[j].w); }
        const float rinv = 1.0f / sqrtf(wave_sum(ss) * (1.f / D) + EPS);
#pragma unroll
        for (int j = 0; j < 4; ++j) xr[64 * j] = v[j] * rinv * *(const f32x4*)(nw + 4 * (lane + 64 * j));
    }
}

constexpr int LDS_BYTES = 147456, LDS_CTL = 131072;
constexpr int NPH_LAYER = 16, NPH = 1 + DEPTH * NPH_LAYER;

__device__ __forceinline__ void ph_prologue(const P& p, MKLAS unsigned char* lds) {
    const int tid = tid_fresh(), b = blockIdx.x, G = gridDim.x;
    MKLAS float* s0 = (MKLAS float*)lds;
    MKLAS float* red = s0 + 2048;
    for (int i = tid; i < 1024; i += NT) { s0[i] = siluf(p.in[1][i]); s0[1024 + i] = siluf(p.in[3][i]); }
    __syncthreads();
    float* MOD = WSP(float, WS_MOD);
    for (int u = b; u < DEPTH * 96; u += G) {
        const int l = u / 96, n0 = (u % 96) * 64, c = tid & 63, ks = tid >> 6;
        const float* W = p.in[4] + (size_t)l * 1024 * 6144 + n0 + c;
        float a0 = 0.f, a1 = 0.f;
#pragma unroll 8
        for (int i = 0; i < 128; ++i) { const int k = ks * 128 + i; const float w = W[(size_t)k * 6144]; a0 += s0[k] * w; a1 += s0[1024 + k] * w; }
        red[(ks * 64 + c) * 2] = a0; red[(ks * 64 + c) * 2 + 1] = a1;
        __syncthreads();
        if (tid < 128) { const int cc = tid & 63, w = tid >> 6; float s = 0.f;
#pragma unroll
            for (int k2 = 0; k2 < 8; ++k2) s += red[(k2 * 64 + cc) * 2 + w];
            MOD[(l * 2 + w) * 6144 + n0 + cc] = s + p.in[5][l * 6144 + n0 + cc]; }
        __syncthreads();
    }
    if (b == G - 1) {
        float* LB = WSP(float, WS_LB);
        for (int idx = tid; idx < 2 * 512; idx += NT) { const int dir = idx >> 9, ch = idx & 511;
            float x[DEPTH], m = -3.0e38f;
#pragma unroll
            for (int l = 0; l < DEPTH; ++l) { x[l] = p.in[9][(dir * DEPTH + l) * 512 + ch]; m = fmaxf(m, x[l]); }
            float s = 0.f;
#pragma unroll
            for (int l = 0; l < DEPTH; ++l) { x[l] = expf(x[l] - m); s += x[l]; }
            float cum = 0.f; const float p0 = x[0] / s;
#pragma unroll
            for (int l = 0; l < DEPTH; ++l) { cum += x[l] / s; LB[(dir * DEPTH + l) * 512 + ch] = fminf(fmaxf(cum - p0, 0.f), 1.0f - 1e-6f); } }
    }
    if (b == (G > 1 ? G - 2 : 0)) {
        float* RT = WSP(float, WS_ROPE);
        for (int idx = tid; idx < 256 * 32; idx += NT) { const int pos = idx >> 5, i = idx & 31;
            double bp = 1.0; for (int q = 0; q < i; ++q) bp *= 0.7498942093324559;
            const float inv = (float)bp; const float ang = (float)pos * inv;
            const double a = (double)ang, n = rint(a * 0.15915494309189535), r = a - n * 6.283185307179586, r2 = r * r;
            double ts = r, tc = 1.0, sn = r, cs = 1.0;
            for (int k = 1; k <= 14; ++k) { tc *= -r2 / (double)((2 * k - 1) * (2 * k)); cs += tc; ts *= -r2 / (double)((2 * k) * (2 * k + 1)); sn += ts; }
            RT[idx * 2] = (float)cs; RT[idx * 2 + 1] = (float)sn; }
    }
    if (b == (G > 2 ? G - 3 : 0)) {
        float* LG = WSP(float, WS_LGAM);
        if (tid < DEPTH * 2 * 4) LG[tid] = -log1pf(expf(-p.in[11][tid]));
    }
    { float* WRT = WSP(float, WS_WRT);
        for (int idx = b * NT + tid; idx < DEPTH * 48 * 1024; idx += G * NT) { const int l = idx / (48 * 1024), n = (idx >> 10) % 48, k = idx & 1023;
            WRT[idx] = n < 32 ? p.in[18][((size_t)l * D + k) * NE + n] : (n < 36 ? p.in[16][((size_t)l * D + k) * 4 + (n - 32)] : 0.f); } }
    fill_convert<false>(p, 0, lds, (unsigned*)(p.ws + WS_CTL) + CW_CNT + 64 * 12, (volatile MKLAS int*)(lds + LDS_CTL + 8));
}


template <class F> __device__ __forceinline__ void ctx_gemm(MKLAS unsigned char* lds, const bf16_t* A, const bf16_t* Bt, int N, int K, const F& f) {
    const int tid = tid_fresh(), lane = tid & 63, w = __builtin_amdgcn_readfirstlane(tid >> 6), r16 = lane & 15, g = lane >> 4;
    const int br = w & 1, bc = (w >> 1) & 1, kh = w >> 2;
    MKLAS f32x4* red = (MKLAS f32x4*)lds;
    const int nitems = 4 * (N / 64), kspan = K / 2;
    for (int it = blockIdx.x; it < nitems; it += gridDim.x) {
        const int ir = it & 3, ic = it >> 2;
        const bf16_t* ap = A + (size_t)(64 * ir + 32 * br + r16) * K + kh * kspan + 8 * g;
        const bf16_t* bp = Bt + (size_t)(64 * ic + 32 * bc + r16) * K + kh * kspan + 8 * g;
        f32x4 acc[2][2];
#pragma unroll
        for (int i = 0; i < 2; ++i)
#pragma unroll
            for (int jn = 0; jn < 2; ++jn) acc[i][jn] = (f32x4){0.f, 0.f, 0.f, 0.f};
#pragma unroll 8
        for (int ks = 0; ks < kspan / 32; ++ks) {
            const bf16x8 a0 = *(const bf16x8*)(ap + 32 * ks), a1 = *(const bf16x8*)(ap + (size_t)16 * K + 32 * ks);
            const bf16x8 b0 = *(const bf16x8*)(bp + 32 * ks), b1 = *(const bf16x8*)(bp + (size_t)16 * K + 32 * ks);
            acc[0][0] = MFMA16(b0, a0, acc[0][0]); acc[0][1] = MFMA16(b1, a0, acc[0][1]); acc[1][0] = MFMA16(b0, a1, acc[1][0]); acc[1][1] = MFMA16(b1, a1, acc[1][1]);
        }
        if (kh) {
#pragma unroll
            for (int i = 0; i < 2; ++i)
#pragma unroll
                for (int jn = 0; jn < 2; ++jn) red[((w - 4) * 4 + i * 2 + jn) * 64 + lane] = acc[i][jn];
        }
        __syncthreads();
        if (!kh) { pg8::Unit u; u.pm = 0; u.pn = (64 * ic) >> 8; u.be = 0;
#pragma unroll
            for (int i = 0; i < 2; ++i)
#pragma unroll
                for (int jn = 0; jn < 2; ++jn) f(64 * ir + 32 * br + 16 * i + r16, 64 * ic + 32 * bc + 16 * jn + 4 * g, acc[i][jn] + red[(w * 4 + i * 2 + jn) * 64 + lane], u); }
        __syncthreads();
    }
}
struct LatentOrder : pg8::StaticOrder {
    __device__ __forceinline__ bool next(int i, pg8::Unit& u) const { if (!pg8::StaticOrder::next(i, u)) return false; u.pm += 1; return true; } };
template <class F> __device__ __forceinline__ void run_gemm_latent(MKLAS unsigned char* lds, const bf16_t* A, const bf16_t* Bt, int N, int K, const F& f) {
    pg8::Gemm g{A, Bt, L, N, K, 0}; LatentOrder S; S.init(T, N, (int)gridDim.x, (int)blockIdx.x);
    EpiGen<F> E{f};
    pg8::gemm_phase<EpiGen<F>, LatentOrder, false>(lds, g, S, E, nullptr);
}
template <class F> __device__ __forceinline__ void run_gemm(MKLAS unsigned char* lds, const bf16_t* A, const bf16_t* Bt, int M, int N, int K, const F& f) {
    pg8::Gemm g{A, Bt, M, N, K, 0}; pg8::StaticOrder S; S.init(M, N, (int)gridDim.x, (int)blockIdx.x);
    EpiGen<F> E{f};
    pg8::gemm_phase<EpiGen<F>, pg8::StaticOrder, false>(lds, g, S, E, nullptr);
}

#ifndef MK_MASK
#define MK_MASK 0xfffff
#endif
#define KON(j) ((MK_MASK >> (j)) & 1)
#define IN(k) (lo <= (k) && (k) < hi)
#ifndef MK_XBAR
#define MK_XBAR 0
#endif
#ifndef MK_PROBE
#define MK_PROBE 0
#endif
#ifndef MK_PROBE_WORK
#define MK_PROBE_WORK 0u
#endif
#ifndef MK_PROBE_WAIT
#define MK_PROBE_WAIT 0u
#endif
#if MK_PROBE
#define PROBE_MARK(kind, iswait) do { if (blockIdx.x == 0 && threadIdx.x == 0) { const unsigned long long now_ = wall_clock64(); const unsigned long long d_ = now_ - *(volatile MKLAS unsigned long long*)(lctl + 4); \
        if ((((iswait) ? MK_PROBE_WAIT : MK_PROBE_WORK) >> (kind)) & 1u) *(volatile MKLAS unsigned long long*)(lctl + 6) += d_; *(volatile MKLAS unsigned long long*)(lctl + 4) = now_; } } while (0)
#else
#define PROBE_MARK(kind, iswait) do { } while (0)
#endif
#define SEAMK(k, kind) do { PROBE_MARK(kind, 0); if (IN(k) && IN((k) + 1)) { xcd_barrier(bar); } PROBE_MARK(kind, 1); } while (0)
#define SEAM(k) do { if (IN(k) && IN((k) + 1)) { xcd_barrier(bar); for (int xb_ = 0; xb_ < MK_XBAR; ++xb_) xcd_barrier(bar); } } while (0)
template <int l> __device__ __forceinline__ void run_layer(const P& p, MKLAS unsigned char* lds, const XcdBarrier& bar, const int lo, const int hi, volatile MKLAS unsigned* lctl) {
    constexpr bool last = (l == DEPTH - 1);
    const int b = 1 + l * NPH_LAYER;
    unsigned* const ctl = (unsigned*)(p.ws + WS_CTL);
    volatile MKLAS int* const slot = (volatile MKLAS int*)(lctl + 2);
    if (KON(1) && IN(b + 0)) { if (l == 0) ph_hnorm(p, l); } SEAMK(b + 0, 1);
    if (KON(2) && IN(b + 1)) { FnA f{WSP(bf16_t, WS_QH), WSP(bf16_t, WS_VH), WSP(bf16_t, WS_RQ), WSP(bf16_t, WS_RK), WSP(bf16_t, WS_RV), WSP(float, WS_LF), WSP(float, WS_LB) + l * 512};
        ctx_gemm(lds, WSP(bf16_t, WS_H), WSP(bf16_t, WS_WIN), NA, D, f);
        run_gemm_latent(lds, WSP(bf16_t, WS_H), WSP(bf16_t, WS_WIN), NA, D, f); } SEAMK(b + 1, 2);
    if (KON(3) && IN(b + 2)) { ph_rope(p); } SEAMK(b + 2, 3);
    if (KON(3) && IN(b + 3)) { ph_scan_pass1(p, l, lds, ctl + CW_CNT + 64 * (l * 4 + 0), slot); } SEAMK(b + 3, 4);
    if (KON(3) && IN(b + 4)) { ph_scan_pass2(p, l); } SEAMK(b + 4, 5);
    if (KON(4) && IN(b + 5)) { ph_scan_pass3<1>(p, l, lds, ctl + CW_CNT + 64 * (l * 4 + 1), slot); } SEAMK(b + 5, 6);
    if (KON(4) && IN(b + 6)) { ph_scan_pass3<2>(p, l, lds, ctl + CW_CNT + 64 * (l * 4 + 2), slot); } SEAMK(b + 6, 7);
    if (KON(5) && IN(b + 7)) { FnB f{WSP(bf16_t, WS_OHG), WSP(bf16_t, WS_ORT), WSP(bf16_t, WS_GA), WSP(bf16_t, WS_GB)};
        if (last) run_gemm_latent(lds, WSP(bf16_t, WS_H), WSP(bf16_t, WS_WIN) + (size_t)NA * D, NB, D, f); else run_gemm(lds, WSP(bf16_t, WS_H), WSP(bf16_t, WS_WIN) + (size_t)NA * D, L, NB, D, f);
        fill_convert<true>(p, l, lds, ctl + CW_CNT + 64 * (8 + l * 2 + 0), slot); } SEAMK(b + 7, 8);
    if (KON(6) && IN(b + 8)) { FnM1 f{WSP(bf16_t, WS_GA), WSP(float, WS_M1)};
        if (!last) ctx_gemm(lds, WSP(bf16_t, WS_OHG), WSP(bf16_t, WS_WOHG), D, 512, f);
        run_gemm_latent(lds, WSP(bf16_t, WS_OHG), WSP(bf16_t, WS_WOHG), D, 512, f); } SEAMK(b + 8, 9);
    if (KON(7) && IN(b + 9)) { FnM2 f{WSP(bf16_t, WS_GB), WSP(float, WS_M1), WSP(bf16_t, WS_MB)};
        if (!last) ctx_gemm(lds, WSP(bf16_t, WS_ORT), WSP(bf16_t, WS_WORET), D, D, f);
        run_gemm_latent(lds, WSP(bf16_t, WS_ORT), WSP(bf16_t, WS_WORET), D, D, f); } SEAMK(b + 9, 10);
    if (KON(8) && IN(b + 10)) { FnX f{l == 0 ? p.in[2] : WSP(float, WS_CTX), l == 0 ? p.in[0] : p.out, WSP(float, WS_CTX), p.out, WSP(float, WS_MOD) + l * 2 * 6144};
        if (!last) ctx_gemm(lds, WSP(bf16_t, WS_MB), WSP(bf16_t, WS_WOUT), D, D, f);
        run_gemm_latent(lds, WSP(bf16_t, WS_MB), WSP(bf16_t, WS_WOUT), D, D, f); } SEAMK(b + 10, 11);
    if (KON(9) && IN(b + 11)) { ph_router(p, l, lds, ctl + CW_ECNT + l * NE * 16); } SEAMK(b + 11, 12);
    if (KON(10) && IN(b + 12)) { ph_moe_scatter(p, l, lds); } SEAMK(b + 12, 13);
    if (KON(11) && IN(b + 13)) { const int* TE = WSP(int, WS_TILEE); MoeOrder S{TE, TE[255], 2, (int)gridDim.x, (int)blockIdx.x};
        pg8::Gemm g{WSP(bf16_t, WS_XG), WSP(bf16_t, WS_WGU), XG_ROWS, 512, D, (size_t)512 * D * 2}; EpiGU E{WSP(bf16_t, WS_ACT)};
        pg8::gemm_phase<EpiGU, MoeOrder, false>(lds, g, S, E, nullptr);
        if (!last) fill_convert<false>(p, l + 1, lds, ctl + CW_CNT + 64 * (8 + l * 2 + 1), slot); } SEAMK(b + 13, 14);
    if (KON(12) && IN(b + 14)) { const int* TE = WSP(int, WS_TILEE); MoeOrder S{TE, TE[255], 4, (int)gridDim.x, (int)blockIdx.x};
        pg8::Gemm g{WSP(bf16_t, WS_ACT), WSP(bf16_t, WS_WD), XG_ROWS, D, DE, (size_t)D * DE * 2}; EpiGen<FnYA> E{FnYA{WSP(float, WS_ROWW), WSP(bf16_t, WS_YA)}};
        pg8::gemm_phase<EpiGen<FnYA>, MoeOrder, false>(lds, g, S, E, nullptr); } SEAMK(b + 14, 15);
    if (KON(13) && IN(b + 15)) { ph_moe_combine(p, l); } SEAMK(b + 15, 16);
}

__global__ void __launch_bounds__(NT, 2) fwd(P p) {
    extern __shared__ __attribute__((aligned(16))) unsigned char lds_raw[];
    MKLAS unsigned char* lds = (MKLAS unsigned char*)lds_raw;
    volatile MKLAS unsigned* lctl = (volatile MKLAS unsigned*)(lds + LDS_CTL);
    if (threadIdx.x < 8) lctl[threadIdx.x] = 0u;
    __syncthreads();
#if MK_PROBE
    if (blockIdx.x == 0 && threadIdx.x == 0) *(volatile MKLAS unsigned long long*)(lctl + 4) = wall_clock64();
#endif
    const int lo = p.ph_lo, hi = p.ph_hi;
    const bool multi = (hi - lo) > 1;
    XcdBarrier bar; bar.bar = (unsigned*)(p.ws + WS_CTL) + CW_BAR; bar.x = 0; bar.st = nullptr;
    if (multi) bar = xcd_barrier_post((unsigned*)(p.ws + WS_CTL) + CW_BAR, lctl);
    if (KON(0) && IN(0)) { ph_prologue(p, lds); } SEAMK(0, 0);
    run_layer<0>(p, lds, bar, lo, hi, lctl);
    run_layer<1>(p, lds, bar, lo, hi, lctl);
    static_assert(DEPTH == 2, "two layers written out");
#if MK_PROBE
    if (blockIdx.x == 0 && threadIdx.x == 0) { const unsigned long long t0_ = wall_clock64(), d_ = 4ull * *(volatile MKLAS unsigned long long*)(lctl + 6); while (wall_clock64() - t0_ < d_) __builtin_amdgcn_s_sleep(8); }
#endif
#undef IN
#undef SEAM
}
}

#ifndef MK_ONE_LAUNCH
#define MK_ONE_LAUNCH 1
#endif
extern "C" void kernel_launch(void* const* d_in, const int* in_sizes, int n_in, void* d_out, int out_size, void* d_ws, size_t ws_size, hipStream_t stream) {
    using namespace mk;
    static int grid = 0;
    if (grid == 0) {
        if (n_in != 24 || in_sizes[0] != T * D || out_size != T * D || ws_size < WS_END) { fprintf(stderr, "kernel_launch: unexpected shapes / workspace (n_in %d, ws %zu, need %zu); nothing launched\n", n_in, ws_size, (size_t)WS_END); grid = -1; return; }
        int dev = 0, cus = 0, per_cu = 0;
        if (hipGetDevice(&dev) != hipSuccess || hipDeviceGetAttribute(&cus, hipDeviceAttributeMultiprocessorCount, dev) != hipSuccess) { grid = -1; return; }
        if (hipFuncSetAttribute((const void*)fwd, hipFuncAttributeMaxDynamicSharedMemorySize, LDS_BYTES) != hipSuccess) { fprintf(stderr, "kernel_launch: hipFuncSetAttribute failed\n"); grid = -1; return; }
        if (hipOccupancyMaxActiveBlocksPerMultiprocessor(&per_cu, (const void*)fwd, NT, LDS_BYTES) != hipSuccess || per_cu < 1) { fprintf(stderr, "kernel_launch: occupancy query says %d\n", per_cu); (void)hipGetLastError(); per_cu = 1; }
        grid = cus;
    }
    if (grid < 0) return;
    if (hipMemsetAsync((char*)d_ws + WS_CTL, 0, CTL_BYTES, stream) != hipSuccess) return;
    P p{};
    for (int i = 0; i < 24; ++i) p.in[i] = (const float*)d_in[i];
    p.out = (float*)d_out; p.ws = (unsigned char*)d_ws;
#if MK_ONE_LAUNCH
    p.ph_lo = 0; p.ph_hi = NPH;
    hipLaunchKernelGGL(fwd, dim3(grid), dim3(NT), LDS_BYTES, stream, p);
#else
    for (int ph = 0; ph < NPH; ++ph) { p.ph_lo = ph; p.ph_hi = ph + 1; hipLaunchKernelGGL(fwd, dim3(grid), dim3(NT), LDS_BYTES, stream, p); }
#endif
}
```

```cpp
#include <hip/hip_runtime.h>
#include <cstdio>
#include <cstdint>
__device__ __forceinline__ int tid_fresh() { int t = (int)threadIdx.x; asm volatile("" : "+v"(t)); return t; }
namespace pg8 {
#define PG8_LAS __attribute__((address_space(3)))
typedef unsigned short bf16_t;
typedef short bf16x8 __attribute__((ext_vector_type(8)));
typedef float f32x4 __attribute__((ext_vector_type(4)));
typedef unsigned u32x4 __attribute__((ext_vector_type(4)));
constexpr int BM = 256, BK = 64, HALF = 128, HTB = HALF * BK * 2  , STAGE_BYTES = 8 * HTB, NXCD = 8, WGM = 8;

__host__ __device__ __forceinline__ int lds_byte(int r, int c) { const int st = (r >> 4) * 2 + (c >> 5), rr = r & 15, cc = c & 31, ob = rr * 64 + cc * 2; return st * 1024 + (ob ^ (((ob >> 9) & 1) << 5)); }
__host__ __device__ __forceinline__ void stage_rc(int b, int& R, int& C) { const int st = b / 1024, sb = b % 1024, swz = sb ^ (((sb >> 9) & 1) << 5); R = (st >> 1) * 16 + swz / 64; C = (st & 1) * 32 + (swz % 64) / 2; }
__host__ __device__ __forceinline__ int perm32(int rho) { const int n = rho >> 4, i = rho & 15; return 8 * (i >> 2) + 4 * n + (i & 3); }

struct Unit { int pm, pn, be; };
struct Gemm { const bf16_t* A; const bf16_t* Bt; int M, N, K; size_t bstride; };

struct StaticOrder {
    static constexpr bool GATHER = false;
    int nM, nN, nwg, G, c;
    __host__ __device__ void init(int M, int N, int G_, int c_) { nM = M / BM; nN = N / BM; nwg = nM * nN; G = G_; c = c_; }
    __host__ __device__ bool next(int i, Unit& u) const {
        const long L = (long)i * G + c; if (L >= nwg) return false;
        int wgid = (int)L; { const int q = nwg / NXCD, r = nwg % NXCD, xcd = wgid % NXCD, off = wgid / NXCD; wgid = (xcd < r ? xcd * (q + 1) : r * (q + 1) + (xcd - r) * q) + off; }
        const int nig = WGM * nN, gid = wgid / nig, fm = gid * WGM, gsz = (nM - fm) < WGM ? (nM - fm) : WGM;
        u.pm = fm + ((wgid % nig) % gsz); u.pn = (wgid % nig) / gsz; u.be = 0; return true;
    }
    __device__ __forceinline__ void a_ready(const Unit&) const {}
    __device__ __forceinline__ void done(const Unit&) const {}
};

typedef float cvt_f32x2 __attribute__((ext_vector_type(2)));
typedef __bf16 cvt_bf16x2 __attribute__((ext_vector_type(2)));
__device__ __forceinline__ unsigned cvt_pk_bf16(float lo, float hi) { const cvt_f32x2 v = {lo, hi}; return __builtin_bit_cast(unsigned, __builtin_convertvector(v, cvt_bf16x2)); }
template <class Epi, class Sched, bool STAMP = false>
__device__ __forceinline__ void gemm_phase(PG8_LAS unsigned char* lds, const Gemm g, const Sched& S, const Epi& E, unsigned long long* stamps) {
    const int tid = tid_fresh(), wid = __builtin_amdgcn_readfirstlane(tid >> 6), lane = tid & 63, wr = wid >> 2, wc = wid & 3, fr = lane & 15, fq = lane >> 4;
    const int K = g.K, nt = K / BK;
    int ts_lo = 0, ts_hi = 0, nts = 0; const unsigned long long rt_entry = STAMP ? (unsigned long long)wall_clock64() : 0ull;
#define PG8_STAMP() do { if (STAMP && wid == 0 && nts < 64) { const unsigned long long _c = (unsigned long long)clock64(); \
        ts_lo = (lane == nts) ? (int)(unsigned)_c : ts_lo; ts_hi = (lane == nts) ? (int)(unsigned)(_c >> 32) : ts_hi; ++nts; } } while (0)
    PG8_STAMP();
    unsigned voffA[2], voffB[2];
#pragma unroll
    for (int i = 0; i < 2; ++i) { int R, C; stage_rc(tid * 16 + i * 8192, R, C); const int Rb = Epi::PERM ? ((R & ~31) + perm32(R & 31)) : R;
        voffA[i] = (unsigned)(R * K + C) * 2u; voffB[i] = (unsigned)(Rb * K + C) * 2u; }
    unsigned vA0[2] = {0u, 0u}, vA1[2] = {0u, 0u}, nvA0[2] = {0u, 0u}, nvA1[2] = {0u, 0u}; int gR[2] = {0, 0}, gC[2] = {0, 0};
    if constexpr (Sched::GATHER) {
#pragma unroll
        for (int i = 0; i < 2; ++i) stage_rc(tid * 16 + i * 8192, gR[i], gC[i]); }
#define PG8_GOFF(u, v0, v1) do { _Pragma("unroll") for (int _i = 0; _i < 2; ++_i) { v0[_i] = S.row_byte_off(u, gR[_i]) + (unsigned)gC[_i] * 2u; v1[_i] = S.row_byte_off(u, 128 + gR[_i]) + (unsigned)gC[_i] * 2u; } } while (0)
#define PG8_STAGE_A(bufoff, base, half, nxtsel) do { if constexpr (Sched::GATHER) { unsigned sel_[2]; _Pragma("unroll") for (int _j = 0; _j < 2; ++_j) sel_[_j] = (nxtsel) ? ((half) ? nvA1[_j] : nvA0[_j]) : ((half) ? vA1[_j] : vA0[_j]); \
        PG8_STAGE(bufoff, base, sel_); } else { PG8_STAGE(bufoff, (base) + ((half) ? hstep : (size_t)0), voffA); } } while (0)
    const size_t kstep = (size_t)(BK * 2);
    const size_t hstep = (size_t)HALF * K * 2;
    const size_t tstep = 2 * hstep;
    const unsigned ldsw = (unsigned)wid * 1024u;
    const int aoff = lds_byte(wr * 64 + fr, fq * 8), boff = lds_byte(wc * 32 + fr, fq * 8);
#define PG8_SA(b, h) (((b) * 2 + (h)) * HTB)
#define PG8_SB(b, h) ((4 + (b) * 2 + (h)) * HTB)
#define PG8_STAGE(bufoff, gbase, voff) do { _Pragma("unroll") for (int _i = 0; _i < 2; ++_i) \
        __builtin_amdgcn_global_load_lds((const unsigned*)((const char*)(gbase) + (voff)[_i]), (PG8_LAS unsigned*)(lds + (bufoff) + ldsw + _i * 8192), 16, 0, 0); } while (0)
#define PG8_LDA(dst, b, h) do { _Pragma("unroll") for (int m = 0; m < 4; ++m) _Pragma("unroll") for (int k = 0; k < 2; ++k) dst[m][k] = *(const PG8_LAS bf16x8*)(lds + PG8_SA(b, h) + aoff + m * 2048 + k * 1024); } while (0)
#define PG8_LDB(dst, b, h) do { _Pragma("unroll") for (int n = 0; n < 2; ++n) _Pragma("unroll") for (int k = 0; k < 2; ++k) dst[n][k] = *(const PG8_LAS bf16x8*)(lds + PG8_SB(b, h) + boff + n * 2048 + k * 1024); } while (0)
#define PG8_MMA(ai, bj, At, Bt) do { __builtin_amdgcn_s_setprio(1); _Pragma("unroll") for (int m = 0; m < 4; ++m) _Pragma("unroll") for (int n = 0; n < 2; ++n) _Pragma("unroll") for (int k = 0; k < 2; ++k) \
        acc[ai][bj][m][n] = __builtin_amdgcn_mfma_f32_16x16x32_bf16(Bt[n][k], At[m][k], acc[ai][bj][m][n], 0, 0, 0); __builtin_amdgcn_s_setprio(0); } while (0)
#define PG8_WAIT_V(n) asm volatile("s_waitcnt vmcnt(" #n ")" ::: "memory")
#define PG8_WAIT_L(n) asm volatile("s_waitcnt lgkmcnt(" #n ")" ::: "memory")
#define PG8_BAR __builtin_amdgcn_s_barrier()
#define PG8_SCHED __builtin_amdgcn_sched_barrier(0)
    Unit cur, nxt; int ui = 0;
    if (!S.next(0, cur)) return;
    f32x4 acc[2][2][4][2];
#pragma unroll
    for (int a = 0; a < 2; ++a)
#pragma unroll
        for (int b = 0; b < 2; ++b)
#pragma unroll
            for (int m = 0; m < 4; ++m)
#pragma unroll
                for (int n = 0; n < 2; ++n) acc[a][b][m][n] = (f32x4){0.f, 0.f, 0.f, 0.f};
    bf16x8 At[4][2], B0[2][2], B1[2][2];
    const char* cA = Sched::GATHER ? (const char*)g.A : (const char*)g.A + (size_t)cur.pm * tstep; const char* cB = (const char*)g.Bt + (size_t)cur.be * g.bstride + (size_t)cur.pn * tstep;
    S.a_ready(cur);
    if constexpr (Sched::GATHER) PG8_GOFF(cur, vA0, vA1);
    PG8_STAGE(PG8_SB(0, 0), cB, voffB); PG8_STAGE_A(PG8_SA(0, 0), cA, 0, false); PG8_STAGE(PG8_SB(0, 1), cB + hstep, voffB); PG8_STAGE_A(PG8_SA(0, 1), cA, 1, false);
    if (wr == 1) PG8_BAR;
    PG8_WAIT_V(4); PG8_BAR;
    PG8_STAGE(PG8_SB(1, 0), cB + kstep, voffB); PG8_STAGE_A(PG8_SA(1, 0), cA + kstep, 0, false); PG8_STAGE(PG8_SB(1, 1), cB + hstep + kstep, voffB);
    PG8_WAIT_V(6); PG8_BAR;
    PG8_STAMP();
    for (;;) {
        const bool has_next = S.next(ui + 1, nxt);
        const char* nA = Sched::GATHER ? (const char*)g.A : (has_next ? (const char*)g.A + (size_t)nxt.pm * tstep : cA); const char* nB = has_next ? (const char*)g.Bt + (size_t)nxt.be * g.bstride + (size_t)nxt.pn * tstep : cB;
        if constexpr (Sched::GATHER) { if (has_next) PG8_GOFF(nxt, nvA0, nvA1); else {
#pragma unroll
                for (int _i = 0; _i < 2; ++_i) { nvA0[_i] = vA0[_i]; nvA1[_i] = vA1[_i]; } } }
        for (int t = 0; t < nt; t += 2) {
            const bool last = (t == nt - 2);
            const char* a1 = cA + (size_t)(t + 1) * kstep;
            const char* a2 = last ? nA : cA + (size_t)(t + 2) * kstep; const char* b2 = last ? nB : cB + (size_t)(t + 2) * kstep;
            const char* a3 = a2 + kstep; const char* b3 = b2 + kstep;
            if (last && has_next) S.a_ready(nxt);
            PG8_LDB(B0, 0, 0); PG8_SCHED; PG8_LDA(At, 0, 0); PG8_STAGE_A(PG8_SA(1, 1), a1, 1, false);
            PG8_WAIT_L(8); PG8_BAR; PG8_WAIT_L(0); PG8_MMA(0, 0, At, B0); PG8_BAR; PG8_SCHED;
            PG8_LDB(B1, 0, 1); PG8_STAGE(PG8_SB(0, 0), b2, voffB);
            PG8_BAR; PG8_WAIT_L(0); PG8_MMA(0, 1, At, B1); PG8_BAR;
            PG8_LDA(At, 0, 1); PG8_STAGE_A(PG8_SA(0, 0), a2, 0, last);
            PG8_BAR; PG8_WAIT_L(0); PG8_MMA(1, 0, At, B0); PG8_BAR; PG8_SCHED;
            PG8_STAGE(PG8_SB(0, 1), b2 + hstep, voffB);
            PG8_WAIT_V(6); PG8_BAR; PG8_MMA(1, 1, At, B1); PG8_BAR;
            PG8_LDB(B0, 1, 0); PG8_SCHED; PG8_LDA(At, 1, 0); PG8_STAGE_A(PG8_SA(0, 1), a2, 1, last);
            PG8_WAIT_L(8); PG8_BAR; PG8_WAIT_L(0); PG8_MMA(0, 0, At, B0); PG8_BAR; PG8_SCHED;
            PG8_LDB(B1, 1, 1); PG8_STAGE(PG8_SB(1, 0), b3, voffB);
            PG8_BAR; PG8_WAIT_L(0); PG8_MMA(0, 1, At, B1); PG8_BAR;
            PG8_LDA(At, 1, 1); PG8_STAGE_A(PG8_SA(1, 0), a3, 0, last);
            PG8_BAR; PG8_WAIT_L(0); PG8_MMA(1, 0, At, B0); PG8_BAR; PG8_SCHED;
            PG8_STAGE(PG8_SB(1, 1), b3 + hstep, voffB);
            PG8_WAIT_V(6); PG8_BAR; PG8_MMA(1, 1, At, B1); PG8_BAR;
        }
        PG8_STAMP();
        if constexpr (!Epi::AFTER_DRAIN) { E(acc, cur, wr, wc, fr, fq); S.done(cur); }
        PG8_STAMP();
        if (!has_next) break;
#pragma unroll
        for (int a = 0; a < 2; ++a)
#pragma unroll
            for (int b = 0; b < 2; ++b)
#pragma unroll
                for (int m = 0; m < 4; ++m)
#pragma unroll
                    for (int n = 0; n < 2; ++n) acc[a][b][m][n] = (f32x4){0.f, 0.f, 0.f, 0.f};
        if constexpr (Sched::GATHER) {
#pragma unroll
            for (int _i = 0; _i < 2; ++_i) { vA0[_i] = nvA0[_i]; vA1[_i] = nvA1[_i]; } }
        cur = nxt; cA = nA; cB = nB; ++ui;
    }
    PG8_WAIT_V(0);
    if (wr == 0) PG8_BAR;
    PG8_BAR;
    if constexpr (Epi::AFTER_DRAIN) { E.fused(acc, cur, wr, wc, fr, fq, lds, wid, lane); S.done(cur); }
    PG8_STAMP();
    if (STAMP && wid == 0) { stamps[lane] = lane < nts ? (((unsigned long long)(unsigned)ts_hi << 32) | (unsigned)ts_lo) : 0ull;
        if (lane == 62) stamps[62] = rt_entry; if (lane == 63) stamps[63] = (unsigned long long)wall_clock64(); }
#undef PG8_STAMP
#undef PG8_SA
#undef PG8_SB
#undef PG8_STAGE
#undef PG8_STAGE_A
#undef PG8_GOFF
#undef PG8_LDA
#undef PG8_LDB
#undef PG8_MMA
#undef PG8_WAIT_V
#undef PG8_WAIT_L
#undef PG8_BAR
#undef PG8_SCHED
}
}


#define XB_TMO      128
#define XB_XCNT(j)  (256  + 64 * (j))
#define XB_XSUB(j)  (1280 + 64 * (j))
#define XB_XGEN(j)  (2304 + 64 * (j))
#define XB_TOP      3328
#define XB_TOPGEN   3392
#define XCD_BAR_WORDS 3456
#define XB_SPIN_CAP (1u << 18)
#define LAS __attribute__((address_space(3)))

__device__ __forceinline__ unsigned xb_ld(unsigned* p)              { return __hip_atomic_load(p, __ATOMIC_RELAXED, __HIP_MEMORY_SCOPE_AGENT); }
__device__ __forceinline__ unsigned xb_add(unsigned* p, unsigned v) { return __hip_atomic_fetch_add(p, v, __ATOMIC_RELAXED, __HIP_MEMORY_SCOPE_AGENT); }
__device__ __forceinline__ unsigned xb_xcc_id() { return (unsigned)__builtin_amdgcn_s_getreg((3 << 11) | 20) & 0xFu; }
#define XB_SPIN(cond, bar) do { unsigned _sp = 0; while (cond) { __builtin_amdgcn_s_sleep(1); \
    if ((++_sp & 255u) == 0u) { if (xb_ld(&(bar)[XB_TMO])) break; if (_sp > XB_SPIN_CAP) { atomicAdd(&(bar)[XB_TMO], 1u); break; } } } } while (0)

struct XcdBarrier {
    unsigned* bar; unsigned x;
    volatile LAS unsigned* st;
};

__device__ __forceinline__ XcdBarrier xcd_barrier_post(unsigned* bar, volatile LAS unsigned* st) {
    XcdBarrier b; b.bar = bar; b.x = xb_xcc_id(); b.st = st;
    if (threadIdx.x == 0) (void)xb_add(&bar[XB_XCNT(b.x)], 1u);
    return b;
}
__device__ __forceinline__ void xcd_barrier_complete(unsigned* bar, unsigned x, unsigned& nloc, unsigned& nx) {
    const unsigned G = gridDim.x * gridDim.y * gridDim.z;
    unsigned sum, cnt, mine, sp = 0u;
    for (;;) {
        sum = 0u; cnt = 0u; mine = 0u;
#pragma unroll
        for (unsigned j = 0; j < 16; ++j) { const unsigned c = xb_ld(&bar[XB_XCNT(j)]); sum += c; cnt += (c > 0u) ? 1u : 0u; mine = (j == x) ? c : mine; }
        if (sum == G) break;
        __builtin_amdgcn_s_sleep(1);
        if ((++sp & 255u) == 0u) { if (xb_ld(&bar[XB_TMO])) break; if (sp > XB_SPIN_CAP) { atomicAdd(&bar[XB_TMO], 1u); break; } }
    }
    nloc = mine > 0u ? mine : 1u; nx = cnt > 0u ? cnt : 1u;
}

__device__ __forceinline__ void xcd_barrier(const XcdBarrier& b) {
    asm volatile("s_waitcnt vmcnt(0)" ::: "memory");
    __syncthreads();
    if (threadIdx.x == 0) {
        unsigned* bar = b.bar;
        __builtin_amdgcn_s_waitcnt(0);
        unsigned nloc = b.st[0], nx = b.st[1];
        if (nloc == 0u) { xcd_barrier_complete(bar, b.x, nloc, nx); b.st[0] = nloc; b.st[1] = nx; }
        const unsigned old = xb_add(&bar[XB_XSUB(b.x)], 1u);
        const unsigned gen = old / nloc;
        if (old + 1u == (gen + 1u) * nloc) {
            __builtin_amdgcn_fence(__ATOMIC_RELEASE, "agent");
            asm volatile("s_waitcnt vmcnt(0)" ::: "memory");
            const unsigned og = xb_add(&bar[XB_TOP], 1u);
            const unsigned tg = og / nx;
            if (og + 1u == (tg + 1u) * nx) xb_add(&bar[XB_TOPGEN], 1u);
            else XB_SPIN(xb_ld(&bar[XB_TOPGEN]) == tg, bar);
            __builtin_amdgcn_fence(__ATOMIC_ACQUIRE, "agent");
            xb_add(&bar[XB_XGEN(b.x)], 1u);
            asm volatile("s_waitcnt vmcnt(0)" ::: "memory");
        } else {
            XB_SPIN(xb_ld(&bar[XB_XGEN(b.x)]) == gen, bar);
            __builtin_amdgcn_fence(__ATOMIC_ACQUIRE, "agent");
            asm volatile("s_waitcnt vmcnt(0)" ::: "memory");
        }
    }
    __syncthreads();
}


namespace mk {
using pg8::bf16_t; using pg8::f32x4; using pg8::u32x4; using pg8::cvt_pk_bf16;
#define MKLAS __attribute__((address_space(3)))
typedef unsigned u32x2 __attribute__((ext_vector_type(2)));
typedef float f32x2 __attribute__((ext_vector_type(2)));

constexpr int D = 1024, T = 16384, LC = 256, L = T + LC, DEPTH = 2;
constexpr int NA = 4096, NB = 3584;
constexpr int NE = 32, DE = 256;
constexpr float EPS = 1e-6f;
constexpr int NT = 512, NW = 8;
constexpr int LDS_CTL_OFF = 131072;

constexpr size_t MiB = 1u << 20, QMiB = 1u << 18;
constexpr size_t WS_CTL = 0, CTL_BYTES = 1 * MiB;
constexpr size_t WS_MOD = 1 * MiB, WS_LB = WS_MOD + 128 * 1024, WS_ROPE = WS_MOD + 192 * 1024, WS_LGAM = WS_MOD + 256 * 1024, WS_WRT = WS_MOD + 512 * 1024;
constexpr size_t WS_AE = 2 * MiB, WS_AW = WS_AE + 256 * 1024, WS_APOS = WS_AE + 512 * 1024, WS_ROWW = WS_AE + 768 * 1024, WS_TILEE = WS_AE + 1024 * 1024, WS_ASLOT = WS_AE + 1280 * 1024;
constexpr size_t WS_TOK = 58 * MiB;
constexpr size_t WS_CTX = 4 * MiB;
constexpr size_t WS_WIN = 5 * MiB, WS_WOHG = 20 * MiB, WS_WORET = 21 * MiB, WS_WOUT = 23 * MiB;
constexpr size_t WS_H = 25 * MiB;
constexpr size_t WS_QH = 58 * MiB, WS_VH = WS_QH + 65 * QMiB, WS_RQ = WS_VH + 65 * QMiB, WS_RK = WS_RQ + 65 * QMiB;
constexpr size_t WS_RV = 123 * MiB;
constexpr size_t WS_LF = WS_RV + 130 * QMiB;
constexpr size_t WS_OHG = WS_LF + 260 * QMiB;
constexpr size_t WS_ORT = WS_OHG + 65 * QMiB;
constexpr size_t WS_OF = WS_ORT + 130 * QMiB;
constexpr size_t WS_END = WS_OF + 390 * QMiB;
constexpr size_t WS_GA = WS_QH, WS_GB = WS_QH + 130 * QMiB;
constexpr size_t WS_M1 = WS_LF;
constexpr size_t WS_MB = WS_RV;
constexpr int CW_BAR = 4096, CW_CNT = 8192, CW_ECNT = 12288;

struct P { const float* in[24]; float* out; unsigned char* ws; int ph_lo, ph_hi; };
__device__ __forceinline__ unsigned char* ws_fresh(unsigned char* w) { asm volatile("" : "+s"(w)); return w; }
#define WSP(type, off) ((type*)(p.ws + (off)))

__device__ __forceinline__ float bf2f(bf16_t b) { return __uint_as_float(((unsigned)b) << 16); }
__device__ __forceinline__ bf16_t f2bf(float f) { return (bf16_t)(cvt_pk_bf16(f, 0.f) & 0xffffu); }
__device__ __forceinline__ float fexp(float x) { return __builtin_amdgcn_exp2f(x * 1.4426950408889634f); }
__device__ __forceinline__ float flog(float x) { return __builtin_amdgcn_logf(x) * 0.6931471805599453f; }
__device__ __forceinline__ float siluf(float x) { return x * __builtin_amdgcn_rcpf(1.f + fexp(-x)); }
__device__ __forceinline__ float sigmf(float x) { return __builtin_amdgcn_rcpf(1.f + fexp(-x)); }
__device__ __forceinline__ float wave_sum(float v) {
#pragma unroll
    for (int o = 1; o < 64; o <<= 1) v += __shfl_xor(v, o);
    return v;
}
__device__ __forceinline__ const float* xrow_in(const P& p, int l, int r) {
    if (l == 0) return r < LC ? p.in[2] + (size_t)r * D : p.in[0] + (size_t)(r - LC) * D;
    return r < LC ? WSP(float, WS_CTX) + (size_t)r * D : p.out + (size_t)(r - LC) * D;
}
__device__ __forceinline__ float* xrow_st(const P& p, int r) { return r < LC ? WSP(float, WS_CTX) + (size_t)r * D : p.out + (size_t)(r - LC) * D; }
__device__ __forceinline__ int seq_row(int dir, int i) { return dir == 0 ? i : (i < LC ? LC - 1 - i : L + LC - 1 - i); }

__device__ __forceinline__ void tr_item(const float* W, int K, int N, bf16_t* WT, int k0, int n0, int outrow0, MKLAS float* tile, bool swap45 = false) {
    const int tid = tid_fresh(), r = tid >> 6, c = tid & 63;
#pragma unroll
    for (int i = 0; i < 8; ++i) tile[(r + 8 * i) * 65 + c] = W[(size_t)(k0 + r + 8 * i) * N + n0 + c];
    __syncthreads();
    const int nn = tid >> 3, kc = tid & 7;
    const MKLAS float* s = tile + (kc * 8) * 65 + nn;
    u32x4 o; o.x = cvt_pk_bf16(s[0], s[65]); o.y = cvt_pk_bf16(s[130], s[195]); o.z = cvt_pk_bf16(s[260], s[325]); o.w = cvt_pk_bf16(s[390], s[455]);
    const int nno = swap45 ? ((((nn & 31) >> 2) << 3) | ((nn >> 5) << 2) | (nn & 3)) : nn;
    *(u32x4*)(WT + (size_t)(outrow0 + nno) * K + k0 + kc * 8) = o;
    __syncthreads();
}
__device__ __forceinline__ int win_perm(int n) { return n < 2048 ? n : (n < 2560 ? 4096 + (n - 2048) : (n < 4608 ? 2048 + (n - 2560) : n)); }
constexpr int MIXER_ITEMS = 16 * 120 + 8 * 16 + 16 * 16 + 16 * 16;
__device__ __forceinline__ void mixer_item(const P& p, int l, int it, MKLAS float* tile) {
    constexpr int I_IN = 16 * 120, I_OHG = 8 * 16, I_ORT = 16 * 16;
    int r = it;
    if (r < I_IN) { const int kb = r / 120, nb = r % 120; tr_item(p.in[8] + (size_t)l * D * 7680, D, 7680, WSP(bf16_t, WS_WIN), kb * 64, nb * 64, win_perm(nb * 64), tile, nb * 64 >= 2560 && nb * 64 < 3584); return; } r -= I_IN;
    if (r < I_OHG) { const int kb = r / 16, nb = r % 16; tr_item(p.in[13] + (size_t)l * 512 * D, 512, D, WSP(bf16_t, WS_WOHG), kb * 64, nb * 64, nb * 64, tile); return; } r -= I_OHG;
    if (r < I_ORT) { const int kb = r / 16, nb = r % 16; tr_item(p.in[14] + (size_t)l * D * D, D, D, WSP(bf16_t, WS_WORET), kb * 64, nb * 64, nb * 64, tile); return; } r -= I_ORT;
    { const int kb = r / 16, nb = r % 16; tr_item(p.in[15] + (size_t)l * D * D, D, D, WSP(bf16_t, WS_WOUT), kb * 64, nb * 64, nb * 64, tile); }
}
__device__ __forceinline__ void convert_mixer_weights(const P& p, int l, MKLAS unsigned char* lds) {
    for (int it = blockIdx.x; it < MIXER_ITEMS; it += gridDim.x) mixer_item(p, l, it, (MKLAS float*)lds);
}

__device__ __forceinline__ void ph_hnorm(const P& p, int l) {
    const int tid_ = tid_fresh(), lane = tid_ & 63, wave = tid_ >> 6;
    const float* MOD = WSP(float, WS_MOD); bf16_t* H = WSP(bf16_t, WS_H);
    const float* nw = p.in[6] + l * D;
    for (int r = blockIdx.x * NW + wave; r < L; r += gridDim.x * NW) {
        const f32x4* xr = (const f32x4*)xrow_in(p, l, r) + lane;
        const float* mod = MOD + (l * 2 + (r < LC ? 1 : 0)) * 6144;
        f32x4 v[4]; float ss = 0.f;
#pragma unroll
        for (int j = 0; j < 4; ++j) { v[j] = xr[64 * j]; ss += (v[j].x * v[j].x + v[j].y * v[j].y) + (v[j].z * v[j].z + v[j].w * v[j].w); }
        const float rinv = 1.0f / sqrtf(wave_sum(ss) * (1.f / D) + EPS);
        u32x2* o = (u32x2*)(H + (size_t)r * D) + lane;
#pragma unroll
        for (int j = 0; j < 4; ++j) { const int c = 4 * (lane + 64 * j);
            const f32x4 w = *(const f32x4*)(nw + c), sh = *(const f32x4*)(mod + c), sc = *(const f32x4*)(mod + 1024 + c);
            const f32x4 h = v[j] * rinv * w * (sc + 1.0f) + sh;
            u32x2 q; q.x = cvt_pk_bf16(h.x, h.y); q.y = cvt_pk_bf16(h.z, h.w); o[64 * j] = q; }
    }
}

template <class F> struct EpiGen {
    static constexpr bool PERM = true, AFTER_DRAIN = false;
    F f;
    __device__ __forceinline__ void operator()(const f32x4 (&acc)[2][2][4][2], const pg8::Unit& u, int wr, int wc, int fr, int fq) const {
        const int row0 = u.pm * 256 + wr * 64 + fr, col0 = u.pn * 256 + wc * 32 + 8 * fq;
        if constexpr (!F::HAS_LOAD) {
            const typename F::R none{};
#pragma unroll
            for (int g = 0; g < 8; ++g)
#pragma unroll
                for (int bj = 0; bj < 2; ++bj) f.apply8(row0 + (g >> 2) * 128 + (g & 3) * 16, col0 + bj * 128, acc[g >> 2][bj][g & 3][0], acc[g >> 2][bj][g & 3][1], none, u);
        } else {
            typename F::R cur[2], nxt[2];
#pragma unroll
            for (int bj = 0; bj < 2; ++bj) cur[bj] = f.load8(row0, col0 + bj * 128, u);
            asm volatile("" ::: "memory");
#pragma unroll
            for (int g = 0; g < 8; ++g) {
                if (g < 7) {
#pragma unroll
                    for (int bj = 0; bj < 2; ++bj) nxt[bj] = f.load8(row0 + ((g + 1) >> 2) * 128 + ((g + 1) & 3) * 16, col0 + bj * 128, u);
                }
                asm volatile("" ::: "memory");
#pragma unroll
                for (int bj = 0; bj < 2; ++bj) f.apply8(row0 + (g >> 2) * 128 + (g & 3) * 16, col0 + bj * 128, acc[g >> 2][bj][g & 3][0], acc[g >> 2][bj][g & 3][1], cur[bj], u);
                asm volatile("" ::: "memory");
#pragma unroll
                for (int bj = 0; bj < 2; ++bj) cur[bj] = nxt[bj];
            }
        }
    }
};
struct NoRegs {};
__device__ __forceinline__ void st_bf4(bf16_t* dst, f32x4 v) { u32x2 q; q.x = cvt_pk_bf16(v.x, v.y); q.y = cvt_pk_bf16(v.z, v.w); *(u32x2*)dst = q; }
__device__ __forceinline__ void st_bf8(bf16_t* dst, f32x4 a, f32x4 b) { u32x4 q; q.x = cvt_pk_bf16(a.x, a.y); q.y = cvt_pk_bf16(a.z, a.w); q.z = cvt_pk_bf16(b.x, b.y); q.w = cvt_pk_bf16(b.z, b.w); *(u32x4*)dst = q; }
__device__ __forceinline__ f32x4 bf2lo4(u32x4 q) { return (f32x4){__uint_as_float(q.x << 16), __uint_as_float(q.x & 0xffff0000u), __uint_as_float(q.y << 16), __uint_as_float(q.y & 0xffff0000u)}; }
__device__ __forceinline__ f32x4 bf2hi4(u32x4 q) { return (f32x4){__uint_as_float(q.z << 16), __uint_as_float(q.z & 0xffff0000u), __uint_as_float(q.w << 16), __uint_as_float(q.w & 0xffff0000u)}; }
__device__ __forceinline__ f32x4 silu4(f32x4 v) { return (f32x4){siluf(v.x), siluf(v.y), siluf(v.z), siluf(v.w)}; }
__device__ __forceinline__ f32x4 sigm4(f32x4 v) { return (f32x4){sigmf(v.x), sigmf(v.y), sigmf(v.z), sigmf(v.w)}; }
__device__ __forceinline__ f32x4 ld_bf4(const bf16_t* src) { const u32x2 q = *(const u32x2*)src; f32x4 v; v.x = __uint_as_float(q.x << 16); v.y = __uint_as_float(q.x & 0xffff0000u); v.z = __uint_as_float(q.y << 16); v.w = __uint_as_float(q.y & 0xffff0000u); return v; }

struct FnA {
    bf16_t *QH, *VH, *RQ, *RK, *RV; float* LF; const float* LB; const float* RT;
    static constexpr bool HAS_LOAD = false; typedef NoRegs R;
    __device__ __forceinline__ f32x4 logf4(f32x4 v, int dir, int ch) const { const f32x4 lb = *(const f32x4*)(LB + dir * DEPTH * 512 + ch); f32x4 o;
#pragma unroll
        for (int j = 0; j < 4; ++j) { const float e = fexp(fminf(-v[j], 69.f));
            o[j] = fmaxf(flog(1.f + lb[j] * e) - flog(1.f + e), -69.0775528f); }
        return o; }
    static __device__ __forceinline__ int rot_dim(int c) { return (c & ~63) | (((c >> 3) & 7) << 2) | (c & 3) | ((c & 4) << 3); }
    __device__ __forceinline__ void operator()(int row, int col, f32x4 v, const pg8::Unit& u) const {
        const int seg = u.pn >> 1;
        if (seg == 0) st_bf4(QH + (size_t)row * 512 + col, silu4(v) * 0.08838834764831845f);
        else if (seg == 1 || seg == 2) { const int dir = seg - 1, ch = col - seg * 512; *(f32x4*)(LF + (size_t)row * 1024 + dir * 512 + ch) = logf4(v, dir, ch); }
        else if (seg == 3) st_bf4(VH + (size_t)row * 512 + (col - 1536), v);
        else if (seg == 4) st_bf4(RQ + (size_t)row * 512 + rot_dim(col - 2048), v * 0.08838834764831845f);
        else if (seg == 5) st_bf4(RK + (size_t)row * 512 + rot_dim(col - 2560), v);
        else st_bf4(RV + (size_t)row * 1024 + (col - 3072), v);
    }
    __device__ __forceinline__ void apply8(int row, int col, f32x4 v0, f32x4 v1, const R&, const pg8::Unit& u) const {
        const int seg = u.pn >> 1;
        if (seg == 0) st_bf8(QH + (size_t)row * 512 + col, silu4(v0) * 0.08838834764831845f, silu4(v1) * 0.08838834764831845f);
        else if (seg == 1 || seg == 2) { const int dir = seg - 1, ch = col - seg * 512; float* o = LF + (size_t)row * 1024 + dir * 512 + ch; *(f32x4*)o = logf4(v0, dir, ch); *(f32x4*)(o + 4) = logf4(v1, dir, ch + 4); }
        else if (seg == 3) st_bf8(VH + (size_t)row * 512 + (col - 1536), v0, v1);
        else if (seg == 4 || seg == 5) {
            const int c = col - (seg == 4 ? 2048 : 2560), d0 = rot_dim(c), half = (d0 >> 6) & 1, i = d0 & 31;
            const float sc = seg == 4 ? 0.08838834764831845f : 1.f;
            bf16_t* o = (seg == 4 ? RQ : RK) + (size_t)row * 512 + d0;
            if (row >= LC) { const int t = row - LC, pos = half ? (t & 63) : (t >> 6);
                const f32x4 cs0 = *(const f32x4*)(RT + (pos * 32 + i) * 2), cs1 = *(const f32x4*)(RT + (pos * 32 + i) * 2 + 4);
                const f32x4 co = {cs0.x, cs0.z, cs1.x, cs1.z}, si = {cs0.y, cs0.w, cs1.y, cs1.w};
                st_bf4(o, (v0 * co - v1 * si) * sc); st_bf4(o + 32, (v0 * si + v1 * co) * sc); }
            else { st_bf4(o, v0 * sc); st_bf4(o + 32, v1 * sc); } }
        else st_bf8(RV + (size_t)row * 1024 + (col - 3072), v0, v1);
    }
};
struct FnB {
    bf16_t *OHG, *ORT, *GA, *GB;
    static constexpr bool HAS_LOAD = true; typedef u32x4 R;
    __device__ __forceinline__ bf16_t* optr(int row, int col, int pn) const { return pn < 2 ? OHG + (size_t)row * 512 + col : ORT + (size_t)row * 1024 + (col - 512); }
    __device__ __forceinline__ R load8(int row, int col, const pg8::Unit& u) const { if (u.pn < 6) return *(const u32x4*)optr(row, col, u.pn); return (u32x4){0u, 0u, 0u, 0u}; }
    __device__ __forceinline__ void apply8(int row, int col, f32x4 v0, f32x4 v1, const R& r, const pg8::Unit& u) const {
        const int pn = u.pn;
        if (pn < 6) st_bf8(optr(row, col, pn), bf2lo4(r) * silu4(v0), bf2hi4(r) * silu4(v1));
        else st_bf8(pn < 10 ? GA + (size_t)row * 1024 + (col - 1536) : GB + (size_t)row * 1024 + (col - 2560), sigm4(v0), sigm4(v1));
    }
};
__device__ __forceinline__ f32x4 bf4_to_f32(u32x2 q) { return (f32x4){__uint_as_float(q.x << 16), __uint_as_float(q.x & 0xffff0000u), __uint_as_float(q.y << 16), __uint_as_float(q.y & 0xffff0000u)}; }
struct FnM1 { const bf16_t* GA; float* M1;
    static constexpr bool HAS_LOAD = true; typedef u32x4 R;
    __device__ __forceinline__ R load8(int row, int col, const pg8::Unit&) const { return *(const u32x4*)(GA + (size_t)row * D + col); }
    __device__ __forceinline__ void apply8(int row, int col, f32x4 v0, f32x4 v1, const R& r, const pg8::Unit&) const { float* o = M1 + (size_t)row * D + col; *(f32x4*)o = bf2lo4(r) * v0; *(f32x4*)(o + 4) = bf2hi4(r) * v1; }
    __device__ __forceinline__ void operator()(int row, int col, f32x4 v, const pg8::Unit&) const { *(f32x4*)(M1 + (size_t)row * D + col) = bf4_to_f32(*(const u32x2*)(GA + (size_t)row * D + col)) * v; } };
struct RegsM2 { f32x4 m0, m1; u32x4 g; };
struct FnM2 { const bf16_t* GB; const float* M1; bf16_t* MB;
    static constexpr bool HAS_LOAD = true; typedef RegsM2 R;
    __device__ __forceinline__ R load8(int row, int col, const pg8::Unit&) const { R r; const float* m = M1 + (size_t)row * D + col; r.m0 = *(const f32x4*)m; r.m1 = *(const f32x4*)(m + 4); r.g = *(const u32x4*)(GB + (size_t)row * D + col); return r; }
    __device__ __forceinline__ void apply8(int row, int col, f32x4 v0, f32x4 v1, const R& r, const pg8::Unit&) const { st_bf8(MB + (size_t)row * D + col, r.m0 + bf2lo4(r.g) * v0, r.m1 + bf2hi4(r.g) * v1); }
    __device__ __forceinline__ void operator()(int row, int col, f32x4 v, const pg8::Unit&) const { st_bf4(MB + (size_t)row * D + col, *(const f32x4*)(M1 + (size_t)row * D + col) + bf4_to_f32(*(const u32x2*)(GB + (size_t)row * D + col)) * v); } };
struct RegsX { f32x4 x0, x1; };
struct FnX { const float *xc_in, *xl_in; float *xc_out, *xl_out; const float* MODL;
    static constexpr bool HAS_LOAD = true; typedef RegsX R;
    __device__ __forceinline__ R load8(int row, int col, const pg8::Unit&) const { const bool isc = row < LC; const float* x = (isc ? xc_in : xl_in) + (size_t)(isc ? row : row - LC) * D + col; R r; r.x0 = *(const f32x4*)x; r.x1 = *(const f32x4*)(x + 4); return r; }
    __device__ __forceinline__ void apply8(int row, int col, f32x4 v0, f32x4 v1, const R& r, const pg8::Unit&) const {
        const bool isc = row < LC; const float* g = MODL + (isc ? 6144 : 0) + 2 * 1024 + col; float* o = (isc ? xc_out : xl_out) + (size_t)(isc ? row : row - LC) * D + col;
        *(f32x4*)o = r.x0 + *(const f32x4*)g * v0; *(f32x4*)(o + 4) = r.x1 + *(const f32x4*)(g + 4) * v1; }
    __device__ __forceinline__ void operator()(int row, int col, f32x4 v, const pg8::Unit&) const {
        const bool isc = row < LC; const size_t off = (size_t)(isc ? row : row - LC) * D + col;
        *(f32x4*)((isc ? xc_out : xl_out) + off) = *(const f32x4*)((isc ? xc_in : xl_in) + off) + *(const f32x4*)(MODL + (isc ? 6144 : 0) + 2 * 1024 + col) * v; } };

__device__ __forceinline__ void ph_scan_naive(const P& p, int l, MKLAS unsigned char* lds) {
    const int tid = tid_fresh(), lane = tid & 63, wave = tid >> 6;
    MKLAS float* part = (MKLAS float*)lds;
    const bf16_t *QH = WSP(bf16_t, WS_QH), *VH = WSP(bf16_t, WS_VH), *RQ = WSP(bf16_t, WS_RQ), *RK = WSP(bf16_t, WS_RK), *RV = WSP(bf16_t, WS_RV);
    const float *LF = WSP(float, WS_LF), *RT = WSP(float, WS_ROPE), *LG = WSP(float, WS_LGAM);
    float* OF = WSP(float, WS_OF);
    for (int u = blockIdx.x; u < 192; u += gridDim.x) {
        const bool ret = u >= 64; const int h = ret ? (u - 64) / 32 : u / 16, es = ret ? (u - 64) % 32 : u % 16;
        const int d = tid & 127, eg = tid >> 7, e0 = es * 8 + eg * 2;
        const int obase = ret ? 512 + h * 256 + es * 8 : h * 128 + es * 8;
        const bool lower = (d & 63) < 32; const int dp = d ^ 32, ri = d & 31, half = d >> 6;
        for (int dir = 0; dir < 2; ++dir) {
            float S0 = 0.f, S1 = 0.f;
            const float gam = ret ? expf(LG[(l * 2 + dir) * 4 + h]) : 0.f;
            for (int i0 = 0; i0 < L; i0 += 8) {
                float qv[8], kv[8], fv[8], v0[8], v1[8];
#pragma unroll
                for (int s = 0; s < 8; ++s) { const int r = seq_row(dir, i0 + s);
                    if (!ret) { qv[s] = bf2f(QH[(size_t)r * 512 + h * 128 + d]); const float f = fexp(LF[(size_t)r * 1024 + dir * 512 + h * 128 + d]); fv[s] = f; kv[s] = 1.f - f;
                        const unsigned vv = *(const unsigned*)(VH + (size_t)r * 512 + h * 128 + e0); v0[s] = __uint_as_float(vv << 16); v1[s] = __uint_as_float(vv & 0xffff0000u); }
                    else { float q = bf2f(RQ[(size_t)r * 512 + h * 128 + d]), k = bf2f(RK[(size_t)r * 512 + h * 128 + d]);
                        if (r >= LC) { const int t = r - LC, pos = half ? (t & 63) : (t >> 6); const float cs = RT[(pos * 32 + ri) * 2], sn = RT[(pos * 32 + ri) * 2 + 1];
                            const float qp = bf2f(RQ[(size_t)r * 512 + h * 128 + dp]), kp = bf2f(RK[(size_t)r * 512 + h * 128 + dp]);
                            q = q * cs + (lower ? -qp : qp) * sn; k = k * cs + (lower ? -kp : kp) * sn; }
                        qv[s] = q; kv[s] = k; fv[s] = gam;
                        const unsigned vv = *(const unsigned*)(RV + (size_t)r * 1024 + h * 256 + e0); v0[s] = __uint_as_float(vv << 16); v1[s] = __uint_as_float(vv & 0xffff0000u); }
                }
#pragma unroll
                for (int s = 0; s < 8; ++s) { S0 = fv[s] * S0 + kv[s] * v0[s]; S1 = fv[s] * S1 + kv[s] * v1[s];
                    const float p0 = wave_sum(S0 * qv[s]), p1 = wave_sum(S1 * qv[s]);
                    if (lane == 0) { part[(s * 8 + wave) * 2] = p0; part[(s * 8 + wave) * 2 + 1] = p1; } }
                __syncthreads();
                if (tid < 64) { const int s = tid >> 3, egg = (tid >> 1) & 3, j = tid & 1;
                    const float val = part[(s * 8 + 2 * egg) * 2 + j] + part[(s * 8 + 2 * egg + 1) * 2 + j];
                    float* o = OF + (size_t)seq_row(dir, i0 + s) * 1536 + obase + egg * 2 + j;
                    if (dir == 0) *o = val; else *o += val; }
                __syncthreads();
            }
        }
    }
}
__device__ __forceinline__ void ph_onorm(const P& p, int l) {
    const int tid_ = tid_fresh(), lane = tid_ & 63, wave = tid_ >> 6;
    const float* OF = WSP(float, WS_OF); bf16_t *OHG = WSP(bf16_t, WS_OHG), *ORT = WSP(bf16_t, WS_ORT);
    const float *hw = p.in[10] + l * 512, *gw = p.in[12] + l * 1024;
    for (int r = blockIdx.x * NW + wave; r < L; r += gridDim.x * NW) {
        const float* o = OF + (size_t)r * 1536;
#pragma unroll
        for (int h = 0; h < 4; ++h) { const int c = h * 128 + lane * 2; const float a = o[c], b = o[c + 1];
            const float rinv = 1.0f / sqrtf(wave_sum(a * a + b * b) * (1.f / 128.f) + EPS);
            *(unsigned*)(OHG + (size_t)r * 512 + c) = cvt_pk_bf16(a * rinv * hw[c], b * rinv * hw[c + 1]); }
#pragma unroll
        for (int h = 0; h < 4; ++h) { const int c = h * 256 + lane * 4; f32x4 v = *(const f32x4*)(o + 512 + c);
            const float mu = wave_sum((v.x + v.y) + (v.z + v.w)) * (1.f / 256.f); v = v - mu;
            const float rinv = 1.0f / sqrtf(wave_sum((v.x * v.x + v.y * v.y) + (v.z * v.z + v.w * v.w)) * (1.f / 256.f) + EPS);
            st_bf4(ORT + (size_t)r * 1024 + c, v * rinv * *(const f32x4*)(gw + c)); }
    }
}


typedef short bf16x8 __attribute__((ext_vector_type(8)));
typedef short s16x4 __attribute__((ext_vector_type(4)));
#define MFMA16(a, b, c) __builtin_amdgcn_mfma_f32_16x16x32_bf16((a), (b), (c), 0, 0, 0)
constexpr size_t WS_STH = WS_OF, WS_STR = WS_OF + (size_t)8 * 65 * 16384 * 2, WS_ATOT = WS_OF + 49 * MiB;

__device__ __forceinline__ bf16x8 ld_frag_row(const MKLAS bf16_t* tile, int stride, int row0, int k0, int lane) {
    return *(const MKLAS bf16x8*)(tile + (row0 + (lane & 15)) * stride + k0 + 8 * (lane >> 4));
}
__device__ __forceinline__ bf16x8 ld_frag_tr(const MKLAS bf16_t* tile, int stride, int k0, int col0, int lane) {
    const int g = lane >> 4, q = (lane & 15) >> 2, pp = lane & 3;
    const MKLAS bf16_t* a = tile + (k0 + 8 * g + q) * stride + col0 + 4 * pp;
    const s16x4 lo = __builtin_amdgcn_ds_read_tr16_b64_v4i16((MKLAS s16x4*)a), hi = __builtin_amdgcn_ds_read_tr16_b64_v4i16((MKLAS s16x4*)(a + 4 * stride));
    return (bf16x8){lo[0], lo[1], lo[2], lo[3], hi[0], hi[1], hi[2], hi[3]};
}
__device__ __forceinline__ bf16x8 pack8(f32x4 a, f32x4 b) { u32x4 r; r.x = cvt_pk_bf16(a.x, a.y); r.y = cvt_pk_bf16(a.z, a.w); r.z = cvt_pk_bf16(b.x, b.y); r.w = cvt_pk_bf16(b.z, b.w); return __builtin_bit_cast(bf16x8, r); }
__device__ __forceinline__ float bflo(unsigned u) { return __uint_as_float(u << 16); }
__device__ __forceinline__ float bfhi(unsigned u) { return __uint_as_float(u & 0xffff0000u); }
__device__ __forceinline__ u32x4 scale_piece(u32x4 v, float s) { u32x4 r; r.x = cvt_pk_bf16(bflo(v.x) * s, bfhi(v.x) * s); r.y = cvt_pk_bf16(bflo(v.y) * s, bfhi(v.y) * s); r.z = cvt_pk_bf16(bflo(v.z) * s, bfhi(v.z) * s); r.w = cvt_pk_bf16(bflo(v.w) * s, bfhi(v.w) * s); return r; }

__device__ __forceinline__ void ph_rope(const P& p) {
    const int tid_ = tid_fresh(), lane = tid_ & 63, wave = tid_ >> 6;
    const float* RT = WSP(float, WS_ROPE);
    const int d0 = 8 * (lane & 15), half = d0 >> 6, i0 = d0 & 31; const bool lower = (d0 & 63) < 32;
    for (int r = LC + blockIdx.x * NW + wave; r < L; r += gridDim.x * NW) {
        const int t = r - LC, pos = half ? (t & 63) : (t >> 6);
        const f32x4* cs = (const f32x4*)(RT + (pos * 32 + i0) * 2);
        const f32x4 c0 = cs[0], c1 = cs[1], c2 = cs[2], c3 = cs[3];
        const float co[8] = {c0.x, c0.z, c1.x, c1.z, c2.x, c2.z, c3.x, c3.z}, si[8] = {c0.y, c0.w, c1.y, c1.w, c2.y, c2.w, c3.y, c3.w};
#pragma unroll
        for (int which = 0; which < 2; ++which) {
            u32x4* ptr = (u32x4*)((which ? WSP(bf16_t, WS_RK) : WSP(bf16_t, WS_RQ)) + (size_t)r * 512) + lane;
            const u32x4 v = *ptr; u32x4 pv;
            pv.x = __shfl_xor(v.x, 4); pv.y = __shfl_xor(v.y, 4); pv.z = __shfl_xor(v.z, 4); pv.w = __shfl_xor(v.w, 4);
            const unsigned vv[4] = {v.x, v.y, v.z, v.w}, pp[4] = {pv.x, pv.y, pv.z, pv.w}; unsigned oo[4];
#pragma unroll
            for (int k = 0; k < 4; ++k) {
                const float x0 = bflo(vv[k]), x1 = bfhi(vv[k]), q0 = bflo(pp[k]), q1 = bfhi(pp[k]);
                const float y0 = x0 * co[2 * k] + (lower ? -q0 : q0) * si[2 * k], y1 = x1 * co[2 * k + 1] + (lower ? -q1 : q1) * si[2 * k + 1];
                oo[k] = cvt_pk_bf16(y0, y1); }
            u32x4 o; o.x = oo[0]; o.y = oo[1]; o.z = oo[2]; o.w = oo[3]; *ptr = o;
        }
    }
}

template <bool RET, int MODE>
__device__ __forceinline__ void scan_unit(const P& p, int l, int h, int c, int dir, MKLAS unsigned char* lds, bool zero_init = false) {
    constexpr int C = RET ? 64 : 32, NCH = 256 / C, NET = RET ? 2 : 1, DV = RET ? 256 : 128, QS = 136, VS = DV + 8, PS = C + 8, NTT = C / 16, NKS2 = C / 32;
    const int tid = tid_fresh(), lane = tid & 63, w = __builtin_amdgcn_readfirstlane(tid >> 6), r16 = lane & 15, quad = lane >> 4;
    MKLAS bf16_t* Qn = (MKLAS bf16_t*)lds; MKLAS bf16_t* Kn = Qn + C * QS; MKLAS bf16_t* Vn = Kn + C * QS; MKLAS bf16_t* Pm = Vn + C * VS;
    MKLAS float* TOT = (MKLAS float*)(Pm + C * PS); MKLAS float* E12 = TOT + 512; MKLAS float* RED = E12 + 256; MKLAS float* DQK = RED + 1024;
    const int e0 = 16 * NET * w, row0 = 256 * c, chain = dir * 4 + h;
    const bf16_t* Qg = RET ? WSP(bf16_t, WS_RQ) + h * 128 : WSP(bf16_t, WS_QH) + h * 128;
    const bf16_t* Kg = WSP(bf16_t, WS_RK) + h * 128;
    const bf16_t* Vg = RET ? WSP(bf16_t, WS_RV) + h * 256 : WSP(bf16_t, WS_VH) + h * 128;
    const float* LFg = WSP(float, WS_LF) + dir * 512 + h * 128;
    bf16_t* ST = RET ? WSP(bf16_t, WS_STR) + (((size_t)chain * 65 + c) << 15) : WSP(bf16_t, WS_STH) + (((size_t)chain * 65 + c) << 14);
    const float lg = RET ? WSP(float, WS_LGAM)[(l * 2 + dir) * 4 + h] : 0.f;
    if (RET && tid < 64) { DQK[2 * tid] = fexp((float)(tid + 1) * lg); DQK[2 * tid + 1] = fexp(-(float)(tid + 1) * lg); }
    const float e2s = RET ? fexp((float)C * lg) : 1.f;

    f32x4 Sacc[8][NET];
#pragma unroll
    for (int i = 0; i < 8; ++i)
#pragma unroll
        for (int n = 0; n < NET; ++n) {
            if (MODE == 0 || zero_init) Sacc[i][n] = (f32x4){0.f, 0.f, 0.f, 0.f};
            else { const u32x2 q = *(const u32x2*)(ST + (size_t)(e0 + 16 * n + r16) * 128 + 16 * i + 4 * quad); Sacc[i][n] = (f32x4){bflo(q.x), bfhi(q.x), bflo(q.y), bfhi(q.y)}; }
        }
    float btot = 0.f;
    float lfv[8]; unsigned short qv[8]; u32x4 hv = {0, 0, 0, 0};
    u32x4 qp[2], kp[2], vp[4];
    const int hd = tid & 127, hseg = tid >> 7;
#define TOKROW(pos) (row0 + (dir ? 255 - (pos) : (pos)))
#define LOAD_CHUNK(j) do { \
        if (!RET) { _Pragma("unroll") for (int ii = 0; ii < 8; ++ii) { const size_t rr = (size_t)TOKROW(C * (j) + 8 * hseg + ii); lfv[ii] = LFg[rr * 1024 + hd]; if (MODE != 0) qv[ii] = Qg[rr * 512 + hd]; } \
            { const size_t rr = (size_t)TOKROW(C * (j) + (tid >> 4)); hv = *(const u32x4*)(Vg + rr * 512 + 8 * (tid & 15)); } } \
        else { _Pragma("unroll") for (int m = 0; m < 2; ++m) { const int pc = tid + 512 * m; const size_t rr = (size_t)TOKROW(C * (j) + (pc >> 4)); \
                if (MODE != 0) qp[m] = *(const u32x4*)(Qg + rr * 512 + 8 * (pc & 15)); kp[m] = *(const u32x4*)(Kg + rr * 512 + 8 * (pc & 15)); } \
            _Pragma("unroll") for (int m = 0; m < 4; ++m) { const int pc = tid + 512 * m; const size_t rr = (size_t)TOKROW(C * (j) + (pc >> 5)); vp[m] = *(const u32x4*)(Vg + rr * 1024 + 8 * (pc & 31)); } } \
    } while (0)
    LOAD_CHUNK(0);
    if (MODE != 0) { for (int i = tid; i < C * PS / 8; i += NT) ((MKLAS u32x4*)Pm)[i] = (u32x4){0u, 0u, 0u, 0u}; }
    __syncthreads();
    for (int j = 0; j < NCH; ++j) {
        if (!RET) {
            float pl[8]; float run = 0.f;
#pragma unroll
            for (int ii = 0; ii < 8; ++ii) { run += lfv[ii]; pl[ii] = run; }
            TOT[hseg * 128 + hd] = run;
            __syncthreads();
            const float t0 = TOT[hd], t1 = TOT[128 + hd], t2 = TOT[256 + hd], t3 = TOT[384 + hd];
            const float off = hseg == 0 ? 0.f : (hseg == 1 ? t0 : (hseg == 2 ? t0 + t1 : t0 + t1 + t2));
            const float rref = t0 + t1, blast = (t0 + t1) + (t2 + t3);
#pragma unroll
            for (int ii = 0; ii < 8; ++ii) { const int pos = 8 * hseg + ii; const float b = off + pl[ii];
                const float kk = 1.f - fexp(lfv[ii]);
                Kn[pos * QS + hd] = f2bf(kk * fexp(fminf(rref - b, 60.f)));
                if (MODE != 0) Qn[pos * QS + hd] = f2bf(bf2f(qv[ii]) * fexp(fminf(b - rref, 60.f))); }
            if (hseg == 0) { E12[hd] = fexp(rref); E12[128 + hd] = fexp(blast - rref); btot += blast; }
            *(MKLAS u32x4*)(Vn + (tid >> 4) * VS + 8 * (tid & 15)) = hv;
        } else {
#pragma unroll
            for (int m = 0; m < 2; ++m) { const int pc = tid + 512 * m, pos = pc >> 4;
                *(MKLAS u32x4*)(Kn + pos * QS + 8 * (pc & 15)) = scale_piece(kp[m], DQK[2 * pos + 1]);
                if (MODE != 0) *(MKLAS u32x4*)(Qn + pos * QS + 8 * (pc & 15)) = scale_piece(qp[m], DQK[2 * pos]); }
#pragma unroll
            for (int m = 0; m < 4; ++m) { const int pc = tid + 512 * m; *(MKLAS u32x4*)(Vn + (pc >> 5) * VS + 8 * (pc & 31)) = vp[m]; }
        }
        if (j + 1 < NCH) LOAD_CHUNK(j + 1);
        __syncthreads();
        if (MODE != 0) {
            constexpr int NTILE = NTT * (NTT + 1) / 2;
#pragma unroll
            for (int rep = 0; rep < (NTILE + 7) / 8; ++rep) {
                const int q = w + 8 * rep;
                if (q < NTILE) {
                    int tt = 0, st = q;
#pragma unroll
                    for (int z = 1; z < NTT; ++z) if (q >= z * (z + 1) / 2) { tt = z; st = q - z * (z + 1) / 2; }
                    f32x4 sc = {0.f, 0.f, 0.f, 0.f};
#pragma unroll
                    for (int ks = 0; ks < 4; ++ks) sc = MFMA16(ld_frag_row(Qn, QS, 16 * tt, 32 * ks, lane), ld_frag_row(Kn, QS, 16 * st, 32 * ks, lane), sc);
#pragma unroll
                    for (int jj = 0; jj < 4; ++jj) { const bool keep = (st < tt) || (r16 <= 4 * quad + jj); Pm[(16 * tt + 4 * quad + jj) * PS + 16 * st + r16] = f2bf(keep ? sc[jj] : 0.f); }
                }
            }
            __syncthreads();
        }
        bf16x8 Vf[NKS2][NET];
#pragma unroll
        for (int k2 = 0; k2 < NKS2; ++k2)
#pragma unroll
            for (int n = 0; n < NET; ++n) Vf[k2][n] = ld_frag_tr(Vn, VS, 32 * k2, e0 + 16 * n, lane);
        if (!RET) {
#pragma unroll
            for (int i = 0; i < 8; ++i) { const f32x4 e1 = *(const MKLAS f32x4*)(E12 + 16 * i + 4 * quad);
#pragma unroll
                for (int n = 0; n < NET; ++n) Sacc[i][n] = Sacc[i][n] * e1; }
        }
        f32x4 oacc[NTT][NET];
        if (MODE != 0) {
#pragma unroll
            for (int tt = 0; tt < NTT; ++tt)
#pragma unroll
                for (int n = 0; n < NET; ++n) oacc[tt][n] = (f32x4){0.f, 0.f, 0.f, 0.f};
#pragma unroll
            for (int ks = 0; ks < 4; ++ks) {
                bf16x8 Bf[NET];
#pragma unroll
                for (int n = 0; n < NET; ++n) Bf[n] = pack8(Sacc[2 * ks][n], Sacc[2 * ks + 1][n]);
#pragma unroll
                for (int tt = 0; tt < NTT; ++tt) {
                    const MKLAS bf16_t* qa = Qn + (16 * tt + r16) * QS + 32 * ks + 4 * quad;
                    const s16x4 a0 = *(const MKLAS s16x4*)qa, a1 = *(const MKLAS s16x4*)(qa + 16);
                    const bf16x8 Af = (bf16x8){a0[0], a0[1], a0[2], a0[3], a1[0], a1[1], a1[2], a1[3]};
#pragma unroll
                    for (int n = 0; n < NET; ++n) oacc[tt][n] = MFMA16(Bf[n], Af, oacc[tt][n]);
                }
            }
#pragma unroll
            for (int k2 = 0; k2 < NKS2; ++k2)
#pragma unroll
                for (int tt = 0; tt < NTT; ++tt) {
                    if (32 * k2 > 16 * tt + 15) continue;
                    const bf16x8 Af = ld_frag_row(Pm, PS, 16 * tt, 32 * k2, lane);
#pragma unroll
                    for (int n = 0; n < NET; ++n) oacc[tt][n] = MFMA16(Vf[k2][n], Af, oacc[tt][n]);
                }
        }
#pragma unroll
        for (int i = 0; i < 8; ++i)
#pragma unroll
            for (int k2 = 0; k2 < NKS2; ++k2) { const bf16x8 Af = ld_frag_tr(Kn, QS, 32 * k2, 16 * i, lane);
#pragma unroll
                for (int n = 0; n < NET; ++n) Sacc[i][n] = MFMA16(Af, Vf[k2][n], Sacc[i][n]); }
#pragma unroll
        for (int i = 0; i < 8; ++i) { f32x4 e2; if (!RET) e2 = *(const MKLAS f32x4*)(E12 + 128 + 16 * i + 4 * quad); else e2 = (f32x4){e2s, e2s, e2s, e2s};
#pragma unroll
            for (int n = 0; n < NET; ++n) Sacc[i][n] = Sacc[i][n] * e2; }
        if (MODE != 0) {
            bf16_t* Og = (RET ? WSP(bf16_t, WS_ORT) + h * 256 : WSP(bf16_t, WS_OHG) + h * 128) + e0 + 4 * quad;
            constexpr int OS = RET ? 1024 : 512;
            if (MODE == 1) {
#pragma unroll
                for (int tt = 0; tt < NTT; ++tt) { const size_t rr = (size_t)TOKROW(C * j + 16 * tt + r16);
#pragma unroll
                    for (int n = 0; n < NET; ++n) st_bf4(Og + rr * OS + 16 * n, oacc[tt][n]); }
            } else {
#pragma unroll
                for (int tt = 0; tt < NTT; ++tt) { float s1 = 0.f, s2 = 0.f; const size_t rb = (size_t)TOKROW(C * j + 16 * tt + r16);
#pragma unroll
                    for (int n = 0; n < NET; ++n) { const u32x2 obv = *(const u32x2*)(Og + rb * OS + 16 * n); const f32x4 v = oacc[tt][n] + (f32x4){bflo(obv.x), bfhi(obv.x), bflo(obv.y), bfhi(obv.y)}; oacc[tt][n] = v;
                        s1 += (v.x + v.y) + (v.z + v.w); s2 += (v.x * v.x + v.y * v.y) + (v.z * v.z + v.w * v.w); }
                    s1 += __shfl_xor(s1, 16); s2 += __shfl_xor(s2, 16); s1 += __shfl_xor(s1, 32); s2 += __shfl_xor(s2, 32);
                    if (quad == 0) { RED[(w * 64 + 16 * tt + r16) * 2] = s1; RED[(w * 64 + 16 * tt + r16) * 2 + 1] = s2; } }
                __syncthreads();
                const float* nw = (RET ? p.in[12] + l * 1024 + h * 256 : p.in[10] + l * 512 + h * 128) + e0 + 4 * quad;
#pragma unroll
                for (int tt = 0; tt < NTT; ++tt) { const int tpos = 16 * tt + r16; const size_t rr = (size_t)TOKROW(C * j + tpos); float s1 = 0.f, s2 = 0.f;
#pragma unroll
                    for (int ww = 0; ww < 8; ++ww) { const f32x2 q = *(const MKLAS f32x2*)(RED + (ww * 64 + tpos) * 2); s1 += q.x; s2 += q.y; }
                    const float mean = RET ? s1 * (1.f / 256.f) : 0.f;
                    const float var = RET ? fmaxf(s2 * (1.f / 256.f) - mean * mean, 0.f) : s2 * (1.f / 128.f);
                    const float rinv = 1.0f / sqrtf(var + EPS);
#pragma unroll
                    for (int n = 0; n < NET; ++n) st_bf4(Og + rr * OS + 16 * n, (oacc[tt][n] - mean) * rinv * *(const f32x4*)(nw + 16 * n)); }
            }
        }
        if (RET) __syncthreads();
    }
    if (MODE == 0) {
#pragma unroll
        for (int i = 0; i < 8; ++i)
#pragma unroll
            for (int n = 0; n < NET; ++n) { u32x2 q; q.x = cvt_pk_bf16(Sacc[i][n].x, Sacc[i][n].y); q.y = cvt_pk_bf16(Sacc[i][n].z, Sacc[i][n].w);
                *(u32x2*)(ST + (size_t)(e0 + 16 * n + r16) * 128 + 16 * i + 4 * quad) = q; }
        if (!RET && hseg == 0) WSP(float, WS_ATOT)[((size_t)chain * 65 + c) * 128 + hd] = fexp(btot);
    }
#undef LOAD_CHUNK
#undef TOKROW
}

__device__ __forceinline__ int next_unit(unsigned* ctr, volatile MKLAS int* slot) {
    __syncthreads();
    if (threadIdx.x == 0) *slot = (int)__hip_atomic_fetch_add(ctr, 1u, __ATOMIC_RELAXED, __HIP_MEMORY_SCOPE_AGENT);
    __syncthreads();
    return *slot;
}
__device__ __forceinline__ void ph_scan_pass1(const P& p, int l, MKLAS unsigned char* lds, unsigned* ctr, volatile MKLAS int* slot) {
    const int nctx = (l == DEPTH - 1) ? 0 : 8;
    for (;;) { const int u0 = next_unit(ctr, slot); if (u0 >= 1040 + nctx) break;
        if (u0 < nctx) { const int h = u0 & 3;
            if (u0 < 4) { scan_unit<true, 1>(p, l, h, 0, 1, lds, true); __syncthreads(); scan_unit<true, 2>(p, l, h, 0, 0, lds, true); }
            else { scan_unit<false, 1>(p, l, h, 0, 1, lds, true); __syncthreads(); scan_unit<false, 2>(p, l, h, 0, 0, lds, true); }
            continue; }
        const int u = u0 - nctx;
        const bool ret = u < 520; const int v = ret ? u : u - 520, dir = v / 260, rem = v % 260, h = rem / 65, c = rem % 65;
        if (ret) scan_unit<true, 0>(p, l, h, c, dir, lds); else scan_unit<false, 0>(p, l, h, c, dir, lds); }
}
template <int MODE> __device__ __forceinline__ void ph_scan_pass3(const P& p, int l, MKLAS unsigned char* lds, unsigned* ctr, volatile MKLAS int* slot) {
    for (;;) { const int u = next_unit(ctr, slot); if (u >= 512) break;
        const bool ret = u < 256; const int v = ret ? u : u - 256, h = v >> 6, c = (v & 63) + 1;
        if (ret) scan_unit<true, MODE>(p, l, h, c, MODE == 1 ? 1 : 0, lds); else scan_unit<false, MODE>(p, l, h, c, MODE == 1 ? 1 : 0, lds); }
}
__device__ __forceinline__ void ph_scan_pass2(const P& p, int l) {
    const int tid = tid_fresh();
    const float* LG = WSP(float, WS_LGAM); const float* AT = WSP(float, WS_ATOT);
    for (int item = blockIdx.x * NT + tid; item < 32768 + 65536; item += gridDim.x * NT) {
        const bool ret = item >= 32768; const int it = ret ? item - 32768 : item, per = ret ? 8192 : 4096, chain = it / per, q4 = it % per, dir = chain >> 2, h = chain & 3, dd = (q4 * 4) & 127;
        bf16_t* base = (ret ? WSP(bf16_t, WS_STR) : WSP(bf16_t, WS_STH)) + (size_t)chain * 65 * (per * 4) + (size_t)q4 * 4;
        const float ar = ret ? fexp(256.f * LG[(l * 2 + dir) * 4 + h]) : 0.f;
        f32x4 S = {0.f, 0.f, 0.f, 0.f};
        for (int b0 = 0; b0 < 65; b0 += 13) {
            u32x2 U[13]; f32x4 A[13];
#pragma unroll
            for (int s = 0; s < 13; ++s) { const int step = b0 + s, c = dir == 0 ? step : (step == 0 ? 0 : 65 - step);
                U[s] = *(const u32x2*)(base + (size_t)c * (per * 4));
                A[s] = ret ? (f32x4){ar, ar, ar, ar} : *(const f32x4*)(AT + ((size_t)chain * 65 + c) * 128 + dd); }
#pragma unroll
            for (int s = 0; s < 13; ++s) { const int step = b0 + s, c = dir == 0 ? step : (step == 0 ? 0 : 65 - step);
                u32x2 o; o.x = cvt_pk_bf16(S.x, S.y); o.y = cvt_pk_bf16(S.z, S.w); *(u32x2*)(base + (size_t)c * (per * 4)) = o;
                S = A[s] * S + (f32x4){bflo(U[s].x), bfhi(U[s].x), bflo(U[s].y), bfhi(U[s].y)}; }
        }
    }
}

__device__ __forceinline__ void ph_router(const P& p, int l, MKLAS unsigned char* lds, unsigned* ecnt) {
    const int tid = tid_fresh(), lane = tid & 63, w = __builtin_amdgcn_readfirstlane(tid >> 6), r16 = lane & 15, g = lane >> 4;
    MKLAS float* ssum = (MKLAS float*)lds;
    MKLAS float* plog = ssum + 128;
    MKLAS float* lg = plog + 8 * 16 * 52;
    const float* MOD = WSP(float, WS_MOD); bf16_t* H = WSP(bf16_t, WS_H);
    int* AE = WSP(int, WS_AE); float* AW = WSP(float, WS_AW); int* APOS = WSP(int, WS_APOS); int* TOK = WSP(int, WS_TOK);
    const int cb = 128 * w + 4 * g;
    const float* nw = p.in[7] + l * D + cb;
    const float* WRT = WSP(float, WS_WRT) + (size_t)l * 48 * 1024 + (size_t)r16 * 1024 + cb;
    const float *bg = p.in[17] + l * 4, *be = p.in[19] + l * NE;
    const int r_lo = (l == DEPTH - 1) ? LC : 0, ntile = (L - r_lo) / 16;
    for (int t = blockIdx.x; t < ntile; t += gridDim.x) {
        const int r = r_lo + 16 * t + r16;
        const float* xr = xrow_st(p, r) + cb;
        const float* mod = MOD + (l * 2 + (r < LC ? 1 : 0)) * 6144 + cb;
        f32x4 x[8]; float ss = 0.f;
#pragma unroll
        for (int m = 0; m < 8; ++m) { x[m] = *(const f32x4*)(xr + 16 * m); ss += (x[m].x * x[m].x + x[m].y * x[m].y) + (x[m].z * x[m].z + x[m].w * x[m].w); }
        ss += __shfl_xor(ss, 16); ss += __shfl_xor(ss, 32);
        if (g == 0) ssum[w * 16 + r16] = ss;
        __syncthreads();
        float tot = 0.f;
#pragma unroll
        for (int ww = 0; ww < 8; ++ww) tot += ssum[ww * 16 + r16];
        const float rinv = 1.0f / sqrtf(tot * (1.f / D) + EPS);
        f32x4 acc[3];
#pragma unroll
        for (int nt = 0; nt < 3; ++nt) acc[nt] = (f32x4){0.f, 0.f, 0.f, 0.f};
        bf16_t* ho = H + (size_t)r * D + cb;
#pragma unroll
        for (int m = 0; m < 8; ++m) {
            const f32x4 wv = *(const f32x4*)(nw + 16 * m), sh = *(const f32x4*)(mod + 3 * 1024 + 16 * m), sc = *(const f32x4*)(mod + 4 * 1024 + 16 * m);
            const f32x4 h = x[m] * rinv * wv * (sc + 1.0f) + sh;
            st_bf4(ho + 16 * m, h);
#pragma unroll
            for (int nt = 0; nt < 3; ++nt) { const f32x4 b = *(const f32x4*)(WRT + (size_t)nt * 16 * 1024 + 16 * m);
#pragma unroll
                for (int j = 0; j < 4; ++j) acc[nt] = __builtin_amdgcn_mfma_f32_16x16x4f32(h[j], b[j], acc[nt], 0, 0, 0); }
        }
#pragma unroll
        for (int nt = 0; nt < 3; ++nt)
#pragma unroll
            for (int j = 0; j < 4; ++j) plog[(w * 16 + 4 * g + j) * 52 + 16 * nt + r16] = acc[nt][j];
        __syncthreads();
        { const int row = tid >> 5, col = tid & 31; float a = 0.f;
#pragma unroll
            for (int ww = 0; ww < 8; ++ww) a += plog[(ww * 16 + row) * 52 + col];
            lg[row * 52 + col] = a;
            if (tid < 64) { const int row2 = tid >> 2, col2 = 32 + (tid & 3); float a2 = 0.f;
#pragma unroll
                for (int ww = 0; ww < 8; ++ww) a2 += plog[(ww * 16 + row2) * 52 + col2];
                lg[row2 * 52 + col2] = a2; } }
        __syncthreads();
        if (tid < 16) {
            const MKLAS float* my = lg + tid * 52;
            float gl[4];
#pragma unroll
            for (int q = 0; q < 4; ++q) gl[q] = my[32 + q] + bg[q];
            int grp = 0; float gm = gl[0];
#pragma unroll
            for (int q = 1; q < 4; ++q) if (gl[q] > gm) { gm = gl[q]; grp = q; }
            float gs = 0.f;
#pragma unroll
            for (int q = 0; q < 4; ++q) gs += expf(gl[q] - gm);
            const float gval = 1.0f / gs;
            float el[8];
#pragma unroll
            for (int j = 0; j < 8; ++j) el[j] = my[grp * 8 + j] + be[grp * 8 + j];
            int i1 = 0; float v1 = el[0];
#pragma unroll
            for (int j = 1; j < 8; ++j) if (el[j] > v1) { v1 = el[j]; i1 = j; }
            int i2 = -1; float v2 = -3.0e38f;
#pragma unroll
            for (int j = 0; j < 8; ++j) if (j != i1 && el[j] > v2) { v2 = el[j]; i2 = j; }
            const float e2 = expf(v2 - v1), w1 = 1.0f / (1.0f + e2), w2 = e2 / (1.0f + e2);
            const int ea0 = grp * 8 + i1, ea1 = grp * 8 + i2, rr = r_lo + 16 * t + tid;
            AE[2 * rr] = ea0; AE[2 * rr + 1] = ea1; AW[2 * rr] = gval * w1; AW[2 * rr + 1] = gval * w2;
            const int p0 = (int)__hip_atomic_fetch_add(ecnt + 16 * ea0, 1u, __ATOMIC_RELAXED, __HIP_MEMORY_SCOPE_AGENT);
            const int p1 = (int)__hip_atomic_fetch_add(ecnt + 16 * ea1, 1u, __ATOMIC_RELAXED, __HIP_MEMORY_SCOPE_AGENT);
            APOS[2 * rr] = p0; APOS[2 * rr + 1] = p1; TOK[(size_t)ea0 * L + p0] = rr; TOK[(size_t)ea1 * L + p1] = rr;
        }
    }
}
constexpr int XG_ROWS = 41472;
constexpr size_t WS_WGU = WS_OF, WS_WD = WS_OF + 32 * MiB;
constexpr size_t WS_XG = WS_QH, WS_ACT = WS_XG + (size_t)XG_ROWS * 2048, WS_YA = 160 * MiB;
static_assert(WS_ACT + (size_t)XG_ROWS * 512 <= WS_YA && WS_YA + (size_t)XG_ROWS * 2048 <= WS_OF, "MoE overlays");
constexpr int EXPERT_ITEMS = 3 * 2048;
__device__ __forceinline__ void expert_item(const P& p, int l, int it, MKLAS float* tile) {
    const int which = it >> 11, r = it & 2047, e = r >> 6, q = r & 63;
    if (which < 2) { const int kb = q >> 2, nb = q & 3, n0 = nb * 64;
        tr_item(p.in[20 + which] + ((size_t)l * NE + e) * D * DE, D, DE, WSP(bf16_t, WS_WGU) + (size_t)e * 512 * D, kb * 64, n0, (n0 >> 7) * 256 + which * 128 + (n0 & 127), tile); }
    else { const int kb = q >> 4, nb = q & 15;
        tr_item(p.in[22] + ((size_t)l * NE + e) * DE * D, DE, D, WSP(bf16_t, WS_WD) + (size_t)e * D * DE, kb * 64, nb * 64, nb * 64, tile); }
}
template <bool EXPERTS> __device__ __forceinline__ void fill_convert(const P& p, int l, MKLAS unsigned char* lds, unsigned* ctr, volatile MKLAS int* slot) {
    for (;;) { const int it = next_unit(ctr, slot); if (it >= (EXPERTS ? EXPERT_ITEMS : MIXER_ITEMS)) break;
        if (EXPERTS) expert_item(p, l, it, (MKLAS float*)lds); else mixer_item(p, l, it, (MKLAS float*)lds); }
}
constexpr int MOE_TAB = LDS_CTL_OFF + 64;
__device__ __forceinline__ void moe_tables(const P& p, int l, MKLAS unsigned char* lds, bool publish) {
    MKLAS int* off = (MKLAS int*)(lds + MOE_TAB); MKLAS int* cnt = off + 64; MKLAS int* te = off + 96;
    const unsigned* ecnt = (const unsigned*)(p.ws + WS_CTL) + CW_ECNT + l * NE * 16;
    const int tid = tid_fresh();
    __syncthreads();
    if (tid == 0) { int o = 0; for (int e = 0; e < NE; ++e) { const int c = (int)__hip_atomic_load(ecnt + 16 * e, __ATOMIC_RELAXED, __HIP_MEMORY_SCOPE_AGENT); off[e] = o; cnt[e] = c; o += (c + 255) & ~255; } off[NE] = o; off[NE + 1] = o >> 8; }
    __syncthreads();
    const int nt = off[NE + 1];
    for (int t = tid; t < nt; t += NT) { int e = 0; for (int k = 1; k < NE; ++k) if (t * 256 >= off[k]) e = k; te[t] = e; }
    __syncthreads();
    if (publish && blockIdx.x == 0) { int* TE = WSP(int, WS_TILEE); if (tid == 0) TE[255] = nt; for (int t = tid; t < nt; t += NT) TE[t] = te[t]; }
}
struct MoeOrder { static constexpr bool GATHER = false; const int* tile_e; int ntiles, nN, G, c;
    __device__ __forceinline__ bool next(int i, pg8::Unit& u) const { const long Lx = (long)i * G + c; if (Lx >= (long)ntiles * nN) return false; u.pm = (int)(Lx / nN); u.pn = (int)(Lx % nN); u.be = tile_e[u.pm]; return true; }
    __device__ __forceinline__ void a_ready(const pg8::Unit&) const {}
    __device__ __forceinline__ void done(const pg8::Unit&) const {} };
struct MoeGatherOrder { static constexpr bool GATHER = true; const MKLAS int* off; const MKLAS int* cnt; const MKLAS int* te; const int* tok; int ntiles, nN, G, c;
    __device__ __forceinline__ bool next(int i, pg8::Unit& u) const { const long Lx = (long)i * G + c; if (Lx >= (long)ntiles * nN) return false; u.pm = (int)(Lx / nN); u.pn = (int)(Lx % nN); u.be = te[u.pm]; return true; }
    __device__ __forceinline__ unsigned row_byte_off(const pg8::Unit& u, int r) const { const int pos = 256 * u.pm - off[u.be] + r; const int t = pos < cnt[u.be] ? tok[(size_t)u.be * L + pos] : 0; return (unsigned)t * (unsigned)(D * 2); }
    __device__ __forceinline__ void a_ready(const pg8::Unit&) const {}
    __device__ __forceinline__ void done(const pg8::Unit&) const {} };
struct EpiGU { static constexpr bool PERM = true, AFTER_DRAIN = false; bf16_t* ACT;
    __device__ __forceinline__ void operator()(const f32x4 (&acc)[2][2][4][2], const pg8::Unit& u, int wr, int wc, int fr, int fq) const {
        const int row0 = u.pm * 256 + wr * 64 + fr, col0 = u.pn * 128 + wc * 32 + 8 * fq;
#pragma unroll
        for (int ai = 0; ai < 2; ++ai)
#pragma unroll
            for (int m = 0; m < 4; ++m) st_bf8(ACT + (size_t)(row0 + ai * 128 + m * 16) * DE + col0, silu4(acc[ai][0][m][0]) * acc[ai][1][m][0], silu4(acc[ai][0][m][1]) * acc[ai][1][m][1]);
    } };
struct FnYA { bf16_t* YA;
    static constexpr bool HAS_LOAD = false; typedef NoRegs R;
    __device__ __forceinline__ void apply8(int row, int col, f32x4 v0, f32x4 v1, const R&, const pg8::Unit&) const { st_bf8(YA + (size_t)row * D + col, v0, v1); } };
__device__ __forceinline__ void ph_moe_combine(const P& p, int l, MKLAS unsigned char* lds) {
    moe_tables(p, l, lds, false);
    const MKLAS int* off = (const MKLAS int*)(lds + MOE_TAB);
    const int tid_ = tid_fresh(), lane = tid_ & 63, wave = tid_ >> 6;
    const float* MOD = WSP(float, WS_MOD); const bf16_t* YA = WSP(bf16_t, WS_YA); bf16_t* H = WSP(bf16_t, WS_H);
    const int* AE = WSP(int, WS_AE); const int* APOS = WSP(int, WS_APOS); const float* AW = WSP(float, WS_AW);
    const bool last = (l == DEPTH - 1);
    const float* nw = last ? p.in[23] : p.in[6] + (l + 1) * D;
    for (int r = (last ? LC : 0) + blockIdx.x * NW + wave; r < L; r += gridDim.x * NW) {
        const int isc = r < LC ? 1 : 0;
        const float* g2 = MOD + (l * 2 + isc) * 6144 + 5 * 1024;
        float* xo = xrow_st(p, r);
        const int sa = off[AE[2 * r]] + APOS[2 * r], sb = off[AE[2 * r + 1]] + APOS[2 * r + 1]; const float wa = AW[2 * r], wb = AW[2 * r + 1];
        const u32x2* ya = (const u32x2*)(YA + (size_t)sa * D) + lane; const u32x2* yb = (const u32x2*)(YA + (size_t)sb * D) + lane;
        f32x4 v[4]; float ss = 0.f;
#pragma unroll
        for (int j = 0; j < 4; ++j) { const int c = 4 * (lane + 64 * j); const u32x2 a = ya[64 * j], b = yb[64 * j];
            const f32x4 y = (f32x4){wa * bflo(a.x) + wb * bflo(b.x), wa * bfhi(a.x) + wb * bfhi(b.x), wa * bflo(a.y) + wb * bflo(b.y), wa * bfhi(a.y) + wb * bfhi(b.y)};
            v[j] = *(const f32x4*)(xo + c) + *(const f32x4*)(g2 + c) * y;
            ss += (v[j].x * v[j].x + v[j].y * v[j].y) + (v[j].z * v[j].z + v[j].w * v[j].w); }
        const float rinv = 1.0f / sqrtf(wave_sum(ss) * (1.f / D) + EPS);
        if (last) {
#pragma unroll
            for (int j = 0; j < 4; ++j) { const int c = 4 * (lane + 64 * j); *(f32x4*)(xo + c) = v[j] * rinv * *(const f32x4*)(nw + c); }
        } else {
            const float* mod = MOD + ((l + 1) * 2 + isc) * 6144;
            u32x2* o = (u32x2*)(H + (size_t)r * D) + lane;
#pragma unroll
            for (int j = 0; j < 4; ++j) { const int c = 4 * (lane + 64 * j); *(f32x4*)(xo + c) = v[j];
                const f32x4 hh = v[j] * rinv * *(const f32x4*)(nw + c) * (*(const f32x4*)(mod + 1024 + c) + 1.0f) + *(const f32x4*)(mod + c);
                u32x2 q; q.x = cvt_pk_bf16(hh.x, hh.y); q.y = cvt_pk_bf16(hh.z, hh.w); o[64 * j] = q; }
        }
    }
}

__device__ __forceinline__ void ph_moe_naive(const P& p, int l, MKLAS unsigned char* lds) {
    const int tid = tid_fresh();
    MKLAS float* hs = (MKLAS float*)lds; MKLAS float* gu = hs + 1024; MKLAS float* act = gu + 512;
    const float* MOD = WSP(float, WS_MOD); const bf16_t* H = WSP(bf16_t, WS_H);
    const int* AE = WSP(int, WS_AE); const float* AW = WSP(float, WS_AW);
    const int r_lo = (l == DEPTH - 1) ? LC : 0;
    for (int r = r_lo + blockIdx.x; r < L; r += gridDim.x) {
        for (int i = tid; i < 1024; i += NT) hs[i] = bf2f(H[(size_t)r * D + i]);
        __syncthreads();
        float y0 = 0.f, y1 = 0.f;
        for (int k = 0; k < 2; ++k) {
            const int e = AE[2 * r + k]; const float w = AW[2 * r + k];
            const float* Wx = (tid < 256 ? p.in[20] : p.in[21]) + ((size_t)l * NE + e) * D * DE + (tid & 255);
            float a = 0.f;
#pragma unroll 8
            for (int dd = 0; dd < D; ++dd) a += hs[dd] * Wx[(size_t)dd * DE];
            gu[tid] = a;
            __syncthreads();
            if (tid < 256) act[tid] = siluf(gu[tid]) * gu[256 + tid];
            __syncthreads();
            const float* Wd = p.in[22] + ((size_t)l * NE + e) * DE * D + tid;
            float b0 = 0.f, b1 = 0.f;
#pragma unroll 8
            for (int j = 0; j < DE; ++j) { const float a2 = act[j]; b0 += a2 * Wd[(size_t)j * D]; b1 += a2 * Wd[(size_t)j * D + 512]; }
            y0 += w * b0; y1 += w * b1;
            __syncthreads();
        }
        const float* g2 = MOD + (l * 2 + (r < LC ? 1 : 0)) * 6144 + 5 * 1024;
        float* xo = xrow_st(p, r);
        xo[tid] += g2[tid] * y0; xo[tid + 512] += g2[tid + 512] * y1;
    }
}
__device__ __forceinline__ void ph_final(const P& p) {
    const int tid_ = tid_fresh(), lane = tid_ & 63, wave = tid_ >> 6;
    const float* nw = p.in[23];
    for (int r = blockIdx.x * NW + wave; r < T; r += gridDim.x * NW) {
        f32x4* xr = (f32x4*)(p.out + (size_t)r * D) + lane;
        f32x4 v[4]; float ss = 0.f;
#pragma unroll
        for (int j = 0; j < 4; ++j) { v[j] = xr[64 * j]; ss += (v[j].x * v[j].x + v[j].y * v[j].y) + (v[j].z * v[j].z + v[j].w * v[j].w); }
        const float rinv = 1.0f / sqrtf(wave_sum(ss) * (1.f / D) + EPS);
#pragma unroll
        for (int j = 0; j < 4; ++j) xr[64 * j] = v[j] * rinv * *(const f32x4*)(nw + 4 * (lane + 64 * j));
    }
}

constexpr int LDS_BYTES = 147456, LDS_CTL = LDS_CTL_OFF;
constexpr int NPH_LAYER = 13, NPH = 1 + DEPTH * NPH_LAYER;

__device__ __forceinline__ void ph_prologue(const P& p, MKLAS unsigned char* lds) {
    const int tid = tid_fresh(), b = blockIdx.x, G = gridDim.x;
    MKLAS float* s0 = (MKLAS float*)lds;
    MKLAS float* red = s0 + 2048;
    for (int i = tid; i < 1024; i += NT) { s0[i] = siluf(p.in[1][i]); s0[1024 + i] = siluf(p.in[3][i]); }
    __syncthreads();
    float* MOD = WSP(float, WS_MOD);
    for (int u = b; u < DEPTH * 96; u += G) {
        const int l = u / 96, n0 = (u % 96) * 64, c = tid & 63, ks = tid >> 6;
        const float* W = p.in[4] + (size_t)l * 1024 * 6144 + n0 + c;
        float a0 = 0.f, a1 = 0.f;
#pragma unroll 8
        for (int i = 0; i < 128; ++i) { const int k = ks * 128 + i; const float w = W[(size_t)k * 6144]; a0 += s0[k] * w; a1 += s0[1024 + k] * w; }
        red[(ks * 64 + c) * 2] = a0; red[(ks * 64 + c) * 2 + 1] = a1;
        __syncthreads();
        if (tid < 128) { const int cc = tid & 63, w = tid >> 6; float s = 0.f;
#pragma unroll
            for (int k2 = 0; k2 < 8; ++k2) s += red[(k2 * 64 + cc) * 2 + w];
            MOD[(l * 2 + w) * 6144 + n0 + cc] = s + p.in[5][l * 6144 + n0 + cc]; }
        __syncthreads();
    }
    if (b == G - 1) {
        float* LB = WSP(float, WS_LB);
        for (int idx = tid; idx < 2 * 512; idx += NT) { const int dir = idx >> 9, ch = idx & 511;
            float x[DEPTH], m = -3.0e38f;
#pragma unroll
            for (int l = 0; l < DEPTH; ++l) { x[l] = p.in[9][(dir * DEPTH + l) * 512 + ch]; m = fmaxf(m, x[l]); }
            float s = 0.f;
#pragma unroll
            for (int l = 0; l < DEPTH; ++l) { x[l] = expf(x[l] - m); s += x[l]; }
            float cum = 0.f; const float p0 = x[0] / s;
#pragma unroll
            for (int l = 0; l < DEPTH; ++l) { cum += x[l] / s; LB[(dir * DEPTH + l) * 512 + ch] = fminf(fmaxf(cum - p0, 0.f), 1.0f - 1e-6f); } }
    }
    if (b == (G > 1 ? G - 2 : 0)) {
        float* RT = WSP(float, WS_ROPE);
        for (int idx = tid; idx < 256 * 32; idx += NT) { const int pos = idx >> 5, i = idx & 31;
            double bp = 1.0; for (int q = 0; q < i; ++q) bp *= 0.7498942093324559;
            const float inv = (float)bp; const float ang = (float)pos * inv;
            const double a = (double)ang, n = rint(a * 0.15915494309189535), r = a - n * 6.283185307179586, r2 = r * r;
            double ts = r, tc = 1.0, sn = r, cs = 1.0;
            for (int k = 1; k <= 14; ++k) { tc *= -r2 / (double)((2 * k - 1) * (2 * k)); cs += tc; ts *= -r2 / (double)((2 * k) * (2 * k + 1)); sn += ts; }
            RT[idx * 2] = (float)cs; RT[idx * 2 + 1] = (float)sn; }
    }
    if (b == (G > 2 ? G - 3 : 0)) {
        float* LG = WSP(float, WS_LGAM);
        if (tid < DEPTH * 2 * 4) LG[tid] = -log1pf(expf(-p.in[11][tid]));
    }
    { float* WRT = WSP(float, WS_WRT);
        for (int idx = b * NT + tid; idx < DEPTH * 48 * 1024; idx += G * NT) { const int l = idx / (48 * 1024), n = (idx >> 10) % 48, k = idx & 1023;
            WRT[idx] = n < 32 ? p.in[18][((size_t)l * D + k) * NE + n] : (n < 36 ? p.in[16][((size_t)l * D + k) * 4 + (n - 32)] : 0.f); } }
    fill_convert<false>(p, 0, lds, (unsigned*)(p.ws + WS_CTL) + CW_CNT + 64 * 12, (volatile MKLAS int*)(lds + LDS_CTL + 8));
}


template <class F> __device__ __forceinline__ void ctx_gemm(MKLAS unsigned char* lds, const bf16_t* A, const bf16_t* Bt, int N, int K, const F& f) {
    const int tid = tid_fresh(), lane = tid & 63, w = __builtin_amdgcn_readfirstlane(tid >> 6), r16 = lane & 15, g = lane >> 4;
    const int br = w & 1, bc = (w >> 1) & 1, kh = w >> 2;
    MKLAS f32x4* red = (MKLAS f32x4*)lds;
    const int nitems = 4 * (N / 64), kspan = K / 2;
    for (int it = blockIdx.x; it < nitems; it += gridDim.x) {
        const int ir = it & 3, ic = it >> 2;
        const bf16_t* ap = A + (size_t)(64 * ir + 32 * br + r16) * K + kh * kspan + 8 * g;
        const bf16_t* bp = Bt + (size_t)(64 * ic + 32 * bc + r16) * K + kh * kspan + 8 * g;
        f32x4 acc[2][2];
#pragma unroll
        for (int i = 0; i < 2; ++i)
#pragma unroll
            for (int jn = 0; jn < 2; ++jn) acc[i][jn] = (f32x4){0.f, 0.f, 0.f, 0.f};
#pragma unroll 8
        for (int ks = 0; ks < kspan / 32; ++ks) {
            const bf16x8 a0 = *(const bf16x8*)(ap + 32 * ks), a1 = *(const bf16x8*)(ap + (size_t)16 * K + 32 * ks);
            const bf16x8 b0 = *(const bf16x8*)(bp + 32 * ks), b1 = *(const bf16x8*)(bp + (size_t)16 * K + 32 * ks);
            acc[0][0] = MFMA16(b0, a0, acc[0][0]); acc[0][1] = MFMA16(b1, a0, acc[0][1]); acc[1][0] = MFMA16(b0, a1, acc[1][0]); acc[1][1] = MFMA16(b1, a1, acc[1][1]);
        }
        if (kh) {
#pragma unroll
            for (int i = 0; i < 2; ++i)
#pragma unroll
                for (int jn = 0; jn < 2; ++jn) red[((w - 4) * 4 + i * 2 + jn) * 64 + lane] = acc[i][jn];
        }
        __syncthreads();
        if (!kh) { pg8::Unit u; u.pm = 0; u.pn = (64 * ic) >> 8; u.be = 0;
#pragma unroll
            for (int i = 0; i < 2; ++i)
#pragma unroll
                for (int jn = 0; jn < 2; ++jn) f(64 * ir + 32 * br + 16 * i + r16, 64 * ic + 32 * bc + 16 * jn + 4 * g, acc[i][jn] + red[(w * 4 + i * 2 + jn) * 64 + lane], u); }
        __syncthreads();
    }
}
struct LatentOrder : pg8::StaticOrder {
    __device__ __forceinline__ bool next(int i, pg8::Unit& u) const { if (!pg8::StaticOrder::next(i, u)) return false; u.pm += 1; return true; } };
template <class F> __device__ __forceinline__ void run_gemm_latent(MKLAS unsigned char* lds, const bf16_t* A, const bf16_t* Bt, int N, int K, const F& f) {
    pg8::Gemm g{A, Bt, L, N, K, 0}; LatentOrder S; S.init(T, N, (int)gridDim.x, (int)blockIdx.x);
    EpiGen<F> E{f};
    pg8::gemm_phase<EpiGen<F>, LatentOrder, false>(lds, g, S, E, nullptr);
}
template <class F> __device__ __forceinline__ void run_gemm(MKLAS unsigned char* lds, const bf16_t* A, const bf16_t* Bt, int M, int N, int K, const F& f) {
    pg8::Gemm g{A, Bt, M, N, K, 0}; pg8::StaticOrder S; S.init(M, N, (int)gridDim.x, (int)blockIdx.x);
    EpiGen<F> E{f};
    pg8::gemm_phase<EpiGen<F>, pg8::StaticOrder, false>(lds, g, S, E, nullptr);
}

#ifndef MK_MASK
#define MK_MASK 0xfffff
#endif
#define KON(j) ((MK_MASK >> (j)) & 1)
#define IN(k) (lo <= (k) && (k) < hi)
#ifndef MK_XBAR
#define MK_XBAR 0
#endif
#ifndef MK_PROBE
#define MK_PROBE 0
#endif
#ifndef MK_PROBE_WORK
#define MK_PROBE_WORK 0u
#endif
#ifndef MK_PROBE_WAIT
#define MK_PROBE_WAIT 0u
#endif
#if MK_PROBE
#define PROBE_MARK(kind, iswait) do { if (blockIdx.x == 0 && threadIdx.x == 0) { const unsigned long long now_ = wall_clock64(); const unsigned long long d_ = now_ - *(volatile MKLAS unsigned long long*)(lctl + 4); \
        if ((((iswait) ? MK_PROBE_WAIT : MK_PROBE_WORK) >> (kind)) & 1u) *(volatile MKLAS unsigned long long*)(lctl + 6) += d_; *(volatile MKLAS unsigned long long*)(lctl + 4) = now_; } } while (0)
#else
#define PROBE_MARK(kind, iswait) do { } while (0)
#endif
#define SEAMK(k, kind) do { PROBE_MARK(kind, 0); if (IN(k) && IN((k) + 1)) { xcd_barrier(bar); } PROBE_MARK(kind, 1); } while (0)
#define SEAM(k) do { if (IN(k) && IN((k) + 1)) { xcd_barrier(bar); for (int xb_ = 0; xb_ < MK_XBAR; ++xb_) xcd_barrier(bar); } } while (0)
template <int l> __device__ __forceinline__ void run_layer(const P& p, MKLAS unsigned char* lds, const XcdBarrier& bar, const int lo, const int hi, volatile MKLAS unsigned* lctl) {
    constexpr bool last = (l == DEPTH - 1);
    const int b = 1 + l * NPH_LAYER;
    unsigned* const ctl = (unsigned*)(p.ws + WS_CTL);
    volatile MKLAS int* const slot = (volatile MKLAS int*)(lctl + 2);
    if (KON(1) && IN(b + 0)) { if (l == 0) ph_hnorm(p, l); } SEAMK(b + 0, 1);
    if (KON(2) && IN(b + 1)) { FnA f{WSP(bf16_t, WS_QH), WSP(bf16_t, WS_VH), WSP(bf16_t, WS_RQ), WSP(bf16_t, WS_RK), WSP(bf16_t, WS_RV), WSP(float, WS_LF), WSP(float, WS_LB) + l * 512, WSP(float, WS_ROPE)};
        ctx_gemm(lds, WSP(bf16_t, WS_H), WSP(bf16_t, WS_WIN), NA, D, f);
        run_gemm_latent(lds, WSP(bf16_t, WS_H), WSP(bf16_t, WS_WIN), NA, D, f); } SEAMK(b + 1, 2);
    if (KON(3) && IN(b + 2)) { ph_scan_pass1(p, l, lds, ctl + CW_CNT + 64 * (l * 4 + 0), slot); } SEAMK(b + 2, 4);
    if (KON(3) && IN(b + 3)) { ph_scan_pass2(p, l); } SEAMK(b + 3, 5);
    if (KON(4) && IN(b + 4)) { ph_scan_pass3<1>(p, l, lds, ctl + CW_CNT + 64 * (l * 4 + 1), slot); } SEAMK(b + 4, 6);
    if (KON(4) && IN(b + 5)) { ph_scan_pass3<2>(p, l, lds, ctl + CW_CNT + 64 * (l * 4 + 2), slot); } SEAMK(b + 5, 7);
    if (KON(5) && IN(b + 6)) { FnB f{WSP(bf16_t, WS_OHG), WSP(bf16_t, WS_ORT), WSP(bf16_t, WS_GA), WSP(bf16_t, WS_GB)};
        if (last) run_gemm_latent(lds, WSP(bf16_t, WS_H), WSP(bf16_t, WS_WIN) + (size_t)NA * D, NB, D, f); else run_gemm(lds, WSP(bf16_t, WS_H), WSP(bf16_t, WS_WIN) + (size_t)NA * D, L, NB, D, f);
        fill_convert<true>(p, l, lds, ctl + CW_CNT + 64 * (8 + l * 2 + 0), slot); } SEAMK(b + 6, 8);
    if (KON(7) && IN(b + 7)) {
        { FnM1 f{WSP(bf16_t, WS_GA), WSP(float, WS_M1)};
          if (!last) ctx_gemm(lds, WSP(bf16_t, WS_OHG), WSP(bf16_t, WS_WOHG), D, 512, f);
          run_gemm_latent(lds, WSP(bf16_t, WS_OHG), WSP(bf16_t, WS_WOHG), D, 512, f); }
        { FnM2 f{WSP(bf16_t, WS_GB), WSP(float, WS_M1), WSP(bf16_t, WS_MB)};
          if (!last) ctx_gemm(lds, WSP(bf16_t, WS_ORT), WSP(bf16_t, WS_WORET), D, D, f);
          run_gemm_latent(lds, WSP(bf16_t, WS_ORT), WSP(bf16_t, WS_WORET), D, D, f); } } SEAMK(b + 7, 10);
    if (KON(8) && IN(b + 8)) { FnX f{l == 0 ? p.in[2] : WSP(float, WS_CTX), l == 0 ? p.in[0] : p.out, WSP(float, WS_CTX), p.out, WSP(float, WS_MOD) + l * 2 * 6144};
        if (!last) ctx_gemm(lds, WSP(bf16_t, WS_MB), WSP(bf16_t, WS_WOUT), D, D, f);
        run_gemm_latent(lds, WSP(bf16_t, WS_MB), WSP(bf16_t, WS_WOUT), D, D, f); } SEAMK(b + 8, 11);
    if (KON(9) && IN(b + 9)) { ph_router(p, l, lds, ctl + CW_ECNT + l * NE * 16); } SEAMK(b + 9, 12);
    if (KON(11) && IN(b + 10)) { moe_tables(p, l, lds, true);
        const MKLAS int* tb = (const MKLAS int*)(lds + MOE_TAB);
        MoeGatherOrder S{tb, tb + 64, tb + 96, WSP(int, WS_TOK), tb[NE + 1], 2, (int)gridDim.x, (int)blockIdx.x};
        pg8::Gemm g{WSP(bf16_t, WS_H), WSP(bf16_t, WS_WGU), XG_ROWS, 512, D, (size_t)512 * D * 2}; EpiGU E{WSP(bf16_t, WS_ACT)};
        pg8::gemm_phase<EpiGU, MoeGatherOrder, false>(lds, g, S, E, nullptr);
        if (!last) fill_convert<false>(p, l + 1, lds, ctl + CW_CNT + 64 * (8 + l * 2 + 1), slot); } SEAMK(b + 10, 14);
    if (KON(12) && IN(b + 11)) { const int* TE = WSP(int, WS_TILEE); MoeOrder S{TE, TE[255], 4, (int)gridDim.x, (int)blockIdx.x};
        pg8::Gemm g{WSP(bf16_t, WS_ACT), WSP(bf16_t, WS_WD), XG_ROWS, D, DE, (size_t)D * DE * 2}; EpiGen<FnYA> E{FnYA{WSP(bf16_t, WS_YA)}};
        pg8::gemm_phase<EpiGen<FnYA>, MoeOrder, false>(lds, g, S, E, nullptr); } SEAMK(b + 11, 15);
    if (KON(13) && IN(b + 12)) { ph_moe_combine(p, l, lds); } SEAMK(b + 12, 16);
}

__global__ void __launch_bounds__(NT, 2) fwd(P p) {
    extern __shared__ __attribute__((aligned(16))) unsigned char lds_raw[];
    MKLAS unsigned char* lds = (MKLAS unsigned char*)lds_raw;
    volatile MKLAS unsigned* lctl = (volatile MKLAS unsigned*)(lds + LDS_CTL);
    if (threadIdx.x < 8) lctl[threadIdx.x] = 0u;
    __syncthreads();
#if MK_PROBE
    if (blockIdx.x == 0 && threadIdx.x == 0) *(volatile MKLAS unsigned long long*)(lctl + 4) = wall_clock64();
#endif
    const int lo = p.ph_lo, hi = p.ph_hi;
    const bool multi = (hi - lo) > 1;
    XcdBarrier bar; bar.bar = (unsigned*)(p.ws + WS_CTL) + CW_BAR; bar.x = 0; bar.st = nullptr;
    if (multi) bar = xcd_barrier_post((unsigned*)(p.ws + WS_CTL) + CW_BAR, lctl);
    if (KON(0) && IN(0)) { ph_prologue(p, lds); } SEAMK(0, 0);
    run_layer<0>(p, lds, bar, lo, hi, lctl);
    run_layer<1>(p, lds, bar, lo, hi, lctl);
    static_assert(DEPTH == 2, "two layers written out");
#if MK_PROBE
    if (blockIdx.x == 0 && threadIdx.x == 0) { const unsigned long long t0_ = wall_clock64(), d_ = 4ull * *(volatile MKLAS unsigned long long*)(lctl + 6); while (wall_clock64() - t0_ < d_) __builtin_amdgcn_s_sleep(8); }
#endif
#undef IN
#undef SEAM
}
}

#ifndef MK_ONE_LAUNCH
#define MK_ONE_LAUNCH 1
#endif
extern "C" void kernel_launch(void* const* d_in, const int* in_sizes, int n_in, void* d_out, int out_size, void* d_ws, size_t ws_size, hipStream_t stream) {
    using namespace mk;
    static int grid = 0;
    if (grid == 0) {
        if (n_in != 24 || in_sizes[0] != T * D || out_size != T * D || ws_size < WS_END) { fprintf(stderr, "kernel_launch: unexpected shapes / workspace (n_in %d, ws %zu, need %zu); nothing launched\n", n_in, ws_size, (size_t)WS_END); grid = -1; return; }
        int dev = 0, cus = 0, per_cu = 0;
        if (hipGetDevice(&dev) != hipSuccess || hipDeviceGetAttribute(&cus, hipDeviceAttributeMultiprocessorCount, dev) != hipSuccess) { grid = -1; return; }
        if (hipFuncSetAttribute((const void*)fwd, hipFuncAttributeMaxDynamicSharedMemorySize, LDS_BYTES) != hipSuccess) { fprintf(stderr, "kernel_launch: hipFuncSetAttribute failed\n"); grid = -1; return; }
        if (hipOccupancyMaxActiveBlocksPerMultiprocessor(&per_cu, (const void*)fwd, NT, LDS_BYTES) != hipSuccess || per_cu < 1) { fprintf(stderr, "kernel_launch: occupancy query says %d\n", per_cu); (void)hipGetLastError(); per_cu = 1; }
        grid = cus;
    }
    if (grid < 0) return;
    if (hipMemsetAsync((char*)d_ws + WS_CTL, 0, CTL_BYTES, stream) != hipSuccess) return;
    P p{};
    for (int i = 0; i < 24; ++i) p.in[i] = (const float*)d_in[i];
    p.out = (float*)d_out; p.ws = (unsigned char*)d_ws;
#if MK_ONE_LAUNCH
    p.ph_lo = 0; p.ph_hi = NPH;
    hipLaunchKernelGGL(fwd, dim3(grid), dim3(NT), LDS_BYTES, stream, p);
#else
    for (int ph = 0; ph < NPH; ++ph) { p.ph_lo = ph; p.ph_hi = ph + 1; hipLaunchKernelGGL(fwd, dim3(grid), dim3(NT), LDS_BYTES, stream, p); }
#endif
}
```

```cpp
#include <hip/hip_runtime.h>
#include <cstdio>
#include <cstdint>
__device__ __forceinline__ int tid_fresh() { int t = (int)threadIdx.x; asm volatile("" : "+v"(t)); return t; }
namespace pg8 {
#define PG8_LAS __attribute__((address_space(3)))
typedef unsigned short bf16_t;
typedef short bf16x8 __attribute__((ext_vector_type(8)));
typedef float f32x4 __attribute__((ext_vector_type(4)));
typedef unsigned u32x4 __attribute__((ext_vector_type(4)));
constexpr int BM = 256, BK = 64, HALF = 128, HTB = HALF * BK * 2  , STAGE_BYTES = 8 * HTB, NXCD = 8, WGM = 8;

__host__ __device__ __forceinline__ int lds_byte(int r, int c) { const int st = (r >> 4) * 2 + (c >> 5), rr = r & 15, cc = c & 31, ob = rr * 64 + cc * 2; return st * 1024 + (ob ^ (((ob >> 9) & 1) << 5)); }
__host__ __device__ __forceinline__ void stage_rc(int b, int& R, int& C) { const int st = b / 1024, sb = b % 1024, swz = sb ^ (((sb >> 9) & 1) << 5); R = (st >> 1) * 16 + swz / 64; C = (st & 1) * 32 + (swz % 64) / 2; }
__host__ __device__ __forceinline__ int perm32(int rho) { const int n = rho >> 4, i = rho & 15; return 8 * (i >> 2) + 4 * n + (i & 3); }

struct Unit { int pm, pn, be; };
struct Gemm { const bf16_t* A; const bf16_t* Bt; int M, N, K; size_t bstride; };

struct StaticOrder {
    static constexpr bool GATHER = false;
    int nM, nN, nwg, G, c;
    __host__ __device__ void init(int M, int N, int G_, int c_) { nM = M / BM; nN = N / BM; nwg = nM * nN; G = G_; c = c_; }
    __host__ __device__ bool next(int i, Unit& u) const {
        const long L = (long)i * G + c; if (L >= nwg) return false;
        int wgid = (int)L; { const int q = nwg / NXCD, r = nwg % NXCD, xcd = wgid % NXCD, off = wgid / NXCD; wgid = (xcd < r ? xcd * (q + 1) : r * (q + 1) + (xcd - r) * q) + off; }
        const int nig = WGM * nN, gid = wgid / nig, fm = gid * WGM, gsz = (nM - fm) < WGM ? (nM - fm) : WGM;
        u.pm = fm + ((wgid % nig) % gsz); u.pn = (wgid % nig) / gsz; u.be = 0; return true;
    }
    __device__ __forceinline__ void a_ready(const Unit&) const {}
    __device__ __forceinline__ void done(const Unit&) const {}
};

typedef float cvt_f32x2 __attribute__((ext_vector_type(2)));
typedef __bf16 cvt_bf16x2 __attribute__((ext_vector_type(2)));
__device__ __forceinline__ unsigned cvt_pk_bf16(float lo, float hi) { const cvt_f32x2 v = {lo, hi}; return __builtin_bit_cast(unsigned, __builtin_convertvector(v, cvt_bf16x2)); }
template <class Epi, class Sched, bool STAMP = false>
__device__ __forceinline__ void gemm_phase(PG8_LAS unsigned char* lds, const Gemm g, const Sched& S, const Epi& E, unsigned long long* stamps) {
    const int tid = tid_fresh(), wid = __builtin_amdgcn_readfirstlane(tid >> 6), lane = tid & 63, wr = wid >> 2, wc = wid & 3, fr = lane & 15, fq = lane >> 4;
    const int K = g.K, nt = K / BK;
    int ts_lo = 0, ts_hi = 0, nts = 0; const unsigned long long rt_entry = STAMP ? (unsigned long long)wall_clock64() : 0ull;
#define PG8_STAMP() do { if (STAMP && wid == 0 && nts < 64) { const unsigned long long _c = (unsigned long long)clock64(); \
        ts_lo = (lane == nts) ? (int)(unsigned)_c : ts_lo; ts_hi = (lane == nts) ? (int)(unsigned)(_c >> 32) : ts_hi; ++nts; } } while (0)
    PG8_STAMP();
    unsigned voffA[2], voffB[2];
#pragma unroll
    for (int i = 0; i < 2; ++i) { int R, C; stage_rc(tid * 16 + i * 8192, R, C); const int Rb = Epi::PERM ? ((R & ~31) + perm32(R & 31)) : R;
        voffA[i] = (unsigned)(R * K + C) * 2u; voffB[i] = (unsigned)(Rb * K + C) * 2u; }
    unsigned vA0[2] = {0u, 0u}, vA1[2] = {0u, 0u}, nvA0[2] = {0u, 0u}, nvA1[2] = {0u, 0u}; int gR[2] = {0, 0}, gC[2] = {0, 0};
    if constexpr (Sched::GATHER) {
#pragma unroll
        for (int i = 0; i < 2; ++i) stage_rc(tid * 16 + i * 8192, gR[i], gC[i]); }
#define PG8_GOFF(u, v0, v1) do { _Pragma("unroll") for (int _i = 0; _i < 2; ++_i) { v0[_i] = S.row_byte_off(u, gR[_i]) + (unsigned)gC[_i] * 2u; v1[_i] = S.row_byte_off(u, 128 + gR[_i]) + (unsigned)gC[_i] * 2u; } } while (0)
#define PG8_STAGE_A(bufoff, base, half, nxtsel) do { if constexpr (Sched::GATHER) { unsigned sel_[2]; _Pragma("unroll") for (int _j = 0; _j < 2; ++_j) sel_[_j] = (nxtsel) ? ((half) ? nvA1[_j] : nvA0[_j]) : ((half) ? vA1[_j] : vA0[_j]); \
        PG8_STAGE(bufoff, base, sel_); } else { PG8_STAGE(bufoff, (base) + ((half) ? hstep : (size_t)0), voffA); } } while (0)
    const size_t kstep = (size_t)(BK * 2);
    const size_t hstep = (size_t)HALF * K * 2;
    const size_t tstep = 2 * hstep;
    const unsigned ldsw = (unsigned)wid * 1024u;
    const int aoff = lds_byte(wr * 64 + fr, fq * 8), boff = lds_byte(wc * 32 + fr, fq * 8);
#define PG8_SA(b, h) (((b) * 2 + (h)) * HTB)
#define PG8_SB(b, h) ((4 + (b) * 2 + (h)) * HTB)
#define PG8_STAGE(bufoff, gbase, voff) do { _Pragma("unroll") for (int _i = 0; _i < 2; ++_i) \
        __builtin_amdgcn_global_load_lds((const unsigned*)((const char*)(gbase) + (voff)[_i]), (PG8_LAS unsigned*)(lds + (bufoff) + ldsw + _i * 8192), 16, 0, 0); } while (0)
#define PG8_LDA(dst, b, h) do { _Pragma("unroll") for (int m = 0; m < 4; ++m) _Pragma("unroll") for (int k = 0; k < 2; ++k) dst[m][k] = *(const PG8_LAS bf16x8*)(lds + PG8_SA(b, h) + aoff + m * 2048 + k * 1024); } while (0)
#define PG8_LDB(dst, b, h) do { _Pragma("unroll") for (int n = 0; n < 2; ++n) _Pragma("unroll") for (int k = 0; k < 2; ++k) dst[n][k] = *(const PG8_LAS bf16x8*)(lds + PG8_SB(b, h) + boff + n * 2048 + k * 1024); } while (0)
#define PG8_MMA(ai, bj, At, Bt) do { __builtin_amdgcn_s_setprio(1); _Pragma("unroll") for (int m = 0; m < 4; ++m) _Pragma("unroll") for (int n = 0; n < 2; ++n) _Pragma("unroll") for (int k = 0; k < 2; ++k) \
        acc[ai][bj][m][n] = __builtin_amdgcn_mfma_f32_16x16x32_bf16(Bt[n][k], At[m][k], acc[ai][bj][m][n], 0, 0, 0); __builtin_amdgcn_s_setprio(0); } while (0)
#define PG8_WAIT_V(n) asm volatile("s_waitcnt vmcnt(" #n ")" ::: "memory")
#define PG8_WAIT_L(n) asm volatile("s_waitcnt lgkmcnt(" #n ")" ::: "memory")
#define PG8_BAR __builtin_amdgcn_s_barrier()
#define PG8_SCHED __builtin_amdgcn_sched_barrier(0)
    Unit cur, nxt; int ui = 0;
    if (!S.next(0, cur)) return;
    f32x4 acc[2][2][4][2];
#pragma unroll
    for (int a = 0; a < 2; ++a)
#pragma unroll
        for (int b = 0; b < 2; ++b)
#pragma unroll
            for (int m = 0; m < 4; ++m)
#pragma unroll
                for (int n = 0; n < 2; ++n) acc[a][b][m][n] = (f32x4){0.f, 0.f, 0.f, 0.f};
    bf16x8 At[4][2], B0[2][2], B1[2][2];
    const char* cA = Sched::GATHER ? (const char*)g.A : (const char*)g.A + (size_t)cur.pm * tstep; const char* cB = (const char*)g.Bt + (size_t)cur.be * g.bstride + (size_t)cur.pn * tstep;
    S.a_ready(cur);
    if constexpr (Sched::GATHER) PG8_GOFF(cur, vA0, vA1);
    PG8_STAGE(PG8_SB(0, 0), cB, voffB); PG8_STAGE_A(PG8_SA(0, 0), cA, 0, false); PG8_STAGE(PG8_SB(0, 1), cB + hstep, voffB); PG8_STAGE_A(PG8_SA(0, 1), cA, 1, false);
    if (wr == 1) PG8_BAR;
    PG8_WAIT_V(4); PG8_BAR;
    PG8_STAGE(PG8_SB(1, 0), cB + kstep, voffB); PG8_STAGE_A(PG8_SA(1, 0), cA + kstep, 0, false); PG8_STAGE(PG8_SB(1, 1), cB + hstep + kstep, voffB);
    PG8_WAIT_V(6); PG8_BAR;
    PG8_STAMP();
    for (;;) {
        const bool has_next = S.next(ui + 1, nxt);
        const char* nA = Sched::GATHER ? (const char*)g.A : (has_next ? (const char*)g.A + (size_t)nxt.pm * tstep : cA); const char* nB = has_next ? (const char*)g.Bt + (size_t)nxt.be * g.bstride + (size_t)nxt.pn * tstep : cB;
        if constexpr (Sched::GATHER) { if (has_next) PG8_GOFF(nxt, nvA0, nvA1); else {
#pragma unroll
                for (int _i = 0; _i < 2; ++_i) { nvA0[_i] = vA0[_i]; nvA1[_i] = vA1[_i]; } } }
        for (int t = 0; t < nt; t += 2) {
            const bool last = (t == nt - 2);
            const char* a1 = cA + (size_t)(t + 1) * kstep;
            const char* a2 = last ? nA : cA + (size_t)(t + 2) * kstep; const char* b2 = last ? nB : cB + (size_t)(t + 2) * kstep;
            const char* a3 = a2 + kstep; const char* b3 = b2 + kstep;
            if (last && has_next) S.a_ready(nxt);
            PG8_LDB(B0, 0, 0); PG8_SCHED; PG8_LDA(At, 0, 0); PG8_STAGE_A(PG8_SA(1, 1), a1, 1, false);
            PG8_WAIT_L(8); PG8_BAR; PG8_WAIT_L(0); PG8_MMA(0, 0, At, B0); PG8_BAR; PG8_SCHED;
            PG8_LDB(B1, 0, 1); PG8_STAGE(PG8_SB(0, 0), b2, voffB);
            PG8_BAR; PG8_WAIT_L(0); PG8_MMA(0, 1, At, B1); PG8_BAR;
            PG8_LDA(At, 0, 1); PG8_STAGE_A(PG8_SA(0, 0), a2, 0, last);
            PG8_BAR; PG8_WAIT_L(0); PG8_MMA(1, 0, At, B0); PG8_BAR; PG8_SCHED;
            PG8_STAGE(PG8_SB(0, 1), b2 + hstep, voffB);
            PG8_WAIT_V(6); PG8_BAR; PG8_MMA(1, 1, At, B1); PG8_BAR;
            PG8_LDB(B0, 1, 0); PG8_SCHED; PG8_LDA(At, 1, 0); PG8_STAGE_A(PG8_SA(0, 1), a2, 1, last);
            PG8_WAIT_L(8); PG8_BAR; PG8_WAIT_L(0); PG8_MMA(0, 0, At, B0); PG8_BAR; PG8_SCHED;
            PG8_LDB(B1, 1, 1); PG8_STAGE(PG8_SB(1, 0), b3, voffB);
            PG8_BAR; PG8_WAIT_L(0); PG8_MMA(0, 1, At, B1); PG8_BAR;
            PG8_LDA(At, 1, 1); PG8_STAGE_A(PG8_SA(1, 0), a3, 0, last);
            PG8_BAR; PG8_WAIT_L(0); PG8_MMA(1, 0, At, B0); PG8_BAR; PG8_SCHED;
            PG8_STAGE(PG8_SB(1, 1), b3 + hstep, voffB);
            PG8_WAIT_V(6); PG8_BAR; PG8_MMA(1, 1, At, B1); PG8_BAR;
        }
        PG8_STAMP();
        if constexpr (!Epi::AFTER_DRAIN) { E(acc, cur, wr, wc, fr, fq); S.done(cur); }
        PG8_STAMP();
        if (!has_next) break;
#pragma unroll
        for (int a = 0; a < 2; ++a)
#pragma unroll
            for (int b = 0; b < 2; ++b)
#pragma unroll
                for (int m = 0; m < 4; ++m)
#pragma unroll
                    for (int n = 0; n < 2; ++n) acc[a][b][m][n] = (f32x4){0.f, 0.f, 0.f, 0.f};
        if constexpr (Sched::GATHER) {
#pragma unroll
            for (int _i = 0; _i < 2; ++_i) { vA0[_i] = nvA0[_i]; vA1[_i] = nvA1[_i]; } }
        cur = nxt; cA = nA; cB = nB; ++ui;
    }
    PG8_WAIT_V(0);
    if (wr == 0) PG8_BAR;
    PG8_BAR;
    if constexpr (Epi::AFTER_DRAIN) { E.fused(acc, cur, wr, wc, fr, fq, lds, wid, lane); S.done(cur); }
    PG8_STAMP();
    if (STAMP && wid == 0) { stamps[lane] = lane < nts ? (((unsigned long long)(unsigned)ts_hi << 32) | (unsigned)ts_lo) : 0ull;
        if (lane == 62) stamps[62] = rt_entry; if (lane == 63) stamps[63] = (unsigned long long)wall_clock64(); }
#undef PG8_STAMP
#undef PG8_SA
#undef PG8_SB
#undef PG8_STAGE
#undef PG8_STAGE_A
#undef PG8_GOFF
#undef PG8_LDA
#undef PG8_LDB
#undef PG8_MMA
#undef PG8_WAIT_V
#undef PG8_WAIT_L
#undef PG8_BAR
#undef PG8_SCHED
}
}


#define XB_TMO      128
#define XB_XCNT(j)  (256  + 64 * (j))
#define XB_XSUB(j)  (1280 + 64 * (j))
#define XB_XGEN(j)  (2304 + 64 * (j))
#define XB_TOP      3328
#define XB_TOPGEN   3392
#define XCD_BAR_WORDS 3456
#define XB_SPIN_CAP (1u << 18)
#define LAS __attribute__((address_space(3)))

__device__ __forceinline__ unsigned xb_ld(unsigned* p)              { return __hip_atomic_load(p, __ATOMIC_RELAXED, __HIP_MEMORY_SCOPE_AGENT); }
__device__ __forceinline__ unsigned xb_add(unsigned* p, unsigned v) { return __hip_atomic_fetch_add(p, v, __ATOMIC_RELAXED, __HIP_MEMORY_SCOPE_AGENT); }
__device__ __forceinline__ unsigned xb_xcc_id() { return (unsigned)__builtin_amdgcn_s_getreg((3 << 11) | 20) & 0xFu; }
#define XB_SPIN(cond, bar) do { unsigned _sp = 0; while (cond) { __builtin_amdgcn_s_sleep(1); \
    if ((++_sp & 255u) == 0u) { if (xb_ld(&(bar)[XB_TMO])) break; if (_sp > XB_SPIN_CAP) { atomicAdd(&(bar)[XB_TMO], 1u); break; } } } } while (0)

struct XcdBarrier {
    unsigned* bar; unsigned x;
    volatile LAS unsigned* st;
};

__device__ __forceinline__ XcdBarrier xcd_barrier_post(unsigned* bar, volatile LAS unsigned* st) {
    XcdBarrier b; b.bar = bar; b.x = xb_xcc_id(); b.st = st;
    if (threadIdx.x == 0) (void)xb_add(&bar[XB_XCNT(b.x)], 1u);
    return b;
}
__device__ __forceinline__ void xcd_barrier_complete(unsigned* bar, unsigned x, unsigned& nloc, unsigned& nx) {
    const unsigned G = gridDim.x * gridDim.y * gridDim.z;
    unsigned sum, cnt, mine, sp = 0u;
    for (;;) {
        sum = 0u; cnt = 0u; mine = 0u;
#pragma unroll
        for (unsigned j = 0; j < 16; ++j) { const unsigned c = xb_ld(&bar[XB_XCNT(j)]); sum += c; cnt += (c > 0u) ? 1u : 0u; mine = (j == x) ? c : mine; }
        if (sum == G) break;
        __builtin_amdgcn_s_sleep(1);
        if ((++sp & 255u) == 0u) { if (xb_ld(&bar[XB_TMO])) break; if (sp > XB_SPIN_CAP) { atomicAdd(&bar[XB_TMO], 1u); break; } }
    }
    nloc = mine > 0u ? mine : 1u; nx = cnt > 0u ? cnt : 1u;
}

__device__ __forceinline__ void xcd_barrier(const XcdBarrier& b) {
    asm volatile("s_waitcnt vmcnt(0)" ::: "memory");
    __syncthreads();
    if (threadIdx.x == 0) {
        unsigned* bar = b.bar;
        __builtin_amdgcn_s_waitcnt(0);
        unsigned nloc = b.st[0], nx = b.st[1];
        if (nloc == 0u) { xcd_barrier_complete(bar, b.x, nloc, nx); b.st[0] = nloc; b.st[1] = nx; }
        const unsigned old = xb_add(&bar[XB_XSUB(b.x)], 1u);
        const unsigned gen = old / nloc;
        if (old + 1u == (gen + 1u) * nloc) {
            __builtin_amdgcn_fence(__ATOMIC_RELEASE, "agent");
            asm volatile("s_waitcnt vmcnt(0)" ::: "memory");
            const unsigned og = xb_add(&bar[XB_TOP], 1u);
            const unsigned tg = og / nx;
            if (og + 1u == (tg + 1u) * nx) xb_add(&bar[XB_TOPGEN], 1u);
            else XB_SPIN(xb_ld(&bar[XB_TOPGEN]) == tg, bar);
            __builtin_amdgcn_fence(__ATOMIC_ACQUIRE, "agent");
            xb_add(&bar[XB_XGEN(b.x)], 1u);
            asm volatile("s_waitcnt vmcnt(0)" ::: "memory");
        } else {
            XB_SPIN(xb_ld(&bar[XB_XGEN(b.x)]) == gen, bar);
            __builtin_amdgcn_fence(__ATOMIC_ACQUIRE, "agent");
            asm volatile("s_waitcnt vmcnt(0)" ::: "memory");
        }
    }
    __syncthreads();
}


namespace mk {
using pg8::bf16_t; using pg8::f32x4; using pg8::u32x4; using pg8::cvt_pk_bf16;
#define MKLAS __attribute__((address_space(3)))
typedef unsigned u32x2 __attribute__((ext_vector_type(2)));
typedef float f32x2 __attribute__((ext_vector_type(2)));

constexpr int D = 1024, T = 16384, LC = 256, L = T + LC, DEPTH = 2;
constexpr int NA = 4096, NB = 3584;
constexpr int NE = 32, DE = 256;
constexpr float EPS = 1e-6f;
constexpr int NT = 512, NW = 8;
constexpr int LDS_CTL_OFF = 131072;

constexpr size_t MiB = 1u << 20, QMiB = 1u << 18;
constexpr size_t WS_CTL = 0, CTL_BYTES = 1 * MiB;
constexpr size_t WS_MOD = 1 * MiB, WS_LB = WS_MOD + 128 * 1024, WS_ROPE = WS_MOD + 192 * 1024, WS_LGAM = WS_MOD + 256 * 1024, WS_WRT = WS_MOD + 512 * 1024;
constexpr size_t WS_AE = 2 * MiB, WS_AW = WS_AE + 256 * 1024, WS_APOS = WS_AE + 512 * 1024, WS_TILEE = WS_AE + 1024 * 1024;
constexpr size_t WS_TOK = 58 * MiB;
constexpr size_t WS_CTX = 4 * MiB;
constexpr size_t WS_WIN = 5 * MiB, WS_WOHG = 20 * MiB, WS_WORET = 21 * MiB, WS_WOUT = 23 * MiB;
constexpr size_t WS_H = 25 * MiB;
constexpr size_t WS_QH = 58 * MiB, WS_VH = WS_QH + 65 * QMiB, WS_RQ = WS_VH + 65 * QMiB, WS_RK = WS_RQ + 65 * QMiB;
constexpr size_t WS_RV = 123 * MiB;
constexpr size_t WS_LF = WS_RV + 130 * QMiB;
constexpr size_t WS_OHG = WS_LF + 260 * QMiB;
constexpr size_t WS_ORT = WS_OHG + 65 * QMiB;
constexpr size_t WS_OF = WS_ORT + 130 * QMiB;
constexpr size_t WS_END = WS_OF + 390 * QMiB;
constexpr size_t WS_GA = WS_QH, WS_GB = WS_QH + 130 * QMiB;
constexpr size_t WS_M1 = WS_LF;
constexpr size_t WS_MB = WS_RV;
constexpr int CW_BAR = 4096, CW_CNT = 8192, CW_ECNT = 12288;

struct P { const float* in[24]; float* out; unsigned char* ws; int ph_lo, ph_hi; };
__device__ __forceinline__ unsigned char* ws_fresh(unsigned char* w) { asm volatile("" : "+s"(w)); return w; }
#define WSP(type, off) ((type*)(p.ws + (off)))

__device__ __forceinline__ float bf2f(bf16_t b) { return __uint_as_float(((unsigned)b) << 16); }
__device__ __forceinline__ bf16_t f2bf(float f) { return (bf16_t)(cvt_pk_bf16(f, 0.f) & 0xffffu); }
__device__ __forceinline__ float fexp(float x) { return __builtin_amdgcn_exp2f(x * 1.4426950408889634f); }
__device__ __forceinline__ float flog(float x) { return __builtin_amdgcn_logf(x) * 0.6931471805599453f; }
__device__ __forceinline__ float siluf(float x) { return x * __builtin_amdgcn_rcpf(1.f + fexp(-x)); }
__device__ __forceinline__ float sigmf(float x) { return __builtin_amdgcn_rcpf(1.f + fexp(-x)); }
__device__ __forceinline__ float wave_sum(float v) {
#pragma unroll
    for (int o = 1; o < 64; o <<= 1) v += __shfl_xor(v, o);
    return v;
}
__device__ __forceinline__ const float* xrow_in(const P& p, int l, int r) {
    if (l == 0) return r < LC ? p.in[2] + (size_t)r * D : p.in[0] + (size_t)(r - LC) * D;
    return r < LC ? WSP(float, WS_CTX) + (size_t)r * D : p.out + (size_t)(r - LC) * D;
}
__device__ __forceinline__ float* xrow_st(const P& p, int r) { return r < LC ? WSP(float, WS_CTX) + (size_t)r * D : p.out + (size_t)(r - LC) * D; }
__device__ __forceinline__ int seq_row(int dir, int i) { return dir == 0 ? i : (i < LC ? LC - 1 - i : L + LC - 1 - i); }

__device__ __forceinline__ void tr_item(const float* W, int K, int N, bf16_t* WT, int k0, int n0, int outrow0, MKLAS float* tile, bool swap45 = false) {
    const int tid = tid_fresh(), r = tid >> 6, c = tid & 63;
#pragma unroll
    for (int i = 0; i < 8; ++i) tile[(r + 8 * i) * 65 + c] = W[(size_t)(k0 + r + 8 * i) * N + n0 + c];
    __syncthreads();
    const int nn = tid >> 3, kc = tid & 7;
    const MKLAS float* s = tile + (kc * 8) * 65 + nn;
    u32x4 o; o.x = cvt_pk_bf16(s[0], s[65]); o.y = cvt_pk_bf16(s[130], s[195]); o.z = cvt_pk_bf16(s[260], s[325]); o.w = cvt_pk_bf16(s[390], s[455]);
    const int nno = swap45 ? ((((nn & 31) >> 2) << 3) | ((nn >> 5) << 2) | (nn & 3)) : nn;
    *(u32x4*)(WT + (size_t)(outrow0 + nno) * K + k0 + kc * 8) = o;
    __syncthreads();
}
__device__ __forceinline__ int win_perm(int n) { return n < 2048 ? n : (n < 2560 ? 4096 + (n - 2048) : (n < 4608 ? 2048 + (n - 2560) : n)); }
constexpr int MIXER_ITEMS = 16 * 120 + 8 * 16 + 16 * 16 + 16 * 16;
__device__ __forceinline__ void mixer_item(const P& p, int l, int it, MKLAS float* tile) {
    constexpr int I_IN = 16 * 120, I_OHG = 8 * 16, I_ORT = 16 * 16;
    int r = it;
    if (r < I_IN) { const int kb = r / 120, nb = r % 120; tr_item(p.in[8] + (size_t)l * D * 7680, D, 7680, WSP(bf16_t, WS_WIN), kb * 64, nb * 64, win_perm(nb * 64), tile, nb * 64 >= 2560 && nb * 64 < 3584); return; } r -= I_IN;
    if (r < I_OHG) { const int kb = r / 16, nb = r % 16; tr_item(p.in[13] + (size_t)l * 512 * D, 512, D, WSP(bf16_t, WS_WOHG), kb * 64, nb * 64, nb * 64, tile); return; } r -= I_OHG;
    if (r < I_ORT) { const int kb = r / 16, nb = r % 16; tr_item(p.in[14] + (size_t)l * D * D, D, D, WSP(bf16_t, WS_WORET), kb * 64, nb * 64, nb * 64, tile); return; } r -= I_ORT;
    { const int kb = r / 16, nb = r % 16; tr_item(p.in[15] + (size_t)l * D * D, D, D, WSP(bf16_t, WS_WOUT), kb * 64, nb * 64, nb * 64, tile); }
}

__device__ __forceinline__ void ph_hnorm(const P& p, int l) {
    const int tid_ = tid_fresh(), lane = tid_ & 63, wave = tid_ >> 6;
    const float* MOD = WSP(float, WS_MOD); bf16_t* H = WSP(bf16_t, WS_H);
    const float* nw = p.in[6] + l * D;
    for (int r = blockIdx.x * NW + wave; r < L; r += gridDim.x * NW) {
        const f32x4* xr = (const f32x4*)xrow_in(p, l, r) + lane;
        const float* mod = MOD + (l * 2 + (r < LC ? 1 : 0)) * 6144;
        f32x4 v[4]; float ss = 0.f;
#pragma unroll
        for (int j = 0; j < 4; ++j) { v[j] = xr[64 * j]; ss += (v[j].x * v[j].x + v[j].y * v[j].y) + (v[j].z * v[j].z + v[j].w * v[j].w); }
        const float rinv = 1.0f / sqrtf(wave_sum(ss) * (1.f / D) + EPS);
        u32x2* o = (u32x2*)(H + (size_t)r * D) + lane;
#pragma unroll
        for (int j = 0; j < 4; ++j) { const int c = 4 * (lane + 64 * j);
            const f32x4 w = *(const f32x4*)(nw + c), sh = *(const f32x4*)(mod + c), sc = *(const f32x4*)(mod + 1024 + c);
            const f32x4 h = v[j] * rinv * w * (sc + 1.0f) + sh;
            u32x2 q; q.x = cvt_pk_bf16(h.x, h.y); q.y = cvt_pk_bf16(h.z, h.w); o[64 * j] = q; }
    }
}

template <class F> struct EpiGen {
    static constexpr bool PERM = true, AFTER_DRAIN = false;
    F f;
    __device__ __forceinline__ void operator()(const f32x4 (&acc)[2][2][4][2], const pg8::Unit& u, int wr, int wc, int fr, int fq) const {
        const int row0 = u.pm * 256 + wr * 64 + fr, col0 = u.pn * 256 + wc * 32 + 8 * fq;
        if constexpr (!F::HAS_LOAD) {
            const typename F::R none{};
#pragma unroll
            for (int g = 0; g < 8; ++g)
#pragma unroll
                for (int bj = 0; bj < 2; ++bj) f.apply8(row0 + (g >> 2) * 128 + (g & 3) * 16, col0 + bj * 128, acc[g >> 2][bj][g & 3][0], acc[g >> 2][bj][g & 3][1], none, u);
        } else {
            typename F::R cur[2], nxt[2];
#pragma unroll
            for (int bj = 0; bj < 2; ++bj) cur[bj] = f.load8(row0, col0 + bj * 128, u);
            asm volatile("" ::: "memory");
#pragma unroll
            for (int g = 0; g < 8; ++g) {
                if (g < 7) {
#pragma unroll
                    for (int bj = 0; bj < 2; ++bj) nxt[bj] = f.load8(row0 + ((g + 1) >> 2) * 128 + ((g + 1) & 3) * 16, col0 + bj * 128, u);
                }
                asm volatile("" ::: "memory");
#pragma unroll
                for (int bj = 0; bj < 2; ++bj) f.apply8(row0 + (g >> 2) * 128 + (g & 3) * 16, col0 + bj * 128, acc[g >> 2][bj][g & 3][0], acc[g >> 2][bj][g & 3][1], cur[bj], u);
                asm volatile("" ::: "memory");
#pragma unroll
                for (int bj = 0; bj < 2; ++bj) cur[bj] = nxt[bj];
            }
        }
    }
};
struct NoRegs {};
__device__ __forceinline__ void st_bf4(bf16_t* dst, f32x4 v) { u32x2 q; q.x = cvt_pk_bf16(v.x, v.y); q.y = cvt_pk_bf16(v.z, v.w); *(u32x2*)dst = q; }
__device__ __forceinline__ void st_bf8(bf16_t* dst, f32x4 a, f32x4 b) { u32x4 q; q.x = cvt_pk_bf16(a.x, a.y); q.y = cvt_pk_bf16(a.z, a.w); q.z = cvt_pk_bf16(b.x, b.y); q.w = cvt_pk_bf16(b.z, b.w); *(u32x4*)dst = q; }
__device__ __forceinline__ f32x4 bf2lo4(u32x4 q) { return (f32x4){__uint_as_float(q.x << 16), __uint_as_float(q.x & 0xffff0000u), __uint_as_float(q.y << 16), __uint_as_float(q.y & 0xffff0000u)}; }
__device__ __forceinline__ f32x4 bf2hi4(u32x4 q) { return (f32x4){__uint_as_float(q.z << 16), __uint_as_float(q.z & 0xffff0000u), __uint_as_float(q.w << 16), __uint_as_float(q.w & 0xffff0000u)}; }
__device__ __forceinline__ f32x4 silu4(f32x4 v) { return (f32x4){siluf(v.x), siluf(v.y), siluf(v.z), siluf(v.w)}; }
__device__ __forceinline__ f32x4 sigm4(f32x4 v) { return (f32x4){sigmf(v.x), sigmf(v.y), sigmf(v.z), sigmf(v.w)}; }
__device__ __forceinline__ f32x4 ld_bf4(const bf16_t* src) { const u32x2 q = *(const u32x2*)src; f32x4 v; v.x = __uint_as_float(q.x << 16); v.y = __uint_as_float(q.x & 0xffff0000u); v.z = __uint_as_float(q.y << 16); v.w = __uint_as_float(q.y & 0xffff0000u); return v; }

struct FnA {
    bf16_t *QH, *VH, *RQ, *RK, *RV; float* LF; const float* LB; const float* RT;
    static constexpr bool HAS_LOAD = false; typedef NoRegs R;
    __device__ __forceinline__ f32x4 logf4(f32x4 v, int dir, int ch) const { const f32x4 lb = *(const f32x4*)(LB + dir * DEPTH * 512 + ch); f32x4 o;
#pragma unroll
        for (int j = 0; j < 4; ++j) { const float e = fexp(fminf(-v[j], 69.f));
            o[j] = fmaxf(flog(1.f + lb[j] * e) - flog(1.f + e), -69.0775528f); }
        return o; }
    static __device__ __forceinline__ int rot_dim(int c) { return (c & ~63) | (((c >> 3) & 7) << 2) | (c & 3) | ((c & 4) << 3); }
    __device__ __forceinline__ void operator()(int row, int col, f32x4 v, const pg8::Unit& u) const {
        const int seg = u.pn >> 1;
        if (seg == 0) st_bf4(QH + (size_t)row * 512 + col, silu4(v) * 0.08838834764831845f);
        else if (seg == 1 || seg == 2) { const int dir = seg - 1, ch = col - seg * 512; *(f32x4*)(LF + (size_t)row * 1024 + dir * 512 + ch) = logf4(v, dir, ch); }
        else if (seg == 3) st_bf4(VH + (size_t)row * 512 + (col - 1536), v);
        else if (seg == 4) st_bf4(RQ + (size_t)row * 512 + rot_dim(col - 2048), v * 0.08838834764831845f);
        else if (seg == 5) st_bf4(RK + (size_t)row * 512 + rot_dim(col - 2560), v);
        else st_bf4(RV + (size_t)row * 1024 + (col - 3072), v);
    }
    __device__ __forceinline__ void apply8(int row, int col, f32x4 v0, f32x4 v1, const R&, const pg8::Unit& u) const {
        const int seg = u.pn >> 1;
        if (seg == 0) st_bf8(QH + (size_t)row * 512 + col, silu4(v0) * 0.08838834764831845f, silu4(v1) * 0.08838834764831845f);
        else if (seg == 1 || seg == 2) { const int dir = seg - 1, ch = col - seg * 512; float* o = LF + (size_t)row * 1024 + dir * 512 + ch; *(f32x4*)o = logf4(v0, dir, ch); *(f32x4*)(o + 4) = logf4(v1, dir, ch + 4); }
        else if (seg == 3) st_bf8(VH + (size_t)row * 512 + (col - 1536), v0, v1);
        else if (seg == 4 || seg == 5) {
            const int c = col - (seg == 4 ? 2048 : 2560), d0 = rot_dim(c), half = (d0 >> 6) & 1, i = d0 & 31;
            const float sc = seg == 4 ? 0.08838834764831845f : 1.f;
            bf16_t* o = (seg == 4 ? RQ : RK) + (size_t)row * 512 + d0;
            if (row >= LC) { const int t = row - LC, pos = half ? (t & 63) : (t >> 6);
                const f32x4 cs0 = *(const f32x4*)(RT + (pos * 32 + i) * 2), cs1 = *(const f32x4*)(RT + (pos * 32 + i) * 2 + 4);
                const f32x4 co = {cs0.x, cs0.z, cs1.x, cs1.z}, si = {cs0.y, cs0.w, cs1.y, cs1.w};
                st_bf4(o, (v0 * co - v1 * si) * sc); st_bf4(o + 32, (v0 * si + v1 * co) * sc); }
            else { st_bf4(o, v0 * sc); st_bf4(o + 32, v1 * sc); } }
        else st_bf8(RV + (size_t)row * 1024 + (col - 3072), v0, v1);
    }
};
struct FnB {
    bf16_t *OHG, *ORT, *GA, *GB;
    static constexpr bool HAS_LOAD = true; typedef u32x4 R;
    __device__ __forceinline__ bf16_t* optr(int row, int col, int pn) const { return pn < 2 ? OHG + (size_t)row * 512 + col : ORT + (size_t)row * 1024 + (col - 512); }
    __device__ __forceinline__ R load8(int row, int col, const pg8::Unit& u) const { if (u.pn < 6) return *(const u32x4*)optr(row, col, u.pn); return (u32x4){0u, 0u, 0u, 0u}; }
    __device__ __forceinline__ void apply8(int row, int col, f32x4 v0, f32x4 v1, const R& r, const pg8::Unit& u) const {
        const int pn = u.pn;
        if (pn < 6) st_bf8(optr(row, col, pn), bf2lo4(r) * silu4(v0), bf2hi4(r) * silu4(v1));
        else st_bf8(pn < 10 ? GA + (size_t)row * 1024 + (col - 1536) : GB + (size_t)row * 1024 + (col - 2560), sigm4(v0), sigm4(v1));
    }
};
__device__ __forceinline__ f32x4 bf4_to_f32(u32x2 q) { return (f32x4){__uint_as_float(q.x << 16), __uint_as_float(q.x & 0xffff0000u), __uint_as_float(q.y << 16), __uint_as_float(q.y & 0xffff0000u)}; }
struct FnM1 { const bf16_t* GA; float* M1;
    static constexpr bool HAS_LOAD = true; typedef u32x4 R;
    __device__ __forceinline__ R load8(int row, int col, const pg8::Unit&) const { return *(const u32x4*)(GA + (size_t)row * D + col); }
    __device__ __forceinline__ void apply8(int row, int col, f32x4 v0, f32x4 v1, const R& r, const pg8::Unit&) const { float* o = M1 + (size_t)row * D + col; *(f32x4*)o = bf2lo4(r) * v0; *(f32x4*)(o + 4) = bf2hi4(r) * v1; }
    __device__ __forceinline__ void operator()(int row, int col, f32x4 v, const pg8::Unit&) const { *(f32x4*)(M1 + (size_t)row * D + col) = bf4_to_f32(*(const u32x2*)(GA + (size_t)row * D + col)) * v; } };
struct RegsM2 { f32x4 m0, m1; u32x4 g; };
struct FnM2 { const bf16_t* GB; const float* M1; bf16_t* MB;
    static constexpr bool HAS_LOAD = true; typedef RegsM2 R;
    __device__ __forceinline__ R load8(int row, int col, const pg8::Unit&) const { R r; const float* m = M1 + (size_t)row * D + col; r.m0 = *(const f32x4*)m; r.m1 = *(const f32x4*)(m + 4); r.g = *(const u32x4*)(GB + (size_t)row * D + col); return r; }
    __device__ __forceinline__ void apply8(int row, int col, f32x4 v0, f32x4 v1, const R& r, const pg8::Unit&) const { st_bf8(MB + (size_t)row * D + col, r.m0 + bf2lo4(r.g) * v0, r.m1 + bf2hi4(r.g) * v1); }
    __device__ __forceinline__ void operator()(int row, int col, f32x4 v, const pg8::Unit&) const { st_bf4(MB + (size_t)row * D + col, *(const f32x4*)(M1 + (size_t)row * D + col) + bf4_to_f32(*(const u32x2*)(GB + (size_t)row * D + col)) * v); } };
struct RegsX { f32x4 x0, x1; };
struct FnX { const float *xc_in, *xl_in; float *xc_out, *xl_out; const float* MODL;
    static constexpr bool HAS_LOAD = true; typedef RegsX R;
    __device__ __forceinline__ R load8(int row, int col, const pg8::Unit&) const { const bool isc = row < LC; const float* x = (isc ? xc_in : xl_in) + (size_t)(isc ? row : row - LC) * D + col; R r; r.x0 = *(const f32x4*)x; r.x1 = *(const f32x4*)(x + 4); return r; }
    __device__ __forceinline__ void apply8(int row, int col, f32x4 v0, f32x4 v1, const R& r, const pg8::Unit&) const {
        const bool isc = row < LC; const float* g = MODL + (isc ? 6144 : 0) + 2 * 1024 + col; float* o = (isc ? xc_out : xl_out) + (size_t)(isc ? row : row - LC) * D + col;
        *(f32x4*)o = r.x0 + *(const f32x4*)g * v0; *(f32x4*)(o + 4) = r.x1 + *(const f32x4*)(g + 4) * v1; }
    __device__ __forceinline__ void operator()(int row, int col, f32x4 v, const pg8::Unit&) const {
        const bool isc = row < LC; const size_t off = (size_t)(isc ? row : row - LC) * D + col;
        *(f32x4*)((isc ? xc_out : xl_out) + off) = *(const f32x4*)((isc ? xc_in : xl_in) + off) + *(const f32x4*)(MODL + (isc ? 6144 : 0) + 2 * 1024 + col) * v; } };

typedef short bf16x8 __attribute__((ext_vector_type(8)));
typedef short s16x4 __attribute__((ext_vector_type(4)));
#define MFMA16(a, b, c) __builtin_amdgcn_mfma_f32_16x16x32_bf16((a), (b), (c), 0, 0, 0)
constexpr size_t WS_STH = WS_OF, WS_STR = WS_OF + (size_t)8 * 65 * 16384 * 2, WS_ATOT = WS_OF + 49 * MiB;

__device__ __forceinline__ bf16x8 ld_frag_row(const MKLAS bf16_t* tile, int stride, int row0, int k0, int lane) {
    return *(const MKLAS bf16x8*)(tile + (row0 + (lane & 15)) * stride + k0 + 8 * (lane >> 4));
}
__device__ __forceinline__ bf16x8 ld_frag_tr(const MKLAS bf16_t* tile, int stride, int k0, int col0, int lane) {
    const int g = lane >> 4, q = (lane & 15) >> 2, pp = lane & 3;
    const MKLAS bf16_t* a = tile + (k0 + 8 * g + q) * stride + col0 + 4 * pp;
    const s16x4 lo = __builtin_amdgcn_ds_read_tr16_b64_v4i16((MKLAS s16x4*)a), hi = __builtin_amdgcn_ds_read_tr16_b64_v4i16((MKLAS s16x4*)(a + 4 * stride));
    return (bf16x8){lo[0], lo[1], lo[2], lo[3], hi[0], hi[1], hi[2], hi[3]};
}
__device__ __forceinline__ bf16x8 pack8(f32x4 a, f32x4 b) { u32x4 r; r.x = cvt_pk_bf16(a.x, a.y); r.y = cvt_pk_bf16(a.z, a.w); r.z = cvt_pk_bf16(b.x, b.y); r.w = cvt_pk_bf16(b.z, b.w); return __builtin_bit_cast(bf16x8, r); }
__device__ __forceinline__ float bflo(unsigned u) { return __uint_as_float(u << 16); }
__device__ __forceinline__ float bfhi(unsigned u) { return __uint_as_float(u & 0xffff0000u); }
__device__ __forceinline__ u32x4 scale_piece(u32x4 v, float s) { u32x4 r; r.x = cvt_pk_bf16(bflo(v.x) * s, bfhi(v.x) * s); r.y = cvt_pk_bf16(bflo(v.y) * s, bfhi(v.y) * s); r.z = cvt_pk_bf16(bflo(v.z) * s, bfhi(v.z) * s); r.w = cvt_pk_bf16(bflo(v.w) * s, bfhi(v.w) * s); return r; }

template <bool RET, int MODE>
__device__ __forceinline__ void scan_unit(const P& p, int l, int h, int c, int dir, MKLAS unsigned char* lds, bool zero_init = false) {
    constexpr int C = RET ? 64 : 32, NCH = 256 / C, NET = RET ? 2 : 1, DV = RET ? 256 : 128, QS = 136, VS = DV + 8, PS = C + 8, NTT = C / 16, NKS2 = C / 32;
    const int tid = tid_fresh(), lane = tid & 63, w = __builtin_amdgcn_readfirstlane(tid >> 6), r16 = lane & 15, quad = lane >> 4;
    MKLAS bf16_t* Qn = (MKLAS bf16_t*)lds; MKLAS bf16_t* Kn = Qn + C * QS; MKLAS bf16_t* Vn = Kn + C * QS; MKLAS bf16_t* Pm = Vn + C * VS;
    MKLAS float* TOT = (MKLAS float*)(Pm + C * PS); MKLAS float* E12 = TOT + 512; MKLAS float* RED = E12 + 256; MKLAS float* DQK = RED + 1024;
    const int e0 = 16 * NET * w, row0 = 256 * c, chain = dir * 4 + h;
    const bf16_t* Qg = RET ? WSP(bf16_t, WS_RQ) + h * 128 : WSP(bf16_t, WS_QH) + h * 128;
    const bf16_t* Kg = WSP(bf16_t, WS_RK) + h * 128;
    const bf16_t* Vg = RET ? WSP(bf16_t, WS_RV) + h * 256 : WSP(bf16_t, WS_VH) + h * 128;
    const float* LFg = WSP(float, WS_LF) + dir * 512 + h * 128;
    bf16_t* ST = RET ? WSP(bf16_t, WS_STR) + (((size_t)chain * 65 + c) << 15) : WSP(bf16_t, WS_STH) + (((size_t)chain * 65 + c) << 14);
    const float lg = RET ? WSP(float, WS_LGAM)[(l * 2 + dir) * 4 + h] : 0.f;
    if (RET && tid < 64) { DQK[2 * tid] = fexp((float)(tid + 1) * lg); DQK[2 * tid + 1] = fexp(-(float)(tid + 1) * lg); }
    const float e2s = RET ? fexp((float)C * lg) : 1.f;

    f32x4 Sacc[8][NET];
#pragma unroll
    for (int i = 0; i < 8; ++i)
#pragma unroll
        for (int n = 0; n < NET; ++n) {
            if (MODE == 0 || zero_init) Sacc[i][n] = (f32x4){0.f, 0.f, 0.f, 0.f};
            else { const u32x2 q = *(const u32x2*)(ST + (size_t)(e0 + 16 * n + r16) * 128 + 16 * i + 4 * quad); Sacc[i][n] = (f32x4){bflo(q.x), bfhi(q.x), bflo(q.y), bfhi(q.y)}; }
        }
    float btot = 0.f;
    float lfv[8]; unsigned short qv[8]; u32x4 hv = {0, 0, 0, 0};
    u32x4 qp[2], kp[2], vp[4];
    const int hd = tid & 127, hseg = tid >> 7;
#define TOKROW(pos) (row0 + (dir ? 255 - (pos) : (pos)))
#define LOAD_CHUNK(j) do { \
        if (!RET) { _Pragma("unroll") for (int ii = 0; ii < 8; ++ii) { const size_t rr = (size_t)TOKROW(C * (j) + 8 * hseg + ii); lfv[ii] = LFg[rr * 1024 + hd]; if (MODE != 0) qv[ii] = Qg[rr * 512 + hd]; } \
            { const size_t rr = (size_t)TOKROW(C * (j) + (tid >> 4)); hv = *(const u32x4*)(Vg + rr * 512 + 8 * (tid & 15)); } } \
        else { _Pragma("unroll") for (int m = 0; m < 2; ++m) { const int pc = tid + 512 * m; const size_t rr = (size_t)TOKROW(C * (j) + (pc >> 4)); \
                if (MODE != 0) qp[m] = *(const u32x4*)(Qg + rr * 512 + 8 * (pc & 15)); kp[m] = *(const u32x4*)(Kg + rr * 512 + 8 * (pc & 15)); } \
            _Pragma("unroll") for (int m = 0; m < 4; ++m) { const int pc = tid + 512 * m; const size_t rr = (size_t)TOKROW(C * (j) + (pc >> 5)); vp[m] = *(const u32x4*)(Vg + rr * 1024 + 8 * (pc & 31)); } } \
    } while (0)
    LOAD_CHUNK(0);
    if (MODE != 0) { for (int i = tid; i < C * PS / 8; i += NT) ((MKLAS u32x4*)Pm)[i] = (u32x4){0u, 0u, 0u, 0u}; }
    __syncthreads();
    for (int j = 0; j < NCH; ++j) {
        if (!RET) {
            float pl[8]; float run = 0.f;
#pragma unroll
            for (int ii = 0; ii < 8; ++ii) { run += lfv[ii]; pl[ii] = run; }
            TOT[hseg * 128 + hd] = run;
            __syncthreads();
            const float t0 = TOT[hd], t1 = TOT[128 + hd], t2 = TOT[256 + hd], t3 = TOT[384 + hd];
            const float off = hseg == 0 ? 0.f : (hseg == 1 ? t0 : (hseg == 2 ? t0 + t1 : t0 + t1 + t2));
            const float rref = t0 + t1, blast = (t0 + t1) + (t2 + t3);
#pragma unroll
            for (int ii = 0; ii < 8; ++ii) { const int pos = 8 * hseg + ii; const float b = off + pl[ii];
                const float kk = 1.f - fexp(lfv[ii]);
                Kn[pos * QS + hd] = f2bf(kk * fexp(fminf(rref - b, 60.f)));
                if (MODE != 0) Qn[pos * QS + hd] = f2bf(bf2f(qv[ii]) * fexp(fminf(b - rref, 60.f))); }
            if (hseg == 0) { E12[hd] = fexp(rref); E12[128 + hd] = fexp(blast - rref); btot += blast; }
            *(MKLAS u32x4*)(Vn + (tid >> 4) * VS + 8 * (tid & 15)) = hv;
        } else {
#pragma unroll
            for (int m = 0; m < 2; ++m) { const int pc = tid + 512 * m, pos = pc >> 4;
                *(MKLAS u32x4*)(Kn + pos * QS + 8 * (pc & 15)) = scale_piece(kp[m], DQK[2 * pos + 1]);
                if (MODE != 0) *(MKLAS u32x4*)(Qn + pos * QS + 8 * (pc & 15)) = scale_piece(qp[m], DQK[2 * pos]); }
#pragma unroll
            for (int m = 0; m < 4; ++m) { const int pc = tid + 512 * m; *(MKLAS u32x4*)(Vn + (pc >> 5) * VS + 8 * (pc & 31)) = vp[m]; }
        }
        if (j + 1 < NCH) LOAD_CHUNK(j + 1);
        __syncthreads();
        if (MODE != 0) {
            constexpr int NTILE = NTT * (NTT + 1) / 2;
#pragma unroll
            for (int rep = 0; rep < (NTILE + 7) / 8; ++rep) {
                const int q = w + 8 * rep;
                if (q < NTILE) {
                    int tt = 0, st = q;
#pragma unroll
                    for (int z = 1; z < NTT; ++z) if (q >= z * (z + 1) / 2) { tt = z; st = q - z * (z + 1) / 2; }
                    f32x4 sc = {0.f, 0.f, 0.f, 0.f};
#pragma unroll
                    for (int ks = 0; ks < 4; ++ks) sc = MFMA16(ld_frag_row(Qn, QS, 16 * tt, 32 * ks, lane), ld_frag_row(Kn, QS, 16 * st, 32 * ks, lane), sc);
#pragma unroll
                    for (int jj = 0; jj < 4; ++jj) { const bool keep = (st < tt) || (r16 <= 4 * quad + jj); Pm[(16 * tt + 4 * quad + jj) * PS + 16 * st + r16] = f2bf(keep ? sc[jj] : 0.f); }
                }
            }
            __syncthreads();
        }
        bf16x8 Vf[NKS2][NET];
#pragma unroll
        for (int k2 = 0; k2 < NKS2; ++k2)
#pragma unroll
            for (int n = 0; n < NET; ++n) Vf[k2][n] = ld_frag_tr(Vn, VS, 32 * k2, e0 + 16 * n, lane);
        if (!RET) {
#pragma unroll
            for (int i = 0; i < 8; ++i) { const f32x4 e1 = *(const MKLAS f32x4*)(E12 + 16 * i + 4 * quad);
#pragma unroll
                for (int n = 0; n < NET; ++n) Sacc[i][n] = Sacc[i][n] * e1; }
        }
        f32x4 oacc[NTT][NET];
        if (MODE != 0) {
#pragma unroll
            for (int tt = 0; tt < NTT; ++tt)
#pragma unroll
                for (int n = 0; n < NET; ++n) oacc[tt][n] = (f32x4){0.f, 0.f, 0.f, 0.f};
#pragma unroll
            for (int ks = 0; ks < 4; ++ks) {
                bf16x8 Bf[NET];
#pragma unroll
                for (int n = 0; n < NET; ++n) Bf[n] = pack8(Sacc[2 * ks][n], Sacc[2 * ks + 1][n]);
#pragma unroll
                for (int tt = 0; tt < NTT; ++tt) {
                    const MKLAS bf16_t* qa = Qn + (16 * tt + r16) * QS + 32 * ks + 4 * quad;
                    const s16x4 a0 = *(const MKLAS s16x4*)qa, a1 = *(const MKLAS s16x4*)(qa + 16);
                    const bf16x8 Af = (bf16x8){a0[0], a0[1], a0[2], a0[3], a1[0], a1[1], a1[2], a1[3]};
#pragma unroll
                    for (int n = 0; n < NET; ++n) oacc[tt][n] = MFMA16(Bf[n], Af, oacc[tt][n]);
                }
            }
#pragma unroll
            for (int k2 = 0; k2 < NKS2; ++k2)
#pragma unroll
                for (int tt = 0; tt < NTT; ++tt) {
                    if (32 * k2 > 16 * tt + 15) continue;
                    const bf16x8 Af = ld_frag_row(Pm, PS, 16 * tt, 32 * k2, lane);
#pragma unroll
                    for (int n = 0; n < NET; ++n) oacc[tt][n] = MFMA16(Vf[k2][n], Af, oacc[tt][n]);
                }
        }
#pragma unroll
        for (int i = 0; i < 8; ++i)
#pragma unroll
            for (int k2 = 0; k2 < NKS2; ++k2) { const bf16x8 Af = ld_frag_tr(Kn, QS, 32 * k2, 16 * i, lane);
#pragma unroll
                for (int n = 0; n < NET; ++n) Sacc[i][n] = MFMA16(Af, Vf[k2][n], Sacc[i][n]); }
#pragma unroll
        for (int i = 0; i < 8; ++i) { f32x4 e2; if (!RET) e2 = *(const MKLAS f32x4*)(E12 + 128 + 16 * i + 4 * quad); else e2 = (f32x4){e2s, e2s, e2s, e2s};
#pragma unroll
            for (int n = 0; n < NET; ++n) Sacc[i][n] = Sacc[i][n] * e2; }
        if (MODE != 0) {
            bf16_t* Og = (RET ? WSP(bf16_t, WS_ORT) + h * 256 : WSP(bf16_t, WS_OHG) + h * 128) + e0 + 4 * quad;
            constexpr int OS = RET ? 1024 : 512;
            if (MODE == 1) {
#pragma unroll
                for (int tt = 0; tt < NTT; ++tt) { const size_t rr = (size_t)TOKROW(C * j + 16 * tt + r16);
#pragma unroll
                    for (int n = 0; n < NET; ++n) st_bf4(Og + rr * OS + 16 * n, oacc[tt][n]); }
            } else {
#pragma unroll
                for (int tt = 0; tt < NTT; ++tt) { float s1 = 0.f, s2 = 0.f; const size_t rb = (size_t)TOKROW(C * j + 16 * tt + r16);
#pragma unroll
                    for (int n = 0; n < NET; ++n) { const u32x2 obv = *(const u32x2*)(Og + rb * OS + 16 * n); const f32x4 v = oacc[tt][n] + (f32x4){bflo(obv.x), bfhi(obv.x), bflo(obv.y), bfhi(obv.y)}; oacc[tt][n] = v;
                        s1 += (v.x + v.y) + (v.z + v.w); s2 += (v.x * v.x + v.y * v.y) + (v.z * v.z + v.w * v.w); }
                    s1 += __shfl_xor(s1, 16); s2 += __shfl_xor(s2, 16); s1 += __shfl_xor(s1, 32); s2 += __shfl_xor(s2, 32);
                    if (quad == 0) { RED[(w * 64 + 16 * tt + r16) * 2] = s1; RED[(w * 64 + 16 * tt + r16) * 2 + 1] = s2; } }
                __syncthreads();
                const float* nw = (RET ? p.in[12] + l * 1024 + h * 256 : p.in[10] + l * 512 + h * 128) + e0 + 4 * quad;
#pragma unroll
                for (int tt = 0; tt < NTT; ++tt) { const int tpos = 16 * tt + r16; const size_t rr = (size_t)TOKROW(C * j + tpos); float s1 = 0.f, s2 = 0.f;
#pragma unroll
                    for (int ww = 0; ww < 8; ++ww) { const f32x2 q = *(const MKLAS f32x2*)(RED + (ww * 64 + tpos) * 2); s1 += q.x; s2 += q.y; }
                    const float mean = RET ? s1 * (1.f / 256.f) : 0.f;
                    const float var = RET ? fmaxf(s2 * (1.f / 256.f) - mean * mean, 0.f) : s2 * (1.f / 128.f);
                    const float rinv = 1.0f / sqrtf(var + EPS);
#pragma unroll
                    for (int n = 0; n < NET; ++n) st_bf4(Og + rr * OS + 16 * n, (oacc[tt][n] - mean) * rinv * *(const f32x4*)(nw + 16 * n)); }
            }
        }
        if (RET) __syncthreads();
    }
    if (MODE == 0) {
#pragma unroll
        for (int i = 0; i < 8; ++i)
#pragma unroll
            for (int n = 0; n < NET; ++n) { u32x2 q; q.x = cvt_pk_bf16(Sacc[i][n].x, Sacc[i][n].y); q.y = cvt_pk_bf16(Sacc[i][n].z, Sacc[i][n].w);
                *(u32x2*)(ST + (size_t)(e0 + 16 * n + r16) * 128 + 16 * i + 4 * quad) = q; }
        if (!RET && hseg == 0) WSP(float, WS_ATOT)[((size_t)chain * 65 + c) * 128 + hd] = fexp(btot);
    }
#undef LOAD_CHUNK
#undef TOKROW
}

__device__ __forceinline__ int next_unit(unsigned* ctr, volatile MKLAS int* slot) {
    __syncthreads();
    if (threadIdx.x == 0) *slot = (int)__hip_atomic_fetch_add(ctr, 1u, __ATOMIC_RELAXED, __HIP_MEMORY_SCOPE_AGENT);
    __syncthreads();
    return *slot;
}
__device__ __forceinline__ void ph_scan_pass1(const P& p, int l, MKLAS unsigned char* lds, unsigned* ctr, volatile MKLAS int* slot) {
    const int nctx = (l == DEPTH - 1) ? 0 : 8;
    for (;;) { const int u0 = next_unit(ctr, slot); if (u0 >= 1040 + nctx) break;
        if (u0 < nctx) { const int h = u0 & 3;
            if (u0 < 4) { scan_unit<true, 1>(p, l, h, 0, 1, lds, true); __syncthreads(); scan_unit<true, 2>(p, l, h, 0, 0, lds, true); }
            else { scan_unit<false, 1>(p, l, h, 0, 1, lds, true); __syncthreads(); scan_unit<false, 2>(p, l, h, 0, 0, lds, true); }
            continue; }
        const int u = u0 - nctx;
        const bool ret = u < 520; const int v = ret ? u : u - 520, dir = v / 260, rem = v % 260, h = rem / 65, c = rem % 65;
        if (ret) scan_unit<true, 0>(p, l, h, c, dir, lds); else scan_unit<false, 0>(p, l, h, c, dir, lds); }
}
template <int MODE> __device__ __forceinline__ void ph_scan_pass3(const P& p, int l, MKLAS unsigned char* lds, unsigned*, volatile MKLAS int*) {
    for (int u = blockIdx.x; u < 512; u += gridDim.x) {
        const bool ret = u < 256; const int v = ret ? u : u - 256, h = v >> 6, c = (v & 63) + 1;
        __syncthreads();
        if (ret) scan_unit<true, MODE>(p, l, h, c, MODE == 1 ? 1 : 0, lds); else scan_unit<false, MODE>(p, l, h, c, MODE == 1 ? 1 : 0, lds); }
}
__device__ __forceinline__ void ph_scan_pass2(const P& p, int l) {
    const int tid = tid_fresh();
    const float* LG = WSP(float, WS_LGAM); const float* AT = WSP(float, WS_ATOT);
    for (int item = blockIdx.x * NT + tid; item < 32768 + 65536; item += gridDim.x * NT) {
        const bool ret = item >= 32768; const int it = ret ? item - 32768 : item, per = ret ? 8192 : 4096, chain = it / per, q4 = it % per, dir = chain >> 2, h = chain & 3, dd = (q4 * 4) & 127;
        bf16_t* base = (ret ? WSP(bf16_t, WS_STR) : WSP(bf16_t, WS_STH)) + (size_t)chain * 65 * (per * 4) + (size_t)q4 * 4;
        const float ar = ret ? fexp(256.f * LG[(l * 2 + dir) * 4 + h]) : 0.f;
        f32x4 S = {0.f, 0.f, 0.f, 0.f};
        for (int b0 = 0; b0 < 65; b0 += 13) {
            u32x2 U[13]; f32x4 A[13];
#pragma unroll
            for (int s = 0; s < 13; ++s) { const int step = b0 + s, c = dir == 0 ? step : (step == 0 ? 0 : 65 - step);
                U[s] = *(const u32x2*)(base + (size_t)c * (per * 4));
                A[s] = ret ? (f32x4){ar, ar, ar, ar} : *(const f32x4*)(AT + ((size_t)chain * 65 + c) * 128 + dd); }
#pragma unroll
            for (int s = 0; s < 13; ++s) { const int step = b0 + s, c = dir == 0 ? step : (step == 0 ? 0 : 65 - step);
                u32x2 o; o.x = cvt_pk_bf16(S.x, S.y); o.y = cvt_pk_bf16(S.z, S.w); *(u32x2*)(base + (size_t)c * (per * 4)) = o;
                S = A[s] * S + (f32x4){bflo(U[s].x), bfhi(U[s].x), bflo(U[s].y), bfhi(U[s].y)}; }
        }
    }
}

__device__ __forceinline__ void ph_router(const P& p, int l, MKLAS unsigned char* lds, unsigned* ecnt) {
    const int tid = tid_fresh(), lane = tid & 63, w = __builtin_amdgcn_readfirstlane(tid >> 6), r16 = lane & 15, g = lane >> 4;
    MKLAS float* ssum = (MKLAS float*)lds;
    MKLAS float* plog = ssum + 128;
    MKLAS float* lg = plog + 8 * 16 * 52;
    const float* MOD = WSP(float, WS_MOD); bf16_t* H = WSP(bf16_t, WS_H);
    int* AE = WSP(int, WS_AE); float* AW = WSP(float, WS_AW); int* APOS = WSP(int, WS_APOS); int* TOK = WSP(int, WS_TOK);
    const int cb = 128 * w + 4 * g;
    const float* nw = p.in[7] + l * D + cb;
    const float* WRT = WSP(float, WS_WRT) + (size_t)l * 48 * 1024 + (size_t)r16 * 1024 + cb;
    const float *bg = p.in[17] + l * 4, *be = p.in[19] + l * NE;
    const int r_lo = (l == DEPTH - 1) ? LC : 0, ntile = (L - r_lo) / 16;
    for (int t = blockIdx.x; t < ntile; t += gridDim.x) {
        const int r = r_lo + 16 * t + r16;
        const float* xr = xrow_st(p, r) + cb;
        const float* mod = MOD + (l * 2 + (r < LC ? 1 : 0)) * 6144 + cb;
        f32x4 x[8]; float ss = 0.f;
#pragma unroll
        for (int m = 0; m < 8; ++m) { x[m] = *(const f32x4*)(xr + 16 * m); ss += (x[m].x * x[m].x + x[m].y * x[m].y) + (x[m].z * x[m].z + x[m].w * x[m].w); }
        ss += __shfl_xor(ss, 16); ss += __shfl_xor(ss, 32);
        if (g == 0) ssum[w * 16 + r16] = ss;
        __syncthreads();
        float tot = 0.f;
#pragma unroll
        for (int ww = 0; ww < 8; ++ww) tot += ssum[ww * 16 + r16];
        const float rinv = 1.0f / sqrtf(tot * (1.f / D) + EPS);
        f32x4 acc[3];
#pragma unroll
        for (int nt = 0; nt < 3; ++nt) acc[nt] = (f32x4){0.f, 0.f, 0.f, 0.f};
        bf16_t* ho = H + (size_t)r * D + cb;
#pragma unroll
        for (int m = 0; m < 8; ++m) {
            const f32x4 wv = *(const f32x4*)(nw + 16 * m), sh = *(const f32x4*)(mod + 3 * 1024 + 16 * m), sc = *(const f32x4*)(mod + 4 * 1024 + 16 * m);
            const f32x4 h = x[m] * rinv * wv * (sc + 1.0f) + sh;
            st_bf4(ho + 16 * m, h);
#pragma unroll
            for (int nt = 0; nt < 3; ++nt) { const f32x4 b = *(const f32x4*)(WRT + (size_t)nt * 16 * 1024 + 16 * m);
#pragma unroll
                for (int j = 0; j < 4; ++j) acc[nt] = __builtin_amdgcn_mfma_f32_16x16x4f32(h[j], b[j], acc[nt], 0, 0, 0); }
        }
#pragma unroll
        for (int nt = 0; nt < 3; ++nt)
#pragma unroll
            for (int j = 0; j < 4; ++j) plog[(w * 16 + 4 * g + j) * 52 + 16 * nt + r16] = acc[nt][j];
        __syncthreads();
        { const int row = tid >> 5, col = tid & 31; float a = 0.f;
#pragma unroll
            for (int ww = 0; ww < 8; ++ww) a += plog[(ww * 16 + row) * 52 + col];
            lg[row * 52 + col] = a;
            if (tid < 64) { const int row2 = tid >> 2, col2 = 32 + (tid & 3); float a2 = 0.f;
#pragma unroll
                for (int ww = 0; ww < 8; ++ww) a2 += plog[(ww * 16 + row2) * 52 + col2];
                lg[row2 * 52 + col2] = a2; } }
        __syncthreads();
        if (tid < 16) {
            const MKLAS float* my = lg + tid * 52;
            float gl[4];
#pragma unroll
            for (int q = 0; q < 4; ++q) gl[q] = my[32 + q] + bg[q];
            int grp = 0; float gm = gl[0];
#pragma unroll
            for (int q = 1; q < 4; ++q) if (gl[q] > gm) { gm = gl[q]; grp = q; }
            float gs = 0.f;
#pragma unroll
            for (int q = 0; q < 4; ++q) gs += expf(gl[q] - gm);
            const float gval = 1.0f / gs;
            float el[8];
#pragma unroll
            for (int j = 0; j < 8; ++j) el[j] = my[grp * 8 + j] + be[grp * 8 + j];
            int i1 = 0; float v1 = el[0];
#pragma unroll
            for (int j = 1; j < 8; ++j) if (el[j] > v1) { v1 = el[j]; i1 = j; }
            int i2 = -1; float v2 = -3.0e38f;
#pragma unroll
            for (int j = 0; j < 8; ++j) if (j != i1 && el[j] > v2) { v2 = el[j]; i2 = j; }
            const float e2 = expf(v2 - v1), w1 = 1.0f / (1.0f + e2), w2 = e2 / (1.0f + e2);
            const int ea0 = grp * 8 + i1, ea1 = grp * 8 + i2, rr = r_lo + 16 * t + tid;
            AE[2 * rr] = ea0; AE[2 * rr + 1] = ea1; AW[2 * rr] = gval * w1; AW[2 * rr + 1] = gval * w2;
            const int p0 = (int)__hip_atomic_fetch_add(ecnt + 16 * ea0, 1u, __ATOMIC_RELAXED, __HIP_MEMORY_SCOPE_AGENT);
            const int p1 = (int)__hip_atomic_fetch_add(ecnt + 16 * ea1, 1u, __ATOMIC_RELAXED, __HIP_MEMORY_SCOPE_AGENT);
            APOS[2 * rr] = p0; APOS[2 * rr + 1] = p1; TOK[(size_t)ea0 * L + p0] = rr; TOK[(size_t)ea1 * L + p1] = rr;
        }
    }
}
constexpr int XG_ROWS = 41472;
constexpr size_t WS_WGU = WS_OF, WS_WD = WS_OF + 32 * MiB;
constexpr size_t WS_XG = WS_QH, WS_ACT = WS_XG + (size_t)XG_ROWS * 2048, WS_YA = 160 * MiB;
static_assert(WS_ACT + (size_t)XG_ROWS * 512 <= WS_YA && WS_YA + (size_t)XG_ROWS * 2048 <= WS_OF, "MoE overlays");
constexpr int EXPERT_ITEMS = 3 * 2048;
__device__ __forceinline__ void expert_item(const P& p, int l, int it, MKLAS float* tile) {
    const int which = it >> 11, r = it & 2047, e = r >> 6, q = r & 63;
    if (which < 2) { const int kb = q >> 2, nb = q & 3, n0 = nb * 64;
        tr_item(p.in[20 + which] + ((size_t)l * NE + e) * D * DE, D, DE, WSP(bf16_t, WS_WGU) + (size_t)e * 512 * D, kb * 64, n0, (n0 >> 7) * 256 + which * 128 + (n0 & 127), tile); }
    else { const int kb = q >> 4, nb = q & 15;
        tr_item(p.in[22] + ((size_t)l * NE + e) * DE * D, DE, D, WSP(bf16_t, WS_WD) + (size_t)e * D * DE, kb * 64, nb * 64, nb * 64, tile); }
}
template <bool EXPERTS> __device__ __forceinline__ void fill_convert(const P& p, int l, MKLAS unsigned char* lds, unsigned* ctr, volatile MKLAS int* slot) {
    for (;;) { const int it = next_unit(ctr, slot); if (it >= (EXPERTS ? EXPERT_ITEMS : MIXER_ITEMS)) break;
        if (EXPERTS) expert_item(p, l, it, (MKLAS float*)lds); else mixer_item(p, l, it, (MKLAS float*)lds); }
}
constexpr int MOE_TAB = LDS_CTL_OFF + 64;
__device__ __forceinline__ void moe_tables(const P& p, int l, MKLAS unsigned char* lds, bool publish) {
    MKLAS int* off = (MKLAS int*)(lds + MOE_TAB); MKLAS int* cnt = off + 64; MKLAS int* te = off + 96;
    const unsigned* ecnt = (const unsigned*)(p.ws + WS_CTL) + CW_ECNT + l * NE * 16;
    const int tid = tid_fresh();
    __syncthreads();
    if (tid == 0) { int o = 0; for (int e = 0; e < NE; ++e) { const int c = (int)__hip_atomic_load(ecnt + 16 * e, __ATOMIC_RELAXED, __HIP_MEMORY_SCOPE_AGENT); off[e] = o; cnt[e] = c; o += (c + 255) & ~255; } off[NE] = o; off[NE + 1] = o >> 8; }
    __syncthreads();
    const int nt = off[NE + 1];
    for (int t = tid; t < nt; t += NT) { int e = 0; for (int k = 1; k < NE; ++k) if (t * 256 >= off[k]) e = k; te[t] = e; }
    __syncthreads();
    if (publish && blockIdx.x == 0) { int* TE = WSP(int, WS_TILEE); if (tid == 0) TE[255] = nt; for (int t = tid; t < nt; t += NT) TE[t] = te[t]; }
}
struct MoeOrder { static constexpr bool GATHER = false; const int* tile_e; int ntiles, nN, G, c;
    __device__ __forceinline__ bool next(int i, pg8::Unit& u) const { const long Lx = (long)i * G + c; if (Lx >= (long)ntiles * nN) return false; u.pm = (int)(Lx / nN); u.pn = (int)(Lx % nN); u.be = tile_e[u.pm]; return true; }
    __device__ __forceinline__ void a_ready(const pg8::Unit&) const {}
    __device__ __forceinline__ void done(const pg8::Unit&) const {} };
struct MoeGatherOrder { static constexpr bool GATHER = true; const MKLAS int* off; const MKLAS int* cnt; const MKLAS int* te; const int* tok; int ntiles, nN, G, c;
    __device__ __forceinline__ bool next(int i, pg8::Unit& u) const { const long Lx = (long)i * G + c; if (Lx >= (long)ntiles * nN) return false; u.pm = (int)(Lx / nN); u.pn = (int)(Lx % nN); u.be = te[u.pm]; return true; }
    __device__ __forceinline__ unsigned row_byte_off(const pg8::Unit& u, int r) const { const int pos = 256 * u.pm - off[u.be] + r; const int t = pos < cnt[u.be] ? tok[(size_t)u.be * L + pos] : 0; return (unsigned)t * (unsigned)(D * 2); }
    __device__ __forceinline__ void a_ready(const pg8::Unit&) const {}
    __device__ __forceinline__ void done(const pg8::Unit&) const {} };
struct EpiGU { static constexpr bool PERM = true, AFTER_DRAIN = false; bf16_t* ACT;
    __device__ __forceinline__ void operator()(const f32x4 (&acc)[2][2][4][2], const pg8::Unit& u, int wr, int wc, int fr, int fq) const {
        const int row0 = u.pm * 256 + wr * 64 + fr, col0 = u.pn * 128 + wc * 32 + 8 * fq;
#pragma unroll
        for (int ai = 0; ai < 2; ++ai)
#pragma unroll
            for (int m = 0; m < 4; ++m) st_bf8(ACT + (size_t)(row0 + ai * 128 + m * 16) * DE + col0, silu4(acc[ai][0][m][0]) * acc[ai][1][m][0], silu4(acc[ai][0][m][1]) * acc[ai][1][m][1]);
    } };
struct FnYA { bf16_t* YA;
    static constexpr bool HAS_LOAD = false; typedef NoRegs R;
    __device__ __forceinline__ void apply8(int row, int col, f32x4 v0, f32x4 v1, const R&, const pg8::Unit&) const { st_bf8(YA + (size_t)row * D + col, v0, v1); } };
__device__ __forceinline__ void ph_moe_combine(const P& p, int l, MKLAS unsigned char* lds) {
    moe_tables(p, l, lds, false);
    const MKLAS int* off = (const MKLAS int*)(lds + MOE_TAB);
    const int tid_ = tid_fresh(), lane = tid_ & 63, wave = tid_ >> 6;
    const float* MOD = WSP(float, WS_MOD); const bf16_t* YA = WSP(bf16_t, WS_YA); bf16_t* H = WSP(bf16_t, WS_H);
    const int* AE = WSP(int, WS_AE); const int* APOS = WSP(int, WS_APOS); const float* AW = WSP(float, WS_AW);
    const bool last = (l == DEPTH - 1);
    const float* nw = last ? p.in[23] : p.in[6] + (l + 1) * D;
    for (int r = (last ? LC : 0) + blockIdx.x * NW + wave; r < L; r += gridDim.x * NW) {
        const int isc = r < LC ? 1 : 0;
        const float* g2 = MOD + (l * 2 + isc) * 6144 + 5 * 1024;
        float* xo = xrow_st(p, r);
        const int sa = off[AE[2 * r]] + APOS[2 * r], sb = off[AE[2 * r + 1]] + APOS[2 * r + 1]; const float wa = AW[2 * r], wb = AW[2 * r + 1];
        const u32x2* ya = (const u32x2*)(YA + (size_t)sa * D) + lane; const u32x2* yb = (const u32x2*)(YA + (size_t)sb * D) + lane;
        f32x4 v[4]; float ss = 0.f;
#pragma unroll
        for (int j = 0; j < 4; ++j) { const int c = 4 * (lane + 64 * j); const u32x2 a = ya[64 * j], b = yb[64 * j];
            const f32x4 y = (f32x4){wa * bflo(a.x) + wb * bflo(b.x), wa * bfhi(a.x) + wb * bfhi(b.x), wa * bflo(a.y) + wb * bflo(b.y), wa * bfhi(a.y) + wb * bfhi(b.y)};
            v[j] = *(const f32x4*)(xo + c) + *(const f32x4*)(g2 + c) * y;
            ss += (v[j].x * v[j].x + v[j].y * v[j].y) + (v[j].z * v[j].z + v[j].w * v[j].w); }
        const float rinv = 1.0f / sqrtf(wave_sum(ss) * (1.f / D) + EPS);
        if (last) {
#pragma unroll
            for (int j = 0; j < 4; ++j) { const int c = 4 * (lane + 64 * j); *(f32x4*)(xo + c) = v[j] * rinv * *(const f32x4*)(nw + c); }
        } else {
            const float* mod = MOD + ((l + 1) * 2 + isc) * 6144;
            u32x2* o = (u32x2*)(H + (size_t)r * D) + lane;
#pragma unroll
            for (int j = 0; j < 4; ++j) { const int c = 4 * (lane + 64 * j); *(f32x4*)(xo + c) = v[j];
                const f32x4 hh = v[j] * rinv * *(const f32x4*)(nw + c) * (*(const f32x4*)(mod + 1024 + c) + 1.0f) + *(const f32x4*)(mod + c);
                u32x2 q; q.x = cvt_pk_bf16(hh.x, hh.y); q.y = cvt_pk_bf16(hh.z, hh.w); o[64 * j] = q; }
        }
    }
}

constexpr int LDS_BYTES = 147456, LDS_CTL = LDS_CTL_OFF;
constexpr int NPH_LAYER = 13, NPH = 1 + DEPTH * NPH_LAYER;

__device__ __forceinline__ void ph_prologue(const P& p, MKLAS unsigned char* lds) {
    const int tid = tid_fresh(), b = blockIdx.x, G = gridDim.x;
    MKLAS float* s0 = (MKLAS float*)lds;
    MKLAS float* red = s0 + 2048;
    for (int i = tid; i < 1024; i += NT) { s0[i] = siluf(p.in[1][i]); s0[1024 + i] = siluf(p.in[3][i]); }
    __syncthreads();
    float* MOD = WSP(float, WS_MOD);
    for (int u = b; u < DEPTH * 96; u += G) {
        const int l = u / 96, n0 = (u % 96) * 64, c = tid & 63, ks = tid >> 6;
        const float* W = p.in[4] + (size_t)l * 1024 * 6144 + n0 + c;
        float a0 = 0.f, a1 = 0.f;
#pragma unroll 8
        for (int i = 0; i < 128; ++i) { const int k = ks * 128 + i; const float w = W[(size_t)k * 6144]; a0 += s0[k] * w; a1 += s0[1024 + k] * w; }
        red[(ks * 64 + c) * 2] = a0; red[(ks * 64 + c) * 2 + 1] = a1;
        __syncthreads();
        if (tid < 128) { const int cc = tid & 63, w = tid >> 6; float s = 0.f;
#pragma unroll
            for (int k2 = 0; k2 < 8; ++k2) s += red[(k2 * 64 + cc) * 2 + w];
            MOD[(l * 2 + w) * 6144 + n0 + cc] = s + p.in[5][l * 6144 + n0 + cc]; }
        __syncthreads();
    }
    if (b == G - 1) {
        float* LB = WSP(float, WS_LB);
        for (int idx = tid; idx < 2 * 512; idx += NT) { const int dir = idx >> 9, ch = idx & 511;
            float x[DEPTH], m = -3.0e38f;
#pragma unroll
            for (int l = 0; l < DEPTH; ++l) { x[l] = p.in[9][(dir * DEPTH + l) * 512 + ch]; m = fmaxf(m, x[l]); }
            float s = 0.f;
#pragma unroll
            for (int l = 0; l < DEPTH; ++l) { x[l] = expf(x[l] - m); s += x[l]; }
            float cum = 0.f; const float p0 = x[0] / s;
#pragma unroll
            for (int l = 0; l < DEPTH; ++l) { cum += x[l] / s; LB[(dir * DEPTH + l) * 512 + ch] = fminf(fmaxf(cum - p0, 0.f), 1.0f - 1e-6f); } }
    }
    if (b == (G > 1 ? G - 2 : 0)) {
        float* RT = WSP(float, WS_ROPE);
        for (int idx = tid; idx < 256 * 32; idx += NT) { const int pos = idx >> 5, i = idx & 31;
            double bp = 1.0; for (int q = 0; q < i; ++q) bp *= 0.7498942093324559;
            const float inv = (float)bp; const float ang = (float)pos * inv;
            const double a = (double)ang, n = rint(a * 0.15915494309189535), r = a - n * 6.283185307179586, r2 = r * r;
            double ts = r, tc = 1.0, sn = r, cs = 1.0;
            for (int k = 1; k <= 14; ++k) { tc *= -r2 / (double)((2 * k - 1) * (2 * k)); cs += tc; ts *= -r2 / (double)((2 * k) * (2 * k + 1)); sn += ts; }
            RT[idx * 2] = (float)cs; RT[idx * 2 + 1] = (float)sn; }
    }
    if (b == (G > 2 ? G - 3 : 0)) {
        float* LG = WSP(float, WS_LGAM);
        if (tid < DEPTH * 2 * 4) LG[tid] = -log1pf(expf(-p.in[11][tid]));
    }
    { float* WRT = WSP(float, WS_WRT);
        for (int idx = b * NT + tid; idx < DEPTH * 48 * 1024; idx += G * NT) { const int l = idx / (48 * 1024), n = (idx >> 10) % 48, k = idx & 1023;
            WRT[idx] = n < 32 ? p.in[18][((size_t)l * D + k) * NE + n] : (n < 36 ? p.in[16][((size_t)l * D + k) * 4 + (n - 32)] : 0.f); } }
    fill_convert<false>(p, 0, lds, (unsigned*)(p.ws + WS_CTL) + CW_CNT + 64 * 12, (volatile MKLAS int*)(lds + LDS_CTL + 8));
}


template <class F> __device__ __forceinline__ void ctx_gemm(MKLAS unsigned char* lds, const bf16_t* A, const bf16_t* Bt, int N, int K, const F& f) {
    const int tid = tid_fresh(), lane = tid & 63, w = __builtin_amdgcn_readfirstlane(tid >> 6), r16 = lane & 15, g = lane >> 4;
    const int br = w & 1, bc = (w >> 1) & 1, kh = w >> 2;
    MKLAS f32x4* red = (MKLAS f32x4*)lds;
    const int nitems = 4 * (N / 64), kspan = K / 2;
    for (int it = blockIdx.x; it < nitems; it += gridDim.x) {
        const int ir = it & 3, ic = it >> 2;
        const bf16_t* ap = A + (size_t)(64 * ir + 32 * br + r16) * K + kh * kspan + 8 * g;
        const bf16_t* bp = Bt + (size_t)(64 * ic + 32 * bc + r16) * K + kh * kspan + 8 * g;
        f32x4 acc[2][2];
#pragma unroll
        for (int i = 0; i < 2; ++i)
#pragma unroll
            for (int jn = 0; jn < 2; ++jn) acc[i][jn] = (f32x4){0.f, 0.f, 0.f, 0.f};
#pragma unroll 8
        for (int ks = 0; ks < kspan / 32; ++ks) {
            const bf16x8 a0 = *(const bf16x8*)(ap + 32 * ks), a1 = *(const bf16x8*)(ap + (size_t)16 * K + 32 * ks);
            const bf16x8 b0 = *(const bf16x8*)(bp + 32 * ks), b1 = *(const bf16x8*)(bp + (size_t)16 * K + 32 * ks);
            acc[0][0] = MFMA16(b0, a0, acc[0][0]); acc[0][1] = MFMA16(b1, a0, acc[0][1]); acc[1][0] = MFMA16(b0, a1, acc[1][0]); acc[1][1] = MFMA16(b1, a1, acc[1][1]);
        }
        if (kh) {
#pragma unroll
            for (int i = 0; i < 2; ++i)
#pragma unroll
                for (int jn = 0; jn < 2; ++jn) red[((w - 4) * 4 + i * 2 + jn) * 64 + lane] = acc[i][jn];
        }
        __syncthreads();
        if (!kh) { pg8::Unit u; u.pm = 0; u.pn = (64 * ic) >> 8; u.be = 0;
#pragma unroll
            for (int i = 0; i < 2; ++i)
#pragma unroll
                for (int jn = 0; jn < 2; ++jn) f(64 * ir + 32 * br + 16 * i + r16, 64 * ic + 32 * bc + 16 * jn + 4 * g, acc[i][jn] + red[(w * 4 + i * 2 + jn) * 64 + lane], u); }
        __syncthreads();
    }
}
struct LatentOrder : pg8::StaticOrder {
    __device__ __forceinline__ bool next(int i, pg8::Unit& u) const { if (!pg8::StaticOrder::next(i, u)) return false; u.pm += 1; return true; } };
template <class F> __device__ __forceinline__ void run_gemm_latent(MKLAS unsigned char* lds, const bf16_t* A, const bf16_t* Bt, int N, int K, const F& f) {
    pg8::Gemm g{A, Bt, L, N, K, 0}; LatentOrder S; S.init(T, N, (int)gridDim.x, (int)blockIdx.x);
    EpiGen<F> E{f};
    pg8::gemm_phase<EpiGen<F>, LatentOrder, false>(lds, g, S, E, nullptr);
}
template <class F> __device__ __forceinline__ void run_gemm(MKLAS unsigned char* lds, const bf16_t* A, const bf16_t* Bt, int M, int N, int K, const F& f) {
    pg8::Gemm g{A, Bt, M, N, K, 0}; pg8::StaticOrder S; S.init(M, N, (int)gridDim.x, (int)blockIdx.x);
    EpiGen<F> E{f};
    pg8::gemm_phase<EpiGen<F>, pg8::StaticOrder, false>(lds, g, S, E, nullptr);
}

#ifndef MK_MASK
#define MK_MASK 0xfffff
#endif
#define KON(j) ((MK_MASK >> (j)) & 1)
#define IN(k) (lo <= (k) && (k) < hi)
#ifndef MK_PROBE
#define MK_PROBE 0
#endif
#ifndef MK_PROBE_WORK
#define MK_PROBE_WORK 0u
#endif
#ifndef MK_PROBE_WAIT
#define MK_PROBE_WAIT 0u
#endif
#if MK_PROBE
#define PROBE_MARK(kind, iswait) do { if (blockIdx.x == 0 && threadIdx.x == 0) { const unsigned long long now_ = wall_clock64(); const unsigned long long d_ = now_ - *(volatile MKLAS unsigned long long*)(lctl + 4); \
        if ((((iswait) ? MK_PROBE_WAIT : MK_PROBE_WORK) >> (kind)) & 1u) *(volatile MKLAS unsigned long long*)(lctl + 6) += d_; *(volatile MKLAS unsigned long long*)(lctl + 4) = now_; } } while (0)
#else
#define PROBE_MARK(kind, iswait) do { } while (0)
#endif
#define SEAMK(k, kind) do { PROBE_MARK(kind, 0); if (IN(k) && IN((k) + 1)) { xcd_barrier(bar); } PROBE_MARK(kind, 1); } while (0)
template <int l> __device__ __forceinline__ void run_layer(const P& p, MKLAS unsigned char* lds, const XcdBarrier& bar, const int lo, const int hi, volatile MKLAS unsigned* lctl) {
    constexpr bool last = (l == DEPTH - 1);
    const int b = 1 + l * NPH_LAYER;
    unsigned* const ctl = (unsigned*)(p.ws + WS_CTL);
    volatile MKLAS int* const slot = (volatile MKLAS int*)(lctl + 2);
    if (KON(1) && IN(b + 0)) { if (l == 0) ph_hnorm(p, l); } SEAMK(b + 0, 1);
    if (KON(2) && IN(b + 1)) { FnA f{WSP(bf16_t, WS_QH), WSP(bf16_t, WS_VH), WSP(bf16_t, WS_RQ), WSP(bf16_t, WS_RK), WSP(bf16_t, WS_RV), WSP(float, WS_LF), WSP(float, WS_LB) + l * 512, WSP(float, WS_ROPE)};
        ctx_gemm(lds, WSP(bf16_t, WS_H), WSP(bf16_t, WS_WIN), NA, D, f);
        run_gemm_latent(lds, WSP(bf16_t, WS_H), WSP(bf16_t, WS_WIN), NA, D, f); } SEAMK(b + 1, 2);
    if (KON(3) && IN(b + 2)) { ph_scan_pass1(p, l, lds, ctl + CW_CNT + 64 * (l * 4 + 0), slot); } SEAMK(b + 2, 4);
    if (KON(3) && IN(b + 3)) { ph_scan_pass2(p, l); } SEAMK(b + 3, 5);
    if (KON(4) && IN(b + 4)) { ph_scan_pass3<1>(p, l, lds, ctl + CW_CNT + 64 * (l * 4 + 1), slot); } SEAMK(b + 4, 6);
    if (KON(4) && IN(b + 5)) { ph_scan_pass3<2>(p, l, lds, ctl + CW_CNT + 64 * (l * 4 + 2), slot); } SEAMK(b + 5, 7);
    if (KON(5) && IN(b + 6)) { FnB f{WSP(bf16_t, WS_OHG), WSP(bf16_t, WS_ORT), WSP(bf16_t, WS_GA), WSP(bf16_t, WS_GB)};
        if (last) run_gemm_latent(lds, WSP(bf16_t, WS_H), WSP(bf16_t, WS_WIN) + (size_t)NA * D, NB, D, f); else run_gemm(lds, WSP(bf16_t, WS_H), WSP(bf16_t, WS_WIN) + (size_t)NA * D, L, NB, D, f);
        fill_convert<true>(p, l, lds, ctl + CW_CNT + 64 * (8 + l * 2 + 0), slot); } SEAMK(b + 6, 8);
    if (KON(7) && IN(b + 7)) {
        { FnM1 f{WSP(bf16_t, WS_GA), WSP(float, WS_M1)};
          if (!last) ctx_gemm(lds, WSP(bf16_t, WS_OHG), WSP(bf16_t, WS_WOHG), D, 512, f);
          run_gemm_latent(lds, WSP(bf16_t, WS_OHG), WSP(bf16_t, WS_WOHG), D, 512, f); }
        { FnM2 f{WSP(bf16_t, WS_GB), WSP(float, WS_M1), WSP(bf16_t, WS_MB)};
          if (!last) ctx_gemm(lds, WSP(bf16_t, WS_ORT), WSP(bf16_t, WS_WORET), D, D, f);
          run_gemm_latent(lds, WSP(bf16_t, WS_ORT), WSP(bf16_t, WS_WORET), D, D, f); } } SEAMK(b + 7, 10);
    if (KON(8) && IN(b + 8)) { FnX f{l == 0 ? p.in[2] : WSP(float, WS_CTX), l == 0 ? p.in[0] : p.out, WSP(float, WS_CTX), p.out, WSP(float, WS_MOD) + l * 2 * 6144};
        if (!last) ctx_gemm(lds, WSP(bf16_t, WS_MB), WSP(bf16_t, WS_WOUT), D, D, f);
        run_gemm_latent(lds, WSP(bf16_t, WS_MB), WSP(bf16_t, WS_WOUT), D, D, f); } SEAMK(b + 8, 11);
    if (KON(9) && IN(b + 9)) { ph_router(p, l, lds, ctl + CW_ECNT + l * NE * 16); } SEAMK(b + 9, 12);
    if (KON(11) && IN(b + 10)) { moe_tables(p, l, lds, true);
        const MKLAS int* tb = (const MKLAS int*)(lds + MOE_TAB);
        MoeGatherOrder S{tb, tb + 64, tb + 96, WSP(int, WS_TOK), tb[NE + 1], 2, (int)gridDim.x, (int)blockIdx.x};
        pg8::Gemm g{WSP(bf16_t, WS_H), WSP(bf16_t, WS_WGU), XG_ROWS, 512, D, (size_t)512 * D * 2}; EpiGU E{WSP(bf16_t, WS_ACT)};
        pg8::gemm_phase<EpiGU, MoeGatherOrder, false>(lds, g, S, E, nullptr);
        if (!last) fill_convert<false>(p, l + 1, lds, ctl + CW_CNT + 64 * (8 + l * 2 + 1), slot); } SEAMK(b + 10, 14);
    if (KON(12) && IN(b + 11)) { const int* TE = WSP(int, WS_TILEE); MoeOrder S{TE, TE[255], 4, (int)gridDim.x, (int)blockIdx.x};
        pg8::Gemm g{WSP(bf16_t, WS_ACT), WSP(bf16_t, WS_WD), XG_ROWS, D, DE, (size_t)D * DE * 2}; EpiGen<FnYA> E{FnYA{WSP(bf16_t, WS_YA)}};
        pg8::gemm_phase<EpiGen<FnYA>, MoeOrder, false>(lds, g, S, E, nullptr); } SEAMK(b + 11, 15);
    if (KON(13) && IN(b + 12)) { ph_moe_combine(p, l, lds); } SEAMK(b + 12, 16);
}

__global__ void __launch_bounds__(NT, 2) fwd(P p) {
    extern __shared__ __attribute__((aligned(16))) unsigned char lds_raw[];
    MKLAS unsigned char* lds = (MKLAS unsigned char*)lds_raw;
    volatile MKLAS unsigned* lctl = (volatile MKLAS unsigned*)(lds + LDS_CTL);
    if (threadIdx.x < 8) lctl[threadIdx.x] = 0u;
    __syncthreads();
#if MK_PROBE
    if (blockIdx.x == 0 && threadIdx.x == 0) *(volatile MKLAS unsigned long long*)(lctl + 4) = wall_clock64();
#endif
    const int lo = p.ph_lo, hi = p.ph_hi;
    const bool multi = (hi - lo) > 1;
    XcdBarrier bar; bar.bar = (unsigned*)(p.ws + WS_CTL) + CW_BAR; bar.x = 0; bar.st = nullptr;
    if (multi) bar = xcd_barrier_post((unsigned*)(p.ws + WS_CTL) + CW_BAR, lctl);
    if (KON(0) && IN(0)) { ph_prologue(p, lds); } SEAMK(0, 0);
    run_layer<0>(p, lds, bar, lo, hi, lctl);
    run_layer<1>(p, lds, bar, lo, hi, lctl);
    static_assert(DEPTH == 2, "two layers written out");
#if MK_PROBE
    if (blockIdx.x == 0 && threadIdx.x == 0) { const unsigned long long t0_ = wall_clock64(), d_ = 4ull * *(volatile MKLAS unsigned long long*)(lctl + 6); while (wall_clock64() - t0_ < d_) __builtin_amdgcn_s_sleep(8); }
#endif
#undef IN
}
}

#ifndef MK_ONE_LAUNCH
#define MK_ONE_LAUNCH 1
#endif
extern "C" void kernel_launch(void* const* d_in, const int* in_sizes, int n_in, void* d_out, int out_size, void* d_ws, size_t ws_size, hipStream_t stream) {
    using namespace mk;
    static int grid = 0;
    if (grid == 0) {
        if (n_in != 24 || in_sizes[0] != T * D || out_size != T * D || ws_size < WS_END) { fprintf(stderr, "kernel_launch: unexpected shapes / workspace (n_in %d, ws %zu, need %zu); nothing launched\n", n_in, ws_size, (size_t)WS_END); grid = -1; return; }
        int dev = 0, cus = 0, per_cu = 0;
        if (hipGetDevice(&dev) != hipSuccess || hipDeviceGetAttribute(&cus, hipDeviceAttributeMultiprocessorCount, dev) != hipSuccess) { grid = -1; return; }
        if (hipFuncSetAttribute((const void*)fwd, hipFuncAttributeMaxDynamicSharedMemorySize, LDS_BYTES) != hipSuccess) { fprintf(stderr, "kernel_launch: hipFuncSetAttribute failed\n"); grid = -1; return; }
        if (hipOccupancyMaxActiveBlocksPerMultiprocessor(&per_cu, (const void*)fwd, NT, LDS_BYTES) != hipSuccess || per_cu < 1) { fprintf(stderr, "kernel_launch: occupancy query says %d\n", per_cu); (void)hipGetLastError(); per_cu = 1; }
        grid = cus;
    }
    if (grid < 0) return;
    if (hipMemsetAsync((char*)d_ws + WS_CTL, 0, CTL_BYTES, stream) != hipSuccess) return;
    P p{};
    for (int i = 0; i < 24; ++i) p.in[i] = (const float*)d_in[i];
    p.out = (float*)d_out; p.ws = (unsigned char*)d_ws;
#if MK_ONE_LAUNCH
    p.ph_lo = 0; p.ph_hi = NPH;
    hipLaunchKernelGGL(fwd, dim3(grid), dim3(NT), LDS_BYTES, stream, p);
#else
    for (int ph = 0; ph < NPH; ++ph) { p.ph_lo = ph; p.ph_hi = ph + 1; hipLaunchKernelGGL(fwd, dim3(grid), dim3(NT), LDS_BYTES, stream, p); }
#endif
}
```

```cpp
#include <hip/hip_runtime.h>
#include <cstdio>
#include <cstdint>
__device__ __forceinline__ int tid_fresh() { int t = (int)threadIdx.x; asm volatile("" : "+v"(t)); return t; }
namespace pg8 {
#define PG8_LAS __attribute__((address_space(3)))
typedef unsigned short bf16_t;
typedef short bf16x8 __attribute__((ext_vector_type(8)));
typedef float f32x4 __attribute__((ext_vector_type(4)));
typedef unsigned u32x4 __attribute__((ext_vector_type(4)));
constexpr int BM = 256, BK = 64, HALF = 128, HTB = HALF * BK * 2  , STAGE_BYTES = 8 * HTB, NXCD = 8, WGM = 8;

__host__ __device__ __forceinline__ int lds_byte(int r, int c) { const int st = (r >> 4) * 2 + (c >> 5), rr = r & 15, cc = c & 31, ob = rr * 64 + cc * 2; return st * 1024 + (ob ^ (((ob >> 9) & 1) << 5)); }
__host__ __device__ __forceinline__ void stage_rc(int b, int& R, int& C) { const int st = b / 1024, sb = b % 1024, swz = sb ^ (((sb >> 9) & 1) << 5); R = (st >> 1) * 16 + swz / 64; C = (st & 1) * 32 + (swz % 64) / 2; }
__host__ __device__ __forceinline__ int perm32(int rho) { const int n = rho >> 4, i = rho & 15; return 8 * (i >> 2) + 4 * n + (i & 3); }

struct Unit { int pm, pn, be; };
struct Gemm { const bf16_t* A; const bf16_t* Bt; int M, N, K; size_t bstride; };

struct StaticOrder {
    static constexpr bool GATHER = false;
    int nM, nN, nwg, G, c;
    __host__ __device__ void init(int M, int N, int G_, int c_) { nM = M / BM; nN = N / BM; nwg = nM * nN; G = G_; c = c_; }
    __host__ __device__ bool next(int i, Unit& u) const {
        const long L = (long)i * G + c; if (L >= nwg) return false;
        int wgid = (int)L; { const int q = nwg / NXCD, r = nwg % NXCD, xcd = wgid % NXCD, off = wgid / NXCD; wgid = (xcd < r ? xcd * (q + 1) : r * (q + 1) + (xcd - r) * q) + off; }
        const int nig = WGM * nN, gid = wgid / nig, fm = gid * WGM, gsz = (nM - fm) < WGM ? (nM - fm) : WGM;
        u.pm = fm + ((wgid % nig) % gsz); u.pn = (wgid % nig) / gsz; u.be = 0; return true;
    }
    __device__ __forceinline__ void a_ready(const Unit&) const {}
    __device__ __forceinline__ void done(const Unit&) const {}
};

typedef float cvt_f32x2 __attribute__((ext_vector_type(2)));
typedef __bf16 cvt_bf16x2 __attribute__((ext_vector_type(2)));
__device__ __forceinline__ unsigned cvt_pk_bf16(float lo, float hi) { const cvt_f32x2 v = {lo, hi}; return __builtin_bit_cast(unsigned, __builtin_convertvector(v, cvt_bf16x2)); }
template <class Epi, class Sched, bool STAMP = false>
__device__ __forceinline__ void gemm_phase(PG8_LAS unsigned char* lds, const Gemm g, const Sched& S, const Epi& E, unsigned long long* stamps) {
    const int tid = tid_fresh(), wid = __builtin_amdgcn_readfirstlane(tid >> 6), lane = tid & 63, wr = wid >> 2, wc = wid & 3, fr = lane & 15, fq = lane >> 4;
    const int K = g.K, nt = K / BK;
    int ts_lo = 0, ts_hi = 0, nts = 0; const unsigned long long rt_entry = STAMP ? (unsigned long long)wall_clock64() : 0ull;
#define PG8_STAMP() do { if (STAMP && wid == 0 && nts < 64) { const unsigned long long _c = (unsigned long long)clock64(); \
        ts_lo = (lane == nts) ? (int)(unsigned)_c : ts_lo; ts_hi = (lane == nts) ? (int)(unsigned)(_c >> 32) : ts_hi; ++nts; } } while (0)
    PG8_STAMP();
    unsigned voffA[2], voffB[2];
#pragma unroll
    for (int i = 0; i < 2; ++i) { int R, C; stage_rc(tid * 16 + i * 8192, R, C); const int Rb = Epi::PERM ? ((R & ~31) + perm32(R & 31)) : R;
        voffA[i] = (unsigned)(R * K + C) * 2u; voffB[i] = (unsigned)(Rb * K + C) * 2u; }
    unsigned vA0[2] = {0u, 0u}, vA1[2] = {0u, 0u}, nvA0[2] = {0u, 0u}, nvA1[2] = {0u, 0u}; int gR[2] = {0, 0}, gC[2] = {0, 0};
    if constexpr (Sched::GATHER) {
#pragma unroll
        for (int i = 0; i < 2; ++i) stage_rc(tid * 16 + i * 8192, gR[i], gC[i]); }
#define PG8_GOFF(u, v0, v1) do { _Pragma("unroll") for (int _i = 0; _i < 2; ++_i) { v0[_i] = S.row_byte_off(u, gR[_i]) + (unsigned)gC[_i] * 2u; v1[_i] = S.row_byte_off(u, 128 + gR[_i]) + (unsigned)gC[_i] * 2u; } } while (0)
#define PG8_STAGE_A(bufoff, base, half, nxtsel) do { if constexpr (Sched::GATHER) { unsigned sel_[2]; _Pragma("unroll") for (int _j = 0; _j < 2; ++_j) sel_[_j] = (nxtsel) ? ((half) ? nvA1[_j] : nvA0[_j]) : ((half) ? vA1[_j] : vA0[_j]); \
        PG8_STAGE(bufoff, base, sel_); } else { PG8_STAGE(bufoff, (base) + ((half) ? hstep : (size_t)0), voffA); } } while (0)
    const size_t kstep = (size_t)(BK * 2);
    const size_t hstep = (size_t)HALF * K * 2;
    const size_t tstep = 2 * hstep;
    const unsigned ldsw = (unsigned)wid * 1024u;
    const int aoff = lds_byte(wr * 64 + fr, fq * 8), boff = lds_byte(wc * 32 + fr, fq * 8);
#define PG8_SA(b, h) (((b) * 2 + (h)) * HTB)
#define PG8_SB(b, h) ((4 + (b) * 2 + (h)) * HTB)
#define PG8_STAGE(bufoff, gbase, voff) do { _Pragma("unroll") for (int _i = 0; _i < 2; ++_i) \
        __builtin_amdgcn_global_load_lds((const unsigned*)((const char*)(gbase) + (voff)[_i]), (PG8_LAS unsigned*)(lds + (bufoff) + ldsw + _i * 8192), 16, 0, 0); } while (0)
#define PG8_LDA(dst, b, h) do { _Pragma("unroll") for (int m = 0; m < 4; ++m) _Pragma("unroll") for (int k = 0; k < 2; ++k) dst[m][k] = *(const PG8_LAS bf16x8*)(lds + PG8_SA(b, h) + aoff + m * 2048 + k * 1024); } while (0)
#define PG8_LDB(dst, b, h) do { _Pragma("unroll") for (int n = 0; n < 2; ++n) _Pragma("unroll") for (int k = 0; k < 2; ++k) dst[n][k] = *(const PG8_LAS bf16x8*)(lds + PG8_SB(b, h) + boff + n * 2048 + k * 1024); } while (0)
#define PG8_MMA(ai, bj, At, Bt) do { __builtin_amdgcn_s_setprio(1); _Pragma("unroll") for (int m = 0; m < 4; ++m) _Pragma("unroll") for (int n = 0; n < 2; ++n) _Pragma("unroll") for (int k = 0; k < 2; ++k) \
        acc[ai][bj][m][n] = __builtin_amdgcn_mfma_f32_16x16x32_bf16(Bt[n][k], At[m][k], acc[ai][bj][m][n], 0, 0, 0); __builtin_amdgcn_s_setprio(0); } while (0)
#define PG8_WAIT_V(n) asm volatile("s_waitcnt vmcnt(" #n ")" ::: "memory")
#define PG8_WAIT_L(n) asm volatile("s_waitcnt lgkmcnt(" #n ")" ::: "memory")
#define PG8_BAR __builtin_amdgcn_s_barrier()
#define PG8_SCHED __builtin_amdgcn_sched_barrier(0)
    Unit cur, nxt; int ui = 0;
    if (!S.next(0, cur)) return;
    f32x4 acc[2][2][4][2];
#pragma unroll
    for (int a = 0; a < 2; ++a)
#pragma unroll
        for (int b = 0; b < 2; ++b)
#pragma unroll
            for (int m = 0; m < 4; ++m)
#pragma unroll
                for (int n = 0; n < 2; ++n) acc[a][b][m][n] = (f32x4){0.f, 0.f, 0.f, 0.f};
    bf16x8 At[4][2], B0[2][2], B1[2][2];
    const char* cA = Sched::GATHER ? (const char*)g.A : (const char*)g.A + (size_t)cur.pm * tstep; const char* cB = (const char*)g.Bt + (size_t)cur.be * g.bstride + (size_t)cur.pn * tstep;
    S.a_ready(cur);
    if constexpr (Sched::GATHER) PG8_GOFF(cur, vA0, vA1);
    PG8_STAGE(PG8_SB(0, 0), cB, voffB); PG8_STAGE_A(PG8_SA(0, 0), cA, 0, false); PG8_STAGE(PG8_SB(0, 1), cB + hstep, voffB); PG8_STAGE_A(PG8_SA(0, 1), cA, 1, false);
    if (wr == 1) PG8_BAR;
    PG8_WAIT_V(4); PG8_BAR;
    PG8_STAGE(PG8_SB(1, 0), cB + kstep, voffB); PG8_STAGE_A(PG8_SA(1, 0), cA + kstep, 0, false); PG8_STAGE(PG8_SB(1, 1), cB + hstep + kstep, voffB);
    PG8_WAIT_V(6); PG8_BAR;
    PG8_STAMP();
    for (;;) {
        const bool has_next = S.next(ui + 1, nxt);
        const char* nA = Sched::GATHER ? (const char*)g.A : (has_next ? (const char*)g.A + (size_t)nxt.pm * tstep : cA); const char* nB = has_next ? (const char*)g.Bt + (size_t)nxt.be * g.bstride + (size_t)nxt.pn * tstep : cB;
        if constexpr (Sched::GATHER) { if (has_next) PG8_GOFF(nxt, nvA0, nvA1); else {
#pragma unroll
                for (int _i = 0; _i < 2; ++_i) { nvA0[_i] = vA0[_i]; nvA1[_i] = vA1[_i]; } } }
        for (int t = 0; t < nt; t += 2) {
            const bool last = (t == nt - 2);
            const char* a1 = cA + (size_t)(t + 1) * kstep;
            const char* a2 = last ? nA : cA + (size_t)(t + 2) * kstep; const char* b2 = last ? nB : cB + (size_t)(t + 2) * kstep;
            const char* a3 = a2 + kstep; const char* b3 = b2 + kstep;
            if (last && has_next) S.a_ready(nxt);
            PG8_LDB(B0, 0, 0); PG8_SCHED; PG8_LDA(At, 0, 0); PG8_STAGE_A(PG8_SA(1, 1), a1, 1, false);
            PG8_WAIT_L(8); PG8_BAR; PG8_WAIT_L(0); PG8_MMA(0, 0, At, B0); PG8_BAR; PG8_SCHED;
            PG8_LDB(B1, 0, 1); PG8_STAGE(PG8_SB(0, 0), b2, voffB);
            PG8_BAR; PG8_WAIT_L(0); PG8_MMA(0, 1, At, B1); PG8_BAR;
            PG8_LDA(At, 0, 1); PG8_STAGE_A(PG8_SA(0, 0), a2, 0, last);
            PG8_BAR; PG8_WAIT_L(0); PG8_MMA(1, 0, At, B0); PG8_BAR; PG8_SCHED;
            PG8_STAGE(PG8_SB(0, 1), b2 + hstep, voffB);
            PG8_WAIT_V(6); PG8_BAR; PG8_MMA(1, 1, At, B1); PG8_BAR;
            PG8_LDB(B0, 1, 0); PG8_SCHED; PG8_LDA(At, 1, 0); PG8_STAGE_A(PG8_SA(0, 1), a2, 1, last);
            PG8_WAIT_L(8); PG8_BAR; PG8_WAIT_L(0); PG8_MMA(0, 0, At, B0); PG8_BAR; PG8_SCHED;
            PG8_LDB(B1, 1, 1); PG8_STAGE(PG8_SB(1, 0), b3, voffB);
            PG8_BAR; PG8_WAIT_L(0); PG8_MMA(0, 1, At, B1); PG8_BAR;
            PG8_LDA(At, 1, 1); PG8_STAGE_A(PG8_SA(1, 0), a3, 0, last);
            PG8_BAR; PG8_WAIT_L(0); PG8_MMA(1, 0, At, B0); PG8_BAR; PG8_SCHED;
            PG8_STAGE(PG8_SB(1, 1), b3 + hstep, voffB);
            PG8_WAIT_V(6); PG8_BAR; PG8_MMA(1, 1, At, B1); PG8_BAR;
        }
        PG8_STAMP();
        if constexpr (!Epi::AFTER_DRAIN) { E(acc, cur, wr, wc, fr, fq); S.done(cur); }
        PG8_STAMP();
        if (!has_next) break;
#pragma unroll
        for (int a = 0; a < 2; ++a)
#pragma unroll
            for (int b = 0; b < 2; ++b)
#pragma unroll
                for (int m = 0; m < 4; ++m)
#pragma unroll
                    for (int n = 0; n < 2; ++n) acc[a][b][m][n] = (f32x4){0.f, 0.f, 0.f, 0.f};
        if constexpr (Sched::GATHER) {
#pragma unroll
            for (int _i = 0; _i < 2; ++_i) { vA0[_i] = nvA0[_i]; vA1[_i] = nvA1[_i]; } }
        cur = nxt; cA = nA; cB = nB; ++ui;
    }
    PG8_WAIT_V(0);
    if (wr == 0) PG8_BAR;
    PG8_BAR;
    if constexpr (Epi::AFTER_DRAIN) { E.fused(acc, cur, wr, wc, fr, fq, lds, wid, lane); S.done(cur); }
    PG8_STAMP();
    if (STAMP && wid == 0) { stamps[lane] = lane < nts ? (((unsigned long long)(unsigned)ts_hi << 32) | (unsigned)ts_lo) : 0ull;
        if (lane == 62) stamps[62] = rt_entry; if (lane == 63) stamps[63] = (unsigned long long)wall_clock64(); }
#undef PG8_STAMP
#undef PG8_SA
#undef PG8_SB
#undef PG8_STAGE
#undef PG8_STAGE_A
#undef PG8_GOFF
#undef PG8_LDA
#undef PG8_LDB
#undef PG8_MMA
#undef PG8_WAIT_V
#undef PG8_WAIT_L
#undef PG8_BAR
#undef PG8_SCHED
}
}


#define XB_TMO      128
#define XB_XCNT(j)  (256  + 64 * (j))
#define XB_XSUB(j)  (1280 + 64 * (j))
#define XB_XGEN(j)  (2304 + 64 * (j))
#define XB_TOP      3328
#define XB_TOPGEN   3392
#define XCD_BAR_WORDS 3456
#define XB_SPIN_CAP (1u << 18)
#define LAS __attribute__((address_space(3)))

__device__ __forceinline__ unsigned xb_ld(unsigned* p)              { return __hip_atomic_load(p, __ATOMIC_RELAXED, __HIP_MEMORY_SCOPE_AGENT); }
__device__ __forceinline__ unsigned xb_add(unsigned* p, unsigned v) { return __hip_atomic_fetch_add(p, v, __ATOMIC_RELAXED, __HIP_MEMORY_SCOPE_AGENT); }
__device__ __forceinline__ unsigned xb_xcc_id() { return (unsigned)__builtin_amdgcn_s_getreg((3 << 11) | 20) & 0xFu; }
#define XB_SPIN(cond, bar) do { unsigned _sp = 0; while (cond) { __builtin_amdgcn_s_sleep(1); \
    if ((++_sp & 255u) == 0u) { if (xb_ld(&(bar)[XB_TMO])) break; if (_sp > XB_SPIN_CAP) { atomicAdd(&(bar)[XB_TMO], 1u); break; } } } } while (0)

struct XcdBarrier {
    unsigned* bar; unsigned x;
    volatile LAS unsigned* st;
};

__device__ __forceinline__ XcdBarrier xcd_barrier_post(unsigned* bar, volatile LAS unsigned* st) {
    XcdBarrier b; b.bar = bar; b.x = xb_xcc_id(); b.st = st;
    if (threadIdx.x == 0) (void)xb_add(&bar[XB_XCNT(b.x)], 1u);
    return b;
}
__device__ __forceinline__ void xcd_barrier_complete(unsigned* bar, unsigned x, unsigned& nloc, unsigned& nx) {
    const unsigned G = gridDim.x * gridDim.y * gridDim.z;
    unsigned sum, cnt, mine, sp = 0u;
    for (;;) {
        sum = 0u; cnt = 0u; mine = 0u;
#pragma unroll
        for (unsigned j = 0; j < 16; ++j) { const unsigned c = xb_ld(&bar[XB_XCNT(j)]); sum += c; cnt += (c > 0u) ? 1u : 0u; mine = (j == x) ? c : mine; }
        if (sum == G) break;
        __builtin_amdgcn_s_sleep(1);
        if ((++sp & 255u) == 0u) { if (xb_ld(&bar[XB_TMO])) break; if (sp > XB_SPIN_CAP) { atomicAdd(&bar[XB_TMO], 1u); break; } }
    }
    nloc = mine > 0u ? mine : 1u; nx = cnt > 0u ? cnt : 1u;
}

__device__ __forceinline__ void xcd_barrier(const XcdBarrier& b) {
    asm volatile("s_waitcnt vmcnt(0)" ::: "memory");
    __syncthreads();
    if (threadIdx.x == 0) {
        unsigned* bar = b.bar;
        __builtin_amdgcn_s_waitcnt(0);
        unsigned nloc = b.st[0], nx = b.st[1];
        if (nloc == 0u) { xcd_barrier_complete(bar, b.x, nloc, nx); b.st[0] = nloc; b.st[1] = nx; }
        const unsigned old = xb_add(&bar[XB_XSUB(b.x)], 1u);
        const unsigned gen = old / nloc;
        if (old + 1u == (gen + 1u) * nloc) {
            __builtin_amdgcn_fence(__ATOMIC_RELEASE, "agent");
            asm volatile("s_waitcnt vmcnt(0)" ::: "memory");
            const unsigned og = xb_add(&bar[XB_TOP], 1u);
            const unsigned tg = og / nx;
            if (og + 1u == (tg + 1u) * nx) xb_add(&bar[XB_TOPGEN], 1u);
            else XB_SPIN(xb_ld(&bar[XB_TOPGEN]) == tg, bar);
            __builtin_amdgcn_fence(__ATOMIC_ACQUIRE, "agent");
            xb_add(&bar[XB_XGEN(b.x)], 1u);
            asm volatile("s_waitcnt vmcnt(0)" ::: "memory");
        } else {
            XB_SPIN(xb_ld(&bar[XB_XGEN(b.x)]) == gen, bar);
            __builtin_amdgcn_fence(__ATOMIC_ACQUIRE, "agent");
            asm volatile("s_waitcnt vmcnt(0)" ::: "memory");
        }
    }
    __syncthreads();
}


namespace mk {
using pg8::bf16_t; using pg8::f32x4; using pg8::u32x4; using pg8::cvt_pk_bf16;
#define MKLAS __attribute__((address_space(3)))
typedef unsigned u32x2 __attribute__((ext_vector_type(2)));
typedef float f32x2 __attribute__((ext_vector_type(2)));

constexpr int D = 1024, T = 16384, LC = 256, L = T + LC, DEPTH = 2;
constexpr int NA = 4096, NB = 3584;
constexpr int NE = 32, DE = 256;
constexpr float EPS = 1e-6f;
constexpr int NT = 512, NW = 8;
constexpr int LDS_CTL_OFF = 131072;

constexpr size_t MiB = 1u << 20, QMiB = 1u << 18;
constexpr size_t WS_CTL = 0, CTL_BYTES = 1 * MiB;
constexpr size_t WS_MOD = 1 * MiB, WS_LB = WS_MOD + 128 * 1024, WS_ROPE = WS_MOD + 192 * 1024, WS_LGAM = WS_MOD + 256 * 1024, WS_WRT = WS_MOD + 512 * 1024;
constexpr size_t WS_AE = 2 * MiB, WS_AW = WS_AE + 256 * 1024, WS_APOS = WS_AE + 512 * 1024, WS_TILEE = WS_AE + 1024 * 1024;
constexpr size_t WS_TOK = 58 * MiB;
constexpr size_t WS_CTX = 4 * MiB;
constexpr size_t WS_WIN = 5 * MiB, WS_WOHG = 20 * MiB, WS_WORET = 21 * MiB, WS_WOUT = 23 * MiB;
constexpr size_t WS_H = 25 * MiB;
constexpr size_t WS_QH = 58 * MiB, WS_VH = WS_QH + 65 * QMiB, WS_RQ = WS_VH + 65 * QMiB, WS_RK = WS_RQ + 65 * QMiB;
constexpr size_t WS_RV = 123 * MiB;
constexpr size_t WS_LF = WS_RV + 130 * QMiB;
constexpr size_t WS_OHG = WS_LF + 260 * QMiB;
constexpr size_t WS_ORT = WS_OHG + 65 * QMiB;
constexpr size_t WS_OF = WS_ORT + 130 * QMiB;
constexpr size_t WS_END = WS_OF + 390 * QMiB;
constexpr size_t WS_GA = WS_QH, WS_GB = WS_QH + 130 * QMiB;
constexpr size_t WS_M1 = WS_LF;
constexpr size_t WS_MB = WS_RV;
constexpr int CW_BAR = 4096, CW_CNT = 8192, CW_ECNT = 12288;

struct P { const float* in[24]; float* out; unsigned char* ws; int ph_lo, ph_hi; };
__device__ __forceinline__ unsigned char* ws_fresh(unsigned char* w) { asm volatile("" : "+s"(w)); return w; }
#define WSP(type, off) ((type*)(p.ws + (off)))

__device__ __forceinline__ float bf2f(bf16_t b) { return __uint_as_float(((unsigned)b) << 16); }
__device__ __forceinline__ bf16_t f2bf(float f) { return (bf16_t)(cvt_pk_bf16(f, 0.f) & 0xffffu); }
__device__ __forceinline__ float fexp(float x) { return __builtin_amdgcn_exp2f(x * 1.4426950408889634f); }
__device__ __forceinline__ float flog(float x) { return __builtin_amdgcn_logf(x) * 0.6931471805599453f; }
__device__ __forceinline__ float siluf(float x) { return x * __builtin_amdgcn_rcpf(1.f + fexp(-x)); }
__device__ __forceinline__ float sigmf(float x) { return __builtin_amdgcn_rcpf(1.f + fexp(-x)); }
__device__ __forceinline__ float wave_sum(float v) {
#pragma unroll
    for (int o = 1; o < 64; o <<= 1) v += __shfl_xor(v, o);
    return v;
}
__device__ __forceinline__ const float* xrow_in(const P& p, int l, int r) {
    if (l == 0) return r < LC ? p.in[2] + (size_t)r * D : p.in[0] + (size_t)(r - LC) * D;
    return r < LC ? WSP(float, WS_CTX) + (size_t)r * D : p.out + (size_t)(r - LC) * D;
}
__device__ __forceinline__ float* xrow_st(const P& p, int r) { return r < LC ? WSP(float, WS_CTX) + (size_t)r * D : p.out + (size_t)(r - LC) * D; }
__device__ __forceinline__ int seq_row(int dir, int i) { return dir == 0 ? i : (i < LC ? LC - 1 - i : L + LC - 1 - i); }

__device__ __forceinline__ void tr_load(const float* W, int N, int k0, int n0, MKLAS float* tile) {
    const int tid = tid_fresh(), r = tid >> 6, c = tid & 63;
#pragma unroll
    for (int i = 0; i < 8; ++i) tile[(r + 8 * i) * 65 + c] = W[(size_t)(k0 + r + 8 * i) * N + n0 + c];
}
__device__ __forceinline__ void tr_store(bf16_t* WT, int K, int k0, int outrow0, const MKLAS float* tile, bool swap45 = false) {
    const int tid = tid_fresh(), nn = tid >> 3, kc = tid & 7;
    const MKLAS float* s = tile + (kc * 8) * 65 + nn;
    u32x4 o; o.x = cvt_pk_bf16(s[0], s[65]); o.y = cvt_pk_bf16(s[130], s[195]); o.z = cvt_pk_bf16(s[260], s[325]); o.w = cvt_pk_bf16(s[390], s[455]);
    const int nno = swap45 ? ((((nn & 31) >> 2) << 3) | ((nn >> 5) << 2) | (nn & 3)) : nn;
    *(u32x4*)(WT + (size_t)(outrow0 + nno) * K + k0 + kc * 8) = o;
}
constexpr int TRT = 64 * 65;
__device__ __forceinline__ int win_perm(int n) { return n < 2048 ? n : (n < 2560 ? 4096 + (n - 2048) : (n < 4608 ? 2048 + (n - 2560) : n)); }
constexpr int MIXER_ITEMS = 16 * 30 + 8 * 4 + 16 * 4 + 16 * 4;
__device__ __forceinline__ void mixer_item(const P& p, int l, int it, MKLAS float* tile) {
    constexpr int I_IN = 16 * 30, I_OHG = 8 * 4, I_ORT = 16 * 4;
    const float* W; bf16_t* WT; int K, N, kb, ng, kind;
    if (it < I_IN) { kind = 0; kb = it / 30; ng = it % 30; W = p.in[8] + (size_t)l * D * 7680; WT = WSP(bf16_t, WS_WIN); K = D; N = 7680; }
    else if (it < I_IN + I_OHG) { kind = 1; const int r = it - I_IN; kb = r >> 2; ng = r & 3; W = p.in[13] + (size_t)l * 512 * D; WT = WSP(bf16_t, WS_WOHG); K = 512; N = D; }
    else if (it < I_IN + I_OHG + I_ORT) { kind = 2; const int r = it - I_IN - I_OHG; kb = r >> 2; ng = r & 3; W = p.in[14] + (size_t)l * D * D; WT = WSP(bf16_t, WS_WORET); K = D; N = D; }
    else { kind = 3; const int r = it - I_IN - I_OHG - I_ORT; kb = r >> 2; ng = r & 3; W = p.in[15] + (size_t)l * D * D; WT = WSP(bf16_t, WS_WOUT); K = D; N = D; }
#pragma unroll
    for (int j = 0; j < 4; ++j) tr_load(W, N, kb * 64, (ng * 4 + j) * 64, tile + j * TRT);
    __syncthreads();
#pragma unroll
    for (int j = 0; j < 4; ++j) { const int n0 = (ng * 4 + j) * 64;
        tr_store(WT, K, kb * 64, kind == 0 ? win_perm(n0) : n0, tile + j * TRT, kind == 0 && n0 >= 2560 && n0 < 3584); }
    __syncthreads();
}

__device__ __forceinline__ void ph_hnorm(const P& p, int l) {
    const int tid_ = tid_fresh(), lane = tid_ & 63, wave = tid_ >> 6;
    const float* MOD = WSP(float, WS_MOD); bf16_t* H = WSP(bf16_t, WS_H);
    const float* nw = p.in[6] + l * D;
    for (int r = blockIdx.x * NW + wave; r < L; r += gridDim.x * NW) {
        const f32x4* xr = (const f32x4*)xrow_in(p, l, r) + lane;
        const float* mod = MOD + (l * 2 + (r < LC ? 1 : 0)) * 6144;
        f32x4 v[4]; float ss = 0.f;
#pragma unroll
        for (int j = 0; j < 4; ++j) { v[j] = xr[64 * j]; ss += (v[j].x * v[j].x + v[j].y * v[j].y) + (v[j].z * v[j].z + v[j].w * v[j].w); }
        const float rinv = 1.0f / sqrtf(wave_sum(ss) * (1.f / D) + EPS);
        u32x2* o = (u32x2*)(H + (size_t)r * D) + lane;
#pragma unroll
        for (int j = 0; j < 4; ++j) { const int c = 4 * (lane + 64 * j);
            const f32x4 w = *(const f32x4*)(nw + c), sh = *(const f32x4*)(mod + c), sc = *(const f32x4*)(mod + 1024 + c);
            const f32x4 h = v[j] * rinv * w * (sc + 1.0f) + sh;
            u32x2 q; q.x = cvt_pk_bf16(h.x, h.y); q.y = cvt_pk_bf16(h.z, h.w); o[64 * j] = q; }
    }
}

template <class F> struct EpiGen {
    static constexpr bool PERM = true, AFTER_DRAIN = false;
    F f;
    __device__ __forceinline__ void operator()(const f32x4 (&acc)[2][2][4][2], const pg8::Unit& u, int wr, int wc, int fr, int fq) const {
        const int row0 = u.pm * 256 + wr * 64 + fr, col0 = u.pn * 256 + wc * 32 + 8 * fq;
        if constexpr (!F::HAS_LOAD) {
            const typename F::R none{};
#pragma unroll
            for (int g = 0; g < 8; ++g)
#pragma unroll
                for (int bj = 0; bj < 2; ++bj) f.apply8(row0 + (g >> 2) * 128 + (g & 3) * 16, col0 + bj * 128, acc[g >> 2][bj][g & 3][0], acc[g >> 2][bj][g & 3][1], none, u);
        } else {
            typename F::R cur[2], nxt[2];
#pragma unroll
            for (int bj = 0; bj < 2; ++bj) cur[bj] = f.load8(row0, col0 + bj * 128, u);
            asm volatile("" ::: "memory");
#pragma unroll
            for (int g = 0; g < 8; ++g) {
                if (g < 7) {
#pragma unroll
                    for (int bj = 0; bj < 2; ++bj) nxt[bj] = f.load8(row0 + ((g + 1) >> 2) * 128 + ((g + 1) & 3) * 16, col0 + bj * 128, u);
                }
                asm volatile("" ::: "memory");
#pragma unroll
                for (int bj = 0; bj < 2; ++bj) f.apply8(row0 + (g >> 2) * 128 + (g & 3) * 16, col0 + bj * 128, acc[g >> 2][bj][g & 3][0], acc[g >> 2][bj][g & 3][1], cur[bj], u);
                asm volatile("" ::: "memory");
#pragma unroll
                for (int bj = 0; bj < 2; ++bj) cur[bj] = nxt[bj];
            }
        }
    }
};
struct NoRegs {};
__device__ __forceinline__ void st_bf4(bf16_t* dst, f32x4 v) { u32x2 q; q.x = cvt_pk_bf16(v.x, v.y); q.y = cvt_pk_bf16(v.z, v.w); *(u32x2*)dst = q; }
__device__ __forceinline__ void st_bf8(bf16_t* dst, f32x4 a, f32x4 b) { u32x4 q; q.x = cvt_pk_bf16(a.x, a.y); q.y = cvt_pk_bf16(a.z, a.w); q.z = cvt_pk_bf16(b.x, b.y); q.w = cvt_pk_bf16(b.z, b.w); *(u32x4*)dst = q; }
__device__ __forceinline__ f32x4 bf2lo4(u32x4 q) { return (f32x4){__uint_as_float(q.x << 16), __uint_as_float(q.x & 0xffff0000u), __uint_as_float(q.y << 16), __uint_as_float(q.y & 0xffff0000u)}; }
__device__ __forceinline__ f32x4 bf2hi4(u32x4 q) { return (f32x4){__uint_as_float(q.z << 16), __uint_as_float(q.z & 0xffff0000u), __uint_as_float(q.w << 16), __uint_as_float(q.w & 0xffff0000u)}; }
__device__ __forceinline__ f32x4 silu4(f32x4 v) { return (f32x4){siluf(v.x), siluf(v.y), siluf(v.z), siluf(v.w)}; }
__device__ __forceinline__ f32x4 sigm4(f32x4 v) { return (f32x4){sigmf(v.x), sigmf(v.y), sigmf(v.z), sigmf(v.w)}; }
__device__ __forceinline__ f32x4 ld_bf4(const bf16_t* src) { const u32x2 q = *(const u32x2*)src; f32x4 v; v.x = __uint_as_float(q.x << 16); v.y = __uint_as_float(q.x & 0xffff0000u); v.z = __uint_as_float(q.y << 16); v.w = __uint_as_float(q.y & 0xffff0000u); return v; }

struct FnA {
    bf16_t *QH, *VH, *RQ, *RK, *RV; float* LF; const float* LB; const float* RT;
    static constexpr bool HAS_LOAD = false; typedef NoRegs R;
    __device__ __forceinline__ f32x4 logf4(f32x4 v, int dir, int ch) const { const f32x4 lb = *(const f32x4*)(LB + dir * DEPTH * 512 + ch); f32x4 o;
#pragma unroll
        for (int j = 0; j < 4; ++j) { const float e = fexp(fminf(-v[j], 69.f));
            o[j] = fmaxf(flog(1.f + lb[j] * e) - flog(1.f + e), -69.0775528f); }
        return o; }
    static __device__ __forceinline__ int rot_dim(int c) { return (c & ~63) | (((c >> 3) & 7) << 2) | (c & 3) | ((c & 4) << 3); }
    __device__ __forceinline__ void operator()(int row, int col, f32x4 v, const pg8::Unit& u) const {
        const int seg = u.pn >> 1;
        if (seg == 0) st_bf4(QH + (size_t)row * 512 + col, silu4(v) * 0.08838834764831845f);
        else if (seg == 1 || seg == 2) { const int dir = seg - 1, ch = col - seg * 512; *(f32x4*)(LF + (size_t)row * 1024 + dir * 512 + ch) = logf4(v, dir, ch); }
        else if (seg == 3) st_bf4(VH + (size_t)row * 512 + (col - 1536), v);
        else if (seg == 4) st_bf4(RQ + (size_t)row * 512 + rot_dim(col - 2048), v * 0.08838834764831845f);
        else if (seg == 5) st_bf4(RK + (size_t)row * 512 + rot_dim(col - 2560), v);
        else st_bf4(RV + (size_t)row * 1024 + (col - 3072), v);
    }
    __device__ __forceinline__ void apply8(int row, int col, f32x4 v0, f32x4 v1, const R&, const pg8::Unit& u) const {
        const int seg = u.pn >> 1;
        if (seg == 0) st_bf8(QH + (size_t)row * 512 + col, silu4(v0) * 0.08838834764831845f, silu4(v1) * 0.08838834764831845f);
        else if (seg == 1 || seg == 2) { const int dir = seg - 1, ch = col - seg * 512; float* o = LF + (size_t)row * 1024 + dir * 512 + ch; *(f32x4*)o = logf4(v0, dir, ch); *(f32x4*)(o + 4) = logf4(v1, dir, ch + 4); }
        else if (seg == 3) st_bf8(VH + (size_t)row * 512 + (col - 1536), v0, v1);
        else if (seg == 4 || seg == 5) {
            const int c = col - (seg == 4 ? 2048 : 2560), d0 = rot_dim(c), half = (d0 >> 6) & 1, i = d0 & 31;
            const float sc = seg == 4 ? 0.08838834764831845f : 1.f;
            bf16_t* o = (seg == 4 ? RQ : RK) + (size_t)row * 512 + d0;
            if (row >= LC) { const int t = row - LC, pos = half ? (t & 63) : (t >> 6);
                const f32x4 cs0 = *(const f32x4*)(RT + (pos * 32 + i) * 2), cs1 = *(const f32x4*)(RT + (pos * 32 + i) * 2 + 4);
                const f32x4 co = {cs0.x, cs0.z, cs1.x, cs1.z}, si = {cs0.y, cs0.w, cs1.y, cs1.w};
                st_bf4(o, (v0 * co - v1 * si) * sc); st_bf4(o + 32, (v0 * si + v1 * co) * sc); }
            else { st_bf4(o, v0 * sc); st_bf4(o + 32, v1 * sc); } }
        else st_bf8(RV + (size_t)row * 1024 + (col - 3072), v0, v1);
    }
};
struct FnB {
    bf16_t *OHG, *ORT, *GA, *GB;
    static constexpr bool HAS_LOAD = true; typedef u32x4 R;
    __device__ __forceinline__ bf16_t* optr(int row, int col, int pn) const { return pn < 2 ? OHG + (size_t)row * 512 + col : ORT + (size_t)row * 1024 + (col - 512); }
    __device__ __forceinline__ R load8(int row, int col, const pg8::Unit& u) const { if (u.pn < 6) return *(const u32x4*)optr(row, col, u.pn); return (u32x4){0u, 0u, 0u, 0u}; }
    __device__ __forceinline__ void apply8(int row, int col, f32x4 v0, f32x4 v1, const R& r, const pg8::Unit& u) const {
        const int pn = u.pn;
        if (pn < 6) st_bf8(optr(row, col, pn), bf2lo4(r) * silu4(v0), bf2hi4(r) * silu4(v1));
        else st_bf8(pn < 10 ? GA + (size_t)row * 1024 + (col - 1536) : GB + (size_t)row * 1024 + (col - 2560), sigm4(v0), sigm4(v1));
    }
};
__device__ __forceinline__ f32x4 bf4_to_f32(u32x2 q) { return (f32x4){__uint_as_float(q.x << 16), __uint_as_float(q.x & 0xffff0000u), __uint_as_float(q.y << 16), __uint_as_float(q.y & 0xffff0000u)}; }
struct FnM1 { const bf16_t* GA; float* M1;
    static constexpr bool HAS_LOAD = true; typedef u32x4 R;
    __device__ __forceinline__ R load8(int row, int col, const pg8::Unit&) const { return *(const u32x4*)(GA + (size_t)row * D + col); }
    __device__ __forceinline__ void apply8(int row, int col, f32x4 v0, f32x4 v1, const R& r, const pg8::Unit&) const { float* o = M1 + (size_t)row * D + col; *(f32x4*)o = bf2lo4(r) * v0; *(f32x4*)(o + 4) = bf2hi4(r) * v1; }
    __device__ __forceinline__ void operator()(int row, int col, f32x4 v, const pg8::Unit&) const { *(f32x4*)(M1 + (size_t)row * D + col) = bf4_to_f32(*(const u32x2*)(GA + (size_t)row * D + col)) * v; } };
struct RegsM2 { f32x4 m0, m1; u32x4 g; };
struct FnM2 { const bf16_t* GB; const float* M1; bf16_t* MB;
    static constexpr bool HAS_LOAD = true; typedef RegsM2 R;
    __device__ __forceinline__ R load8(int row, int col, const pg8::Unit&) const { R r; const float* m = M1 + (size_t)row * D + col; r.m0 = *(const f32x4*)m; r.m1 = *(const f32x4*)(m + 4); r.g = *(const u32x4*)(GB + (size_t)row * D + col); return r; }
    __device__ __forceinline__ void apply8(int row, int col, f32x4 v0, f32x4 v1, const R& r, const pg8::Unit&) const { st_bf8(MB + (size_t)row * D + col, r.m0 + bf2lo4(r.g) * v0, r.m1 + bf2hi4(r.g) * v1); }
    __device__ __forceinline__ void operator()(int row, int col, f32x4 v, const pg8::Unit&) const { st_bf4(MB + (size_t)row * D + col, *(const f32x4*)(M1 + (size_t)row * D + col) + bf4_to_f32(*(const u32x2*)(GB + (size_t)row * D + col)) * v); } };
struct RegsX { f32x4 x0, x1; };
struct FnX { const float *xc_in, *xl_in; float *xc_out, *xl_out; const float* MODL;
    static constexpr bool HAS_LOAD = true; typedef RegsX R;
    __device__ __forceinline__ R load8(int row, int col, const pg8::Unit&) const { const bool isc = row < LC; const float* x = (isc ? xc_in : xl_in) + (size_t)(isc ? row : row - LC) * D + col; R r; r.x0 = *(const f32x4*)x; r.x1 = *(const f32x4*)(x + 4); return r; }
    __device__ __forceinline__ void apply8(int row, int col, f32x4 v0, f32x4 v1, const R& r, const pg8::Unit&) const {
        const bool isc = row < LC; const float* g = MODL + (isc ? 6144 : 0) + 2 * 1024 + col; float* o = (isc ? xc_out : xl_out) + (size_t)(isc ? row : row - LC) * D + col;
        *(f32x4*)o = r.x0 + *(const f32x4*)g * v0; *(f32x4*)(o + 4) = r.x1 + *(const f32x4*)(g + 4) * v1; }
    __device__ __forceinline__ void operator()(int row, int col, f32x4 v, const pg8::Unit&) const {
        const bool isc = row < LC; const size_t off = (size_t)(isc ? row : row - LC) * D + col;
        *(f32x4*)((isc ? xc_out : xl_out) + off) = *(const f32x4*)((isc ? xc_in : xl_in) + off) + *(const f32x4*)(MODL + (isc ? 6144 : 0) + 2 * 1024 + col) * v; } };

typedef short bf16x8 __attribute__((ext_vector_type(8)));
typedef short s16x4 __attribute__((ext_vector_type(4)));
#define MFMA16(a, b, c) __builtin_amdgcn_mfma_f32_16x16x32_bf16((a), (b), (c), 0, 0, 0)
constexpr size_t WS_STH = WS_OF, WS_STR = WS_OF + (size_t)8 * 65 * 16384 * 2, WS_ATOT = WS_OF + 49 * MiB;

__device__ __forceinline__ bf16x8 ld_frag_row(const MKLAS bf16_t* tile, int stride, int row0, int k0, int lane) {
    return *(const MKLAS bf16x8*)(tile + (row0 + (lane & 15)) * stride + k0 + 8 * (lane >> 4));
}
__device__ __forceinline__ bf16x8 ld_frag_tr(const MKLAS bf16_t* tile, int stride, int k0, int col0, int lane) {
    const int g = lane >> 4, q = (lane & 15) >> 2, pp = lane & 3;
    const MKLAS bf16_t* a = tile + (k0 + 8 * g + q) * stride + col0 + 4 * pp;
    const s16x4 lo = __builtin_amdgcn_ds_read_tr16_b64_v4i16((MKLAS s16x4*)a), hi = __builtin_amdgcn_ds_read_tr16_b64_v4i16((MKLAS s16x4*)(a + 4 * stride));
    return (bf16x8){lo[0], lo[1], lo[2], lo[3], hi[0], hi[1], hi[2], hi[3]};
}
__device__ __forceinline__ bf16x8 pack8(f32x4 a, f32x4 b) { u32x4 r; r.x = cvt_pk_bf16(a.x, a.y); r.y = cvt_pk_bf16(a.z, a.w); r.z = cvt_pk_bf16(b.x, b.y); r.w = cvt_pk_bf16(b.z, b.w); return __builtin_bit_cast(bf16x8, r); }
__device__ __forceinline__ float bflo(unsigned u) { return __uint_as_float(u << 16); }
__device__ __forceinline__ float bfhi(unsigned u) { return __uint_as_float(u & 0xffff0000u); }
__device__ __forceinline__ u32x4 scale_piece(u32x4 v, float s) { u32x4 r; r.x = cvt_pk_bf16(bflo(v.x) * s, bfhi(v.x) * s); r.y = cvt_pk_bf16(bflo(v.y) * s, bfhi(v.y) * s); r.z = cvt_pk_bf16(bflo(v.z) * s, bfhi(v.z) * s); r.w = cvt_pk_bf16(bflo(v.w) * s, bfhi(v.w) * s); return r; }

template <bool RET, int MODE>
__device__ __forceinline__ void scan_unit(const P& p, int l, int h, int c, int dir, MKLAS unsigned char* lds, bool zero_init = false) {
    constexpr int C = RET ? 64 : 32, NCH = 256 / C, NET = RET ? 2 : 1, DV = RET ? 256 : 128, QS = 136, VS = DV + 8, PS = C + 8, NTT = C / 16, NKS2 = C / 32;
    const int tid = tid_fresh(), lane = tid & 63, w = __builtin_amdgcn_readfirstlane(tid >> 6), r16 = lane & 15, quad = lane >> 4;
    MKLAS bf16_t* Qn = (MKLAS bf16_t*)lds; MKLAS bf16_t* Kn = Qn + C * QS; MKLAS bf16_t* Vn = Kn + C * QS; MKLAS bf16_t* Pm = Vn + C * VS;
    MKLAS float* TOT = (MKLAS float*)(Pm + C * PS); MKLAS float* E12 = TOT + 512; MKLAS float* RED = E12 + 256; MKLAS float* DQK = RED + 1024;
    const int e0 = 16 * NET * w, row0 = 256 * c, chain = dir * 4 + h;
    const bf16_t* Qg = RET ? WSP(bf16_t, WS_RQ) + h * 128 : WSP(bf16_t, WS_QH) + h * 128;
    const bf16_t* Kg = WSP(bf16_t, WS_RK) + h * 128;
    const bf16_t* Vg = RET ? WSP(bf16_t, WS_RV) + h * 256 : WSP(bf16_t, WS_VH) + h * 128;
    const float* LFg = WSP(float, WS_LF) + dir * 512 + h * 128;
    bf16_t* ST = RET ? WSP(bf16_t, WS_STR) + (((size_t)chain * 65 + c) << 15) : WSP(bf16_t, WS_STH) + (((size_t)chain * 65 + c) << 14);
    const float lg = RET ? WSP(float, WS_LGAM)[(l * 2 + dir) * 4 + h] : 0.f;
    if (RET && tid < 64) { DQK[2 * tid] = fexp((float)(tid + 1) * lg); DQK[2 * tid + 1] = fexp(-(float)(tid + 1) * lg); }
    const float e2s = RET ? fexp((float)C * lg) : 1.f;

    f32x4 Sacc[8][NET];
#pragma unroll
    for (int i = 0; i < 8; ++i)
#pragma unroll
        for (int n = 0; n < NET; ++n) {
            if (MODE == 0 || zero_init) Sacc[i][n] = (f32x4){0.f, 0.f, 0.f, 0.f};
            else { const u32x2 q = *(const u32x2*)(ST + (size_t)(e0 + 16 * n + r16) * 128 + 16 * i + 4 * quad); Sacc[i][n] = (f32x4){bflo(q.x), bfhi(q.x), bflo(q.y), bfhi(q.y)}; }
        }
    float btot = 0.f;
    float lfv[8]; unsigned short qv[8]; u32x4 hv = {0, 0, 0, 0};
    u32x4 qp[2], kp[2], vp[4];
    const int hd = tid & 127, hseg = tid >> 7;
#define TOKROW(pos) (row0 + (dir ? 255 - (pos) : (pos)))
#define LOAD_CHUNK(j) do { \
        if (!RET) { _Pragma("unroll") for (int ii = 0; ii < 8; ++ii) { const size_t rr = (size_t)TOKROW(C * (j) + 8 * hseg + ii); lfv[ii] = LFg[rr * 1024 + hd]; if (MODE != 0) qv[ii] = Qg[rr * 512 + hd]; } \
            { const size_t rr = (size_t)TOKROW(C * (j) + (tid >> 4)); hv = *(const u32x4*)(Vg + rr * 512 + 8 * (tid & 15)); } } \
        else { _Pragma("unroll") for (int m = 0; m < 2; ++m) { const int pc = tid + 512 * m; const size_t rr = (size_t)TOKROW(C * (j) + (pc >> 4)); \
                if (MODE != 0) qp[m] = *(const u32x4*)(Qg + rr * 512 + 8 * (pc & 15)); kp[m] = *(const u32x4*)(Kg + rr * 512 + 8 * (pc & 15)); } \
            _Pragma("unroll") for (int m = 0; m < 4; ++m) { const int pc = tid + 512 * m; const size_t rr = (size_t)TOKROW(C * (j) + (pc >> 5)); vp[m] = *(const u32x4*)(Vg + rr * 1024 + 8 * (pc & 31)); } } \
    } while (0)
    LOAD_CHUNK(0);
    if (MODE != 0) { for (int i = tid; i < C * PS / 8; i += NT) ((MKLAS u32x4*)Pm)[i] = (u32x4){0u, 0u, 0u, 0u}; }
    __syncthreads();
    for (int j = 0; j < NCH; ++j) {
        if (!RET) {
            float pl[8]; float run = 0.f;
#pragma unroll
            for (int ii = 0; ii < 8; ++ii) { run += lfv[ii]; pl[ii] = run; }
            TOT[hseg * 128 + hd] = run;
            __syncthreads();
            const float t0 = TOT[hd], t1 = TOT[128 + hd], t2 = TOT[256 + hd], t3 = TOT[384 + hd];
            const float off = hseg == 0 ? 0.f : (hseg == 1 ? t0 : (hseg == 2 ? t0 + t1 : t0 + t1 + t2));
            const float rref = t0 + t1, blast = (t0 + t1) + (t2 + t3);
#pragma unroll
            for (int ii = 0; ii < 8; ++ii) { const int pos = 8 * hseg + ii; const float b = off + pl[ii];
                const float kk = 1.f - fexp(lfv[ii]);
                Kn[pos * QS + hd] = f2bf(kk * fexp(fminf(rref - b, 60.f)));
                if (MODE != 0) Qn[pos * QS + hd] = f2bf(bf2f(qv[ii]) * fexp(fminf(b - rref, 60.f))); }
            if (hseg == 0) { E12[hd] = fexp(rref); E12[128 + hd] = fexp(blast - rref); btot += blast; }
            *(MKLAS u32x4*)(Vn + (tid >> 4) * VS + 8 * (tid & 15)) = hv;
        } else {
#pragma unroll
            for (int m = 0; m < 2; ++m) { const int pc = tid + 512 * m, pos = pc >> 4;
                *(MKLAS u32x4*)(Kn + pos * QS + 8 * (pc & 15)) = scale_piece(kp[m], DQK[2 * pos + 1]);
                if (MODE != 0) *(MKLAS u32x4*)(Qn + pos * QS + 8 * (pc & 15)) = scale_piece(qp[m], DQK[2 * pos]); }
#pragma unroll
            for (int m = 0; m < 4; ++m) { const int pc = tid + 512 * m; *(MKLAS u32x4*)(Vn + (pc >> 5) * VS + 8 * (pc & 31)) = vp[m]; }
        }
        if (j + 1 < NCH) LOAD_CHUNK(j + 1);
        __syncthreads();
        if (MODE != 0) {
            constexpr int NTILE = NTT * (NTT + 1) / 2;
#pragma unroll
            for (int rep = 0; rep < (NTILE + 7) / 8; ++rep) {
                const int q = w + 8 * rep;
                if (q < NTILE) {
                    int tt = 0, st = q;
#pragma unroll
                    for (int z = 1; z < NTT; ++z) if (q >= z * (z + 1) / 2) { tt = z; st = q - z * (z + 1) / 2; }
                    f32x4 sc = {0.f, 0.f, 0.f, 0.f};
#pragma unroll
                    for (int ks = 0; ks < 4; ++ks) sc = MFMA16(ld_frag_row(Qn, QS, 16 * tt, 32 * ks, lane), ld_frag_row(Kn, QS, 16 * st, 32 * ks, lane), sc);
#pragma unroll
                    for (int jj = 0; jj < 4; ++jj) { const bool keep = (st < tt) || (r16 <= 4 * quad + jj); Pm[(16 * tt + 4 * quad + jj) * PS + 16 * st + r16] = f2bf(keep ? sc[jj] : 0.f); }
                }
            }
            __syncthreads();
        }
        bf16x8 Vf[NKS2][NET];
#pragma unroll
        for (int k2 = 0; k2 < NKS2; ++k2)
#pragma unroll
            for (int n = 0; n < NET; ++n) Vf[k2][n] = ld_frag_tr(Vn, VS, 32 * k2, e0 + 16 * n, lane);
        if (!RET) {
#pragma unroll
            for (int i = 0; i < 8; ++i) { const f32x4 e1 = *(const MKLAS f32x4*)(E12 + 16 * i + 4 * quad);
#pragma unroll
                for (int n = 0; n < NET; ++n) Sacc[i][n] = Sacc[i][n] * e1; }
        }
        f32x4 oacc[NTT][NET];
        if (MODE != 0) {
#pragma unroll
            for (int tt = 0; tt < NTT; ++tt)
#pragma unroll
                for (int n = 0; n < NET; ++n) oacc[tt][n] = (f32x4){0.f, 0.f, 0.f, 0.f};
#pragma unroll
            for (int ks = 0; ks < 4; ++ks) {
                bf16x8 Bf[NET];
#pragma unroll
                for (int n = 0; n < NET; ++n) Bf[n] = pack8(Sacc[2 * ks][n], Sacc[2 * ks + 1][n]);
#pragma unroll
                for (int tt = 0; tt < NTT; ++tt) {
                    const MKLAS bf16_t* qa = Qn + (16 * tt + r16) * QS + 32 * ks + 4 * quad;
                    const s16x4 a0 = *(const MKLAS s16x4*)qa, a1 = *(const MKLAS s16x4*)(qa + 16);
                    const bf16x8 Af = (bf16x8){a0[0], a0[1], a0[2], a0[3], a1[0], a1[1], a1[2], a1[3]};
#pragma unroll
                    for (int n = 0; n < NET; ++n) oacc[tt][n] = MFMA16(Bf[n], Af, oacc[tt][n]);
                }
            }
#pragma unroll
            for (int k2 = 0; k2 < NKS2; ++k2)
#pragma unroll
                for (int tt = 0; tt < NTT; ++tt) {
                    if (32 * k2 > 16 * tt + 15) continue;
                    const bf16x8 Af = ld_frag_row(Pm, PS, 16 * tt, 32 * k2, lane);
#pragma unroll
                    for (int n = 0; n < NET; ++n) oacc[tt][n] = MFMA16(Vf[k2][n], Af, oacc[tt][n]);
                }
        }
#pragma unroll
        for (int i = 0; i < 8; ++i)
#pragma unroll
            for (int k2 = 0; k2 < NKS2; ++k2) { const bf16x8 Af = ld_frag_tr(Kn, QS, 32 * k2, 16 * i, lane);
#pragma unroll
                for (int n = 0; n < NET; ++n) Sacc[i][n] = MFMA16(Af, Vf[k2][n], Sacc[i][n]); }
#pragma unroll
        for (int i = 0; i < 8; ++i) { f32x4 e2; if (!RET) e2 = *(const MKLAS f32x4*)(E12 + 128 + 16 * i + 4 * quad); else e2 = (f32x4){e2s, e2s, e2s, e2s};
#pragma unroll
            for (int n = 0; n < NET; ++n) Sacc[i][n] = Sacc[i][n] * e2; }
        if (MODE != 0) {
            bf16_t* Og = (RET ? WSP(bf16_t, WS_ORT) + h * 256 : WSP(bf16_t, WS_OHG) + h * 128) + e0 + 4 * quad;
            constexpr int OS = RET ? 1024 : 512;
            if (MODE == 1) {
#pragma unroll
                for (int tt = 0; tt < NTT; ++tt) { const size_t rr = (size_t)TOKROW(C * j + 16 * tt + r16);
#pragma unroll
                    for (int n = 0; n < NET; ++n) st_bf4(Og + rr * OS + 16 * n, oacc[tt][n]); }
            } else {
#pragma unroll
                for (int tt = 0; tt < NTT; ++tt) { float s1 = 0.f, s2 = 0.f; const size_t rb = (size_t)TOKROW(C * j + 16 * tt + r16);
#pragma unroll
                    for (int n = 0; n < NET; ++n) { const u32x2 obv = *(const u32x2*)(Og + rb * OS + 16 * n); const f32x4 v = oacc[tt][n] + (f32x4){bflo(obv.x), bfhi(obv.x), bflo(obv.y), bfhi(obv.y)}; oacc[tt][n] = v;
                        s1 += (v.x + v.y) + (v.z + v.w); s2 += (v.x * v.x + v.y * v.y) + (v.z * v.z + v.w * v.w); }
                    s1 += __shfl_xor(s1, 16); s2 += __shfl_xor(s2, 16); s1 += __shfl_xor(s1, 32); s2 += __shfl_xor(s2, 32);
                    if (quad == 0) { RED[(w * 64 + 16 * tt + r16) * 2] = s1; RED[(w * 64 + 16 * tt + r16) * 2 + 1] = s2; } }
                __syncthreads();
                const float* nw = (RET ? p.in[12] + l * 1024 + h * 256 : p.in[10] + l * 512 + h * 128) + e0 + 4 * quad;
#pragma unroll
                for (int tt = 0; tt < NTT; ++tt) { const int tpos = 16 * tt + r16; const size_t rr = (size_t)TOKROW(C * j + tpos); float s1 = 0.f, s2 = 0.f;
#pragma unroll
                    for (int ww = 0; ww < 8; ++ww) { const f32x2 q = *(const MKLAS f32x2*)(RED + (ww * 64 + tpos) * 2); s1 += q.x; s2 += q.y; }
                    const float mean = RET ? s1 * (1.f / 256.f) : 0.f;
                    const float var = RET ? fmaxf(s2 * (1.f / 256.f) - mean * mean, 0.f) : s2 * (1.f / 128.f);
                    const float rinv = 1.0f / sqrtf(var + EPS);
#pragma unroll
                    for (int n = 0; n < NET; ++n) st_bf4(Og + rr * OS + 16 * n, (oacc[tt][n] - mean) * rinv * *(const f32x4*)(nw + 16 * n)); }
            }
        }
        if (RET) __syncthreads();
    }
    if (MODE == 0) {
#pragma unroll
        for (int i = 0; i < 8; ++i)
#pragma unroll
            for (int n = 0; n < NET; ++n) { u32x2 q; q.x = cvt_pk_bf16(Sacc[i][n].x, Sacc[i][n].y); q.y = cvt_pk_bf16(Sacc[i][n].z, Sacc[i][n].w);
                *(u32x2*)(ST + (size_t)(e0 + 16 * n + r16) * 128 + 16 * i + 4 * quad) = q; }
        if (!RET && hseg == 0) WSP(float, WS_ATOT)[((size_t)chain * 65 + c) * 128 + hd] = fexp(btot);
    }
#undef LOAD_CHUNK
#undef TOKROW
}

__device__ __forceinline__ int next_unit(unsigned* ctr, volatile MKLAS int* slot) {
    __syncthreads();
    if (threadIdx.x == 0) *slot = (int)__hip_atomic_fetch_add(ctr, 1u, __ATOMIC_RELAXED, __HIP_MEMORY_SCOPE_AGENT);
    __syncthreads();
    return *slot;
}
__device__ __forceinline__ void ph_scan_pass1(const P& p, int l, MKLAS unsigned char* lds, unsigned* ctr, volatile MKLAS int* slot) {
    const int nctx = (l == DEPTH - 1) ? 0 : 8;
    for (;;) { const int u0 = next_unit(ctr, slot); if (u0 >= 1040 + nctx) break;
        if (u0 < nctx) { const int h = u0 & 3;
            if (u0 < 4) { scan_unit<true, 1>(p, l, h, 0, 1, lds, true); __syncthreads(); scan_unit<true, 2>(p, l, h, 0, 0, lds, true); }
            else { scan_unit<false, 1>(p, l, h, 0, 1, lds, true); __syncthreads(); scan_unit<false, 2>(p, l, h, 0, 0, lds, true); }
            continue; }
        const int u = u0 - nctx;
        const bool ret = u < 520; const int v = ret ? u : u - 520, dir = v / 260, rem = v % 260, h = rem / 65, c = rem % 65;
        if (ret) scan_unit<true, 0>(p, l, h, c, dir, lds); else scan_unit<false, 0>(p, l, h, c, dir, lds); }
}
__device__ __forceinline__ void ph_scan_pass3(const P& p, int l, MKLAS unsigned char* lds) {
    for (int u = blockIdx.x; u < 512; u += gridDim.x) {
        const bool ret = u < 256; const int v = ret ? u : u - 256, h = v >> 6, c = (v & 63) + 1;
        __syncthreads();
        if (ret) { scan_unit<true, 1>(p, l, h, c, 1, lds); __syncthreads(); scan_unit<true, 2>(p, l, h, c, 0, lds); }
        else { scan_unit<false, 1>(p, l, h, c, 1, lds); __syncthreads(); scan_unit<false, 2>(p, l, h, c, 0, lds); } }
}
__device__ __forceinline__ void ph_scan_pass2(const P& p, int l) {
    const int tid = tid_fresh();
    const float* LG = WSP(float, WS_LGAM); const float* AT = WSP(float, WS_ATOT);
    for (int item = blockIdx.x * NT + tid; item < 32768 + 65536; item += gridDim.x * NT) {
        const bool ret = item >= 32768; const int it = ret ? item - 32768 : item, per = ret ? 8192 : 4096, chain = it / per, q4 = it % per, dir = chain >> 2, h = chain & 3, dd = (q4 * 4) & 127;
        bf16_t* base = (ret ? WSP(bf16_t, WS_STR) : WSP(bf16_t, WS_STH)) + (size_t)chain * 65 * (per * 4) + (size_t)q4 * 4;
        const float ar = ret ? fexp(256.f * LG[(l * 2 + dir) * 4 + h]) : 0.f;
        f32x4 S = {0.f, 0.f, 0.f, 0.f};
        for (int b0 = 0; b0 < 65; b0 += 13) {
            u32x2 U[13]; f32x4 A[13];
#pragma unroll
            for (int s = 0; s < 13; ++s) { const int step = b0 + s, c = dir == 0 ? step : (step == 0 ? 0 : 65 - step);
                U[s] = *(const u32x2*)(base + (size_t)c * (per * 4));
                A[s] = ret ? (f32x4){ar, ar, ar, ar} : *(const f32x4*)(AT + ((size_t)chain * 65 + c) * 128 + dd); }
#pragma unroll
            for (int s = 0; s < 13; ++s) { const int step = b0 + s, c = dir == 0 ? step : (step == 0 ? 0 : 65 - step);
                u32x2 o; o.x = cvt_pk_bf16(S.x, S.y); o.y = cvt_pk_bf16(S.z, S.w); *(u32x2*)(base + (size_t)c * (per * 4)) = o;
                S = A[s] * S + (f32x4){bflo(U[s].x), bfhi(U[s].x), bflo(U[s].y), bfhi(U[s].y)}; }
        }
    }
}

__device__ __forceinline__ void ph_router(const P& p, int l, MKLAS unsigned char* lds, unsigned* ecnt) {
    const int tid = tid_fresh(), lane = tid & 63, w = __builtin_amdgcn_readfirstlane(tid >> 6), r16 = lane & 15, g = lane >> 4;
    MKLAS float* ssum = (MKLAS float*)lds;
    MKLAS float* plog = ssum + 128;
    MKLAS float* lg = plog + 8 * 16 * 52;
    const float* MOD = WSP(float, WS_MOD); bf16_t* H = WSP(bf16_t, WS_H);
    int* AE = WSP(int, WS_AE); float* AW = WSP(float, WS_AW); int* APOS = WSP(int, WS_APOS); int* TOK = WSP(int, WS_TOK);
    const int cb = 128 * w + 4 * g;
    const float* nw = p.in[7] + l * D + cb;
    const float* WRT = WSP(float, WS_WRT) + (size_t)l * 48 * 1024 + (size_t)r16 * 1024 + cb;
    const float *bg = p.in[17] + l * 4, *be = p.in[19] + l * NE;
    const int r_lo = (l == DEPTH - 1) ? LC : 0, ntile = (L - r_lo) / 16;
    for (int t = blockIdx.x; t < ntile; t += gridDim.x) {
        const int r = r_lo + 16 * t + r16;
        const float* xr = xrow_st(p, r) + cb;
        const float* mod = MOD + (l * 2 + (r < LC ? 1 : 0)) * 6144 + cb;
        f32x4 x[8]; float ss = 0.f;
#pragma unroll
        for (int m = 0; m < 8; ++m) { x[m] = *(const f32x4*)(xr + 16 * m); ss += (x[m].x * x[m].x + x[m].y * x[m].y) + (x[m].z * x[m].z + x[m].w * x[m].w); }
        ss += __shfl_xor(ss, 16); ss += __shfl_xor(ss, 32);
        if (g == 0) ssum[w * 16 + r16] = ss;
        __syncthreads();
        float tot = 0.f;
#pragma unroll
        for (int ww = 0; ww < 8; ++ww) tot += ssum[ww * 16 + r16];
        const float rinv = 1.0f / sqrtf(tot * (1.f / D) + EPS);
        f32x4 acc[3];
#pragma unroll
        for (int nt = 0; nt < 3; ++nt) acc[nt] = (f32x4){0.f, 0.f, 0.f, 0.f};
        bf16_t* ho = H + (size_t)r * D + cb;
#pragma unroll
        for (int m = 0; m < 8; ++m) {
            const f32x4 wv = *(const f32x4*)(nw + 16 * m), sh = *(const f32x4*)(mod + 3 * 1024 + 16 * m), sc = *(const f32x4*)(mod + 4 * 1024 + 16 * m);
            const f32x4 h = x[m] * rinv * wv * (sc + 1.0f) + sh;
            st_bf4(ho + 16 * m, h);
#pragma unroll
            for (int nt = 0; nt < 3; ++nt) { const f32x4 b = *(const f32x4*)(WRT + (size_t)nt * 16 * 1024 + 16 * m);
#pragma unroll
                for (int j = 0; j < 4; ++j) acc[nt] = __builtin_amdgcn_mfma_f32_16x16x4f32(h[j], b[j], acc[nt], 0, 0, 0); }
        }
#pragma unroll
        for (int nt = 0; nt < 3; ++nt)
#pragma unroll
            for (int j = 0; j < 4; ++j) plog[(w * 16 + 4 * g + j) * 52 + 16 * nt + r16] = acc[nt][j];
        __syncthreads();
        { const int row = tid >> 5, col = tid & 31; float a = 0.f;
#pragma unroll
            for (int ww = 0; ww < 8; ++ww) a += plog[(ww * 16 + row) * 52 + col];
            lg[row * 52 + col] = a;
            if (tid < 64) { const int row2 = tid >> 2, col2 = 32 + (tid & 3); float a2 = 0.f;
#pragma unroll
                for (int ww = 0; ww < 8; ++ww) a2 += plog[(ww * 16 + row2) * 52 + col2];
                lg[row2 * 52 + col2] = a2; } }
        __syncthreads();
        if (tid < 16) {
            const MKLAS float* my = lg + tid * 52;
            float gl[4];
#pragma unroll
            for (int q = 0; q < 4; ++q) gl[q] = my[32 + q] + bg[q];
            int grp = 0; float gm = gl[0];
#pragma unroll
            for (int q = 1; q < 4; ++q) if (gl[q] > gm) { gm = gl[q]; grp = q; }
            float gs = 0.f;
#pragma unroll
            for (int q = 0; q < 4; ++q) gs += expf(gl[q] - gm);
            const float gval = 1.0f / gs;
            float el[8];
#pragma unroll
            for (int j = 0; j < 8; ++j) el[j] = my[grp * 8 + j] + be[grp * 8 + j];
            int i1 = 0; float v1 = el[0];
#pragma unroll
            for (int j = 1; j < 8; ++j) if (el[j] > v1) { v1 = el[j]; i1 = j; }
            int i2 = -1; float v2 = -3.0e38f;
#pragma unroll
            for (int j = 0; j < 8; ++j) if (j != i1 && el[j] > v2) { v2 = el[j]; i2 = j; }
            const float e2 = expf(v2 - v1), w1 = 1.0f / (1.0f + e2), w2 = e2 / (1.0f + e2);
            const int ea0 = grp * 8 + i1, ea1 = grp * 8 + i2, rr = r_lo + 16 * t + tid;
            AE[2 * rr] = ea0; AE[2 * rr + 1] = ea1; AW[2 * rr] = gval * w1; AW[2 * rr + 1] = gval * w2;
            const int p0 = (int)__hip_atomic_fetch_add(ecnt + 16 * ea0, 1u, __ATOMIC_RELAXED, __HIP_MEMORY_SCOPE_AGENT);
            const int p1 = (int)__hip_atomic_fetch_add(ecnt + 16 * ea1, 1u, __ATOMIC_RELAXED, __HIP_MEMORY_SCOPE_AGENT);
            APOS[2 * rr] = p0; APOS[2 * rr + 1] = p1; TOK[(size_t)ea0 * L + p0] = rr; TOK[(size_t)ea1 * L + p1] = rr;
        }
    }
}
constexpr int XG_ROWS = 41472;
constexpr size_t WS_WGU = WS_OF, WS_WD = WS_OF + 32 * MiB;
constexpr size_t WS_XG = WS_QH, WS_ACT = WS_XG + (size_t)XG_ROWS * 2048, WS_YA = 160 * MiB;
static_assert(WS_ACT + (size_t)XG_ROWS * 512 <= WS_YA && WS_YA + (size_t)XG_ROWS * 2048 <= WS_OF, "MoE overlays");
constexpr int EXPERT_ITEMS = 3 * 512;
__device__ __forceinline__ void expert_item(const P& p, int l, int it, MKLAS float* tile) {
    const int which = it >> 9, r = it & 511;
    if (which < 2) { const int e = r >> 4, kb = r & 15;
        const float* W = p.in[20 + which] + ((size_t)l * NE + e) * D * DE; bf16_t* WT = WSP(bf16_t, WS_WGU) + (size_t)e * 512 * D;
#pragma unroll
        for (int j = 0; j < 4; ++j) tr_load(W, DE, kb * 64, j * 64, tile + j * TRT);
        __syncthreads();
#pragma unroll
        for (int j = 0; j < 4; ++j) { const int n0 = j * 64; tr_store(WT, D, kb * 64, (n0 >> 7) * 256 + which * 128 + (n0 & 127), tile + j * TRT); }
        __syncthreads(); }
    else { const int e = r >> 4, kb = (r >> 2) & 3, ng = r & 3;
        const float* W = p.in[22] + ((size_t)l * NE + e) * DE * D; bf16_t* WT = WSP(bf16_t, WS_WD) + (size_t)e * D * DE;
#pragma unroll
        for (int j = 0; j < 4; ++j) tr_load(W, D, kb * 64, (ng * 4 + j) * 64, tile + j * TRT);
        __syncthreads();
#pragma unroll
        for (int j = 0; j < 4; ++j) tr_store(WT, DE, kb * 64, (ng * 4 + j) * 64, tile + j * TRT);
        __syncthreads(); }
}
template <bool EXPERTS> __device__ __forceinline__ void fill_convert(const P& p, int l, MKLAS unsigned char* lds, unsigned* ctr, volatile MKLAS int* slot) {
    for (;;) { const int it = next_unit(ctr, slot); if (it >= (EXPERTS ? EXPERT_ITEMS : MIXER_ITEMS)) break;
        if (EXPERTS) expert_item(p, l, it, (MKLAS float*)lds); else mixer_item(p, l, it, (MKLAS float*)lds); }
}
constexpr int MOE_TAB = LDS_CTL_OFF + 64;
__device__ __forceinline__ void moe_tables(const P& p, int l, MKLAS unsigned char* lds, bool publish) {
    MKLAS int* off = (MKLAS int*)(lds + MOE_TAB); MKLAS int* cnt = off + 64; MKLAS int* te = off + 96;
    const unsigned* ecnt = (const unsigned*)(p.ws + WS_CTL) + CW_ECNT + l * NE * 16;
    const int tid = tid_fresh();
    __syncthreads();
    if (tid == 0) { int o = 0; for (int e = 0; e < NE; ++e) { const int c = (int)__hip_atomic_load(ecnt + 16 * e, __ATOMIC_RELAXED, __HIP_MEMORY_SCOPE_AGENT); off[e] = o; cnt[e] = c; o += (c + 255) & ~255; } off[NE] = o; off[NE + 1] = o >> 8; }
    __syncthreads();
    const int nt = off[NE + 1];
    for (int t = tid; t < nt; t += NT) { int e = 0; for (int k = 1; k < NE; ++k) if (t * 256 >= off[k]) e = k; te[t] = e; }
    __syncthreads();
    if (publish && blockIdx.x == 0) { int* TE = WSP(int, WS_TILEE); if (tid == 0) TE[255] = nt; for (int t = tid; t < nt; t += NT) TE[t] = te[t]; }
}
struct MoeOrder { static constexpr bool GATHER = false; const int* tile_e; int ntiles, nN, G, c;
    __device__ __forceinline__ bool next(int i, pg8::Unit& u) const { const long Lx = (long)i * G + c; if (Lx >= (long)ntiles * nN) return false; u.pm = (int)(Lx / nN); u.pn = (int)(Lx % nN); u.be = tile_e[u.pm]; return true; }
    __device__ __forceinline__ void a_ready(const pg8::Unit&) const {}
    __device__ __forceinline__ void done(const pg8::Unit&) const {} };
struct MoeGatherOrder { static constexpr bool GATHER = true; const MKLAS int* off; const MKLAS int* cnt; const MKLAS int* te; const int* tok; int ntiles, nN, G, c;
    __device__ __forceinline__ bool next(int i, pg8::Unit& u) const { const long Lx = (long)i * G + c; if (Lx >= (long)ntiles * nN) return false; u.pm = (int)(Lx / nN); u.pn = (int)(Lx % nN); u.be = te[u.pm]; return true; }
    __device__ __forceinline__ unsigned row_byte_off(const pg8::Unit& u, int r) const { const int pos = 256 * u.pm - off[u.be] + r; const int t = pos < cnt[u.be] ? tok[(size_t)u.be * L + pos] : 0; return (unsigned)t * (unsigned)(D * 2); }
    __device__ __forceinline__ void a_ready(const pg8::Unit&) const {}
    __device__ __forceinline__ void done(const pg8::Unit&) const {} };
struct EpiGU { static constexpr bool PERM = true, AFTER_DRAIN = false; bf16_t* ACT;
    __device__ __forceinline__ void operator()(const f32x4 (&acc)[2][2][4][2], const pg8::Unit& u, int wr, int wc, int fr, int fq) const {
        const int row0 = u.pm * 256 + wr * 64 + fr, col0 = u.pn * 128 + wc * 32 + 8 * fq;
#pragma unroll
        for (int ai = 0; ai < 2; ++ai)
#pragma unroll
            for (int m = 0; m < 4; ++m) st_bf8(ACT + (size_t)(row0 + ai * 128 + m * 16) * DE + col0, silu4(acc[ai][0][m][0]) * acc[ai][1][m][0], silu4(acc[ai][0][m][1]) * acc[ai][1][m][1]);
    } };
struct FnYA { bf16_t* YA;
    static constexpr bool HAS_LOAD = false; typedef NoRegs R;
    __device__ __forceinline__ void apply8(int row, int col, f32x4 v0, f32x4 v1, const R&, const pg8::Unit&) const { st_bf8(YA + (size_t)row * D + col, v0, v1); } };
__device__ __forceinline__ void ph_moe_combine(const P& p, int l, MKLAS unsigned char* lds) {
    moe_tables(p, l, lds, false);
    const MKLAS int* off = (const MKLAS int*)(lds + MOE_TAB);
    const int tid_ = tid_fresh(), lane = tid_ & 63, wave = tid_ >> 6;
    const float* MOD = WSP(float, WS_MOD); const bf16_t* YA = WSP(bf16_t, WS_YA); bf16_t* H = WSP(bf16_t, WS_H);
    const int* AE = WSP(int, WS_AE); const int* APOS = WSP(int, WS_APOS); const float* AW = WSP(float, WS_AW);
    const bool last = (l == DEPTH - 1);
    const float* nw = last ? p.in[23] : p.in[6] + (l + 1) * D;
    for (int r = (last ? LC : 0) + blockIdx.x * NW + wave; r < L; r += gridDim.x * NW) {
        const int isc = r < LC ? 1 : 0;
        const float* g2 = MOD + (l * 2 + isc) * 6144 + 5 * 1024;
        float* xo = xrow_st(p, r);
        const int sa = off[AE[2 * r]] + APOS[2 * r], sb = off[AE[2 * r + 1]] + APOS[2 * r + 1]; const float wa = AW[2 * r], wb = AW[2 * r + 1];
        const u32x2* ya = (const u32x2*)(YA + (size_t)sa * D) + lane; const u32x2* yb = (const u32x2*)(YA + (size_t)sb * D) + lane;
        f32x4 v[4]; float ss = 0.f;
#pragma unroll
        for (int j = 0; j < 4; ++j) { const int c = 4 * (lane + 64 * j); const u32x2 a = ya[64 * j], b = yb[64 * j];
            const f32x4 y = (f32x4){wa * bflo(a.x) + wb * bflo(b.x), wa * bfhi(a.x) + wb * bfhi(b.x), wa * bflo(a.y) + wb * bflo(b.y), wa * bfhi(a.y) + wb * bfhi(b.y)};
            v[j] = *(const f32x4*)(xo + c) + *(const f32x4*)(g2 + c) * y;
            ss += (v[j].x * v[j].x + v[j].y * v[j].y) + (v[j].z * v[j].z + v[j].w * v[j].w); }
        const float rinv = 1.0f / sqrtf(wave_sum(ss) * (1.f / D) + EPS);
        if (last) {
#pragma unroll
            for (int j = 0; j < 4; ++j) { const int c = 4 * (lane + 64 * j); *(f32x4*)(xo + c) = v[j] * rinv * *(const f32x4*)(nw + c); }
        } else {
            const float* mod = MOD + ((l + 1) * 2 + isc) * 6144;
            u32x2* o = (u32x2*)(H + (size_t)r * D) + lane;
#pragma unroll
            for (int j = 0; j < 4; ++j) { const int c = 4 * (lane + 64 * j); *(f32x4*)(xo + c) = v[j];
                const f32x4 hh = v[j] * rinv * *(const f32x4*)(nw + c) * (*(const f32x4*)(mod + 1024 + c) + 1.0f) + *(const f32x4*)(mod + c);
                u32x2 q; q.x = cvt_pk_bf16(hh.x, hh.y); q.y = cvt_pk_bf16(hh.z, hh.w); o[64 * j] = q; }
        }
    }
}

constexpr int LDS_BYTES = 147456, LDS_CTL = LDS_CTL_OFF;
constexpr int NPH_LAYER = 12, NPH = 1 + DEPTH * NPH_LAYER;

__device__ __forceinline__ void ph_prologue(const P& p, MKLAS unsigned char* lds) {
    const int tid = tid_fresh(), b = blockIdx.x, G = gridDim.x;
    MKLAS float* s0 = (MKLAS float*)lds;
    MKLAS float* red = s0 + 2048;
    for (int i = tid; i < 1024; i += NT) { s0[i] = siluf(p.in[1][i]); s0[1024 + i] = siluf(p.in[3][i]); }
    __syncthreads();
    float* MOD = WSP(float, WS_MOD);
    for (int u = b; u < DEPTH * 96; u += G) {
        const int l = u / 96, n0 = (u % 96) * 64, c = tid & 63, ks = tid >> 6;
        const float* W = p.in[4] + (size_t)l * 1024 * 6144 + n0 + c;
        float a0 = 0.f, a1 = 0.f;
#pragma unroll 8
        for (int i = 0; i < 128; ++i) { const int k = ks * 128 + i; const float w = W[(size_t)k * 6144]; a0 += s0[k] * w; a1 += s0[1024 + k] * w; }
        red[(ks * 64 + c) * 2] = a0; red[(ks * 64 + c) * 2 + 1] = a1;
        __syncthreads();
        if (tid < 128) { const int cc = tid & 63, w = tid >> 6; float s = 0.f;
#pragma unroll
            for (int k2 = 0; k2 < 8; ++k2) s += red[(k2 * 64 + cc) * 2 + w];
            MOD[(l * 2 + w) * 6144 + n0 + cc] = s + p.in[5][l * 6144 + n0 + cc]; }
        __syncthreads();
    }
    if (b == G - 1) {
        float* LB = WSP(float, WS_LB);
        for (int idx = tid; idx < 2 * 512; idx += NT) { const int dir = idx >> 9, ch = idx & 511;
            float x[DEPTH], m = -3.0e38f;
#pragma unroll
            for (int l = 0; l < DEPTH; ++l) { x[l] = p.in[9][(dir * DEPTH + l) * 512 + ch]; m = fmaxf(m, x[l]); }
            float s = 0.f;
#pragma unroll
            for (int l = 0; l < DEPTH; ++l) { x[l] = expf(x[l] - m); s += x[l]; }
            float cum = 0.f; const float p0 = x[0] / s;
#pragma unroll
            for (int l = 0; l < DEPTH; ++l) { cum += x[l] / s; LB[(dir * DEPTH + l) * 512 + ch] = fminf(fmaxf(cum - p0, 0.f), 1.0f - 1e-6f); } }
    }
    if (b == (G > 1 ? G - 2 : 0)) {
        float* RT = WSP(float, WS_ROPE);
        for (int idx = tid; idx < 256 * 32; idx += NT) { const int pos = idx >> 5, i = idx & 31;
            double bp = 1.0; for (int q = 0; q < i; ++q) bp *= 0.7498942093324559;
            const float inv = (float)bp; const float ang = (float)pos * inv;
            const double a = (double)ang, n = rint(a * 0.15915494309189535), r = a - n * 6.283185307179586, r2 = r * r;
            double ts = r, tc = 1.0, sn = r, cs = 1.0;
            for (int k = 1; k <= 14; ++k) { tc *= -r2 / (double)((2 * k - 1) * (2 * k)); cs += tc; ts *= -r2 / (double)((2 * k) * (2 * k + 1)); sn += ts; }
            RT[idx * 2] = (float)cs; RT[idx * 2 + 1] = (float)sn; }
    }
    if (b == (G > 2 ? G - 3 : 0)) {
        float* LG = WSP(float, WS_LGAM);
        if (tid < DEPTH * 2 * 4) LG[tid] = -log1pf(expf(-p.in[11][tid]));
    }
    { float* WRT = WSP(float, WS_WRT);
        for (int idx = b * NT + tid; idx < DEPTH * 48 * 1024; idx += G * NT) { const int l = idx / (48 * 1024), n = (idx >> 10) % 48, k = idx & 1023;
            WRT[idx] = n < 32 ? p.in[18][((size_t)l * D + k) * NE + n] : (n < 36 ? p.in[16][((size_t)l * D + k) * 4 + (n - 32)] : 0.f); } }
    fill_convert<false>(p, 0, lds, (unsigned*)(p.ws + WS_CTL) + CW_CNT + 64 * 12, (volatile MKLAS int*)(lds + LDS_CTL + 8));
}


template <class F> __device__ __forceinline__ void ctx_gemm(MKLAS unsigned char* lds, const bf16_t* A, const bf16_t* Bt, int N, int K, const F& f) {
    const int tid = tid_fresh(), lane = tid & 63, w = __builtin_amdgcn_readfirstlane(tid >> 6), r16 = lane & 15, g = lane >> 4;
    const int br = w & 1, bc = (w >> 1) & 1, kh = w >> 2;
    MKLAS f32x4* red = (MKLAS f32x4*)lds;
    const int nitems = 4 * (N / 64), kspan = K / 2;
    for (int it = blockIdx.x; it < nitems; it += gridDim.x) {
        const int ir = it & 3, ic = it >> 2;
        const bf16_t* ap = A + (size_t)(64 * ir + 32 * br + r16) * K + kh * kspan + 8 * g;
        const bf16_t* bp = Bt + (size_t)(64 * ic + 32 * bc + r16) * K + kh * kspan + 8 * g;
        f32x4 acc[2][2];
#pragma unroll
        for (int i = 0; i < 2; ++i)
#pragma unroll
            for (int jn = 0; jn < 2; ++jn) acc[i][jn] = (f32x4){0.f, 0.f, 0.f, 0.f};
#pragma unroll 8
        for (int ks = 0; ks < kspan / 32; ++ks) {
            const bf16x8 a0 = *(const bf16x8*)(ap + 32 * ks), a1 = *(const bf16x8*)(ap + (size_t)16 * K + 32 * ks);
            const bf16x8 b0 = *(const bf16x8*)(bp + 32 * ks), b1 = *(const bf16x8*)(bp + (size_t)16 * K + 32 * ks);
            acc[0][0] = MFMA16(b0, a0, acc[0][0]); acc[0][1] = MFMA16(b1, a0, acc[0][1]); acc[1][0] = MFMA16(b0, a1, acc[1][0]); acc[1][1] = MFMA16(b1, a1, acc[1][1]);
        }
        if (kh) {
#pragma unroll
            for (int i = 0; i < 2; ++i)
#pragma unroll
                for (int jn = 0; jn < 2; ++jn) red[((w - 4) * 4 + i * 2 + jn) * 64 + lane] = acc[i][jn];
        }
        __syncthreads();
        if (!kh) { pg8::Unit u; u.pm = 0; u.pn = (64 * ic) >> 8; u.be = 0;
#pragma unroll
            for (int i = 0; i < 2; ++i)
#pragma unroll
                for (int jn = 0; jn < 2; ++jn) f(64 * ir + 32 * br + 16 * i + r16, 64 * ic + 32 * bc + 16 * jn + 4 * g, acc[i][jn] + red[(w * 4 + i * 2 + jn) * 64 + lane], u); }
        __syncthreads();
    }
}
struct LatentOrder : pg8::StaticOrder {
    __device__ __forceinline__ bool next(int i, pg8::Unit& u) const { if (!pg8::StaticOrder::next(i, u)) return false; u.pm += 1; return true; } };
template <class F> __device__ __forceinline__ void run_gemm_latent(MKLAS unsigned char* lds, const bf16_t* A, const bf16_t* Bt, int N, int K, const F& f) {
    pg8::Gemm g{A, Bt, L, N, K, 0}; LatentOrder S; S.init(T, N, (int)gridDim.x, (int)blockIdx.x);
    EpiGen<F> E{f};
    pg8::gemm_phase<EpiGen<F>, LatentOrder, false>(lds, g, S, E, nullptr);
}
template <class F> __device__ __forceinline__ void run_gemm(MKLAS unsigned char* lds, const bf16_t* A, const bf16_t* Bt, int M, int N, int K, const F& f) {
    pg8::Gemm g{A, Bt, M, N, K, 0}; pg8::StaticOrder S; S.init(M, N, (int)gridDim.x, (int)blockIdx.x);
    EpiGen<F> E{f};
    pg8::gemm_phase<EpiGen<F>, pg8::StaticOrder, false>(lds, g, S, E, nullptr);
}

#ifndef MK_MASK
#define MK_MASK 0xfffff
#endif
#define KON(j) ((MK_MASK >> (j)) & 1)
#define IN(k) (lo <= (k) && (k) < hi)
#ifndef MK_PROBE
#define MK_PROBE 0
#endif
#ifndef MK_PROBE_WORK
#define MK_PROBE_WORK 0u
#endif
#ifndef MK_PROBE_WAIT
#define MK_PROBE_WAIT 0u
#endif
#if MK_PROBE
#define PROBE_MARK(kind, iswait) do { if (blockIdx.x == 0 && threadIdx.x == 0) { const unsigned long long now_ = wall_clock64(); const unsigned long long d_ = now_ - *(volatile MKLAS unsigned long long*)(lctl + 4); \
        if ((((iswait) ? MK_PROBE_WAIT : MK_PROBE_WORK) >> (kind)) & 1u) *(volatile MKLAS unsigned long long*)(lctl + 6) += d_; *(volatile MKLAS unsigned long long*)(lctl + 4) = now_; } } while (0)
#else
#define PROBE_MARK(kind, iswait) do { } while (0)
#endif
#define SEAMK(k, kind) do { PROBE_MARK(kind, 0); if (IN(k) && IN((k) + 1)) { xcd_barrier(bar); } PROBE_MARK(kind, 1); } while (0)
template <int l> __device__ __forceinline__ void run_layer(const P& p, MKLAS unsigned char* lds, const XcdBarrier& bar, const int lo, const int hi, volatile MKLAS unsigned* lctl) {
    constexpr bool last = (l == DEPTH - 1);
    const int b = 1 + l * NPH_LAYER;
    unsigned* const ctl = (unsigned*)(p.ws + WS_CTL);
    volatile MKLAS int* const slot = (volatile MKLAS int*)(lctl + 2);
    if (KON(1) && IN(b + 0)) { if (l == 0) ph_hnorm(p, l); } SEAMK(b + 0, 1);
    if (KON(2) && IN(b + 1)) { FnA f{WSP(bf16_t, WS_QH), WSP(bf16_t, WS_VH), WSP(bf16_t, WS_RQ), WSP(bf16_t, WS_RK), WSP(bf16_t, WS_RV), WSP(float, WS_LF), WSP(float, WS_LB) + l * 512, WSP(float, WS_ROPE)};
        ctx_gemm(lds, WSP(bf16_t, WS_H), WSP(bf16_t, WS_WIN), NA, D, f);
        run_gemm_latent(lds, WSP(bf16_t, WS_H), WSP(bf16_t, WS_WIN), NA, D, f); } SEAMK(b + 1, 2);
    if (KON(3) && IN(b + 2)) { ph_scan_pass1(p, l, lds, ctl + CW_CNT + 64 * (l * 4 + 0), slot); } SEAMK(b + 2, 4);
    if (KON(3) && IN(b + 3)) { ph_scan_pass2(p, l); } SEAMK(b + 3, 5);
    if (KON(4) && IN(b + 4)) { ph_scan_pass3(p, l, lds); } SEAMK(b + 4, 7);
    if (KON(5) && IN(b + 5)) { FnB f{WSP(bf16_t, WS_OHG), WSP(bf16_t, WS_ORT), WSP(bf16_t, WS_GA), WSP(bf16_t, WS_GB)};
        if (last) run_gemm_latent(lds, WSP(bf16_t, WS_H), WSP(bf16_t, WS_WIN) + (size_t)NA * D, NB, D, f); else run_gemm(lds, WSP(bf16_t, WS_H), WSP(bf16_t, WS_WIN) + (size_t)NA * D, L, NB, D, f);
        fill_convert<true>(p, l, lds, ctl + CW_CNT + 64 * (8 + l * 2 + 0), slot); } SEAMK(b + 5, 8);
    if (KON(7) && IN(b + 6)) {
        { FnM1 f{WSP(bf16_t, WS_GA), WSP(float, WS_M1)};
          if (!last) ctx_gemm(lds, WSP(bf16_t, WS_OHG), WSP(bf16_t, WS_WOHG), D, 512, f);
          run_gemm_latent(lds, WSP(bf16_t, WS_OHG), WSP(bf16_t, WS_WOHG), D, 512, f); }
        { FnM2 f{WSP(bf16_t, WS_GB), WSP(float, WS_M1), WSP(bf16_t, WS_MB)};
          if (!last) ctx_gemm(lds, WSP(bf16_t, WS_ORT), WSP(bf16_t, WS_WORET), D, D, f);
          run_gemm_latent(lds, WSP(bf16_t, WS_ORT), WSP(bf16_t, WS_WORET), D, D, f); } } SEAMK(b + 6, 10);
    if (KON(8) && IN(b + 7)) { FnX f{l == 0 ? p.in[2] : WSP(float, WS_CTX), l == 0 ? p.in[0] : p.out, WSP(float, WS_CTX), p.out, WSP(float, WS_MOD) + l * 2 * 6144};
        if (!last) ctx_gemm(lds, WSP(bf16_t, WS_MB), WSP(bf16_t, WS_WOUT), D, D, f);
        run_gemm_latent(lds, WSP(bf16_t, WS_MB), WSP(bf16_t, WS_WOUT), D, D, f); } SEAMK(b + 7, 11);
    if (KON(9) && IN(b + 8)) { ph_router(p, l, lds, ctl + CW_ECNT + l * NE * 16); } SEAMK(b + 8, 12);
    if (KON(11) && IN(b + 9)) { moe_tables(p, l, lds, true);
        const MKLAS int* tb = (const MKLAS int*)(lds + MOE_TAB);
        MoeGatherOrder S{tb, tb + 64, tb + 96, WSP(int, WS_TOK), tb[NE + 1], 2, (int)gridDim.x, (int)blockIdx.x};
        pg8::Gemm g{WSP(bf16_t, WS_H), WSP(bf16_t, WS_WGU), XG_ROWS, 512, D, (size_t)512 * D * 2}; EpiGU E{WSP(bf16_t, WS_ACT)};
        pg8::gemm_phase<EpiGU, MoeGatherOrder, false>(lds, g, S, E, nullptr);
        if (!last) fill_convert<false>(p, l + 1, lds, ctl + CW_CNT + 64 * (8 + l * 2 + 1), slot); } SEAMK(b + 9, 14);
    if (KON(12) && IN(b + 10)) { const int* TE = WSP(int, WS_TILEE); MoeOrder S{TE, TE[255], 4, (int)gridDim.x, (int)blockIdx.x};
        pg8::Gemm g{WSP(bf16_t, WS_ACT), WSP(bf16_t, WS_WD), XG_ROWS, D, DE, (size_t)D * DE * 2}; EpiGen<FnYA> E{FnYA{WSP(bf16_t, WS_YA)}};
        pg8::gemm_phase<EpiGen<FnYA>, MoeOrder, false>(lds, g, S, E, nullptr); } SEAMK(b + 10, 15);
    if (KON(13) && IN(b + 11)) { ph_moe_combine(p, l, lds); } SEAMK(b + 11, 16);
}

__global__ void __launch_bounds__(NT, 2) fwd(P p) {
    extern __shared__ __attribute__((aligned(16))) unsigned char lds_raw[];
    MKLAS unsigned char* lds = (MKLAS unsigned char*)lds_raw;
    volatile MKLAS unsigned* lctl = (volatile MKLAS unsigned*)(lds + LDS_CTL);
    if (threadIdx.x < 8) lctl[threadIdx.x] = 0u;
    __syncthreads();
#if MK_PROBE
    if (blockIdx.x == 0 && threadIdx.x == 0) *(volatile MKLAS unsigned long long*)(lctl + 4) = wall_clock64();
#endif
    const int lo = p.ph_lo, hi = p.ph_hi;
    const bool multi = (hi - lo) > 1;
    XcdBarrier bar; bar.bar = (unsigned*)(p.ws + WS_CTL) + CW_BAR; bar.x = 0; bar.st = nullptr;
    if (multi) bar = xcd_barrier_post((unsigned*)(p.ws + WS_CTL) + CW_BAR, lctl);
    if (KON(0) && IN(0)) { ph_prologue(p, lds); } SEAMK(0, 0);
    run_layer<0>(p, lds, bar, lo, hi, lctl);
    run_layer<1>(p, lds, bar, lo, hi, lctl);
    static_assert(DEPTH == 2, "two layers written out");
#if MK_PROBE
    if (blockIdx.x == 0 && threadIdx.x == 0) { const unsigned long long t0_ = wall_clock64(), d_ = 4ull * *(volatile MKLAS unsigned long long*)(lctl + 6); while (wall_clock64() - t0_ < d_) __builtin_amdgcn_s_sleep(8); }
#endif
#undef IN
}
}

#ifndef MK_ONE_LAUNCH
#define MK_ONE_LAUNCH 1
#endif
extern "C" void kernel_launch(void* const* d_in, const int* in_sizes, int n_in, void* d_out, int out_size, void* d_ws, size_t ws_size, hipStream_t stream) {
    using namespace mk;
    static int grid = 0;
    if (grid == 0) {
        if (n_in != 24 || in_sizes[0] != T * D || out_size != T * D || ws_size < WS_END) { fprintf(stderr, "kernel_launch: unexpected shapes / workspace (n_in %d, ws %zu, need %zu); nothing launched\n", n_in, ws_size, (size_t)WS_END); grid = -1; return; }
        int dev = 0, cus = 0, per_cu = 0;
        if (hipGetDevice(&dev) != hipSuccess || hipDeviceGetAttribute(&cus, hipDeviceAttributeMultiprocessorCount, dev) != hipSuccess) { grid = -1; return; }
        if (hipFuncSetAttribute((const void*)fwd, hipFuncAttributeMaxDynamicSharedMemorySize, LDS_BYTES) != hipSuccess) { fprintf(stderr, "kernel_launch: hipFuncSetAttribute failed\n"); grid = -1; return; }
        if (hipOccupancyMaxActiveBlocksPerMultiprocessor(&per_cu, (const void*)fwd, NT, LDS_BYTES) != hipSuccess || per_cu < 1) { fprintf(stderr, "kernel_launch: occupancy query says %d\n", per_cu); (void)hipGetLastError(); per_cu = 1; }
        grid = cus;
    }
    if (grid < 0) return;
    if (hipMemsetAsync((char*)d_ws + WS_CTL, 0, CTL_BYTES, stream) != hipSuccess) return;
    P p{};
    for (int i = 0; i < 24; ++i) p.in[i] = (const float*)d_in[i];
    p.out = (float*)d_out; p.ws = (unsigned char*)d_ws;
#if MK_ONE_LAUNCH
    p.ph_lo = 0; p.ph_hi = NPH;
    hipLaunchKernelGGL(fwd, dim3(grid), dim3(NT), LDS_BYTES, stream, p);
#else
    for (int ph = 0; ph < NPH; ++ph) { p.ph_lo = ph; p.ph_hi = ph + 1; hipLaunchKernelGGL(fwd, dim3(grid), dim3(NT), LDS_BYTES, stream, p); }
#endif
}
```

```cpp
#include <hip/hip_runtime.h>
#include <cstdio>
#include <cstdint>
__device__ __forceinline__ int tid_fresh() { int t = (int)threadIdx.x; asm volatile("" : "+v"(t)); return t; }
namespace pg8 {
#define PG8_LAS __attribute__((address_space(3)))
typedef unsigned short bf16_t;
typedef short bf16x8 __attribute__((ext_vector_type(8)));
typedef float f32x4 __attribute__((ext_vector_type(4)));
typedef unsigned u32x4 __attribute__((ext_vector_type(4)));
constexpr int BM = 256, BK = 64, HALF = 128, HTB = HALF * BK * 2  , STAGE_BYTES = 8 * HTB, NXCD = 8, WGM = 8;

__host__ __device__ __forceinline__ int lds_byte(int r, int c) { const int st = (r >> 4) * 2 + (c >> 5), rr = r & 15, cc = c & 31, ob = rr * 64 + cc * 2; return st * 1024 + (ob ^ (((ob >> 9) & 1) << 5)); }
__host__ __device__ __forceinline__ void stage_rc(int b, int& R, int& C) { const int st = b / 1024, sb = b % 1024, swz = sb ^ (((sb >> 9) & 1) << 5); R = (st >> 1) * 16 + swz / 64; C = (st & 1) * 32 + (swz % 64) / 2; }
__host__ __device__ __forceinline__ int perm32(int rho) { const int n = rho >> 4, i = rho & 15; return 8 * (i >> 2) + 4 * n + (i & 3); }

struct Unit { int pm, pn, be; };
struct Gemm { const bf16_t* A; const bf16_t* Bt; int M, N, K; size_t bstride; };

struct StaticOrder {
    static constexpr bool GATHER = false;
    int nM, nN, nwg, G, c;
    __host__ __device__ void init(int M, int N, int G_, int c_) { nM = M / BM; nN = N / BM; nwg = nM * nN; G = G_; c = c_; }
    __host__ __device__ bool next(int i, Unit& u) const {
        const long L = (long)i * G + c; if (L >= nwg) return false;
        int wgid = (int)L; { const int q = nwg / NXCD, r = nwg % NXCD, xcd = wgid % NXCD, off = wgid / NXCD; wgid = (xcd < r ? xcd * (q + 1) : r * (q + 1) + (xcd - r) * q) + off; }
        const int nig = WGM * nN, gid = wgid / nig, fm = gid * WGM, gsz = (nM - fm) < WGM ? (nM - fm) : WGM;
        u.pm = fm + ((wgid % nig) % gsz); u.pn = (wgid % nig) / gsz; u.be = 0; return true;
    }
    __device__ __forceinline__ void a_ready(const Unit&) const {}
    __device__ __forceinline__ void done(const Unit&) const {}
};

typedef float cvt_f32x2 __attribute__((ext_vector_type(2)));
typedef __bf16 cvt_bf16x2 __attribute__((ext_vector_type(2)));
__device__ __forceinline__ unsigned cvt_pk_bf16(float lo, float hi) { const cvt_f32x2 v = {lo, hi}; return __builtin_bit_cast(unsigned, __builtin_convertvector(v, cvt_bf16x2)); }
template <class Epi, class Sched, bool STAMP = false>
__device__ __forceinline__ void gemm_phase(PG8_LAS unsigned char* lds, const Gemm g, const Sched& S, const Epi& E, unsigned long long* stamps) {
    const int tid = tid_fresh(), wid = __builtin_amdgcn_readfirstlane(tid >> 6), lane = tid & 63, wr = wid >> 2, wc = wid & 3, fr = lane & 15, fq = lane >> 4;
    const int K = g.K, nt = K / BK;
    int ts_lo = 0, ts_hi = 0, nts = 0; const unsigned long long rt_entry = STAMP ? (unsigned long long)wall_clock64() : 0ull;
#define PG8_STAMP() do { if (STAMP && wid == 0 && nts < 64) { const unsigned long long _c = (unsigned long long)clock64(); \
        ts_lo = (lane == nts) ? (int)(unsigned)_c : ts_lo; ts_hi = (lane == nts) ? (int)(unsigned)(_c >> 32) : ts_hi; ++nts; } } while (0)
    PG8_STAMP();
    unsigned voffA[2], voffB[2];
#pragma unroll
    for (int i = 0; i < 2; ++i) { int R, C; stage_rc(tid * 16 + i * 8192, R, C); const int Rb = Epi::PERM ? ((R & ~31) + perm32(R & 31)) : R;
        voffA[i] = (unsigned)(R * K + C) * 2u; voffB[i] = (unsigned)(Rb * K + C) * 2u; }
    unsigned vA0[2] = {0u, 0u}, vA1[2] = {0u, 0u}, nvA0[2] = {0u, 0u}, nvA1[2] = {0u, 0u}; int gR[2] = {0, 0}, gC[2] = {0, 0};
    if constexpr (Sched::GATHER) {
#pragma unroll
        for (int i = 0; i < 2; ++i) stage_rc(tid * 16 + i * 8192, gR[i], gC[i]); }
#define PG8_GOFF(u, v0, v1) do { _Pragma("unroll") for (int _i = 0; _i < 2; ++_i) { v0[_i] = S.row_byte_off(u, gR[_i]) + (unsigned)gC[_i] * 2u; v1[_i] = S.row_byte_off(u, 128 + gR[_i]) + (unsigned)gC[_i] * 2u; } } while (0)
#define PG8_STAGE_A(bufoff, base, half, nxtsel) do { if constexpr (Sched::GATHER) { unsigned sel_[2]; _Pragma("unroll") for (int _j = 0; _j < 2; ++_j) sel_[_j] = (nxtsel) ? ((half) ? nvA1[_j] : nvA0[_j]) : ((half) ? vA1[_j] : vA0[_j]); \
        PG8_STAGE(bufoff, base, sel_); } else { PG8_STAGE(bufoff, (base) + ((half) ? hstep : (size_t)0), voffA); } } while (0)
    const size_t kstep = (size_t)(BK * 2);
    const size_t hstep = (size_t)HALF * K * 2;
    const size_t tstep = 2 * hstep;
    const unsigned ldsw = (unsigned)wid * 1024u;
    const int aoff = lds_byte(wr * 64 + fr, fq * 8), boff = lds_byte(wc * 32 + fr, fq * 8);
#define PG8_SA(b, h) (((b) * 2 + (h)) * HTB)
#define PG8_SB(b, h) ((4 + (b) * 2 + (h)) * HTB)
#define PG8_STAGE(bufoff, gbase, voff) do { _Pragma("unroll") for (int _i = 0; _i < 2; ++_i) \
        __builtin_amdgcn_global_load_lds((const unsigned*)((const char*)(gbase) + (voff)[_i]), (PG8_LAS unsigned*)(lds + (bufoff) + ldsw + _i * 8192), 16, 0, 0); } while (0)
#define PG8_LDA(dst, b, h) do { _Pragma("unroll") for (int m = 0; m < 4; ++m) _Pragma("unroll") for (int k = 0; k < 2; ++k) dst[m][k] = *(const PG8_LAS bf16x8*)(lds + PG8_SA(b, h) + aoff + m * 2048 + k * 1024); } while (0)
#define PG8_LDB(dst, b, h) do { _Pragma("unroll") for (int n = 0; n < 2; ++n) _Pragma("unroll") for (int k = 0; k < 2; ++k) dst[n][k] = *(const PG8_LAS bf16x8*)(lds + PG8_SB(b, h) + boff + n * 2048 + k * 1024); } while (0)
#define PG8_MMA(ai, bj, At, Bt) do { __builtin_amdgcn_s_setprio(1); _Pragma("unroll") for (int m = 0; m < 4; ++m) _Pragma("unroll") for (int n = 0; n < 2; ++n) _Pragma("unroll") for (int k = 0; k < 2; ++k) \
        acc[ai][bj][m][n] = __builtin_amdgcn_mfma_f32_16x16x32_bf16(Bt[n][k], At[m][k], acc[ai][bj][m][n], 0, 0, 0); __builtin_amdgcn_s_setprio(0); } while (0)
#define PG8_WAIT_V(n) asm volatile("s_waitcnt vmcnt(" #n ")" ::: "memory")
#define PG8_WAIT_L(n) asm volatile("s_waitcnt lgkmcnt(" #n ")" ::: "memory")
#define PG8_BAR __builtin_amdgcn_s_barrier()
#define PG8_SCHED __builtin_amdgcn_sched_barrier(0)
    Unit cur, nxt; int ui = 0;
    if (!S.next(0, cur)) return;
    f32x4 acc[2][2][4][2];
#pragma unroll
    for (int a = 0; a < 2; ++a)
#pragma unroll
        for (int b = 0; b < 2; ++b)
#pragma unroll
            for (int m = 0; m < 4; ++m)
#pragma unroll
                for (int n = 0; n < 2; ++n) acc[a][b][m][n] = (f32x4){0.f, 0.f, 0.f, 0.f};
    bf16x8 At[4][2], B0[2][2], B1[2][2];
    const char* cA = Sched::GATHER ? (const char*)g.A : (const char*)g.A + (size_t)cur.pm * tstep; const char* cB = (const char*)g.Bt + (size_t)cur.be * g.bstride + (size_t)cur.pn * tstep;
    S.a_ready(cur);
    if constexpr (Sched::GATHER) PG8_GOFF(cur, vA0, vA1);
    PG8_STAGE(PG8_SB(0, 0), cB, voffB); PG8_STAGE_A(PG8_SA(0, 0), cA, 0, false); PG8_STAGE(PG8_SB(0, 1), cB + hstep, voffB); PG8_STAGE_A(PG8_SA(0, 1), cA, 1, false);
    if (wr == 1) PG8_BAR;
    PG8_WAIT_V(4); PG8_BAR;
    PG8_STAGE(PG8_SB(1, 0), cB + kstep, voffB); PG8_STAGE_A(PG8_SA(1, 0), cA + kstep, 0, false); PG8_STAGE(PG8_SB(1, 1), cB + hstep + kstep, voffB);
    PG8_WAIT_V(6); PG8_BAR;
    PG8_STAMP();
    for (;;) {
        const bool has_next = S.next(ui + 1, nxt);
        const char* nA = Sched::GATHER ? (const char*)g.A : (has_next ? (const char*)g.A + (size_t)nxt.pm * tstep : cA); const char* nB = has_next ? (const char*)g.Bt + (size_t)nxt.be * g.bstride + (size_t)nxt.pn * tstep : cB;
        if constexpr (Sched::GATHER) { if (has_next) PG8_GOFF(nxt, nvA0, nvA1); else {
#pragma unroll
                for (int _i = 0; _i < 2; ++_i) { nvA0[_i] = vA0[_i]; nvA1[_i] = vA1[_i]; } } }
        for (int t = 0; t < nt; t += 2) {
            const bool last = (t == nt - 2);
            const char* a1 = cA + (size_t)(t + 1) * kstep;
            const char* a2 = last ? nA : cA + (size_t)(t + 2) * kstep; const char* b2 = last ? nB : cB + (size_t)(t + 2) * kstep;
            const char* a3 = a2 + kstep; const char* b3 = b2 + kstep;
            if (last && has_next) S.a_ready(nxt);
            PG8_LDB(B0, 0, 0); PG8_SCHED; PG8_LDA(At, 0, 0); PG8_STAGE_A(PG8_SA(1, 1), a1, 1, false);
            PG8_WAIT_L(8); PG8_BAR; PG8_WAIT_L(0); PG8_MMA(0, 0, At, B0); PG8_BAR; PG8_SCHED;
            PG8_LDB(B1, 0, 1); PG8_STAGE(PG8_SB(0, 0), b2, voffB);
            PG8_BAR; PG8_WAIT_L(0); PG8_MMA(0, 1, At, B1); PG8_BAR;
            PG8_LDA(At, 0, 1); PG8_STAGE_A(PG8_SA(0, 0), a2, 0, last);
            PG8_BAR; PG8_WAIT_L(0); PG8_MMA(1, 0, At, B0); PG8_BAR; PG8_SCHED;
            PG8_STAGE(PG8_SB(0, 1), b2 + hstep, voffB);
            PG8_WAIT_V(6); PG8_BAR; PG8_MMA(1, 1, At, B1); PG8_BAR;
            PG8_LDB(B0, 1, 0); PG8_SCHED; PG8_LDA(At, 1, 0); PG8_STAGE_A(PG8_SA(0, 1), a2, 1, last);
            PG8_WAIT_L(8); PG8_BAR; PG8_WAIT_L(0); PG8_MMA(0, 0, At, B0); PG8_BAR; PG8_SCHED;
            PG8_LDB(B1, 1, 1); PG8_STAGE(PG8_SB(1, 0), b3, voffB);
            PG8_BAR; PG8_WAIT_L(0); PG8_MMA(0, 1, At, B1); PG8_BAR;
            PG8_LDA(At, 1, 1); PG8_STAGE_A(PG8_SA(1, 0), a3, 0, last);
            PG8_BAR; PG8_WAIT_L(0); PG8_MMA(1, 0, At, B0); PG8_BAR; PG8_SCHED;
            PG8_STAGE(PG8_SB(1, 1), b3 + hstep, voffB);
            PG8_WAIT_V(6); PG8_BAR; PG8_MMA(1, 1, At, B1); PG8_BAR;
        }
        PG8_STAMP();
        if constexpr (!Epi::AFTER_DRAIN) { E(acc, cur, wr, wc, fr, fq); S.done(cur); }
        PG8_STAMP();
        if (!has_next) break;
#pragma unroll
        for (int a = 0; a < 2; ++a)
#pragma unroll
            for (int b = 0; b < 2; ++b)
#pragma unroll
                for (int m = 0; m < 4; ++m)
#pragma unroll
                    for (int n = 0; n < 2; ++n) acc[a][b][m][n] = (f32x4){0.f, 0.f, 0.f, 0.f};
        if constexpr (Sched::GATHER) {
#pragma unroll
            for (int _i = 0; _i < 2; ++_i) { vA0[_i] = nvA0[_i]; vA1[_i] = nvA1[_i]; } }
        cur = nxt; cA = nA; cB = nB; ++ui;
    }
    PG8_WAIT_V(0);
    if (wr == 0) PG8_BAR;
    PG8_BAR;
    if constexpr (Epi::AFTER_DRAIN) { E.fused(acc, cur, wr, wc, fr, fq, lds, wid, lane); S.done(cur); }
    PG8_STAMP();
    if (STAMP && wid == 0) { stamps[lane] = lane < nts ? (((unsigned long long)(unsigned)ts_hi << 32) | (unsigned)ts_lo) : 0ull;
        if (lane == 62) stamps[62] = rt_entry; if (lane == 63) stamps[63] = (unsigned long long)wall_clock64(); }
#undef PG8_STAMP
#undef PG8_SA
#undef PG8_SB
#undef PG8_STAGE
#undef PG8_STAGE_A
#undef PG8_GOFF
#undef PG8_LDA
#undef PG8_LDB
#undef PG8_MMA
#undef PG8_WAIT_V
#undef PG8_WAIT_L
#undef PG8_BAR
#undef PG8_SCHED
}
}


#define XB_TMO      128
#define XB_XCNT(j)  (256  + 64 * (j))
#define XB_XSUB(j)  (1280 + 64 * (j))
#define XB_XGEN(j)  (2304 + 64 * (j))
#define XB_TOP      3328
#define XB_TOPGEN   3392
#define XCD_BAR_WORDS 3456
#define XB_SPIN_CAP (1u << 18)
#define LAS __attribute__((address_space(3)))

__device__ __forceinline__ unsigned xb_ld(unsigned* p)              { return __hip_atomic_load(p, __ATOMIC_RELAXED, __HIP_MEMORY_SCOPE_AGENT); }
__device__ __forceinline__ unsigned xb_add(unsigned* p, unsigned v) { return __hip_atomic_fetch_add(p, v, __ATOMIC_RELAXED, __HIP_MEMORY_SCOPE_AGENT); }
__device__ __forceinline__ unsigned xb_xcc_id() { return (unsigned)__builtin_amdgcn_s_getreg((3 << 11) | 20) & 0xFu; }
#define XB_SPIN(cond, bar) do { unsigned _sp = 0; while (cond) { __builtin_amdgcn_s_sleep(1); \
    if ((++_sp & 255u) == 0u) { if (xb_ld(&(bar)[XB_TMO])) break; if (_sp > XB_SPIN_CAP) { atomicAdd(&(bar)[XB_TMO], 1u); break; } } } } while (0)

struct XcdBarrier {
    unsigned* bar; unsigned x;
    volatile LAS unsigned* st;
};

__device__ __forceinline__ XcdBarrier xcd_barrier_post(unsigned* bar, volatile LAS unsigned* st) {
    XcdBarrier b; b.bar = bar; b.x = xb_xcc_id(); b.st = st;
    if (threadIdx.x == 0) (void)xb_add(&bar[XB_XCNT(b.x)], 1u);
    return b;
}
__device__ __forceinline__ void xcd_barrier_complete(unsigned* bar, unsigned x, unsigned& nloc, unsigned& nx) {
    const unsigned G = gridDim.x * gridDim.y * gridDim.z;
    unsigned sum, cnt, mine, sp = 0u;
    for (;;) {
        sum = 0u; cnt = 0u; mine = 0u;
#pragma unroll
        for (unsigned j = 0; j < 16; ++j) { const unsigned c = xb_ld(&bar[XB_XCNT(j)]); sum += c; cnt += (c > 0u) ? 1u : 0u; mine = (j == x) ? c : mine; }
        if (sum == G) break;
        __builtin_amdgcn_s_sleep(1);
        if ((++sp & 255u) == 0u) { if (xb_ld(&bar[XB_TMO])) break; if (sp > XB_SPIN_CAP) { atomicAdd(&bar[XB_TMO], 1u); break; } }
    }
    nloc = mine > 0u ? mine : 1u; nx = cnt > 0u ? cnt : 1u;
}

__device__ __forceinline__ void xcd_barrier(const XcdBarrier& b) {
    asm volatile("s_waitcnt vmcnt(0)" ::: "memory");
    __syncthreads();
    if (threadIdx.x == 0) {
        unsigned* bar = b.bar;
        __builtin_amdgcn_s_waitcnt(0);
        unsigned nloc = b.st[0], nx = b.st[1];
        if (nloc == 0u) { xcd_barrier_complete(bar, b.x, nloc, nx); b.st[0] = nloc; b.st[1] = nx; }
        const unsigned old = xb_add(&bar[XB_XSUB(b.x)], 1u);
        const unsigned gen = old / nloc;
        if (old + 1u == (gen + 1u) * nloc) {
            __builtin_amdgcn_fence(__ATOMIC_RELEASE, "agent");
            asm volatile("s_waitcnt vmcnt(0)" ::: "memory");
            const unsigned og = xb_add(&bar[XB_TOP], 1u);
            const unsigned tg = og / nx;
            if (og + 1u == (tg + 1u) * nx) xb_add(&bar[XB_TOPGEN], 1u);
            else XB_SPIN(xb_ld(&bar[XB_TOPGEN]) == tg, bar);
            __builtin_amdgcn_fence(__ATOMIC_ACQUIRE, "agent");
            xb_add(&bar[XB_XGEN(b.x)], 1u);
            asm volatile("s_waitcnt vmcnt(0)" ::: "memory");
        } else {
            XB_SPIN(xb_ld(&bar[XB_XGEN(b.x)]) == gen, bar);
            __builtin_amdgcn_fence(__ATOMIC_ACQUIRE, "agent");
            asm volatile("s_waitcnt vmcnt(0)" ::: "memory");
        }
    }
    __syncthreads();
}


namespace mk {
using pg8::bf16_t; using pg8::f32x4; using pg8::u32x4; using pg8::cvt_pk_bf16;
#define MKLAS __attribute__((address_space(3)))
typedef unsigned u32x2 __attribute__((ext_vector_type(2)));
typedef float f32x2 __attribute__((ext_vector_type(2)));

constexpr int D = 1024, T = 16384, LC = 256, L = T + LC, DEPTH = 2;
constexpr int NA = 4096, NB = 3584;
constexpr int NE = 32, DE = 256;
constexpr float EPS = 1e-6f;
constexpr int NT = 512, NW = 8;
constexpr int LDS_CTL_OFF = 131072;

constexpr size_t MiB = 1u << 20, QMiB = 1u << 18;
constexpr size_t WS_CTL = 0, CTL_BYTES = 1 * MiB;
constexpr size_t WS_MOD = 1 * MiB, WS_LB = WS_MOD + 128 * 1024, WS_ROPE = WS_MOD + 192 * 1024, WS_LGAM = WS_MOD + 256 * 1024, WS_WRT = WS_MOD + 512 * 1024;
constexpr size_t WS_AE = 2 * MiB, WS_AW = WS_AE + 256 * 1024, WS_APOS = WS_AE + 512 * 1024, WS_TILEE = WS_AE + 1024 * 1024;
constexpr size_t WS_TOK = 58 * MiB;
constexpr size_t WS_CTX = 4 * MiB;
constexpr size_t WS_WIN = 5 * MiB, WS_WOHG = 20 * MiB, WS_WORET = 21 * MiB, WS_WOUT = 23 * MiB;
constexpr size_t WS_H = 25 * MiB;
constexpr size_t WS_QH = 58 * MiB, WS_VH = WS_QH + 65 * QMiB, WS_RQ = WS_VH + 65 * QMiB, WS_RK = WS_RQ + 65 * QMiB;
constexpr size_t WS_RV = 123 * MiB;
constexpr size_t WS_LF = WS_RV + 130 * QMiB;
constexpr size_t WS_OHG = WS_LF + 260 * QMiB;
constexpr size_t WS_ORT = WS_OHG + 65 * QMiB;
constexpr size_t WS_OF = WS_ORT + 130 * QMiB;
constexpr size_t WS_END = WS_OF + 390 * QMiB;
constexpr size_t WS_GA = WS_QH, WS_GB = WS_QH + 130 * QMiB;
constexpr size_t WS_M1 = WS_LF;
constexpr size_t WS_MB = WS_RV;
constexpr int CW_BAR = 4096, CW_CNT = 8192, CW_ECNT = 12288;

struct P { const float* in[24]; float* out; unsigned char* ws; int ph_lo, ph_hi; };
__device__ __forceinline__ unsigned char* ws_fresh(unsigned char* w) { asm volatile("" : "+s"(w)); return w; }
#define WSP(type, off) ((type*)(p.ws + (off)))

__device__ __forceinline__ float bf2f(bf16_t b) { return __uint_as_float(((unsigned)b) << 16); }
__device__ __forceinline__ bf16_t f2bf(float f) { return (bf16_t)(cvt_pk_bf16(f, 0.f) & 0xffffu); }
__device__ __forceinline__ float fexp(float x) { return __builtin_amdgcn_exp2f(x * 1.4426950408889634f); }
__device__ __forceinline__ float flog(float x) { return __builtin_amdgcn_logf(x) * 0.6931471805599453f; }
__device__ __forceinline__ float siluf(float x) { return x * __builtin_amdgcn_rcpf(1.f + fexp(-x)); }
__device__ __forceinline__ float sigmf(float x) { return __builtin_amdgcn_rcpf(1.f + fexp(-x)); }
__device__ __forceinline__ float wave_sum(float v) {
#pragma unroll
    for (int o = 1; o < 64; o <<= 1) v += __shfl_xor(v, o);
    return v;
}
__device__ __forceinline__ const float* xrow_in(const P& p, int l, int r) {
    if (l == 0) return r < LC ? p.in[2] + (size_t)r * D : p.in[0] + (size_t)(r - LC) * D;
    return r < LC ? WSP(float, WS_CTX) + (size_t)r * D : p.out + (size_t)(r - LC) * D;
}
__device__ __forceinline__ float* xrow_st(const P& p, int r) { return r < LC ? WSP(float, WS_CTX) + (size_t)r * D : p.out + (size_t)(r - LC) * D; }
__device__ __forceinline__ int seq_row(int dir, int i) { return dir == 0 ? i : (i < LC ? LC - 1 - i : L + LC - 1 - i); }

__device__ __forceinline__ void tr_load(const float* W, int N, int k0, int n0, MKLAS float* tile) {
    const int tid = tid_fresh(), r = tid >> 6, c = tid & 63;
#pragma unroll
    for (int i = 0; i < 8; ++i) tile[(r + 8 * i) * 65 + c] = W[(size_t)(k0 + r + 8 * i) * N + n0 + c];
}
__device__ __forceinline__ void tr_store(bf16_t* WT, int K, int k0, int outrow0, const MKLAS float* tile, bool swap45 = false) {
    const int tid = tid_fresh(), nn = tid >> 3, kc = tid & 7;
    const MKLAS float* s = tile + (kc * 8) * 65 + nn;
    u32x4 o; o.x = cvt_pk_bf16(s[0], s[65]); o.y = cvt_pk_bf16(s[130], s[195]); o.z = cvt_pk_bf16(s[260], s[325]); o.w = cvt_pk_bf16(s[390], s[455]);
    const int nno = swap45 ? ((((nn & 31) >> 2) << 3) | ((nn >> 5) << 2) | (nn & 3)) : nn;
    *(u32x4*)(WT + (size_t)(outrow0 + nno) * K + k0 + kc * 8) = o;
}
constexpr int TRT = 64 * 65;
__device__ __forceinline__ int win_perm(int n) { return n < 2048 ? n : (n < 2560 ? 4096 + (n - 2048) : (n < 4608 ? 2048 + (n - 2560) : n)); }
constexpr int MIXER_ITEMS = 16 * 30 + 8 * 4 + 16 * 4 + 16 * 4;
__device__ __forceinline__ void mixer_item(const P& p, int l, int it, MKLAS float* tile) {
    constexpr int I_IN = 16 * 30, I_OHG = 8 * 4, I_ORT = 16 * 4;
    const float* W; bf16_t* WT; int K, N, kb, ng, kind;
    if (it < I_IN) { kind = 0; kb = it / 30; ng = it % 30; W = p.in[8] + (size_t)l * D * 7680; WT = WSP(bf16_t, WS_WIN); K = D; N = 7680; }
    else if (it < I_IN + I_OHG) { kind = 1; const int r = it - I_IN; kb = r >> 2; ng = r & 3; W = p.in[13] + (size_t)l * 512 * D; WT = WSP(bf16_t, WS_WOHG); K = 512; N = D; }
    else if (it < I_IN + I_OHG + I_ORT) { kind = 2; const int r = it - I_IN - I_OHG; kb = r >> 2; ng = r & 3; W = p.in[14] + (size_t)l * D * D; WT = WSP(bf16_t, WS_WORET); K = D; N = D; }
    else { kind = 3; const int r = it - I_IN - I_OHG - I_ORT; kb = r >> 2; ng = r & 3; W = p.in[15] + (size_t)l * D * D; WT = WSP(bf16_t, WS_WOUT); K = D; N = D; }
#pragma unroll
    for (int j = 0; j < 4; ++j) tr_load(W, N, kb * 64, (ng * 4 + j) * 64, tile + j * TRT);
    __syncthreads();
#pragma unroll
    for (int j = 0; j < 4; ++j) { const int n0 = (ng * 4 + j) * 64;
        tr_store(WT, K, kb * 64, kind == 0 ? win_perm(n0) : n0, tile + j * TRT, kind == 0 && n0 >= 2560 && n0 < 3584); }
    __syncthreads();
}

__device__ __forceinline__ void ph_hnorm(const P& p, int l) {
    const int tid_ = tid_fresh(), lane = tid_ & 63, wave = tid_ >> 6;
    const float* MOD = WSP(float, WS_MOD); bf16_t* H = WSP(bf16_t, WS_H);
    const float* nw = p.in[6] + l * D;
    for (int r = blockIdx.x * NW + wave; r < L; r += gridDim.x * NW) {
        const f32x4* xr = (const f32x4*)xrow_in(p, l, r) + lane;
        const float* mod = MOD + (l * 2 + (r < LC ? 1 : 0)) * 6144;
        f32x4 v[4]; float ss = 0.f;
#pragma unroll
        for (int j = 0; j < 4; ++j) { v[j] = xr[64 * j]; ss += (v[j].x * v[j].x + v[j].y * v[j].y) + (v[j].z * v[j].z + v[j].w * v[j].w); }
        const float rinv = 1.0f / sqrtf(wave_sum(ss) * (1.f / D) + EPS);
        u32x2* o = (u32x2*)(H + (size_t)r * D) + lane;
#pragma unroll
        for (int j = 0; j < 4; ++j) { const int c = 4 * (lane + 64 * j);
            const f32x4 w = *(const f32x4*)(nw + c), sh = *(const f32x4*)(mod + c), sc = *(const f32x4*)(mod + 1024 + c);
            const f32x4 h = v[j] * rinv * w * (sc + 1.0f) + sh;
            u32x2 q; q.x = cvt_pk_bf16(h.x, h.y); q.y = cvt_pk_bf16(h.z, h.w); o[64 * j] = q; }
    }
}

template <class F> struct EpiGen {
    static constexpr bool PERM = true, AFTER_DRAIN = false;
    F f;
    __device__ __forceinline__ void operator()(const f32x4 (&acc)[2][2][4][2], const pg8::Unit& u, int wr, int wc, int fr, int fq) const {
        const int row0 = u.pm * 256 + wr * 64 + fr, col0 = u.pn * 256 + wc * 32 + 8 * fq;
        if constexpr (!F::HAS_LOAD) {
            const typename F::R none{};
#pragma unroll
            for (int g = 0; g < 8; ++g)
#pragma unroll
                for (int bj = 0; bj < 2; ++bj) f.apply8(row0 + (g >> 2) * 128 + (g & 3) * 16, col0 + bj * 128, acc[g >> 2][bj][g & 3][0], acc[g >> 2][bj][g & 3][1], none, u);
        } else {
            typename F::R cur[2], nxt[2];
#pragma unroll
            for (int bj = 0; bj < 2; ++bj) cur[bj] = f.load8(row0, col0 + bj * 128, u);
            asm volatile("" ::: "memory");
#pragma unroll
            for (int g = 0; g < 8; ++g) {
                if (g < 7) {
#pragma unroll
                    for (int bj = 0; bj < 2; ++bj) nxt[bj] = f.load8(row0 + ((g + 1) >> 2) * 128 + ((g + 1) & 3) * 16, col0 + bj * 128, u);
                }
                asm volatile("" ::: "memory");
#pragma unroll
                for (int bj = 0; bj < 2; ++bj) f.apply8(row0 + (g >> 2) * 128 + (g & 3) * 16, col0 + bj * 128, acc[g >> 2][bj][g & 3][0], acc[g >> 2][bj][g & 3][1], cur[bj], u);
                asm volatile("" ::: "memory");
#pragma unroll
                for (int bj = 0; bj < 2; ++bj) cur[bj] = nxt[bj];
            }
        }
    }
};
struct NoRegs {};
__device__ __forceinline__ void st_bf4(bf16_t* dst, f32x4 v) { u32x2 q; q.x = cvt_pk_bf16(v.x, v.y); q.y = cvt_pk_bf16(v.z, v.w); *(u32x2*)dst = q; }
__device__ __forceinline__ void st_bf8(bf16_t* dst, f32x4 a, f32x4 b) { u32x4 q; q.x = cvt_pk_bf16(a.x, a.y); q.y = cvt_pk_bf16(a.z, a.w); q.z = cvt_pk_bf16(b.x, b.y); q.w = cvt_pk_bf16(b.z, b.w); *(u32x4*)dst = q; }
__device__ __forceinline__ f32x4 bf2lo4(u32x4 q) { return (f32x4){__uint_as_float(q.x << 16), __uint_as_float(q.x & 0xffff0000u), __uint_as_float(q.y << 16), __uint_as_float(q.y & 0xffff0000u)}; }
__device__ __forceinline__ f32x4 bf2hi4(u32x4 q) { return (f32x4){__uint_as_float(q.z << 16), __uint_as_float(q.z & 0xffff0000u), __uint_as_float(q.w << 16), __uint_as_float(q.w & 0xffff0000u)}; }
__device__ __forceinline__ f32x4 silu4(f32x4 v) { return (f32x4){siluf(v.x), siluf(v.y), siluf(v.z), siluf(v.w)}; }
__device__ __forceinline__ f32x4 sigm4(f32x4 v) { return (f32x4){sigmf(v.x), sigmf(v.y), sigmf(v.z), sigmf(v.w)}; }
__device__ __forceinline__ f32x4 ld_bf4(const bf16_t* src) { const u32x2 q = *(const u32x2*)src; f32x4 v; v.x = __uint_as_float(q.x << 16); v.y = __uint_as_float(q.x & 0xffff0000u); v.z = __uint_as_float(q.y << 16); v.w = __uint_as_float(q.y & 0xffff0000u); return v; }

struct FnA {
    bf16_t *QH, *VH, *RQ, *RK, *RV; float* LF; const float* LB; const float* RT;
    static constexpr bool HAS_LOAD = false; typedef NoRegs R;
    __device__ __forceinline__ f32x4 logf4(f32x4 v, int dir, int ch) const { const f32x4 lb = *(const f32x4*)(LB + dir * DEPTH * 512 + ch); f32x4 o;
#pragma unroll
        for (int j = 0; j < 4; ++j) { const float e = fexp(fminf(-v[j], 69.f));
            o[j] = fmaxf(flog(1.f + lb[j] * e) - flog(1.f + e), -69.0775528f); }
        return o; }
    static __device__ __forceinline__ int rot_dim(int c) { return (c & ~63) | (((c >> 3) & 7) << 2) | (c & 3) | ((c & 4) << 3); }
    __device__ __forceinline__ void operator()(int row, int col, f32x4 v, const pg8::Unit& u) const {
        const int seg = u.pn >> 1;
        if (seg == 0) st_bf4(QH + (size_t)row * 512 + col, silu4(v) * 0.08838834764831845f);
        else if (seg == 1 || seg == 2) { const int dir = seg - 1, ch = col - seg * 512; *(f32x4*)(LF + (size_t)row * 1024 + dir * 512 + ch) = logf4(v, dir, ch); }
        else if (seg == 3) st_bf4(VH + (size_t)row * 512 + (col - 1536), v);
        else if (seg == 4) st_bf4(RQ + (size_t)row * 512 + rot_dim(col - 2048), v * 0.08838834764831845f);
        else if (seg == 5) st_bf4(RK + (size_t)row * 512 + rot_dim(col - 2560), v);
        else st_bf4(RV + (size_t)row * 1024 + (col - 3072), v);
    }
    __device__ __forceinline__ void apply8(int row, int col, f32x4 v0, f32x4 v1, const R&, const pg8::Unit& u) const {
        const int seg = u.pn >> 1;
        if (seg == 0) st_bf8(QH + (size_t)row * 512 + col, silu4(v0) * 0.08838834764831845f, silu4(v1) * 0.08838834764831845f);
        else if (seg == 1 || seg == 2) { const int dir = seg - 1, ch = col - seg * 512; float* o = LF + (size_t)row * 1024 + dir * 512 + ch; *(f32x4*)o = logf4(v0, dir, ch); *(f32x4*)(o + 4) = logf4(v1, dir, ch + 4); }
        else if (seg == 3) st_bf8(VH + (size_t)row * 512 + (col - 1536), v0, v1);
        else if (seg == 4 || seg == 5) {
            const int c = col - (seg == 4 ? 2048 : 2560), d0 = rot_dim(c), half = (d0 >> 6) & 1, i = d0 & 31;
            const float sc = seg == 4 ? 0.08838834764831845f : 1.f;
            bf16_t* o = (seg == 4 ? RQ : RK) + (size_t)row * 512 + d0;
            if (row >= LC) { const int t = row - LC, pos = half ? (t & 63) : (t >> 6);
                const f32x4 cs0 = *(const f32x4*)(RT + (pos * 32 + i) * 2), cs1 = *(const f32x4*)(RT + (pos * 32 + i) * 2 + 4);
                const f32x4 co = {cs0.x, cs0.z, cs1.x, cs1.z}, si = {cs0.y, cs0.w, cs1.y, cs1.w};
                st_bf4(o, (v0 * co - v1 * si) * sc); st_bf4(o + 32, (v0 * si + v1 * co) * sc); }
            else { st_bf4(o, v0 * sc); st_bf4(o + 32, v1 * sc); } }
        else st_bf8(RV + (size_t)row * 1024 + (col - 3072), v0, v1);
    }
};
struct FnB {
    bf16_t *OHG, *ORT, *GA, *GB;
    static constexpr bool HAS_LOAD = true; typedef u32x4 R;
    __device__ __forceinline__ bf16_t* optr(int row, int col, int pn) const { return pn < 2 ? OHG + (size_t)row * 512 + col : ORT + (size_t)row * 1024 + (col - 512); }
    __device__ __forceinline__ R load8(int row, int col, const pg8::Unit& u) const { if (u.pn < 6) return *(const u32x4*)optr(row, col, u.pn); return (u32x4){0u, 0u, 0u, 0u}; }
    __device__ __forceinline__ void apply8(int row, int col, f32x4 v0, f32x4 v1, const R& r, const pg8::Unit& u) const {
        const int pn = u.pn;
        if (pn < 6) st_bf8(optr(row, col, pn), bf2lo4(r) * silu4(v0), bf2hi4(r) * silu4(v1));
        else st_bf8(pn < 10 ? GA + (size_t)row * 1024 + (col - 1536) : GB + (size_t)row * 1024 + (col - 2560), sigm4(v0), sigm4(v1));
    }
};
__device__ __forceinline__ f32x4 bf4_to_f32(u32x2 q) { return (f32x4){__uint_as_float(q.x << 16), __uint_as_float(q.x & 0xffff0000u), __uint_as_float(q.y << 16), __uint_as_float(q.y & 0xffff0000u)}; }
struct FnM1 { const bf16_t* GA; float* M1;
    static constexpr bool HAS_LOAD = true; typedef u32x4 R;
    __device__ __forceinline__ R load8(int row, int col, const pg8::Unit&) const { return *(const u32x4*)(GA + (size_t)row * D + col); }
    __device__ __forceinline__ void apply8(int row, int col, f32x4 v0, f32x4 v1, const R& r, const pg8::Unit&) const { float* o = M1 + (size_t)row * D + col; *(f32x4*)o = bf2lo4(r) * v0; *(f32x4*)(o + 4) = bf2hi4(r) * v1; }
    __device__ __forceinline__ void operator()(int row, int col, f32x4 v, const pg8::Unit&) const { *(f32x4*)(M1 + (size_t)row * D + col) = bf4_to_f32(*(const u32x2*)(GA + (size_t)row * D + col)) * v; } };
struct RegsM2 { f32x4 m0, m1; u32x4 g; };
struct FnM2 { const bf16_t* GB; const float* M1; bf16_t* MB;
    static constexpr bool HAS_LOAD = true; typedef RegsM2 R;
    __device__ __forceinline__ R load8(int row, int col, const pg8::Unit&) const { R r; const float* m = M1 + (size_t)row * D + col; r.m0 = *(const f32x4*)m; r.m1 = *(const f32x4*)(m + 4); r.g = *(const u32x4*)(GB + (size_t)row * D + col); return r; }
    __device__ __forceinline__ void apply8(int row, int col, f32x4 v0, f32x4 v1, const R& r, const pg8::Unit&) const { st_bf8(MB + (size_t)row * D + col, r.m0 + bf2lo4(r.g) * v0, r.m1 + bf2hi4(r.g) * v1); }
    __device__ __forceinline__ void operator()(int row, int col, f32x4 v, const pg8::Unit&) const { st_bf4(MB + (size_t)row * D + col, *(const f32x4*)(M1 + (size_t)row * D + col) + bf4_to_f32(*(const u32x2*)(GB + (size_t)row * D + col)) * v); } };
struct RegsX { f32x4 x0, x1; };
struct FnX { const float *xc_in, *xl_in; float *xc_out, *xl_out; const float* MODL;
    static constexpr bool HAS_LOAD = true; typedef RegsX R;
    __device__ __forceinline__ R load8(int row, int col, const pg8::Unit&) const { const bool isc = row < LC; const float* x = (isc ? xc_in : xl_in) + (size_t)(isc ? row : row - LC) * D + col; R r; r.x0 = *(const f32x4*)x; r.x1 = *(const f32x4*)(x + 4); return r; }
    __device__ __forceinline__ void apply8(int row, int col, f32x4 v0, f32x4 v1, const R& r, const pg8::Unit&) const {
        const bool isc = row < LC; const float* g = MODL + (isc ? 6144 : 0) + 2 * 1024 + col; float* o = (isc ? xc_out : xl_out) + (size_t)(isc ? row : row - LC) * D + col;
        *(f32x4*)o = r.x0 + *(const f32x4*)g * v0; *(f32x4*)(o + 4) = r.x1 + *(const f32x4*)(g + 4) * v1; }
    __device__ __forceinline__ void operator()(int row, int col, f32x4 v, const pg8::Unit&) const {
        const bool isc = row < LC; const size_t off = (size_t)(isc ? row : row - LC) * D + col;
        *(f32x4*)((isc ? xc_out : xl_out) + off) = *(const f32x4*)((isc ? xc_in : xl_in) + off) + *(const f32x4*)(MODL + (isc ? 6144 : 0) + 2 * 1024 + col) * v; } };

typedef short bf16x8 __attribute__((ext_vector_type(8)));
typedef short s16x4 __attribute__((ext_vector_type(4)));
#define MFMA16(a, b, c) __builtin_amdgcn_mfma_f32_16x16x32_bf16((a), (b), (c), 0, 0, 0)
constexpr size_t WS_STH = WS_OF, WS_STR = WS_OF + (size_t)8 * 65 * 16384 * 2, WS_ATOT = WS_OF + 49 * MiB;

__device__ __forceinline__ bf16x8 ld_frag_row(const MKLAS bf16_t* tile, int stride, int row0, int k0, int lane) {
    return *(const MKLAS bf16x8*)(tile + (row0 + (lane & 15)) * stride + k0 + 8 * (lane >> 4));
}
__device__ __forceinline__ bf16x8 ld_frag_tr(const MKLAS bf16_t* tile, int stride, int k0, int col0, int lane) {
    const int g = lane >> 4, q = (lane & 15) >> 2, pp = lane & 3;
    const MKLAS bf16_t* a = tile + (k0 + 8 * g + q) * stride + col0 + 4 * pp;
    const s16x4 lo = __builtin_amdgcn_ds_read_tr16_b64_v4i16((MKLAS s16x4*)a), hi = __builtin_amdgcn_ds_read_tr16_b64_v4i16((MKLAS s16x4*)(a + 4 * stride));
    return (bf16x8){lo[0], lo[1], lo[2], lo[3], hi[0], hi[1], hi[2], hi[3]};
}
__device__ __forceinline__ bf16x8 pack8(f32x4 a, f32x4 b) { u32x4 r; r.x = cvt_pk_bf16(a.x, a.y); r.y = cvt_pk_bf16(a.z, a.w); r.z = cvt_pk_bf16(b.x, b.y); r.w = cvt_pk_bf16(b.z, b.w); return __builtin_bit_cast(bf16x8, r); }
__device__ __forceinline__ float bflo(unsigned u) { return __uint_as_float(u << 16); }
__device__ __forceinline__ float bfhi(unsigned u) { return __uint_as_float(u & 0xffff0000u); }
__device__ __forceinline__ u32x4 scale_piece(u32x4 v, float s) { u32x4 r; r.x = cvt_pk_bf16(bflo(v.x) * s, bfhi(v.x) * s); r.y = cvt_pk_bf16(bflo(v.y) * s, bfhi(v.y) * s); r.z = cvt_pk_bf16(bflo(v.z) * s, bfhi(v.z) * s); r.w = cvt_pk_bf16(bflo(v.w) * s, bfhi(v.w) * s); return r; }

template <bool RET, int MODE>
__device__ __forceinline__ void scan_unit(const P& p, int l, int h, int c, int dir, MKLAS unsigned char* lds, bool zero_init = false) {
    constexpr int C = RET ? 64 : 32, NCH = 256 / C, NET = RET ? 2 : 1, DV = RET ? 256 : 128, QS = 136, VS = DV + 8, PS = C + 8, NTT = C / 16, NKS2 = C / 32;
    const int tid = tid_fresh(), lane = tid & 63, w = __builtin_amdgcn_readfirstlane(tid >> 6), r16 = lane & 15, quad = lane >> 4;
    MKLAS bf16_t* Qn = (MKLAS bf16_t*)lds; MKLAS bf16_t* Kn = Qn + C * QS; MKLAS bf16_t* Vn = Kn + C * QS; MKLAS bf16_t* Pm = Vn + C * VS;
    MKLAS float* TOT = (MKLAS float*)(Pm + C * PS); MKLAS float* E12 = TOT + 512; MKLAS float* RED = E12 + 256; MKLAS float* DQK = RED + 1024;
    const int e0 = 16 * NET * w, row0 = 256 * c, chain = dir * 4 + h;
    const bf16_t* Qg = RET ? WSP(bf16_t, WS_RQ) + h * 128 : WSP(bf16_t, WS_QH) + h * 128;
    const bf16_t* Kg = WSP(bf16_t, WS_RK) + h * 128;
    const bf16_t* Vg = RET ? WSP(bf16_t, WS_RV) + h * 256 : WSP(bf16_t, WS_VH) + h * 128;
    const float* LFg = WSP(float, WS_LF) + dir * 512 + h * 128;
    bf16_t* ST = RET ? WSP(bf16_t, WS_STR) + (((size_t)chain * 65 + c) << 15) : WSP(bf16_t, WS_STH) + (((size_t)chain * 65 + c) << 14);
    const float lg = RET ? WSP(float, WS_LGAM)[(l * 2 + dir) * 4 + h] : 0.f;
    if (RET && tid < 64) { DQK[2 * tid] = fexp((float)(tid + 1) * lg); DQK[2 * tid + 1] = fexp(-(float)(tid + 1) * lg); }
    const float e2s = RET ? fexp((float)C * lg) : 1.f;

    f32x4 Sacc[8][NET];
#pragma unroll
    for (int i = 0; i < 8; ++i)
#pragma unroll
        for (int n = 0; n < NET; ++n) {
            if (MODE == 0 || zero_init) Sacc[i][n] = (f32x4){0.f, 0.f, 0.f, 0.f};
            else { const u32x2 q = *(const u32x2*)(ST + (size_t)(e0 + 16 * n + r16) * 128 + 16 * i + 4 * quad); Sacc[i][n] = (f32x4){bflo(q.x), bfhi(q.x), bflo(q.y), bfhi(q.y)}; }
        }
    float btot = 0.f;
    float lfv[8]; unsigned short qv[8]; u32x4 hv = {0, 0, 0, 0};
    u32x4 qp[2], kp[2], vp[4];
    const int hd = tid & 127, hseg = tid >> 7;
#define TOKROW(pos) (row0 + (dir ? 255 - (pos) : (pos)))
#define LOAD_CHUNK(j) do { \
        if (!RET) { _Pragma("unroll") for (int ii = 0; ii < 8; ++ii) { const size_t rr = (size_t)TOKROW(C * (j) + 8 * hseg + ii); lfv[ii] = LFg[rr * 1024 + hd]; if (MODE != 0) qv[ii] = Qg[rr * 512 + hd]; } \
            { const size_t rr = (size_t)TOKROW(C * (j) + (tid >> 4)); hv = *(const u32x4*)(Vg + rr * 512 + 8 * (tid & 15)); } } \
        else { _Pragma("unroll") for (int m = 0; m < 2; ++m) { const int pc = tid + 512 * m; const size_t rr = (size_t)TOKROW(C * (j) + (pc >> 4)); \
                if (MODE != 0) qp[m] = *(const u32x4*)(Qg + rr * 512 + 8 * (pc & 15)); kp[m] = *(const u32x4*)(Kg + rr * 512 + 8 * (pc & 15)); } \
            _Pragma("unroll") for (int m = 0; m < 4; ++m) { const int pc = tid + 512 * m; const size_t rr = (size_t)TOKROW(C * (j) + (pc >> 5)); vp[m] = *(const u32x4*)(Vg + rr * 1024 + 8 * (pc & 31)); } } \
    } while (0)
    LOAD_CHUNK(0);
    if (MODE != 0) { for (int i = tid; i < C * PS / 8; i += NT) ((MKLAS u32x4*)Pm)[i] = (u32x4){0u, 0u, 0u, 0u}; }
    __syncthreads();
    for (int j = 0; j < NCH; ++j) {
        if (!RET) {
            float pl[8]; float run = 0.f;
#pragma unroll
            for (int ii = 0; ii < 8; ++ii) { run += lfv[ii]; pl[ii] = run; }
            TOT[hseg * 128 + hd] = run;
            __syncthreads();
            const float t0 = TOT[hd], t1 = TOT[128 + hd], t2 = TOT[256 + hd], t3 = TOT[384 + hd];
            const float off = hseg == 0 ? 0.f : (hseg == 1 ? t0 : (hseg == 2 ? t0 + t1 : t0 + t1 + t2));
            const float rref = t0 + t1, blast = (t0 + t1) + (t2 + t3);
#pragma unroll
            for (int ii = 0; ii < 8; ++ii) { const int pos = 8 * hseg + ii; const float b = off + pl[ii];
                const float kk = 1.f - fexp(lfv[ii]);
                Kn[pos * QS + hd] = f2bf(kk * fexp(fminf(rref - b, 60.f)));
                if (MODE != 0) Qn[pos * QS + hd] = f2bf(bf2f(qv[ii]) * fexp(fminf(b - rref, 60.f))); }
            if (hseg == 0) { E12[hd] = fexp(rref); E12[128 + hd] = fexp(blast - rref); btot += blast; }
            *(MKLAS u32x4*)(Vn + (tid >> 4) * VS + 8 * (tid & 15)) = hv;
        } else {
#pragma unroll
            for (int m = 0; m < 2; ++m) { const int pc = tid + 512 * m, pos = pc >> 4;
                *(MKLAS u32x4*)(Kn + pos * QS + 8 * (pc & 15)) = scale_piece(kp[m], DQK[2 * pos + 1]);
                if (MODE != 0) *(MKLAS u32x4*)(Qn + pos * QS + 8 * (pc & 15)) = scale_piece(qp[m], DQK[2 * pos]); }
#pragma unroll
            for (int m = 0; m < 4; ++m) { const int pc = tid + 512 * m; *(MKLAS u32x4*)(Vn + (pc >> 5) * VS + 8 * (pc & 31)) = vp[m]; }
        }
        if (j + 1 < NCH) LOAD_CHUNK(j + 1);
        __syncthreads();
        if (MODE != 0) {
            constexpr int NTILE = NTT * (NTT + 1) / 2;
#pragma unroll
            for (int rep = 0; rep < (NTILE + 7) / 8; ++rep) {
                const int q = w + 8 * rep;
                if (q < NTILE) {
                    int tt = 0, st = q;
#pragma unroll
                    for (int z = 1; z < NTT; ++z) if (q >= z * (z + 1) / 2) { tt = z; st = q - z * (z + 1) / 2; }
                    f32x4 sc = {0.f, 0.f, 0.f, 0.f};
#pragma unroll
                    for (int ks = 0; ks < 4; ++ks) sc = MFMA16(ld_frag_row(Qn, QS, 16 * tt, 32 * ks, lane), ld_frag_row(Kn, QS, 16 * st, 32 * ks, lane), sc);
#pragma unroll
                    for (int jj = 0; jj < 4; ++jj) { const bool keep = (st < tt) || (r16 <= 4 * quad + jj); Pm[(16 * tt + 4 * quad + jj) * PS + 16 * st + r16] = f2bf(keep ? sc[jj] : 0.f); }
                }
            }
            __syncthreads();
        }
        bf16x8 Vf[NKS2][NET];
#pragma unroll
        for (int k2 = 0; k2 < NKS2; ++k2)
#pragma unroll
            for (int n = 0; n < NET; ++n) Vf[k2][n] = ld_frag_tr(Vn, VS, 32 * k2, e0 + 16 * n, lane);
        if (!RET) {
#pragma unroll
            for (int i = 0; i < 8; ++i) { const f32x4 e1 = *(const MKLAS f32x4*)(E12 + 16 * i + 4 * quad);
#pragma unroll
                for (int n = 0; n < NET; ++n) Sacc[i][n] = Sacc[i][n] * e1; }
        }
        f32x4 oacc[NTT][NET];
        if (MODE != 0) {
#pragma unroll
            for (int tt = 0; tt < NTT; ++tt)
#pragma unroll
                for (int n = 0; n < NET; ++n) oacc[tt][n] = (f32x4){0.f, 0.f, 0.f, 0.f};
#pragma unroll
            for (int ks = 0; ks < 4; ++ks) {
                bf16x8 Bf[NET];
#pragma unroll
                for (int n = 0; n < NET; ++n) Bf[n] = pack8(Sacc[2 * ks][n], Sacc[2 * ks + 1][n]);
#pragma unroll
                for (int tt = 0; tt < NTT; ++tt) {
                    const MKLAS bf16_t* qa = Qn + (16 * tt + r16) * QS + 32 * ks + 4 * quad;
                    const s16x4 a0 = *(const MKLAS s16x4*)qa, a1 = *(const MKLAS s16x4*)(qa + 16);
                    const bf16x8 Af = (bf16x8){a0[0], a0[1], a0[2], a0[3], a1[0], a1[1], a1[2], a1[3]};
#pragma unroll
                    for (int n = 0; n < NET; ++n) oacc[tt][n] = MFMA16(Bf[n], Af, oacc[tt][n]);
                }
            }
#pragma unroll
            for (int k2 = 0; k2 < NKS2; ++k2)
#pragma unroll
                for (int tt = 0; tt < NTT; ++tt) {
                    if (32 * k2 > 16 * tt + 15) continue;
                    const bf16x8 Af = ld_frag_row(Pm, PS, 16 * tt, 32 * k2, lane);
#pragma unroll
                    for (int n = 0; n < NET; ++n) oacc[tt][n] = MFMA16(Vf[k2][n], Af, oacc[tt][n]);
                }
        }
#pragma unroll
        for (int i = 0; i < 8; ++i)
#pragma unroll
            for (int k2 = 0; k2 < NKS2; ++k2) { const bf16x8 Af = ld_frag_tr(Kn, QS, 32 * k2, 16 * i, lane);
#pragma unroll
                for (int n = 0; n < NET; ++n) Sacc[i][n] = MFMA16(Af, Vf[k2][n], Sacc[i][n]); }
#pragma unroll
        for (int i = 0; i < 8; ++i) { f32x4 e2; if (!RET) e2 = *(const MKLAS f32x4*)(E12 + 128 + 16 * i + 4 * quad); else e2 = (f32x4){e2s, e2s, e2s, e2s};
#pragma unroll
            for (int n = 0; n < NET; ++n) Sacc[i][n] = Sacc[i][n] * e2; }
        if (MODE != 0) {
            bf16_t* Og = (RET ? WSP(bf16_t, WS_ORT) + h * 256 : WSP(bf16_t, WS_OHG) + h * 128) + e0 + 4 * quad;
            constexpr int OS = RET ? 1024 : 512;
            if (MODE == 1) {
#pragma unroll
                for (int tt = 0; tt < NTT; ++tt) { const size_t rr = (size_t)TOKROW(C * j + 16 * tt + r16);
#pragma unroll
                    for (int n = 0; n < NET; ++n) st_bf4(Og + rr * OS + 16 * n, oacc[tt][n]); }
            } else {
#pragma unroll
                for (int tt = 0; tt < NTT; ++tt) { float s1 = 0.f, s2 = 0.f; const size_t rb = (size_t)TOKROW(C * j + 16 * tt + r16);
#pragma unroll
                    for (int n = 0; n < NET; ++n) { const u32x2 obv = *(const u32x2*)(Og + rb * OS + 16 * n); const f32x4 v = oacc[tt][n] + (f32x4){bflo(obv.x), bfhi(obv.x), bflo(obv.y), bfhi(obv.y)}; oacc[tt][n] = v;
                        s1 += (v.x + v.y) + (v.z + v.w); s2 += (v.x * v.x + v.y * v.y) + (v.z * v.z + v.w * v.w); }
                    s1 += __shfl_xor(s1, 16); s2 += __shfl_xor(s2, 16); s1 += __shfl_xor(s1, 32); s2 += __shfl_xor(s2, 32);
                    if (quad == 0) { RED[(w * 64 + 16 * tt + r16) * 2] = s1; RED[(w * 64 + 16 * tt + r16) * 2 + 1] = s2; } }
                __syncthreads();
                const float* nw = (RET ? p.in[12] + l * 1024 + h * 256 : p.in[10] + l * 512 + h * 128) + e0 + 4 * quad;
#pragma unroll
                for (int tt = 0; tt < NTT; ++tt) { const int tpos = 16 * tt + r16; const size_t rr = (size_t)TOKROW(C * j + tpos); float s1 = 0.f, s2 = 0.f;
#pragma unroll
                    for (int ww = 0; ww < 8; ++ww) { const f32x2 q = *(const MKLAS f32x2*)(RED + (ww * 64 + tpos) * 2); s1 += q.x; s2 += q.y; }
                    const float mean = RET ? s1 * (1.f / 256.f) : 0.f;
                    const float var = RET ? fmaxf(s2 * (1.f / 256.f) - mean * mean, 0.f) : s2 * (1.f / 128.f);
                    const float rinv = 1.0f / sqrtf(var + EPS);
#pragma unroll
                    for (int n = 0; n < NET; ++n) st_bf4(Og + rr * OS + 16 * n, (oacc[tt][n] - mean) * rinv * *(const f32x4*)(nw + 16 * n)); }
            }
        }
        if (RET) __syncthreads();
    }
    if (MODE == 0) {
#pragma unroll
        for (int i = 0; i < 8; ++i)
#pragma unroll
            for (int n = 0; n < NET; ++n) { u32x2 q; q.x = cvt_pk_bf16(Sacc[i][n].x, Sacc[i][n].y); q.y = cvt_pk_bf16(Sacc[i][n].z, Sacc[i][n].w);
                *(u32x2*)(ST + (size_t)(e0 + 16 * n + r16) * 128 + 16 * i + 4 * quad) = q; }
        if (!RET && hseg == 0) WSP(float, WS_ATOT)[((size_t)chain * 65 + c) * 128 + hd] = fexp(btot);
    }
#undef LOAD_CHUNK
#undef TOKROW
}

__device__ __forceinline__ int next_unit(unsigned* ctr, volatile MKLAS int* slot) {
    __syncthreads();
    if (threadIdx.x == 0) *slot = (int)__hip_atomic_fetch_add(ctr, 1u, __ATOMIC_RELAXED, __HIP_MEMORY_SCOPE_AGENT);
    __syncthreads();
    return *slot;
}
__device__ __forceinline__ void ph_scan_pass1(const P& p, int l, MKLAS unsigned char* lds, unsigned* ctr, volatile MKLAS int* slot) {
    const int nctx = (l == DEPTH - 1) ? 0 : 8;
    for (;;) { const int u0 = next_unit(ctr, slot); if (u0 >= 1040 + nctx) break;
        if (u0 < nctx) { const int h = u0 & 3;
            if (u0 < 4) { scan_unit<true, 1>(p, l, h, 0, 1, lds, true); __syncthreads(); scan_unit<true, 2>(p, l, h, 0, 0, lds, true); }
            else { scan_unit<false, 1>(p, l, h, 0, 1, lds, true); __syncthreads(); scan_unit<false, 2>(p, l, h, 0, 0, lds, true); }
            continue; }
        const int u = u0 - nctx;
        const bool ret = u < 520; const int v = ret ? u : u - 520, dir = v / 260, rem = v % 260, h = rem / 65, c = rem % 65;
        if (ret) scan_unit<true, 0>(p, l, h, c, dir, lds); else scan_unit<false, 0>(p, l, h, c, dir, lds); }
}
__device__ __forceinline__ void ph_scan_pass3(const P& p, int l, MKLAS unsigned char* lds) {
    for (int u = blockIdx.x; u < 512; u += gridDim.x) {
        const bool ret = u < 256; const int v = ret ? u : u - 256, h = v >> 6, c = (v & 63) + 1;
        __syncthreads();
        if (ret) { scan_unit<true, 1>(p, l, h, c, 1, lds); __syncthreads(); scan_unit<true, 2>(p, l, h, c, 0, lds); }
        else { scan_unit<false, 1>(p, l, h, c, 1, lds); __syncthreads(); scan_unit<false, 2>(p, l, h, c, 0, lds); } }
}
__device__ __forceinline__ void ph_scan_pass2(const P& p, int l) {
    const int tid = tid_fresh();
    const float* LG = WSP(float, WS_LGAM); const float* AT = WSP(float, WS_ATOT);
    for (int item = blockIdx.x * NT + tid; item < 32768 + 65536; item += gridDim.x * NT) {
        const bool ret = item >= 32768; const int it = ret ? item - 32768 : item, per = ret ? 8192 : 4096, chain = it / per, q4 = it % per, dir = chain >> 2, h = chain & 3, dd = (q4 * 4) & 127;
        bf16_t* base = (ret ? WSP(bf16_t, WS_STR) : WSP(bf16_t, WS_STH)) + (size_t)chain * 65 * (per * 4) + (size_t)q4 * 4;
        const float ar = ret ? fexp(256.f * LG[(l * 2 + dir) * 4 + h]) : 0.f;
        f32x4 S = {0.f, 0.f, 0.f, 0.f};
        for (int b0 = 0; b0 < 65; b0 += 13) {
            u32x2 U[13]; f32x4 A[13];
#pragma unroll
            for (int s = 0; s < 13; ++s) { const int step = b0 + s, c = dir == 0 ? step : (step == 0 ? 0 : 65 - step);
                U[s] = *(const u32x2*)(base + (size_t)c * (per * 4));
                A[s] = ret ? (f32x4){ar, ar, ar, ar} : *(const f32x4*)(AT + ((size_t)chain * 65 + c) * 128 + dd); }
#pragma unroll
            for (int s = 0; s < 13; ++s) { const int step = b0 + s, c = dir == 0 ? step : (step == 0 ? 0 : 65 - step);
                u32x2 o; o.x = cvt_pk_bf16(S.x, S.y); o.y = cvt_pk_bf16(S.z, S.w); *(u32x2*)(base + (size_t)c * (per * 4)) = o;
                S = A[s] * S + (f32x4){bflo(U[s].x), bfhi(U[s].x), bflo(U[s].y), bfhi(U[s].y)}; }
        }
    }
}

__device__ __forceinline__ void ph_router(const P& p, int l, MKLAS unsigned char* lds, unsigned* ecnt) {
    const int tid = tid_fresh(), lane = tid & 63, w = __builtin_amdgcn_readfirstlane(tid >> 6), r16 = lane & 15, g = lane >> 4;
    MKLAS float* ssum = (MKLAS float*)lds;
    MKLAS float* plog = ssum + 128;
    MKLAS float* lg = plog + 8 * 16 * 52;
    const float* MOD = WSP(float, WS_MOD); bf16_t* H = WSP(bf16_t, WS_H);
    int* AE = WSP(int, WS_AE); float* AW = WSP(float, WS_AW); int* APOS = WSP(int, WS_APOS); int* TOK = WSP(int, WS_TOK);
    const int cb = 128 * w + 4 * g;
    const float* nw = p.in[7] + l * D + cb;
    const float* WRT = WSP(float, WS_WRT) + (size_t)l * 48 * 1024 + (size_t)r16 * 1024 + cb;
    const float *bg = p.in[17] + l * 4, *be = p.in[19] + l * NE;
    const int r_lo = (l == DEPTH - 1) ? LC : 0, ntile = (L - r_lo) / 16;
    f32x4 bw[8][3];
#pragma unroll
    for (int m = 0; m < 8; ++m)
#pragma unroll
        for (int nt = 0; nt < 3; ++nt) bw[m][nt] = *(const f32x4*)(WRT + (size_t)nt * 16 * 1024 + 16 * m);
    for (int t = blockIdx.x; t < ntile; t += gridDim.x) {
        const int r = r_lo + 16 * t + r16;
        const float* xr = xrow_st(p, r) + cb;
        const float* mod = MOD + (l * 2 + (r < LC ? 1 : 0)) * 6144 + cb;
        f32x4 x[8]; float ss = 0.f;
#pragma unroll
        for (int m = 0; m < 8; ++m) { x[m] = *(const f32x4*)(xr + 16 * m); ss += (x[m].x * x[m].x + x[m].y * x[m].y) + (x[m].z * x[m].z + x[m].w * x[m].w); }
        ss += __shfl_xor(ss, 16); ss += __shfl_xor(ss, 32);
        if (g == 0) ssum[w * 16 + r16] = ss;
        __syncthreads();
        float tot = 0.f;
#pragma unroll
        for (int ww = 0; ww < 8; ++ww) tot += ssum[ww * 16 + r16];
        const float rinv = 1.0f / sqrtf(tot * (1.f / D) + EPS);
        f32x4 acc[3];
#pragma unroll
        for (int nt = 0; nt < 3; ++nt) acc[nt] = (f32x4){0.f, 0.f, 0.f, 0.f};
        bf16_t* ho = H + (size_t)r * D + cb;
#pragma unroll
        for (int m = 0; m < 8; ++m) {
            const f32x4 wv = *(const f32x4*)(nw + 16 * m), sh = *(const f32x4*)(mod + 3 * 1024 + 16 * m), sc = *(const f32x4*)(mod + 4 * 1024 + 16 * m);
            const f32x4 h = x[m] * rinv * wv * (sc + 1.0f) + sh;
            st_bf4(ho + 16 * m, h);
#pragma unroll
            for (int nt = 0; nt < 3; ++nt) { const f32x4 b = bw[m][nt];
#pragma unroll
                for (int j = 0; j < 4; ++j) acc[nt] = __builtin_amdgcn_mfma_f32_16x16x4f32(h[j], b[j], acc[nt], 0, 0, 0); }
        }
#pragma unroll
        for (int nt = 0; nt < 3; ++nt)
#pragma unroll
            for (int j = 0; j < 4; ++j) plog[(w * 16 + 4 * g + j) * 52 + 16 * nt + r16] = acc[nt][j];
        __syncthreads();
        { const int row = tid >> 5, col = tid & 31; float a = 0.f;
#pragma unroll
            for (int ww = 0; ww < 8; ++ww) a += plog[(ww * 16 + row) * 52 + col];
            lg[row * 52 + col] = a;
            if (tid < 64) { const int row2 = tid >> 2, col2 = 32 + (tid & 3); float a2 = 0.f;
#pragma unroll
                for (int ww = 0; ww < 8; ++ww) a2 += plog[(ww * 16 + row2) * 52 + col2];
                lg[row2 * 52 + col2] = a2; } }
        __syncthreads();
        if (tid < 16) {
            const MKLAS float* my = lg + tid * 52;
            float gl[4];
#pragma unroll
            for (int q = 0; q < 4; ++q) gl[q] = my[32 + q] + bg[q];
            int grp = 0; float gm = gl[0];
#pragma unroll
            for (int q = 1; q < 4; ++q) if (gl[q] > gm) { gm = gl[q]; grp = q; }
            float gs = 0.f;
#pragma unroll
            for (int q = 0; q < 4; ++q) gs += expf(gl[q] - gm);
            const float gval = 1.0f / gs;
            float el[8];
#pragma unroll
            for (int j = 0; j < 8; ++j) el[j] = my[grp * 8 + j] + be[grp * 8 + j];
            int i1 = 0; float v1 = el[0];
#pragma unroll
            for (int j = 1; j < 8; ++j) if (el[j] > v1) { v1 = el[j]; i1 = j; }
            int i2 = -1; float v2 = -3.0e38f;
#pragma unroll
            for (int j = 0; j < 8; ++j) if (j != i1 && el[j] > v2) { v2 = el[j]; i2 = j; }
            const float e2 = expf(v2 - v1), w1 = 1.0f / (1.0f + e2), w2 = e2 / (1.0f + e2);
            const int ea0 = grp * 8 + i1, ea1 = grp * 8 + i2, rr = r_lo + 16 * t + tid;
            AE[2 * rr] = ea0; AE[2 * rr + 1] = ea1; AW[2 * rr] = gval * w1; AW[2 * rr + 1] = gval * w2;
            const int p0 = (int)__hip_atomic_fetch_add(ecnt + 16 * ea0, 1u, __ATOMIC_RELAXED, __HIP_MEMORY_SCOPE_AGENT);
            const int p1 = (int)__hip_atomic_fetch_add(ecnt + 16 * ea1, 1u, __ATOMIC_RELAXED, __HIP_MEMORY_SCOPE_AGENT);
            APOS[2 * rr] = p0; APOS[2 * rr + 1] = p1; TOK[(size_t)ea0 * L + p0] = rr; TOK[(size_t)ea1 * L + p1] = rr;
        }
    }
}
constexpr int XG_ROWS = 41472;
constexpr size_t WS_WGU = WS_OF, WS_WD = WS_OF + 32 * MiB;
constexpr size_t WS_XG = WS_QH, WS_ACT = WS_XG + (size_t)XG_ROWS * 2048, WS_YA = 160 * MiB;
static_assert(WS_ACT + (size_t)XG_ROWS * 512 <= WS_YA && WS_YA + (size_t)XG_ROWS * 2048 <= WS_OF, "MoE overlays");
constexpr int EXPERT_ITEMS = 3 * 512;
__device__ __forceinline__ void expert_item(const P& p, int l, int it, MKLAS float* tile) {
    const int which = it >> 9, r = it & 511;
    if (which < 2) { const int e = r >> 4, kb = r & 15;
        const float* W = p.in[20 + which] + ((size_t)l * NE + e) * D * DE; bf16_t* WT = WSP(bf16_t, WS_WGU) + (size_t)e * 512 * D;
#pragma unroll
        for (int j = 0; j < 4; ++j) tr_load(W, DE, kb * 64, j * 64, tile + j * TRT);
        __syncthreads();
#pragma unroll
        for (int j = 0; j < 4; ++j) { const int n0 = j * 64; tr_store(WT, D, kb * 64, (n0 >> 7) * 256 + which * 128 + (n0 & 127), tile + j * TRT); }
        __syncthreads(); }
    else { const int e = r >> 4, kb = (r >> 2) & 3, ng = r & 3;
        const float* W = p.in[22] + ((size_t)l * NE + e) * DE * D; bf16_t* WT = WSP(bf16_t, WS_WD) + (size_t)e * D * DE;
#pragma unroll
        for (int j = 0; j < 4; ++j) tr_load(W, D, kb * 64, (ng * 4 + j) * 64, tile + j * TRT);
        __syncthreads();
#pragma unroll
        for (int j = 0; j < 4; ++j) tr_store(WT, DE, kb * 64, (ng * 4 + j) * 64, tile + j * TRT);
        __syncthreads(); }
}
template <bool EXPERTS> __device__ __forceinline__ void fill_convert(const P& p, int l, MKLAS unsigned char* lds, unsigned* ctr, volatile MKLAS int* slot) {
    for (;;) { const int it = next_unit(ctr, slot); if (it >= (EXPERTS ? EXPERT_ITEMS : MIXER_ITEMS)) break;
        if (EXPERTS) expert_item(p, l, it, (MKLAS float*)lds); else mixer_item(p, l, it, (MKLAS float*)lds); }
}
constexpr int MOE_TAB = LDS_CTL_OFF + 64;
__device__ __forceinline__ void moe_tables(const P& p, int l, MKLAS unsigned char* lds, bool publish) {
    MKLAS int* off = (MKLAS int*)(lds + MOE_TAB); MKLAS int* cnt = off + 64; MKLAS int* te = off + 96;
    const unsigned* ecnt = (const unsigned*)(p.ws + WS_CTL) + CW_ECNT + l * NE * 16;
    const int tid = tid_fresh();
    __syncthreads();
    if (tid == 0) { int o = 0; for (int e = 0; e < NE; ++e) { const int c = (int)__hip_atomic_load(ecnt + 16 * e, __ATOMIC_RELAXED, __HIP_MEMORY_SCOPE_AGENT); off[e] = o; cnt[e] = c; o += (c + 255) & ~255; } off[NE] = o; off[NE + 1] = o >> 8; }
    __syncthreads();
    const int nt = off[NE + 1];
    for (int t = tid; t < nt; t += NT) { int e = 0; for (int k = 1; k < NE; ++k) if (t * 256 >= off[k]) e = k; te[t] = e; }
    __syncthreads();
    if (publish && blockIdx.x == 0) { int* TE = WSP(int, WS_TILEE); if (tid == 0) TE[255] = nt; for (int t = tid; t < nt; t += NT) TE[t] = te[t]; }
}
struct MoeOrder { static constexpr bool GATHER = false; const int* tile_e; int ntiles, nN, G, c;
    __device__ __forceinline__ bool next(int i, pg8::Unit& u) const { const long Lx = (long)i * G + c; if (Lx >= (long)ntiles * nN) return false; u.pm = (int)(Lx / nN); u.pn = (int)(Lx % nN); u.be = tile_e[u.pm]; return true; }
    __device__ __forceinline__ void a_ready(const pg8::Unit&) const {}
    __device__ __forceinline__ void done(const pg8::Unit&) const {} };
struct MoeGatherOrder { static constexpr bool GATHER = true; const MKLAS int* off; const MKLAS int* cnt; const MKLAS int* te; const int* tok; int ntiles, nN, G, c;
    __device__ __forceinline__ bool next(int i, pg8::Unit& u) const { const long Lx = (long)i * G + c; if (Lx >= (long)ntiles * nN) return false; u.pm = (int)(Lx / nN); u.pn = (int)(Lx % nN); u.be = te[u.pm]; return true; }
    __device__ __forceinline__ unsigned row_byte_off(const pg8::Unit& u, int r) const { const int pos = 256 * u.pm - off[u.be] + r; const int t = pos < cnt[u.be] ? tok[(size_t)u.be * L + pos] : 0; return (unsigned)t * (unsigned)(D * 2); }
    __device__ __forceinline__ void a_ready(const pg8::Unit&) const {}
    __device__ __forceinline__ void done(const pg8::Unit&) const {} };
struct EpiGU { static constexpr bool PERM = true, AFTER_DRAIN = false; bf16_t* ACT;
    __device__ __forceinline__ void operator()(const f32x4 (&acc)[2][2][4][2], const pg8::Unit& u, int wr, int wc, int fr, int fq) const {
        const int row0 = u.pm * 256 + wr * 64 + fr, col0 = u.pn * 128 + wc * 32 + 8 * fq;
#pragma unroll
        for (int ai = 0; ai < 2; ++ai)
#pragma unroll
            for (int m = 0; m < 4; ++m) st_bf8(ACT + (size_t)(row0 + ai * 128 + m * 16) * DE + col0, silu4(acc[ai][0][m][0]) * acc[ai][1][m][0], silu4(acc[ai][0][m][1]) * acc[ai][1][m][1]);
    } };
struct FnYA { bf16_t* YA;
    static constexpr bool HAS_LOAD = false; typedef NoRegs R;
    __device__ __forceinline__ void apply8(int row, int col, f32x4 v0, f32x4 v1, const R&, const pg8::Unit&) const { st_bf8(YA + (size_t)row * D + col, v0, v1); } };
__device__ __forceinline__ void ph_moe_combine(const P& p, int l, MKLAS unsigned char* lds) {
    moe_tables(p, l, lds, false);
    const MKLAS int* off = (const MKLAS int*)(lds + MOE_TAB);
    const int tid_ = tid_fresh(), lane = tid_ & 63, wave = tid_ >> 6;
    const float* MOD = WSP(float, WS_MOD); const bf16_t* YA = WSP(bf16_t, WS_YA); bf16_t* H = WSP(bf16_t, WS_H);
    const int* AE = WSP(int, WS_AE); const int* APOS = WSP(int, WS_APOS); const float* AW = WSP(float, WS_AW);
    const bool last = (l == DEPTH - 1);
    const float* nw = last ? p.in[23] : p.in[6] + (l + 1) * D;
    for (int r = (last ? LC : 0) + blockIdx.x * NW + wave; r < L; r += gridDim.x * NW) {
        const int isc = r < LC ? 1 : 0;
        const float* g2 = MOD + (l * 2 + isc) * 6144 + 5 * 1024;
        float* xo = xrow_st(p, r);
        const int sa = off[AE[2 * r]] + APOS[2 * r], sb = off[AE[2 * r + 1]] + APOS[2 * r + 1]; const float wa = AW[2 * r], wb = AW[2 * r + 1];
        const u32x2* ya = (const u32x2*)(YA + (size_t)sa * D) + lane; const u32x2* yb = (const u32x2*)(YA + (size_t)sb * D) + lane;
        f32x4 v[4]; float ss = 0.f;
#pragma unroll
        for (int j = 0; j < 4; ++j) { const int c = 4 * (lane + 64 * j); const u32x2 a = ya[64 * j], b = yb[64 * j];
            const f32x4 y = (f32x4){wa * bflo(a.x) + wb * bflo(b.x), wa * bfhi(a.x) + wb * bfhi(b.x), wa * bflo(a.y) + wb * bflo(b.y), wa * bfhi(a.y) + wb * bfhi(b.y)};
            v[j] = *(const f32x4*)(xo + c) + *(const f32x4*)(g2 + c) * y;
            ss += (v[j].x * v[j].x + v[j].y * v[j].y) + (v[j].z * v[j].z + v[j].w * v[j].w); }
        const float rinv = 1.0f / sqrtf(wave_sum(ss) * (1.f / D) + EPS);
        if (last) {
#pragma unroll
            for (int j = 0; j < 4; ++j) { const int c = 4 * (lane + 64 * j); *(f32x4*)(xo + c) = v[j] * rinv * *(const f32x4*)(nw + c); }
        } else {
            const float* mod = MOD + ((l + 1) * 2 + isc) * 6144;
            u32x2* o = (u32x2*)(H + (size_t)r * D) + lane;
#pragma unroll
            for (int j = 0; j < 4; ++j) { const int c = 4 * (lane + 64 * j); *(f32x4*)(xo + c) = v[j];
                const f32x4 hh = v[j] * rinv * *(const f32x4*)(nw + c) * (*(const f32x4*)(mod + 1024 + c) + 1.0f) + *(const f32x4*)(mod + c);
                u32x2 q; q.x = cvt_pk_bf16(hh.x, hh.y); q.y = cvt_pk_bf16(hh.z, hh.w); o[64 * j] = q; }
        }
    }
}

constexpr int LDS_BYTES = 147456, LDS_CTL = LDS_CTL_OFF;
constexpr int NPH_LAYER = 12, NPH = 1 + DEPTH * NPH_LAYER;

__device__ __forceinline__ void ph_prologue(const P& p, MKLAS unsigned char* lds) {
    const int tid = tid_fresh(), b = blockIdx.x, G = gridDim.x;
    MKLAS float* s0 = (MKLAS float*)lds;
    MKLAS float* red = s0 + 2048;
    for (int i = tid; i < 1024; i += NT) { s0[i] = siluf(p.in[1][i]); s0[1024 + i] = siluf(p.in[3][i]); }
    __syncthreads();
    float* MOD = WSP(float, WS_MOD);
    for (int u = b; u < DEPTH * 96; u += G) {
        const int l = u / 96, n0 = (u % 96) * 64, c = tid & 63, ks = tid >> 6;
        const float* W = p.in[4] + (size_t)l * 1024 * 6144 + n0 + c;
        float a0 = 0.f, a1 = 0.f;
#pragma unroll 8
        for (int i = 0; i < 128; ++i) { const int k = ks * 128 + i; const float w = W[(size_t)k * 6144]; a0 += s0[k] * w; a1 += s0[1024 + k] * w; }
        red[(ks * 64 + c) * 2] = a0; red[(ks * 64 + c) * 2 + 1] = a1;
        __syncthreads();
        if (tid < 128) { const int cc = tid & 63, w = tid >> 6; float s = 0.f;
#pragma unroll
            for (int k2 = 0; k2 < 8; ++k2) s += red[(k2 * 64 + cc) * 2 + w];
            MOD[(l * 2 + w) * 6144 + n0 + cc] = s + p.in[5][l * 6144 + n0 + cc]; }
        __syncthreads();
    }
    if (b == G - 1) {
        float* LB = WSP(float, WS_LB);
        for (int idx = tid; idx < 2 * 512; idx += NT) { const int dir = idx >> 9, ch = idx & 511;
            float x[DEPTH], m = -3.0e38f;
#pragma unroll
            for (int l = 0; l < DEPTH; ++l) { x[l] = p.in[9][(dir * DEPTH + l) * 512 + ch]; m = fmaxf(m, x[l]); }
            float s = 0.f;
#pragma unroll
            for (int l = 0; l < DEPTH; ++l) { x[l] = expf(x[l] - m); s += x[l]; }
            float cum = 0.f; const float p0 = x[0] / s;
#pragma unroll
            for (int l = 0; l < DEPTH; ++l) { cum += x[l] / s; LB[(dir * DEPTH + l) * 512 + ch] = fminf(fmaxf(cum - p0, 0.f), 1.0f - 1e-6f); } }
    }
    if (b == (G > 1 ? G - 2 : 0)) {
        float* RT = WSP(float, WS_ROPE);
        for (int idx = tid; idx < 256 * 32; idx += NT) { const int pos = idx >> 5, i = idx & 31;
            double bp = 1.0; for (int q = 0; q < i; ++q) bp *= 0.7498942093324559;
            const float inv = (float)bp; const float ang = (float)pos * inv;
            const double a = (double)ang, n = rint(a * 0.15915494309189535), r = a - n * 6.283185307179586, r2 = r * r;
            double ts = r, tc = 1.0, sn = r, cs = 1.0;
            for (int k = 1; k <= 14; ++k) { tc *= -r2 / (double)((2 * k - 1) * (2 * k)); cs += tc; ts *= -r2 / (double)((2 * k) * (2 * k + 1)); sn += ts; }
            RT[idx * 2] = (float)cs; RT[idx * 2 + 1] = (float)sn; }
    }
    if (b == (G > 2 ? G - 3 : 0)) {
        float* LG = WSP(float, WS_LGAM);
        if (tid < DEPTH * 2 * 4) LG[tid] = -log1pf(expf(-p.in[11][tid]));
    }
    { float* WRT = WSP(float, WS_WRT);
        for (int idx = b * NT + tid; idx < DEPTH * 48 * 1024; idx += G * NT) { const int l = idx / (48 * 1024), n = (idx >> 10) % 48, k = idx & 1023;
            WRT[idx] = n < 32 ? p.in[18][((size_t)l * D + k) * NE + n] : (n < 36 ? p.in[16][((size_t)l * D + k) * 4 + (n - 32)] : 0.f); } }
    fill_convert<false>(p, 0, lds, (unsigned*)(p.ws + WS_CTL) + CW_CNT + 64 * 12, (volatile MKLAS int*)(lds + LDS_CTL + 8));
}


template <class F> __device__ __forceinline__ void ctx_gemm(MKLAS unsigned char* lds, const bf16_t* A, const bf16_t* Bt, int N, int K, const F& f) {
    const int tid = tid_fresh(), lane = tid & 63, w = __builtin_amdgcn_readfirstlane(tid >> 6), r16 = lane & 15, g = lane >> 4;
    const int br = w & 1, bc = (w >> 1) & 1, kh = w >> 2;
    MKLAS f32x4* red = (MKLAS f32x4*)lds;
    const int nitems = 4 * (N / 64), kspan = K / 2;
    for (int it = blockIdx.x; it < nitems; it += gridDim.x) {
        const int ir = it & 3, ic = it >> 2;
        const bf16_t* ap = A + (size_t)(64 * ir + 32 * br + r16) * K + kh * kspan + 8 * g;
        const bf16_t* bp = Bt + (size_t)(64 * ic + 32 * bc + r16) * K + kh * kspan + 8 * g;
        f32x4 acc[2][2];
#pragma unroll
        for (int i = 0; i < 2; ++i)
#pragma unroll
            for (int jn = 0; jn < 2; ++jn) acc[i][jn] = (f32x4){0.f, 0.f, 0.f, 0.f};
#pragma unroll 8
        for (int ks = 0; ks < kspan / 32; ++ks) {
            const bf16x8 a0 = *(const bf16x8*)(ap + 32 * ks), a1 = *(const bf16x8*)(ap + (size_t)16 * K + 32 * ks);
            const bf16x8 b0 = *(const bf16x8*)(bp + 32 * ks), b1 = *(const bf16x8*)(bp + (size_t)16 * K + 32 * ks);
            acc[0][0] = MFMA16(b0, a0, acc[0][0]); acc[0][1] = MFMA16(b1, a0, acc[0][1]); acc[1][0] = MFMA16(b0, a1, acc[1][0]); acc[1][1] = MFMA16(b1, a1, acc[1][1]);
        }
        if (kh) {
#pragma unroll
            for (int i = 0; i < 2; ++i)
#pragma unroll
                for (int jn = 0; jn < 2; ++jn) red[((w - 4) * 4 + i * 2 + jn) * 64 + lane] = acc[i][jn];
        }
        __syncthreads();
        if (!kh) { pg8::Unit u; u.pm = 0; u.pn = (64 * ic) >> 8; u.be = 0;
#pragma unroll
            for (int i = 0; i < 2; ++i)
#pragma unroll
                for (int jn = 0; jn < 2; ++jn) f(64 * ir + 32 * br + 16 * i + r16, 64 * ic + 32 * bc + 16 * jn + 4 * g, acc[i][jn] + red[(w * 4 + i * 2 + jn) * 64 + lane], u); }
        __syncthreads();
    }
}
struct LatentOrder : pg8::StaticOrder {
    __device__ __forceinline__ bool next(int i, pg8::Unit& u) const { if (!pg8::StaticOrder::next(i, u)) return false; u.pm += 1; return true; } };
template <class F> __device__ __forceinline__ void run_gemm_latent(MKLAS unsigned char* lds, const bf16_t* A, const bf16_t* Bt, int N, int K, const F& f) {
    pg8::Gemm g{A, Bt, L, N, K, 0}; LatentOrder S; S.init(T, N, (int)gridDim.x, (int)blockIdx.x);
    EpiGen<F> E{f};
    pg8::gemm_phase<EpiGen<F>, LatentOrder, false>(lds, g, S, E, nullptr);
}
template <class F> __device__ __forceinline__ void run_gemm(MKLAS unsigned char* lds, const bf16_t* A, const bf16_t* Bt, int M, int N, int K, const F& f) {
    pg8::Gemm g{A, Bt, M, N, K, 0}; pg8::StaticOrder S; S.init(M, N, (int)gridDim.x, (int)blockIdx.x);
    EpiGen<F> E{f};
    pg8::gemm_phase<EpiGen<F>, pg8::StaticOrder, false>(lds, g, S, E, nullptr);
}

#ifndef MK_MASK
#define MK_MASK 0xfffff
#endif
#define KON(j) ((MK_MASK >> (j)) & 1)
#define IN(k) (lo <= (k) && (k) < hi)
#ifndef MK_PROBE
#define MK_PROBE 0
#endif
#ifndef MK_PROBE_WORK
#define MK_PROBE_WORK 0u
#endif
#ifndef MK_PROBE_WAIT
#define MK_PROBE_WAIT 0u
#endif
#if MK_PROBE
#define PROBE_MARK(kind, iswait) do { if (blockIdx.x == 0 && threadIdx.x == 0) { const unsigned long long now_ = wall_clock64(); const unsigned long long d_ = now_ - *(volatile MKLAS unsigned long long*)(lctl + 4); \
        if ((((iswait) ? MK_PROBE_WAIT : MK_PROBE_WORK) >> (kind)) & 1u) *(volatile MKLAS unsigned long long*)(lctl + 6) += d_; *(volatile MKLAS unsigned long long*)(lctl + 4) = now_; } } while (0)
#else
#define PROBE_MARK(kind, iswait) do { } while (0)
#endif
#define SEAMK(k, kind) do { PROBE_MARK(kind, 0); if (IN(k) && IN((k) + 1)) { xcd_barrier(bar); } PROBE_MARK(kind, 1); } while (0)
template <int l> __device__ __forceinline__ void run_layer(const P& p, MKLAS unsigned char* lds, const XcdBarrier& bar, const int lo, const int hi, volatile MKLAS unsigned* lctl) {
    constexpr bool last = (l == DEPTH - 1);
    const int b = 1 + l * NPH_LAYER;
    unsigned* const ctl = (unsigned*)(p.ws + WS_CTL);
    volatile MKLAS int* const slot = (volatile MKLAS int*)(lctl + 2);
    if (KON(1) && IN(b + 0)) { if (l == 0) ph_hnorm(p, l); } SEAMK(b + 0, 1);
    if (KON(2) && IN(b + 1)) { FnA f{WSP(bf16_t, WS_QH), WSP(bf16_t, WS_VH), WSP(bf16_t, WS_RQ), WSP(bf16_t, WS_RK), WSP(bf16_t, WS_RV), WSP(float, WS_LF), WSP(float, WS_LB) + l * 512, WSP(float, WS_ROPE)};
        ctx_gemm(lds, WSP(bf16_t, WS_H), WSP(bf16_t, WS_WIN), NA, D, f);
        run_gemm_latent(lds, WSP(bf16_t, WS_H), WSP(bf16_t, WS_WIN), NA, D, f); } SEAMK(b + 1, 2);
    if (KON(3) && IN(b + 2)) { ph_scan_pass1(p, l, lds, ctl + CW_CNT + 64 * (l * 4 + 0), slot); } SEAMK(b + 2, 4);
    if (KON(3) && IN(b + 3)) { ph_scan_pass2(p, l); } SEAMK(b + 3, 5);
    if (KON(4) && IN(b + 4)) { ph_scan_pass3(p, l, lds); } SEAMK(b + 4, 7);
    if (KON(5) && IN(b + 5)) { FnB f{WSP(bf16_t, WS_OHG), WSP(bf16_t, WS_ORT), WSP(bf16_t, WS_GA), WSP(bf16_t, WS_GB)};
        if (last) run_gemm_latent(lds, WSP(bf16_t, WS_H), WSP(bf16_t, WS_WIN) + (size_t)NA * D, NB, D, f); else run_gemm(lds, WSP(bf16_t, WS_H), WSP(bf16_t, WS_WIN) + (size_t)NA * D, L, NB, D, f);
        fill_convert<true>(p, l, lds, ctl + CW_CNT + 64 * (8 + l * 2 + 0), slot); } SEAMK(b + 5, 8);
    if (KON(7) && IN(b + 6)) {
        { FnM1 f{WSP(bf16_t, WS_GA), WSP(float, WS_M1)};
          if (!last) ctx_gemm(lds, WSP(bf16_t, WS_OHG), WSP(bf16_t, WS_WOHG), D, 512, f);
          run_gemm_latent(lds, WSP(bf16_t, WS_OHG), WSP(bf16_t, WS_WOHG), D, 512, f); }
        { FnM2 f{WSP(bf16_t, WS_GB), WSP(float, WS_M1), WSP(bf16_t, WS_MB)};
          if (!last) ctx_gemm(lds, WSP(bf16_t, WS_ORT), WSP(bf16_t, WS_WORET), D, D, f);
          run_gemm_latent(lds, WSP(bf16_t, WS_ORT), WSP(bf16_t, WS_WORET), D, D, f); } } SEAMK(b + 6, 10);
    if (KON(8) && IN(b + 7)) { FnX f{l == 0 ? p.in[2] : WSP(float, WS_CTX), l == 0 ? p.in[0] : p.out, WSP(float, WS_CTX), p.out, WSP(float, WS_MOD) + l * 2 * 6144};
        if (!last) ctx_gemm(lds, WSP(bf16_t, WS_MB), WSP(bf16_t, WS_WOUT), D, D, f);
        run_gemm_latent(lds, WSP(bf16_t, WS_MB), WSP(bf16_t, WS_WOUT), D, D, f); } SEAMK(b + 7, 11);
    if (KON(9) && IN(b + 8)) { ph_router(p, l, lds, ctl + CW_ECNT + l * NE * 16); } SEAMK(b + 8, 12);
    if (KON(11) && IN(b + 9)) { moe_tables(p, l, lds, true);
        const MKLAS int* tb = (const MKLAS int*)(lds + MOE_TAB);
        MoeGatherOrder S{tb, tb + 64, tb + 96, WSP(int, WS_TOK), tb[NE + 1], 2, (int)gridDim.x, (int)blockIdx.x};
        pg8::Gemm g{WSP(bf16_t, WS_H), WSP(bf16_t, WS_WGU), XG_ROWS, 512, D, (size_t)512 * D * 2}; EpiGU E{WSP(bf16_t, WS_ACT)};
        pg8::gemm_phase<EpiGU, MoeGatherOrder, false>(lds, g, S, E, nullptr);
        if (!last) fill_convert<false>(p, l + 1, lds, ctl + CW_CNT + 64 * (8 + l * 2 + 1), slot); } SEAMK(b + 9, 14);
    if (KON(12) && IN(b + 10)) { const int* TE = WSP(int, WS_TILEE); MoeOrder S{TE, TE[255], 4, (int)gridDim.x, (int)blockIdx.x};
        pg8::Gemm g{WSP(bf16_t, WS_ACT), WSP(bf16_t, WS_WD), XG_ROWS, D, DE, (size_t)D * DE * 2}; EpiGen<FnYA> E{FnYA{WSP(bf16_t, WS_YA)}};
        pg8::gemm_phase<EpiGen<FnYA>, MoeOrder, false>(lds, g, S, E, nullptr); } SEAMK(b + 10, 15);
    if (KON(13) && IN(b + 11)) { ph_moe_combine(p, l, lds); } SEAMK(b + 11, 16);
}

__global__ void __launch_bounds__(NT, 2) fwd(P p) {
    extern __shared__ __attribute__((aligned(16))) unsigned char lds_raw[];
    MKLAS unsigned char* lds = (MKLAS unsigned char*)lds_raw;
    volatile MKLAS unsigned* lctl = (volatile MKLAS unsigned*)(lds + LDS_CTL);
    if (threadIdx.x < 8) lctl[threadIdx.x] = 0u;
    __syncthreads();
#if MK_PROBE
    if (blockIdx.x == 0 && threadIdx.x == 0) *(volatile MKLAS unsigned long long*)(lctl + 4) = wall_clock64();
#endif
    const int lo = p.ph_lo, hi = p.ph_hi;
    const bool multi = (hi - lo) > 1;
    XcdBarrier bar; bar.bar = (unsigned*)(p.ws + WS_CTL) + CW_BAR; bar.x = 0; bar.st = nullptr;
    if (multi) bar = xcd_barrier_post((unsigned*)(p.ws + WS_CTL) + CW_BAR, lctl);
    if (KON(0) && IN(0)) { ph_prologue(p, lds); } SEAMK(0, 0);
    run_layer<0>(p, lds, bar, lo, hi, lctl);
    run_layer<1>(p, lds, bar, lo, hi, lctl);
    static_assert(DEPTH == 2, "two layers written out");
#if MK_PROBE
    if (blockIdx.x == 0 && threadIdx.x == 0) { const unsigned long long t0_ = wall_clock64(), d_ = 4ull * *(volatile MKLAS unsigned long long*)(lctl + 6); while (wall_clock64() - t0_ < d_) __builtin_amdgcn_s_sleep(8); }
#endif
#undef IN
}
}

#ifndef MK_ONE_LAUNCH
#define MK_ONE_LAUNCH 1
#endif
extern "C" void kernel_launch(void* const* d_in, const int* in_sizes, int n_in, void* d_out, int out_size, void* d_ws, size_t ws_size, hipStream_t stream) {
    using namespace mk;
    static int grid = 0;
    if (grid == 0) {
        if (n_in != 24 || in_sizes[0] != T * D || out_size != T * D || ws_size < WS_END) { fprintf(stderr, "kernel_launch: unexpected shapes / workspace (n_in %d, ws %zu, need %zu); nothing launched\n", n_in, ws_size, (size_t)WS_END); grid = -1; return; }
        int dev = 0, cus = 0, per_cu = 0;
        if (hipGetDevice(&dev) != hipSuccess || hipDeviceGetAttribute(&cus, hipDeviceAttributeMultiprocessorCount, dev) != hipSuccess) { grid = -1; return; }
        if (hipFuncSetAttribute((const void*)fwd, hipFuncAttributeMaxDynamicSharedMemorySize, LDS_BYTES) != hipSuccess) { fprintf(stderr, "kernel_launch: hipFuncSetAttribute failed\n"); grid = -1; return; }
        if (hipOccupancyMaxActiveBlocksPerMultiprocessor(&per_cu, (const void*)fwd, NT, LDS_BYTES) != hipSuccess || per_cu < 1) { fprintf(stderr, "kernel_launch: occupancy query says %d\n", per_cu); (void)hipGetLastError(); per_cu = 1; }
        grid = cus;
    }
    if (grid < 0) return;
    if (hipMemsetAsync((char*)d_ws + WS_CTL, 0, CTL_BYTES, stream) != hipSuccess) return;
    P p{};
    for (int i = 0; i < 24; ++i) p.in[i] = (const float*)d_in[i];
    p.out = (float*)d_out; p.ws = (unsigned char*)d_ws;
#if MK_ONE_LAUNCH
    p.ph_lo = 0; p.ph_hi = NPH;
    hipLaunchKernelGGL(fwd, dim3(grid), dim3(NT), LDS_BYTES, stream, p);
#else
    for (int ph = 0; ph < NPH; ++ph) { p.ph_lo = ph; p.ph_hi = ph + 1; hipLaunchKernelGGL(fwd, dim3(grid), dim3(NT), LDS_BYTES, stream, p); }
#endif
}
```

```cpp
#include <hip/hip_runtime.h>
#include <cstdio>
#include <cstdint>
__device__ __forceinline__ int tid_fresh() { int t = (int)threadIdx.x; asm volatile("" : "+v"(t)); return t; }
namespace pg8 {
#define PG8_LAS __attribute__((address_space(3)))
typedef unsigned short bf16_t;
typedef short bf16x8 __attribute__((ext_vector_type(8)));
typedef float f32x4 __attribute__((ext_vector_type(4)));
typedef unsigned u32x4 __attribute__((ext_vector_type(4)));
constexpr int BM = 256, BK = 64, HALF = 128, HTB = HALF * BK * 2  , STAGE_BYTES = 8 * HTB, NXCD = 8, WGM = 8;

__host__ __device__ __forceinline__ int lds_byte(int r, int c) { const int st = (r >> 4) * 2 + (c >> 5), rr = r & 15, cc = c & 31, ob = rr * 64 + cc * 2; return st * 1024 + (ob ^ (((ob >> 9) & 1) << 5)); }
__host__ __device__ __forceinline__ void stage_rc(int b, int& R, int& C) { const int st = b / 1024, sb = b % 1024, swz = sb ^ (((sb >> 9) & 1) << 5); R = (st >> 1) * 16 + swz / 64; C = (st & 1) * 32 + (swz % 64) / 2; }
__host__ __device__ __forceinline__ int perm32(int rho) { const int n = rho >> 4, i = rho & 15; return 8 * (i >> 2) + 4 * n + (i & 3); }

struct Unit { int pm, pn, be; };
struct Gemm { const bf16_t* A; const bf16_t* Bt; int M, N, K; size_t bstride; };

struct StaticOrder {
    static constexpr bool GATHER = false;
    int nM, nN, nwg, G, c;
    __host__ __device__ void init(int M, int N, int G_, int c_) { nM = M / BM; nN = N / BM; nwg = nM * nN; G = G_; c = c_; }
    __host__ __device__ bool next(int i, Unit& u) const {
        const long L = (long)i * G + c; if (L >= nwg) return false;
        int wgid = (int)L; { const int q = nwg / NXCD, r = nwg % NXCD, xcd = wgid % NXCD, off = wgid / NXCD; wgid = (xcd < r ? xcd * (q + 1) : r * (q + 1) + (xcd - r) * q) + off; }
        const int nig = WGM * nN, gid = wgid / nig, fm = gid * WGM, gsz = (nM - fm) < WGM ? (nM - fm) : WGM;
        u.pm = fm + ((wgid % nig) % gsz); u.pn = (wgid % nig) / gsz; u.be = 0; return true;
    }
    __device__ __forceinline__ void a_ready(const Unit&) const {}
    __device__ __forceinline__ void done(const Unit&) const {}
};

typedef float cvt_f32x2 __attribute__((ext_vector_type(2)));
typedef __bf16 cvt_bf16x2 __attribute__((ext_vector_type(2)));
__device__ __forceinline__ unsigned cvt_pk_bf16(float lo, float hi) { const cvt_f32x2 v = {lo, hi}; return __builtin_bit_cast(unsigned, __builtin_convertvector(v, cvt_bf16x2)); }
template <class Epi, class Sched, bool STAMP = false>
__device__ __forceinline__ void gemm_phase(PG8_LAS unsigned char* lds, const Gemm g, const Sched& S, const Epi& E, unsigned long long* stamps) {
    const int tid = tid_fresh(), wid = __builtin_amdgcn_readfirstlane(tid >> 6), lane = tid & 63, wr = wid >> 2, wc = wid & 3, fr = lane & 15, fq = lane >> 4;
    const int K = g.K, nt = K / BK;
    int ts_lo = 0, ts_hi = 0, nts = 0; const unsigned long long rt_entry = STAMP ? (unsigned long long)wall_clock64() : 0ull;
#define PG8_STAMP() do { if (STAMP && wid == 0 && nts < 64) { const unsigned long long _c = (unsigned long long)clock64(); \
        ts_lo = (lane == nts) ? (int)(unsigned)_c : ts_lo; ts_hi = (lane == nts) ? (int)(unsigned)(_c >> 32) : ts_hi; ++nts; } } while (0)
    PG8_STAMP();
    unsigned voffA[2], voffB[2];
#pragma unroll
    for (int i = 0; i < 2; ++i) { int R, C; stage_rc(tid * 16 + i * 8192, R, C); const int Rb = Epi::PERM ? ((R & ~31) + perm32(R & 31)) : R;
        voffA[i] = (unsigned)(R * K + C) * 2u; voffB[i] = (unsigned)(Rb * K + C) * 2u; }
    unsigned vA0[2] = {0u, 0u}, vA1[2] = {0u, 0u}, nvA0[2] = {0u, 0u}, nvA1[2] = {0u, 0u}; int gR[2] = {0, 0}, gC[2] = {0, 0};
    if constexpr (Sched::GATHER) {
#pragma unroll
        for (int i = 0; i < 2; ++i) stage_rc(tid * 16 + i * 8192, gR[i], gC[i]); }
#define PG8_GOFF(u, v0, v1) do { _Pragma("unroll") for (int _i = 0; _i < 2; ++_i) { v0[_i] = S.row_byte_off(u, gR[_i]) + (unsigned)gC[_i] * 2u; v1[_i] = S.row_byte_off(u, 128 + gR[_i]) + (unsigned)gC[_i] * 2u; } } while (0)
#define PG8_STAGE_A(bufoff, base, half, nxtsel) do { if constexpr (Sched::GATHER) { unsigned sel_[2]; _Pragma("unroll") for (int _j = 0; _j < 2; ++_j) sel_[_j] = (nxtsel) ? ((half) ? nvA1[_j] : nvA0[_j]) : ((half) ? vA1[_j] : vA0[_j]); \
        PG8_STAGE(bufoff, base, sel_); } else { PG8_STAGE(bufoff, (base) + ((half) ? hstep : (size_t)0), voffA); } } while (0)
    const size_t kstep = (size_t)(BK * 2);
    const size_t hstep = (size_t)HALF * K * 2;
    const size_t tstep = 2 * hstep;
    const unsigned ldsw = (unsigned)wid * 1024u;
    const int aoff = lds_byte(wr * 64 + fr, fq * 8), boff = lds_byte(wc * 32 + fr, fq * 8);
#define PG8_SA(b, h) (((b) * 2 + (h)) * HTB)
#define PG8_SB(b, h) ((4 + (b) * 2 + (h)) * HTB)
#define PG8_STAGE(bufoff, gbase, voff) do { _Pragma("unroll") for (int _i = 0; _i < 2; ++_i) \
        __builtin_amdgcn_global_load_lds((const unsigned*)((const char*)(gbase) + (voff)[_i]), (PG8_LAS unsigned*)(lds + (bufoff) + ldsw + _i * 8192), 16, 0, 0); } while (0)
#define PG8_LDA(dst, b, h) do { _Pragma("unroll") for (int m = 0; m < 4; ++m) _Pragma("unroll") for (int k = 0; k < 2; ++k) dst[m][k] = *(const PG8_LAS bf16x8*)(lds + PG8_SA(b, h) + aoff + m * 2048 + k * 1024); } while (0)
#define PG8_LDB(dst, b, h) do { _Pragma("unroll") for (int n = 0; n < 2; ++n) _Pragma("unroll") for (int k = 0; k < 2; ++k) dst[n][k] = *(const PG8_LAS bf16x8*)(lds + PG8_SB(b, h) + boff + n * 2048 + k * 1024); } while (0)
#define PG8_MMA(ai, bj, At, Bt) do { __builtin_amdgcn_s_setprio(1); _Pragma("unroll") for (int m = 0; m < 4; ++m) _Pragma("unroll") for (int n = 0; n < 2; ++n) _Pragma("unroll") for (int k = 0; k < 2; ++k) \
        acc[ai][bj][m][n] = __builtin_amdgcn_mfma_f32_16x16x32_bf16(Bt[n][k], At[m][k], acc[ai][bj][m][n], 0, 0, 0); __builtin_amdgcn_s_setprio(0); } while (0)
#define PG8_WAIT_V(n) asm volatile("s_waitcnt vmcnt(" #n ")" ::: "memory")
#define PG8_WAIT_L(n) asm volatile("s_waitcnt lgkmcnt(" #n ")" ::: "memory")
#define PG8_BAR __builtin_amdgcn_s_barrier()
#define PG8_SCHED __builtin_amdgcn_sched_barrier(0)
    Unit cur, nxt; int ui = 0;
    if (!S.next(0, cur)) return;
    f32x4 acc[2][2][4][2];
#pragma unroll
    for (int a = 0; a < 2; ++a)
#pragma unroll
        for (int b = 0; b < 2; ++b)
#pragma unroll
            for (int m = 0; m < 4; ++m)
#pragma unroll
                for (int n = 0; n < 2; ++n) acc[a][b][m][n] = (f32x4){0.f, 0.f, 0.f, 0.f};
    bf16x8 At[4][2], B0[2][2], B1[2][2];
    const char* cA = Sched::GATHER ? (const char*)g.A : (const char*)g.A + (size_t)cur.pm * tstep; const char* cB = (const char*)g.Bt + (size_t)cur.be * g.bstride + (size_t)cur.pn * tstep;
    S.a_ready(cur);
    if constexpr (Sched::GATHER) PG8_GOFF(cur, vA0, vA1);
    PG8_STAGE(PG8_SB(0, 0), cB, voffB); PG8_STAGE_A(PG8_SA(0, 0), cA, 0, false); PG8_STAGE(PG8_SB(0, 1), cB + hstep, voffB); PG8_STAGE_A(PG8_SA(0, 1), cA, 1, false);
    if (wr == 1) PG8_BAR;
    PG8_WAIT_V(4); PG8_BAR;
    PG8_STAGE(PG8_SB(1, 0), cB + kstep, voffB); PG8_STAGE_A(PG8_SA(1, 0), cA + kstep, 0, false); PG8_STAGE(PG8_SB(1, 1), cB + hstep + kstep, voffB);
    PG8_WAIT_V(6); PG8_BAR;
    PG8_STAMP();
    for (;;) {
        const bool has_next = S.next(ui + 1, nxt);
        const char* nA = Sched::GATHER ? (const char*)g.A : (has_next ? (const char*)g.A + (size_t)nxt.pm * tstep : cA); const char* nB = has_next ? (const char*)g.Bt + (size_t)nxt.be * g.bstride + (size_t)nxt.pn * tstep : cB;
        if constexpr (Sched::GATHER) { if (has_next) PG8_GOFF(nxt, nvA0, nvA1); else {
#pragma unroll
                for (int _i = 0; _i < 2; ++_i) { nvA0[_i] = vA0[_i]; nvA1[_i] = vA1[_i]; } } }
        for (int t = 0; t < nt; t += 2) {
            const bool last = (t == nt - 2);
            const char* a1 = cA + (size_t)(t + 1) * kstep;
            const char* a2 = last ? nA : cA + (size_t)(t + 2) * kstep; const char* b2 = last ? nB : cB + (size_t)(t + 2) * kstep;
            const char* a3 = a2 + kstep; const char* b3 = b2 + kstep;
            if (last && has_next) S.a_ready(nxt);
            PG8_LDB(B0, 0, 0); PG8_SCHED; PG8_LDA(At, 0, 0); PG8_STAGE_A(PG8_SA(1, 1), a1, 1, false);
            PG8_WAIT_L(8); PG8_BAR; PG8_WAIT_L(0); PG8_MMA(0, 0, At, B0); PG8_BAR; PG8_SCHED;
            PG8_LDB(B1, 0, 1); PG8_STAGE(PG8_SB(0, 0), b2, voffB);
            PG8_BAR; PG8_WAIT_L(0); PG8_MMA(0, 1, At, B1); PG8_BAR;
            PG8_LDA(At, 0, 1); PG8_STAGE_A(PG8_SA(0, 0), a2, 0, last);
            PG8_BAR; PG8_WAIT_L(0); PG8_MMA(1, 0, At, B0); PG8_BAR; PG8_SCHED;
            PG8_STAGE(PG8_SB(0, 1), b2 + hstep, voffB);
            PG8_WAIT_V(6); PG8_BAR; PG8_MMA(1, 1, At, B1); PG8_BAR;
            PG8_LDB(B0, 1, 0); PG8_SCHED; PG8_LDA(At, 1, 0); PG8_STAGE_A(PG8_SA(0, 1), a2, 1, last);
            PG8_WAIT_L(8); PG8_BAR; PG8_WAIT_L(0); PG8_MMA(0, 0, At, B0); PG8_BAR; PG8_SCHED;
            PG8_LDB(B1, 1, 1); PG8_STAGE(PG8_SB(1, 0), b3, voffB);
            PG8_BAR; PG8_WAIT_L(0); PG8_MMA(0, 1, At, B1); PG8_BAR;
            PG8_LDA(At, 1, 1); PG8_STAGE_A(PG8_SA(1, 0), a3, 0, last);
            PG8_BAR; PG8_WAIT_L(0); PG8_MMA(1, 0, At, B0); PG8_BAR; PG8_SCHED;
            PG8_STAGE(PG8_SB(1, 1), b3 + hstep, voffB);
            PG8_WAIT_V(6); PG8_BAR; PG8_MMA(1, 1, At, B1); PG8_BAR;
        }
        PG8_STAMP();
        if constexpr (!Epi::AFTER_DRAIN) { E(acc, cur, wr, wc, fr, fq); S.done(cur); }
        PG8_STAMP();
        if (!has_next) break;
#pragma unroll
        for (int a = 0; a < 2; ++a)
#pragma unroll
            for (int b = 0; b < 2; ++b)
#pragma unroll
                for (int m = 0; m < 4; ++m)
#pragma unroll
                    for (int n = 0; n < 2; ++n) acc[a][b][m][n] = (f32x4){0.f, 0.f, 0.f, 0.f};
        if constexpr (Sched::GATHER) {
#pragma unroll
            for (int _i = 0; _i < 2; ++_i) { vA0[_i] = nvA0[_i]; vA1[_i] = nvA1[_i]; } }
        cur = nxt; cA = nA; cB = nB; ++ui;
    }
    PG8_WAIT_V(0);
    if (wr == 0) PG8_BAR;
    PG8_BAR;
    if constexpr (Epi::AFTER_DRAIN) { E.fused(acc, cur, wr, wc, fr, fq, lds, wid, lane); S.done(cur); }
    PG8_STAMP();
    if (STAMP && wid == 0) { stamps[lane] = lane < nts ? (((unsigned long long)(unsigned)ts_hi << 32) | (unsigned)ts_lo) : 0ull;
        if (lane == 62) stamps[62] = rt_entry; if (lane == 63) stamps[63] = (unsigned long long)wall_clock64(); }
#undef PG8_STAMP
#undef PG8_SA
#undef PG8_SB
#undef PG8_STAGE
#undef PG8_STAGE_A
#undef PG8_GOFF
#undef PG8_LDA
#undef PG8_LDB
#undef PG8_MMA
#undef PG8_WAIT_V
#undef PG8_WAIT_L
#undef PG8_BAR
#undef PG8_SCHED
}
}


#define XB_TMO      128
#define XB_XCNT(j)  (256  + 64 * (j))
#define XB_XSUB(j)  (1280 + 64 * (j))
#define XB_XGEN(j)  (2304 + 64 * (j))
#define XB_TOP      3328
#define XB_TOPGEN   3392
#define XCD_BAR_WORDS 3456
#define XB_SPIN_CAP (1u << 18)
#define LAS __attribute__((address_space(3)))

__device__ __forceinline__ unsigned xb_ld(unsigned* p)              { return __hip_atomic_load(p, __ATOMIC_RELAXED, __HIP_MEMORY_SCOPE_AGENT); }
__device__ __forceinline__ unsigned xb_add(unsigned* p, unsigned v) { return __hip_atomic_fetch_add(p, v, __ATOMIC_RELAXED, __HIP_MEMORY_SCOPE_AGENT); }
__device__ __forceinline__ unsigned xb_xcc_id() { return (unsigned)__builtin_amdgcn_s_getreg((3 << 11) | 20) & 0xFu; }
#define XB_SPIN(cond, bar) do { unsigned _sp = 0; while (cond) { __builtin_amdgcn_s_sleep(1); \
    if ((++_sp & 255u) == 0u) { if (xb_ld(&(bar)[XB_TMO])) break; if (_sp > XB_SPIN_CAP) { atomicAdd(&(bar)[XB_TMO], 1u); break; } } } } while (0)

struct XcdBarrier {
    unsigned* bar; unsigned x;
    volatile LAS unsigned* st;
};

__device__ __forceinline__ XcdBarrier xcd_barrier_post(unsigned* bar, volatile LAS unsigned* st) {
    XcdBarrier b; b.bar = bar; b.x = xb_xcc_id(); b.st = st;
    if (threadIdx.x == 0) (void)xb_add(&bar[XB_XCNT(b.x)], 1u);
    return b;
}
__device__ __forceinline__ void xcd_barrier_complete(unsigned* bar, unsigned x, unsigned& nloc, unsigned& nx) {
    const unsigned G = gridDim.x * gridDim.y * gridDim.z;
    unsigned sum, cnt, mine, sp = 0u;
    for (;;) {
        sum = 0u; cnt = 0u; mine = 0u;
#pragma unroll
        for (unsigned j = 0; j < 16; ++j) { const unsigned c = xb_ld(&bar[XB_XCNT(j)]); sum += c; cnt += (c > 0u) ? 1u : 0u; mine = (j == x) ? c : mine; }
        if (sum == G) break;
        __builtin_amdgcn_s_sleep(1);
        if ((++sp & 255u) == 0u) { if (xb_ld(&bar[XB_TMO])) break; if (sp > XB_SPIN_CAP) { atomicAdd(&bar[XB_TMO], 1u); break; } }
    }
    nloc = mine > 0u ? mine : 1u; nx = cnt > 0u ? cnt : 1u;
}

__device__ __forceinline__ void xcd_barrier(const XcdBarrier& b) {
    asm volatile("s_waitcnt vmcnt(0)" ::: "memory");
    __syncthreads();
    if (threadIdx.x == 0) {
        unsigned* bar = b.bar;
        __builtin_amdgcn_s_waitcnt(0);
        unsigned nloc = b.st[0], nx = b.st[1];
        if (nloc == 0u) { xcd_barrier_complete(bar, b.x, nloc, nx); b.st[0] = nloc; b.st[1] = nx; }
        const unsigned old = xb_add(&bar[XB_XSUB(b.x)], 1u);
        const unsigned gen = old / nloc;
        if (old + 1u == (gen + 1u) * nloc) {
            __builtin_amdgcn_fence(__ATOMIC_RELEASE, "agent");
            asm volatile("s_waitcnt vmcnt(0)" ::: "memory");
            const unsigned og = xb_add(&bar[XB_TOP], 1u);
            const unsigned tg = og / nx;
            if (og + 1u == (tg + 1u) * nx) xb_add(&bar[XB_TOPGEN], 1u);
            else XB_SPIN(xb_ld(&bar[XB_TOPGEN]) == tg, bar);
            __builtin_amdgcn_fence(__ATOMIC_ACQUIRE, "agent");
            xb_add(&bar[XB_XGEN(b.x)], 1u);
            asm volatile("s_waitcnt vmcnt(0)" ::: "memory");
        } else {
            XB_SPIN(xb_ld(&bar[XB_XGEN(b.x)]) == gen, bar);
            __builtin_amdgcn_fence(__ATOMIC_ACQUIRE, "agent");
            asm volatile("s_waitcnt vmcnt(0)" ::: "memory");
        }
    }
    __syncthreads();
}


namespace mk {
using pg8::bf16_t; using pg8::f32x4; using pg8::u32x4; using pg8::cvt_pk_bf16;
#define MKLAS __attribute__((address_space(3)))
typedef unsigned u32x2 __attribute__((ext_vector_type(2)));
typedef float f32x2 __attribute__((ext_vector_type(2)));

constexpr int D = 1024, T = 16384, LC = 256, L = T + LC, DEPTH = 2;
constexpr int NA = 4096, NB = 3584;
constexpr int NE = 32, DE = 256;
constexpr float EPS = 1e-6f;
constexpr int NT = 512, NW = 8;
constexpr int LDS_CTL_OFF = 131072;

constexpr size_t MiB = 1u << 20, QMiB = 1u << 18;
constexpr size_t WS_CTL = 0, CTL_BYTES = 1 * MiB;
constexpr size_t WS_MOD = 1 * MiB, WS_LB = WS_MOD + 128 * 1024, WS_ROPE = WS_MOD + 192 * 1024, WS_LGAM = WS_MOD + 256 * 1024, WS_WRT = WS_MOD + 512 * 1024;
constexpr size_t WS_AE = 2 * MiB, WS_AW = WS_AE + 256 * 1024, WS_APOS = WS_AE + 512 * 1024, WS_TILEE = WS_AE + 1024 * 1024;
constexpr size_t WS_TOK = 58 * MiB;
constexpr size_t WS_CTX = 4 * MiB;
constexpr size_t WS_WIN = 5 * MiB, WS_WOHG = 20 * MiB, WS_WORET = 21 * MiB, WS_WOUT = 23 * MiB;
constexpr size_t WS_H = 25 * MiB;
constexpr size_t WS_QH = 58 * MiB, WS_VH = WS_QH + 65 * QMiB, WS_RQ = WS_VH + 65 * QMiB, WS_RK = WS_RQ + 65 * QMiB;
constexpr size_t WS_RV = 123 * MiB;
constexpr size_t WS_LF = WS_RV + 130 * QMiB;
constexpr size_t WS_OHG = WS_LF + 260 * QMiB;
constexpr size_t WS_ORT = WS_OHG + 65 * QMiB;
constexpr size_t WS_OF = WS_ORT + 130 * QMiB;
constexpr size_t WS_END = WS_OF + 390 * QMiB;
constexpr size_t WS_GA = WS_QH, WS_GB = WS_QH + 130 * QMiB;
constexpr size_t WS_M1 = WS_LF;
constexpr size_t WS_MB = WS_RV;
constexpr int CW_BAR = 4096, CW_CNT = 8192, CW_ECNT = 12288;

struct P { const float* in[24]; float* out; unsigned char* ws; int ph_lo, ph_hi; };
__device__ __forceinline__ unsigned char* ws_fresh(unsigned char* w) { asm volatile("" : "+s"(w)); return w; }
#define WSP(type, off) ((type*)(p.ws + (off)))

__device__ __forceinline__ float bf2f(bf16_t b) { return __uint_as_float(((unsigned)b) << 16); }
__device__ __forceinline__ bf16_t f2bf(float f) { return (bf16_t)(cvt_pk_bf16(f, 0.f) & 0xffffu); }
__device__ __forceinline__ float fexp(float x) { return __builtin_amdgcn_exp2f(x * 1.4426950408889634f); }
__device__ __forceinline__ float flog(float x) { return __builtin_amdgcn_logf(x) * 0.6931471805599453f; }
__device__ __forceinline__ float siluf(float x) { return x * __builtin_amdgcn_rcpf(1.f + fexp(-x)); }
__device__ __forceinline__ float sigmf(float x) { return __builtin_amdgcn_rcpf(1.f + fexp(-x)); }
__device__ __forceinline__ float wave_sum(float v) {
#pragma unroll
    for (int o = 1; o < 64; o <<= 1) v += __shfl_xor(v, o);
    return v;
}
__device__ __forceinline__ const float* xrow_in(const P& p, int l, int r) {
    if (l == 0) return r < LC ? p.in[2] + (size_t)r * D : p.in[0] + (size_t)(r - LC) * D;
    return r < LC ? WSP(float, WS_CTX) + (size_t)r * D : p.out + (size_t)(r - LC) * D;
}
__device__ __forceinline__ float* xrow_st(const P& p, int r) { return r < LC ? WSP(float, WS_CTX) + (size_t)r * D : p.out + (size_t)(r - LC) * D; }
__device__ __forceinline__ int seq_row(int dir, int i) { return dir == 0 ? i : (i < LC ? LC - 1 - i : L + LC - 1 - i); }

__device__ __forceinline__ void tr_load(const float* W, int N, int k0, int n0, MKLAS float* tile) {
    const int tid = tid_fresh(), r = tid >> 6, c = tid & 63;
#pragma unroll
    for (int i = 0; i < 8; ++i) tile[(r + 8 * i) * 65 + c] = W[(size_t)(k0 + r + 8 * i) * N + n0 + c];
}
__device__ __forceinline__ void tr_store(bf16_t* WT, int K, int k0, int outrow0, const MKLAS float* tile, bool swap45 = false) {
    const int tid = tid_fresh(), nn = tid >> 3, kc = tid & 7;
    const MKLAS float* s = tile + (kc * 8) * 65 + nn;
    u32x4 o; o.x = cvt_pk_bf16(s[0], s[65]); o.y = cvt_pk_bf16(s[130], s[195]); o.z = cvt_pk_bf16(s[260], s[325]); o.w = cvt_pk_bf16(s[390], s[455]);
    const int nno = swap45 ? ((((nn & 31) >> 2) << 3) | ((nn >> 5) << 2) | (nn & 3)) : nn;
    *(u32x4*)(WT + (size_t)(outrow0 + nno) * K + k0 + kc * 8) = o;
}
constexpr int TRT = 64 * 65;
__device__ __forceinline__ int win_perm(int n) { return n < 2048 ? n : (n < 2560 ? 4096 + (n - 2048) : (n < 4608 ? 2048 + (n - 2560) : n)); }
constexpr int MIXER_ITEMS = 16 * 30 + 8 * 4 + 16 * 4 + 16 * 4;
__device__ __forceinline__ void mixer_item(const P& p, int l, int it, MKLAS float* tile) {
    constexpr int I_IN = 16 * 30, I_OHG = 8 * 4, I_ORT = 16 * 4;
    const float* W; bf16_t* WT; int K, N, kb, ng, kind;
    if (it < I_IN) { kind = 0; kb = it / 30; ng = it % 30; W = p.in[8] + (size_t)l * D * 7680; WT = WSP(bf16_t, WS_WIN); K = D; N = 7680; }
    else if (it < I_IN + I_OHG) { kind = 1; const int r = it - I_IN; kb = r >> 2; ng = r & 3; W = p.in[13] + (size_t)l * 512 * D; WT = WSP(bf16_t, WS_WOHG); K = 512; N = D; }
    else if (it < I_IN + I_OHG + I_ORT) { kind = 2; const int r = it - I_IN - I_OHG; kb = r >> 2; ng = r & 3; W = p.in[14] + (size_t)l * D * D; WT = WSP(bf16_t, WS_WORET); K = D; N = D; }
    else { kind = 3; const int r = it - I_IN - I_OHG - I_ORT; kb = r >> 2; ng = r & 3; W = p.in[15] + (size_t)l * D * D; WT = WSP(bf16_t, WS_WOUT); K = D; N = D; }
#pragma unroll
    for (int j = 0; j < 4; ++j) tr_load(W, N, kb * 64, (ng * 4 + j) * 64, tile + j * TRT);
    __syncthreads();
#pragma unroll
    for (int j = 0; j < 4; ++j) { const int n0 = (ng * 4 + j) * 64;
        tr_store(WT, K, kb * 64, kind == 0 ? win_perm(n0) : n0, tile + j * TRT, kind == 0 && n0 >= 2560 && n0 < 3584); }
    __syncthreads();
}

__device__ __forceinline__ void ph_hnorm(const P& p, int l) {
    const int tid_ = tid_fresh(), lane = tid_ & 63, wave = tid_ >> 6;
    const float* MOD = WSP(float, WS_MOD); bf16_t* H = WSP(bf16_t, WS_H);
    const float* nw = p.in[6] + l * D;
    for (int r = blockIdx.x * NW + wave; r < L; r += gridDim.x * NW) {
        const f32x4* xr = (const f32x4*)xrow_in(p, l, r) + lane;
        const float* mod = MOD + (l * 2 + (r < LC ? 1 : 0)) * 6144;
        f32x4 v[4]; float ss = 0.f;
#pragma unroll
        for (int j = 0; j < 4; ++j) { v[j] = xr[64 * j]; ss += (v[j].x * v[j].x + v[j].y * v[j].y) + (v[j].z * v[j].z + v[j].w * v[j].w); }
        const float rinv = 1.0f / sqrtf(wave_sum(ss) * (1.f / D) + EPS);
        u32x2* o = (u32x2*)(H + (size_t)r * D) + lane;
#pragma unroll
        for (int j = 0; j < 4; ++j) { const int c = 4 * (lane + 64 * j);
            const f32x4 w = *(const f32x4*)(nw + c), sh = *(const f32x4*)(mod + c), sc = *(const f32x4*)(mod + 1024 + c);
            const f32x4 h = v[j] * rinv * w * (sc + 1.0f) + sh;
            u32x2 q; q.x = cvt_pk_bf16(h.x, h.y); q.y = cvt_pk_bf16(h.z, h.w); o[64 * j] = q; }
    }
}

template <class F> struct EpiGen {
    static constexpr bool PERM = true, AFTER_DRAIN = false;
    F f;
    __device__ __forceinline__ void operator()(const f32x4 (&acc)[2][2][4][2], const pg8::Unit& u, int wr, int wc, int fr, int fq) const {
        const int row0 = u.pm * 256 + wr * 64 + fr, col0 = u.pn * 256 + wc * 32 + 8 * fq;
        if constexpr (!F::HAS_LOAD) {
            const typename F::R none{};
#pragma unroll
            for (int g = 0; g < 8; ++g)
#pragma unroll
                for (int bj = 0; bj < 2; ++bj) f.apply8(row0 + (g >> 2) * 128 + (g & 3) * 16, col0 + bj * 128, acc[g >> 2][bj][g & 3][0], acc[g >> 2][bj][g & 3][1], none, u);
        } else {
            typename F::R cur[2], nxt[2];
#pragma unroll
            for (int bj = 0; bj < 2; ++bj) cur[bj] = f.load8(row0, col0 + bj * 128, u);
            asm volatile("" ::: "memory");
#pragma unroll
            for (int g = 0; g < 8; ++g) {
                if (g < 7) {
#pragma unroll
                    for (int bj = 0; bj < 2; ++bj) nxt[bj] = f.load8(row0 + ((g + 1) >> 2) * 128 + ((g + 1) & 3) * 16, col0 + bj * 128, u);
                }
                asm volatile("" ::: "memory");
#pragma unroll
                for (int bj = 0; bj < 2; ++bj) f.apply8(row0 + (g >> 2) * 128 + (g & 3) * 16, col0 + bj * 128, acc[g >> 2][bj][g & 3][0], acc[g >> 2][bj][g & 3][1], cur[bj], u);
                asm volatile("" ::: "memory");
#pragma unroll
                for (int bj = 0; bj < 2; ++bj) cur[bj] = nxt[bj];
            }
        }
    }
};
struct NoRegs {};
__device__ __forceinline__ void st_bf4(bf16_t* dst, f32x4 v) { u32x2 q; q.x = cvt_pk_bf16(v.x, v.y); q.y = cvt_pk_bf16(v.z, v.w); *(u32x2*)dst = q; }
__device__ __forceinline__ void st_bf8(bf16_t* dst, f32x4 a, f32x4 b) { u32x4 q; q.x = cvt_pk_bf16(a.x, a.y); q.y = cvt_pk_bf16(a.z, a.w); q.z = cvt_pk_bf16(b.x, b.y); q.w = cvt_pk_bf16(b.z, b.w); *(u32x4*)dst = q; }
__device__ __forceinline__ f32x4 bf2lo4(u32x4 q) { return (f32x4){__uint_as_float(q.x << 16), __uint_as_float(q.x & 0xffff0000u), __uint_as_float(q.y << 16), __uint_as_float(q.y & 0xffff0000u)}; }
__device__ __forceinline__ f32x4 bf2hi4(u32x4 q) { return (f32x4){__uint_as_float(q.z << 16), __uint_as_float(q.z & 0xffff0000u), __uint_as_float(q.w << 16), __uint_as_float(q.w & 0xffff0000u)}; }
__device__ __forceinline__ f32x4 silu4(f32x4 v) { return (f32x4){siluf(v.x), siluf(v.y), siluf(v.z), siluf(v.w)}; }
__device__ __forceinline__ f32x4 sigm4(f32x4 v) { return (f32x4){sigmf(v.x), sigmf(v.y), sigmf(v.z), sigmf(v.w)}; }
__device__ __forceinline__ f32x4 ld_bf4(const bf16_t* src) { const u32x2 q = *(const u32x2*)src; f32x4 v; v.x = __uint_as_float(q.x << 16); v.y = __uint_as_float(q.x & 0xffff0000u); v.z = __uint_as_float(q.y << 16); v.w = __uint_as_float(q.y & 0xffff0000u); return v; }

struct FnA {
    bf16_t *QH, *VH, *RQ, *RK, *RV; float* LF; const float* LB; const float* RT;
    static constexpr bool HAS_LOAD = false; typedef NoRegs R;
    __device__ __forceinline__ f32x4 logf4(f32x4 v, int dir, int ch) const { const f32x4 lb = *(const f32x4*)(LB + dir * DEPTH * 512 + ch); f32x4 o;
#pragma unroll
        for (int j = 0; j < 4; ++j) { const float e = fexp(fminf(-v[j], 69.f));
            o[j] = fmaxf(flog(1.f + lb[j] * e) - flog(1.f + e), -69.0775528f); }
        return o; }
    static __device__ __forceinline__ int rot_dim(int c) { return (c & ~63) | (((c >> 3) & 7) << 2) | (c & 3) | ((c & 4) << 3); }
    __device__ __forceinline__ void operator()(int row, int col, f32x4 v, const pg8::Unit& u) const {
        const int seg = u.pn >> 1;
        if (seg == 0) st_bf4(QH + (size_t)row * 512 + col, silu4(v) * 0.08838834764831845f);
        else if (seg == 1 || seg == 2) { const int dir = seg - 1, ch = col - seg * 512; *(f32x4*)(LF + (size_t)row * 1024 + dir * 512 + ch) = logf4(v, dir, ch); }
        else if (seg == 3) st_bf4(VH + (size_t)row * 512 + (col - 1536), v);
        else if (seg == 4) st_bf4(RQ + (size_t)row * 512 + rot_dim(col - 2048), v * 0.08838834764831845f);
        else if (seg == 5) st_bf4(RK + (size_t)row * 512 + rot_dim(col - 2560), v);
        else st_bf4(RV + (size_t)row * 1024 + (col - 3072), v);
    }
    __device__ __forceinline__ void apply8(int row, int col, f32x4 v0, f32x4 v1, const R&, const pg8::Unit& u) const {
        const int seg = u.pn >> 1;
        if (seg == 0) st_bf8(QH + (size_t)row * 512 + col, silu4(v0) * 0.08838834764831845f, silu4(v1) * 0.08838834764831845f);
        else if (seg == 1 || seg == 2) { const int dir = seg - 1, ch = col - seg * 512; float* o = LF + (size_t)row * 1024 + dir * 512 + ch; *(f32x4*)o = logf4(v0, dir, ch); *(f32x4*)(o + 4) = logf4(v1, dir, ch + 4); }
        else if (seg == 3) st_bf8(VH + (size_t)row * 512 + (col - 1536), v0, v1);
        else if (seg == 4 || seg == 5) {
            const int c = col - (seg == 4 ? 2048 : 2560), d0 = rot_dim(c), half = (d0 >> 6) & 1, i = d0 & 31;
            const float sc = seg == 4 ? 0.08838834764831845f : 1.f;
            bf16_t* o = (seg == 4 ? RQ : RK) + (size_t)row * 512 + d0;
            if (row >= LC) { const int t = row - LC, pos = half ? (t & 63) : (t >> 6);
                const f32x4 cs0 = *(const f32x4*)(RT + (pos * 32 + i) * 2), cs1 = *(const f32x4*)(RT + (pos * 32 + i) * 2 + 4);
                const f32x4 co = {cs0.x, cs0.z, cs1.x, cs1.z}, si = {cs0.y, cs0.w, cs1.y, cs1.w};
                st_bf4(o, (v0 * co - v1 * si) * sc); st_bf4(o + 32, (v0 * si + v1 * co) * sc); }
            else { st_bf4(o, v0 * sc); st_bf4(o + 32, v1 * sc); } }
        else st_bf8(RV + (size_t)row * 1024 + (col - 3072), v0, v1);
    }
};
struct FnB {
    bf16_t *OHG, *ORT, *GA, *GB;
    static constexpr bool HAS_LOAD = true; typedef u32x4 R;
    __device__ __forceinline__ bf16_t* optr(int row, int col, int pn) const { return pn < 2 ? OHG + (size_t)row * 512 + col : ORT + (size_t)row * 1024 + (col - 512); }
    __device__ __forceinline__ R load8(int row, int col, const pg8::Unit& u) const { if (u.pn < 6) return *(const u32x4*)optr(row, col, u.pn); return (u32x4){0u, 0u, 0u, 0u}; }
    __device__ __forceinline__ void apply8(int row, int col, f32x4 v0, f32x4 v1, const R& r, const pg8::Unit& u) const {
        const int pn = u.pn;
        if (pn < 6) st_bf8(optr(row, col, pn), bf2lo4(r) * silu4(v0), bf2hi4(r) * silu4(v1));
        else st_bf8(pn < 10 ? GA + (size_t)row * 1024 + (col - 1536) : GB + (size_t)row * 1024 + (col - 2560), sigm4(v0), sigm4(v1));
    }
};
__device__ __forceinline__ f32x4 bf4_to_f32(u32x2 q) { return (f32x4){__uint_as_float(q.x << 16), __uint_as_float(q.x & 0xffff0000u), __uint_as_float(q.y << 16), __uint_as_float(q.y & 0xffff0000u)}; }
struct FnM1 { const bf16_t* GA; bf16_t* M1;
    static constexpr bool HAS_LOAD = true; typedef u32x4 R;
    __device__ __forceinline__ R load8(int row, int col, const pg8::Unit&) const { return *(const u32x4*)(GA + (size_t)row * D + col); }
    __device__ __forceinline__ void apply8(int row, int col, f32x4 v0, f32x4 v1, const R& r, const pg8::Unit&) const { st_bf8(M1 + (size_t)row * D + col, bf2lo4(r) * v0, bf2hi4(r) * v1); }
    __device__ __forceinline__ void operator()(int row, int col, f32x4 v, const pg8::Unit&) const { st_bf4(M1 + (size_t)row * D + col, bf4_to_f32(*(const u32x2*)(GA + (size_t)row * D + col)) * v); } };
struct RegsM2 { u32x4 m, g; };
struct FnM2 { const bf16_t* GB; const bf16_t* M1; bf16_t* MB;
    static constexpr bool HAS_LOAD = true; typedef RegsM2 R;
    __device__ __forceinline__ R load8(int row, int col, const pg8::Unit&) const { R r; r.m = *(const u32x4*)(M1 + (size_t)row * D + col); r.g = *(const u32x4*)(GB + (size_t)row * D + col); return r; }
    __device__ __forceinline__ void apply8(int row, int col, f32x4 v0, f32x4 v1, const R& r, const pg8::Unit&) const { st_bf8(MB + (size_t)row * D + col, bf2lo4(r.m) + bf2lo4(r.g) * v0, bf2hi4(r.m) + bf2hi4(r.g) * v1); }
    __device__ __forceinline__ void operator()(int row, int col, f32x4 v, const pg8::Unit&) const { st_bf4(MB + (size_t)row * D + col, bf4_to_f32(*(const u32x2*)(M1 + (size_t)row * D + col)) + bf4_to_f32(*(const u32x2*)(GB + (size_t)row * D + col)) * v); } };
struct RegsX { f32x4 x0, x1; };
struct FnX { const float *xc_in, *xl_in; float *xc_out, *xl_out; const float* MODL;
    static constexpr bool HAS_LOAD = true; typedef RegsX R;
    __device__ __forceinline__ R load8(int row, int col, const pg8::Unit&) const { const bool isc = row < LC; const float* x = (isc ? xc_in : xl_in) + (size_t)(isc ? row : row - LC) * D + col; R r; r.x0 = *(const f32x4*)x; r.x1 = *(const f32x4*)(x + 4); return r; }
    __device__ __forceinline__ void apply8(int row, int col, f32x4 v0, f32x4 v1, const R& r, const pg8::Unit&) const {
        const bool isc = row < LC; const float* g = MODL + (isc ? 6144 : 0) + 2 * 1024 + col; float* o = (isc ? xc_out : xl_out) + (size_t)(isc ? row : row - LC) * D + col;
        *(f32x4*)o = r.x0 + *(const f32x4*)g * v0; *(f32x4*)(o + 4) = r.x1 + *(const f32x4*)(g + 4) * v1; }
    __device__ __forceinline__ void operator()(int row, int col, f32x4 v, const pg8::Unit&) const {
        const bool isc = row < LC; const size_t off = (size_t)(isc ? row : row - LC) * D + col;
        *(f32x4*)((isc ? xc_out : xl_out) + off) = *(const f32x4*)((isc ? xc_in : xl_in) + off) + *(const f32x4*)(MODL + (isc ? 6144 : 0) + 2 * 1024 + col) * v; } };

typedef short bf16x8 __attribute__((ext_vector_type(8)));
typedef short s16x4 __attribute__((ext_vector_type(4)));
#define MFMA16(a, b, c) __builtin_amdgcn_mfma_f32_16x16x32_bf16((a), (b), (c), 0, 0, 0)
constexpr size_t WS_STH = WS_OF, WS_STR = WS_OF + (size_t)8 * 65 * 16384 * 2, WS_ATOT = WS_OF + 49 * MiB;

__device__ __forceinline__ bf16x8 ld_frag_row(const MKLAS bf16_t* tile, int stride, int row0, int k0, int lane) {
    return *(const MKLAS bf16x8*)(tile + (row0 + (lane & 15)) * stride + k0 + 8 * (lane >> 4));
}
__device__ __forceinline__ bf16x8 ld_frag_tr(const MKLAS bf16_t* tile, int stride, int k0, int col0, int lane) {
    const int g = lane >> 4, q = (lane & 15) >> 2, pp = lane & 3;
    const MKLAS bf16_t* a = tile + (k0 + 8 * g + q) * stride + col0 + 4 * pp;
    const s16x4 lo = __builtin_amdgcn_ds_read_tr16_b64_v4i16((MKLAS s16x4*)a), hi = __builtin_amdgcn_ds_read_tr16_b64_v4i16((MKLAS s16x4*)(a + 4 * stride));
    return (bf16x8){lo[0], lo[1], lo[2], lo[3], hi[0], hi[1], hi[2], hi[3]};
}
__device__ __forceinline__ bf16x8 pack8(f32x4 a, f32x4 b) { u32x4 r; r.x = cvt_pk_bf16(a.x, a.y); r.y = cvt_pk_bf16(a.z, a.w); r.z = cvt_pk_bf16(b.x, b.y); r.w = cvt_pk_bf16(b.z, b.w); return __builtin_bit_cast(bf16x8, r); }
__device__ __forceinline__ float bflo(unsigned u) { return __uint_as_float(u << 16); }
__device__ __forceinline__ float bfhi(unsigned u) { return __uint_as_float(u & 0xffff0000u); }
__device__ __forceinline__ u32x4 scale_piece(u32x4 v, float s) { u32x4 r; r.x = cvt_pk_bf16(bflo(v.x) * s, bfhi(v.x) * s); r.y = cvt_pk_bf16(bflo(v.y) * s, bfhi(v.y) * s); r.z = cvt_pk_bf16(bflo(v.z) * s, bfhi(v.z) * s); r.w = cvt_pk_bf16(bflo(v.w) * s, bfhi(v.w) * s); return r; }

template <bool RET, int MODE>
__device__ __forceinline__ void scan_unit(const P& p, int l, int h, int c, int dir, MKLAS unsigned char* lds, bool zero_init = false) {
    constexpr int C = RET ? 64 : 32, NCH = 256 / C, NET = RET ? 2 : 1, DV = RET ? 256 : 128, QS = 136, VS = DV + 8, PS = C + 8, NTT = C / 16, NKS2 = C / 32;
    const int tid = tid_fresh(), lane = tid & 63, w = __builtin_amdgcn_readfirstlane(tid >> 6), r16 = lane & 15, quad = lane >> 4;
    MKLAS bf16_t* Qn = (MKLAS bf16_t*)lds; MKLAS bf16_t* Kn = Qn + C * QS; MKLAS bf16_t* Vn = Kn + C * QS; MKLAS bf16_t* Pm = Vn + C * VS;
    MKLAS float* TOT = (MKLAS float*)(Pm + C * PS); MKLAS float* E12 = TOT + 512; MKLAS float* RED = E12 + 256; MKLAS float* DQK = RED + 1024;
    const int e0 = 16 * NET * w, row0 = 256 * c, chain = dir * 4 + h;
    const bf16_t* Qg = RET ? WSP(bf16_t, WS_RQ) + h * 128 : WSP(bf16_t, WS_QH) + h * 128;
    const bf16_t* Kg = WSP(bf16_t, WS_RK) + h * 128;
    const bf16_t* Vg = RET ? WSP(bf16_t, WS_RV) + h * 256 : WSP(bf16_t, WS_VH) + h * 128;
    const float* LFg = WSP(float, WS_LF) + dir * 512 + h * 128;
    bf16_t* ST = RET ? WSP(bf16_t, WS_STR) + (((size_t)chain * 65 + c) << 15) : WSP(bf16_t, WS_STH) + (((size_t)chain * 65 + c) << 14);
    const float lg = RET ? WSP(float, WS_LGAM)[(l * 2 + dir) * 4 + h] : 0.f;
    if (RET && tid < 64) { DQK[2 * tid] = fexp((float)(tid + 1) * lg); DQK[2 * tid + 1] = fexp(-(float)(tid + 1) * lg); }
    const float e2s = RET ? fexp((float)C * lg) : 1.f;

    f32x4 Sacc[8][NET];
#pragma unroll
    for (int i = 0; i < 8; ++i)
#pragma unroll
        for (int n = 0; n < NET; ++n) {
            if (MODE == 0 || zero_init) Sacc[i][n] = (f32x4){0.f, 0.f, 0.f, 0.f};
            else { const u32x2 q = *(const u32x2*)(ST + (size_t)(e0 + 16 * n + r16) * 128 + 16 * i + 4 * quad); Sacc[i][n] = (f32x4){bflo(q.x), bfhi(q.x), bflo(q.y), bfhi(q.y)}; }
        }
    float btot = 0.f;
    float lfv[8]; unsigned short qv[8]; u32x4 hv = {0, 0, 0, 0};
    u32x4 qp[2], kp[2], vp[4];
    const int hd = tid & 127, hseg = tid >> 7;
#define TOKROW(pos) (row0 + (dir ? 255 - (pos) : (pos)))
#define LOAD_CHUNK(j) do { \
        if (!RET) { _Pragma("unroll") for (int ii = 0; ii < 8; ++ii) { const size_t rr = (size_t)TOKROW(C * (j) + 8 * hseg + ii); lfv[ii] = LFg[rr * 1024 + hd]; if (MODE != 0) qv[ii] = Qg[rr * 512 + hd]; } \
            { const size_t rr = (size_t)TOKROW(C * (j) + (tid >> 4)); hv = *(const u32x4*)(Vg + rr * 512 + 8 * (tid & 15)); } } \
        else { _Pragma("unroll") for (int m = 0; m < 2; ++m) { const int pc = tid + 512 * m; const size_t rr = (size_t)TOKROW(C * (j) + (pc >> 4)); \
                if (MODE != 0) qp[m] = *(const u32x4*)(Qg + rr * 512 + 8 * (pc & 15)); kp[m] = *(const u32x4*)(Kg + rr * 512 + 8 * (pc & 15)); } \
            _Pragma("unroll") for (int m = 0; m < 4; ++m) { const int pc = tid + 512 * m; const size_t rr = (size_t)TOKROW(C * (j) + (pc >> 5)); vp[m] = *(const u32x4*)(Vg + rr * 1024 + 8 * (pc & 31)); } } \
    } while (0)
    LOAD_CHUNK(0);
    if (MODE != 0) { for (int i = tid; i < C * PS / 8; i += NT) ((MKLAS u32x4*)Pm)[i] = (u32x4){0u, 0u, 0u, 0u}; }
    __syncthreads();
    for (int j = 0; j < NCH; ++j) {
        if (!RET) {
            float pl[8]; float run = 0.f;
#pragma unroll
            for (int ii = 0; ii < 8; ++ii) { run += lfv[ii]; pl[ii] = run; }
            TOT[hseg * 128 + hd] = run;
            __syncthreads();
            const float t0 = TOT[hd], t1 = TOT[128 + hd], t2 = TOT[256 + hd], t3 = TOT[384 + hd];
            const float off = hseg == 0 ? 0.f : (hseg == 1 ? t0 : (hseg == 2 ? t0 + t1 : t0 + t1 + t2));
            const float rref = t0 + t1, blast = (t0 + t1) + (t2 + t3);
#pragma unroll
            for (int ii = 0; ii < 8; ++ii) { const int pos = 8 * hseg + ii; const float b = off + pl[ii];
                const float kk = 1.f - fexp(lfv[ii]);
                Kn[pos * QS + hd] = f2bf(kk * fexp(fminf(rref - b, 60.f)));
                if (MODE != 0) Qn[pos * QS + hd] = f2bf(bf2f(qv[ii]) * fexp(fminf(b - rref, 60.f))); }
            if (hseg == 0) { E12[hd] = fexp(rref); E12[128 + hd] = fexp(blast - rref); btot += blast; }
            *(MKLAS u32x4*)(Vn + (tid >> 4) * VS + 8 * (tid & 15)) = hv;
        } else {
#pragma unroll
            for (int m = 0; m < 2; ++m) { const int pc = tid + 512 * m, pos = pc >> 4;
                *(MKLAS u32x4*)(Kn + pos * QS + 8 * (pc & 15)) = scale_piece(kp[m], DQK[2 * pos + 1]);
                if (MODE != 0) *(MKLAS u32x4*)(Qn + pos * QS + 8 * (pc & 15)) = scale_piece(qp[m], DQK[2 * pos]); }
#pragma unroll
            for (int m = 0; m < 4; ++m) { const int pc = tid + 512 * m; *(MKLAS u32x4*)(Vn + (pc >> 5) * VS + 8 * (pc & 31)) = vp[m]; }
        }
        if (j + 1 < NCH) LOAD_CHUNK(j + 1);
        __syncthreads();
        if (MODE != 0) {
            constexpr int NTILE = NTT * (NTT + 1) / 2;
#pragma unroll
            for (int rep = 0; rep < (NTILE + 7) / 8; ++rep) {
                const int q = w + 8 * rep;
                if (q < NTILE) {
                    int tt = 0, st = q;
#pragma unroll
                    for (int z = 1; z < NTT; ++z) if (q >= z * (z + 1) / 2) { tt = z; st = q - z * (z + 1) / 2; }
                    f32x4 sc = {0.f, 0.f, 0.f, 0.f};
#pragma unroll
                    for (int ks = 0; ks < 4; ++ks) sc = MFMA16(ld_frag_row(Qn, QS, 16 * tt, 32 * ks, lane), ld_frag_row(Kn, QS, 16 * st, 32 * ks, lane), sc);
#pragma unroll
                    for (int jj = 0; jj < 4; ++jj) { const bool keep = (st < tt) || (r16 <= 4 * quad + jj); Pm[(16 * tt + 4 * quad + jj) * PS + 16 * st + r16] = f2bf(keep ? sc[jj] : 0.f); }
                }
            }
            __syncthreads();
        }
        bf16x8 Vf[NKS2][NET];
#pragma unroll
        for (int k2 = 0; k2 < NKS2; ++k2)
#pragma unroll
            for (int n = 0; n < NET; ++n) Vf[k2][n] = ld_frag_tr(Vn, VS, 32 * k2, e0 + 16 * n, lane);
        if (!RET) {
#pragma unroll
            for (int i = 0; i < 8; ++i) { const f32x4 e1 = *(const MKLAS f32x4*)(E12 + 16 * i + 4 * quad);
#pragma unroll
                for (int n = 0; n < NET; ++n) Sacc[i][n] = Sacc[i][n] * e1; }
        }
        f32x4 oacc[NTT][NET];
        if (MODE != 0) {
#pragma unroll
            for (int tt = 0; tt < NTT; ++tt)
#pragma unroll
                for (int n = 0; n < NET; ++n) oacc[tt][n] = (f32x4){0.f, 0.f, 0.f, 0.f};
#pragma unroll
            for (int ks = 0; ks < 4; ++ks) {
                bf16x8 Bf[NET];
#pragma unroll
                for (int n = 0; n < NET; ++n) Bf[n] = pack8(Sacc[2 * ks][n], Sacc[2 * ks + 1][n]);
#pragma unroll
                for (int tt = 0; tt < NTT; ++tt) {
                    const MKLAS bf16_t* qa = Qn + (16 * tt + r16) * QS + 32 * ks + 4 * quad;
                    const s16x4 a0 = *(const MKLAS s16x4*)qa, a1 = *(const MKLAS s16x4*)(qa + 16);
                    const bf16x8 Af = (bf16x8){a0[0], a0[1], a0[2], a0[3], a1[0], a1[1], a1[2], a1[3]};
#pragma unroll
                    for (int n = 0; n < NET; ++n) oacc[tt][n] = MFMA16(Bf[n], Af, oacc[tt][n]);
                }
            }
#pragma unroll
            for (int k2 = 0; k2 < NKS2; ++k2)
#pragma unroll
                for (int tt = 0; tt < NTT; ++tt) {
                    if (32 * k2 > 16 * tt + 15) continue;
                    const bf16x8 Af = ld_frag_row(Pm, PS, 16 * tt, 32 * k2, lane);
#pragma unroll
                    for (int n = 0; n < NET; ++n) oacc[tt][n] = MFMA16(Vf[k2][n], Af, oacc[tt][n]);
                }
        }
#pragma unroll
        for (int i = 0; i < 8; ++i)
#pragma unroll
            for (int k2 = 0; k2 < NKS2; ++k2) { const bf16x8 Af = ld_frag_tr(Kn, QS, 32 * k2, 16 * i, lane);
#pragma unroll
                for (int n = 0; n < NET; ++n) Sacc[i][n] = MFMA16(Af, Vf[k2][n], Sacc[i][n]); }
#pragma unroll
        for (int i = 0; i < 8; ++i) { f32x4 e2; if (!RET) e2 = *(const MKLAS f32x4*)(E12 + 128 + 16 * i + 4 * quad); else e2 = (f32x4){e2s, e2s, e2s, e2s};
#pragma unroll
            for (int n = 0; n < NET; ++n) Sacc[i][n] = Sacc[i][n] * e2; }
        if (MODE != 0) {
            bf16_t* Og = (RET ? WSP(bf16_t, WS_ORT) + h * 256 : WSP(bf16_t, WS_OHG) + h * 128) + e0 + 4 * quad;
            constexpr int OS = RET ? 1024 : 512;
            if (MODE == 1) {
#pragma unroll
                for (int tt = 0; tt < NTT; ++tt) { const size_t rr = (size_t)TOKROW(C * j + 16 * tt + r16);
#pragma unroll
                    for (int n = 0; n < NET; ++n) st_bf4(Og + rr * OS + 16 * n, oacc[tt][n]); }
            } else {
#pragma unroll
                for (int tt = 0; tt < NTT; ++tt) { float s1 = 0.f, s2 = 0.f; const size_t rb = (size_t)TOKROW(C * j + 16 * tt + r16);
#pragma unroll
                    for (int n = 0; n < NET; ++n) { const u32x2 obv = *(const u32x2*)(Og + rb * OS + 16 * n); const f32x4 v = oacc[tt][n] + (f32x4){bflo(obv.x), bfhi(obv.x), bflo(obv.y), bfhi(obv.y)}; oacc[tt][n] = v;
                        s1 += (v.x + v.y) + (v.z + v.w); s2 += (v.x * v.x + v.y * v.y) + (v.z * v.z + v.w * v.w); }
                    s1 += __shfl_xor(s1, 16); s2 += __shfl_xor(s2, 16); s1 += __shfl_xor(s1, 32); s2 += __shfl_xor(s2, 32);
                    if (quad == 0) { RED[(w * 64 + 16 * tt + r16) * 2] = s1; RED[(w * 64 + 16 * tt + r16) * 2 + 1] = s2; } }
                __syncthreads();
                const float* nw = (RET ? p.in[12] + l * 1024 + h * 256 : p.in[10] + l * 512 + h * 128) + e0 + 4 * quad;
#pragma unroll
                for (int tt = 0; tt < NTT; ++tt) { const int tpos = 16 * tt + r16; const size_t rr = (size_t)TOKROW(C * j + tpos); float s1 = 0.f, s2 = 0.f;
#pragma unroll
                    for (int ww = 0; ww < 8; ++ww) { const f32x2 q = *(const MKLAS f32x2*)(RED + (ww * 64 + tpos) * 2); s1 += q.x; s2 += q.y; }
                    const float mean = RET ? s1 * (1.f / 256.f) : 0.f;
                    const float var = RET ? fmaxf(s2 * (1.f / 256.f) - mean * mean, 0.f) : s2 * (1.f / 128.f);
                    const float rinv = 1.0f / sqrtf(var + EPS);
#pragma unroll
                    for (int n = 0; n < NET; ++n) st_bf4(Og + rr * OS + 16 * n, (oacc[tt][n] - mean) * rinv * *(const f32x4*)(nw + 16 * n)); }
            }
        }
        if (RET) __syncthreads();
    }
    if (MODE == 0) {
#pragma unroll
        for (int i = 0; i < 8; ++i)
#pragma unroll
            for (int n = 0; n < NET; ++n) { u32x2 q; q.x = cvt_pk_bf16(Sacc[i][n].x, Sacc[i][n].y); q.y = cvt_pk_bf16(Sacc[i][n].z, Sacc[i][n].w);
                *(u32x2*)(ST + (size_t)(e0 + 16 * n + r16) * 128 + 16 * i + 4 * quad) = q; }
        if (!RET && hseg == 0) WSP(float, WS_ATOT)[((size_t)chain * 65 + c) * 128 + hd] = fexp(btot);
    }
#undef LOAD_CHUNK
#undef TOKROW
}

__device__ __forceinline__ int next_unit(unsigned* ctr, volatile MKLAS int* slot) {
    __syncthreads();
    if (threadIdx.x == 0) *slot = (int)__hip_atomic_fetch_add(ctr, 1u, __ATOMIC_RELAXED, __HIP_MEMORY_SCOPE_AGENT);
    __syncthreads();
    return *slot;
}
__device__ __forceinline__ void ph_scan_pass1(const P& p, int l, MKLAS unsigned char* lds, unsigned* ctr, volatile MKLAS int* slot) {
    const int nctx = (l == DEPTH - 1) ? 0 : 8;
    for (;;) { const int u0 = next_unit(ctr, slot); if (u0 >= 1040 + nctx) break;
        if (u0 < nctx) { const int h = u0 & 3;
            if (u0 < 4) { scan_unit<true, 1>(p, l, h, 0, 1, lds, true); __syncthreads(); scan_unit<true, 2>(p, l, h, 0, 0, lds, true); }
            else { scan_unit<false, 1>(p, l, h, 0, 1, lds, true); __syncthreads(); scan_unit<false, 2>(p, l, h, 0, 0, lds, true); }
            continue; }
        const int u = u0 - nctx;
        const bool ret = u < 520; const int v = ret ? u : u - 520, dir = v / 260, rem = v % 260, h = rem / 65, c = rem % 65;
        if (ret) scan_unit<true, 0>(p, l, h, c, dir, lds); else scan_unit<false, 0>(p, l, h, c, dir, lds); }
}
__device__ __forceinline__ void ph_scan_pass3(const P& p, int l, MKLAS unsigned char* lds) {
    for (int u = blockIdx.x; u < 512; u += gridDim.x) {
        const bool ret = u < 256; const int v = ret ? u : u - 256, h = v >> 6, c = (v & 63) + 1;
        __syncthreads();
        if (ret) { scan_unit<true, 1>(p, l, h, c, 1, lds); __syncthreads(); scan_unit<true, 2>(p, l, h, c, 0, lds); }
        else { scan_unit<false, 1>(p, l, h, c, 1, lds); __syncthreads(); scan_unit<false, 2>(p, l, h, c, 0, lds); } }
}
__device__ __forceinline__ void ph_scan_pass2(const P& p, int l) {
    const int tid = tid_fresh();
    const float* LG = WSP(float, WS_LGAM); const float* AT = WSP(float, WS_ATOT);
    for (int item = blockIdx.x * NT + tid; item < 32768 + 65536; item += gridDim.x * NT) {
        const bool ret = item >= 32768; const int it = ret ? item - 32768 : item, per = ret ? 8192 : 4096, chain = it / per, q4 = it % per, dir = chain >> 2, h = chain & 3, dd = (q4 * 4) & 127;
        bf16_t* base = (ret ? WSP(bf16_t, WS_STR) : WSP(bf16_t, WS_STH)) + (size_t)chain * 65 * (per * 4) + (size_t)q4 * 4;
        const float ar = ret ? fexp(256.f * LG[(l * 2 + dir) * 4 + h]) : 0.f;
        f32x4 S = {0.f, 0.f, 0.f, 0.f};
        for (int b0 = 0; b0 < 65; b0 += 13) {
            u32x2 U[13]; f32x4 A[13];
#pragma unroll
            for (int s = 0; s < 13; ++s) { const int step = b0 + s, c = dir == 0 ? step : (step == 0 ? 0 : 65 - step);
                U[s] = *(const u32x2*)(base + (size_t)c * (per * 4));
                A[s] = ret ? (f32x4){ar, ar, ar, ar} : *(const f32x4*)(AT + ((size_t)chain * 65 + c) * 128 + dd); }
#pragma unroll
            for (int s = 0; s < 13; ++s) { const int step = b0 + s, c = dir == 0 ? step : (step == 0 ? 0 : 65 - step);
                u32x2 o; o.x = cvt_pk_bf16(S.x, S.y); o.y = cvt_pk_bf16(S.z, S.w); *(u32x2*)(base + (size_t)c * (per * 4)) = o;
                S = A[s] * S + (f32x4){bflo(U[s].x), bfhi(U[s].x), bflo(U[s].y), bfhi(U[s].y)}; }
        }
    }
}

__device__ __forceinline__ void ph_router(const P& p, int l, MKLAS unsigned char* lds, unsigned* ecnt) {
    const int tid = tid_fresh(), lane = tid & 63, w = __builtin_amdgcn_readfirstlane(tid >> 6), r16 = lane & 15, g = lane >> 4;
    MKLAS float* ssum = (MKLAS float*)lds;
    MKLAS float* plog = ssum + 128;
    MKLAS float* lg = plog + 8 * 16 * 52;
    const float* MOD = WSP(float, WS_MOD); bf16_t* H = WSP(bf16_t, WS_H);
    int* AE = WSP(int, WS_AE); float* AW = WSP(float, WS_AW); int* APOS = WSP(int, WS_APOS); int* TOK = WSP(int, WS_TOK);
    const int cb = 128 * w + 4 * g;
    const float* nw = p.in[7] + l * D + cb;
    const float* WRT = WSP(float, WS_WRT) + (size_t)l * 48 * 1024 + (size_t)r16 * 1024 + cb;
    const float *bg = p.in[17] + l * 4, *be = p.in[19] + l * NE;
    const int r_lo = (l == DEPTH - 1) ? LC : 0, ntile = (L - r_lo) / 16;
    f32x4 bw[8][3];
#pragma unroll
    for (int m = 0; m < 8; ++m)
#pragma unroll
        for (int nt = 0; nt < 3; ++nt) bw[m][nt] = *(const f32x4*)(WRT + (size_t)nt * 16 * 1024 + 16 * m);
    for (int t = blockIdx.x; t < ntile; t += gridDim.x) {
        const int r = r_lo + 16 * t + r16;
        const float* xr = xrow_st(p, r) + cb;
        const float* mod = MOD + (l * 2 + (r < LC ? 1 : 0)) * 6144 + cb;
        f32x4 x[8]; float ss = 0.f;
#pragma unroll
        for (int m = 0; m < 8; ++m) { x[m] = *(const f32x4*)(xr + 16 * m); ss += (x[m].x * x[m].x + x[m].y * x[m].y) + (x[m].z * x[m].z + x[m].w * x[m].w); }
        ss += __shfl_xor(ss, 16); ss += __shfl_xor(ss, 32);
        if (g == 0) ssum[w * 16 + r16] = ss;
        __syncthreads();
        float tot = 0.f;
#pragma unroll
        for (int ww = 0; ww < 8; ++ww) tot += ssum[ww * 16 + r16];
        const float rinv = 1.0f / sqrtf(tot * (1.f / D) + EPS);
        f32x4 acc[3];
#pragma unroll
        for (int nt = 0; nt < 3; ++nt) acc[nt] = (f32x4){0.f, 0.f, 0.f, 0.f};
        bf16_t* ho = H + (size_t)r * D + cb;
#pragma unroll
        for (int m = 0; m < 8; ++m) {
            const f32x4 wv = *(const f32x4*)(nw + 16 * m), sh = *(const f32x4*)(mod + 3 * 1024 + 16 * m), sc = *(const f32x4*)(mod + 4 * 1024 + 16 * m);
            const f32x4 h = x[m] * rinv * wv * (sc + 1.0f) + sh;
            st_bf4(ho + 16 * m, h);
#pragma unroll
            for (int nt = 0; nt < 3; ++nt) { const f32x4 b = bw[m][nt];
#pragma unroll
                for (int j = 0; j < 4; ++j) acc[nt] = __builtin_amdgcn_mfma_f32_16x16x4f32(h[j], b[j], acc[nt], 0, 0, 0); }
        }
#pragma unroll
        for (int nt = 0; nt < 3; ++nt)
#pragma unroll
            for (int j = 0; j < 4; ++j) plog[(w * 16 + 4 * g + j) * 52 + 16 * nt + r16] = acc[nt][j];
        __syncthreads();
        { const int row = tid >> 5, col = tid & 31; float a = 0.f;
#pragma unroll
            for (int ww = 0; ww < 8; ++ww) a += plog[(ww * 16 + row) * 52 + col];
            lg[row * 52 + col] = a;
            if (tid < 64) { const int row2 = tid >> 2, col2 = 32 + (tid & 3); float a2 = 0.f;
#pragma unroll
                for (int ww = 0; ww < 8; ++ww) a2 += plog[(ww * 16 + row2) * 52 + col2];
                lg[row2 * 52 + col2] = a2; } }
        __syncthreads();
        if (tid < 16) {
            const MKLAS float* my = lg + tid * 52;
            float gl[4];
#pragma unroll
            for (int q = 0; q < 4; ++q) gl[q] = my[32 + q] + bg[q];
            int grp = 0; float gm = gl[0];
#pragma unroll
            for (int q = 1; q < 4; ++q) if (gl[q] > gm) { gm = gl[q]; grp = q; }
            float gs = 0.f;
#pragma unroll
            for (int q = 0; q < 4; ++q) gs += expf(gl[q] - gm);
            const float gval = 1.0f / gs;
            float el[8];
#pragma unroll
            for (int j = 0; j < 8; ++j) el[j] = my[grp * 8 + j] + be[grp * 8 + j];
            int i1 = 0; float v1 = el[0];
#pragma unroll
            for (int j = 1; j < 8; ++j) if (el[j] > v1) { v1 = el[j]; i1 = j; }
            int i2 = -1; float v2 = -3.0e38f;
#pragma unroll
            for (int j = 0; j < 8; ++j) if (j != i1 && el[j] > v2) { v2 = el[j]; i2 = j; }
            const float e2 = expf(v2 - v1), w1 = 1.0f / (1.0f + e2), w2 = e2 / (1.0f + e2);
            const int ea0 = grp * 8 + i1, ea1 = grp * 8 + i2, rr = r_lo + 16 * t + tid;
            AE[2 * rr] = ea0; AE[2 * rr + 1] = ea1; AW[2 * rr] = gval * w1; AW[2 * rr + 1] = gval * w2;
            const int p0 = (int)__hip_atomic_fetch_add(ecnt + 16 * ea0, 1u, __ATOMIC_RELAXED, __HIP_MEMORY_SCOPE_AGENT);
            const int p1 = (int)__hip_atomic_fetch_add(ecnt + 16 * ea1, 1u, __ATOMIC_RELAXED, __HIP_MEMORY_SCOPE_AGENT);
            APOS[2 * rr] = p0; APOS[2 * rr + 1] = p1; TOK[(size_t)ea0 * L + p0] = rr; TOK[(size_t)ea1 * L + p1] = rr;
        }
    }
}
constexpr int XG_ROWS = 41472;
constexpr size_t WS_WGU = WS_OF, WS_WD = WS_OF + 32 * MiB;
constexpr size_t WS_XG = WS_QH, WS_ACT = WS_XG + (size_t)XG_ROWS * 2048, WS_YA = 160 * MiB;
static_assert(WS_ACT + (size_t)XG_ROWS * 512 <= WS_YA && WS_YA + (size_t)XG_ROWS * 2048 <= WS_OF, "MoE overlays");
constexpr int EXPERT_ITEMS = 3 * 512;
__device__ __forceinline__ void expert_item(const P& p, int l, int it, MKLAS float* tile) {
    const int which = it >> 9, r = it & 511;
    if (which < 2) { const int e = r >> 4, kb = r & 15;
        const float* W = p.in[20 + which] + ((size_t)l * NE + e) * D * DE; bf16_t* WT = WSP(bf16_t, WS_WGU) + (size_t)e * 512 * D;
#pragma unroll
        for (int j = 0; j < 4; ++j) tr_load(W, DE, kb * 64, j * 64, tile + j * TRT);
        __syncthreads();
#pragma unroll
        for (int j = 0; j < 4; ++j) { const int n0 = j * 64; tr_store(WT, D, kb * 64, (n0 >> 7) * 256 + which * 128 + (n0 & 127), tile + j * TRT); }
        __syncthreads(); }
    else { const int e = r >> 4, kb = (r >> 2) & 3, ng = r & 3;
        const float* W = p.in[22] + ((size_t)l * NE + e) * DE * D; bf16_t* WT = WSP(bf16_t, WS_WD) + (size_t)e * D * DE;
#pragma unroll
        for (int j = 0; j < 4; ++j) tr_load(W, D, kb * 64, (ng * 4 + j) * 64, tile + j * TRT);
        __syncthreads();
#pragma unroll
        for (int j = 0; j < 4; ++j) tr_store(WT, DE, kb * 64, (ng * 4 + j) * 64, tile + j * TRT);
        __syncthreads(); }
}
template <bool EXPERTS> __device__ __forceinline__ void fill_convert(const P& p, int l, MKLAS unsigned char* lds, unsigned* ctr, volatile MKLAS int* slot) {
    for (;;) { const int it = next_unit(ctr, slot); if (it >= (EXPERTS ? EXPERT_ITEMS : MIXER_ITEMS)) break;
        if (EXPERTS) expert_item(p, l, it, (MKLAS float*)lds); else mixer_item(p, l, it, (MKLAS float*)lds); }
}
constexpr int MOE_TAB = LDS_CTL_OFF + 64;
__device__ __forceinline__ void moe_tables(const P& p, int l, MKLAS unsigned char* lds, bool publish) {
    MKLAS int* off = (MKLAS int*)(lds + MOE_TAB); MKLAS int* cnt = off + 64; MKLAS int* te = off + 96;
    const unsigned* ecnt = (const unsigned*)(p.ws + WS_CTL) + CW_ECNT + l * NE * 16;
    const int tid = tid_fresh();
    __syncthreads();
    if (tid == 0) { int o = 0; for (int e = 0; e < NE; ++e) { const int c = (int)__hip_atomic_load(ecnt + 16 * e, __ATOMIC_RELAXED, __HIP_MEMORY_SCOPE_AGENT); off[e] = o; cnt[e] = c; o += (c + 255) & ~255; } off[NE] = o; off[NE + 1] = o >> 8; }
    __syncthreads();
    const int nt = off[NE + 1];
    for (int t = tid; t < nt; t += NT) { int e = 0; for (int k = 1; k < NE; ++k) if (t * 256 >= off[k]) e = k; te[t] = e; }
    __syncthreads();
    if (publish && blockIdx.x == 0) { int* TE = WSP(int, WS_TILEE); if (tid == 0) TE[255] = nt; for (int t = tid; t < nt; t += NT) TE[t] = te[t]; }
}
struct MoeOrder { static constexpr bool GATHER = false; const int* tile_e; int ntiles, nN, G, c;
    __device__ __forceinline__ bool next(int i, pg8::Unit& u) const { const long Lx = (long)i * G + c; if (Lx >= (long)ntiles * nN) return false; u.pm = (int)(Lx / nN); u.pn = (int)(Lx % nN); u.be = tile_e[u.pm]; return true; }
    __device__ __forceinline__ void a_ready(const pg8::Unit&) const {}
    __device__ __forceinline__ void done(const pg8::Unit&) const {} };
struct MoeGatherOrder { static constexpr bool GATHER = true; const MKLAS int* off; const MKLAS int* cnt; const MKLAS int* te; const int* tok; int ntiles, nN, G, c;
    __device__ __forceinline__ bool next(int i, pg8::Unit& u) const { const long Lx = (long)i * G + c; if (Lx >= (long)ntiles * nN) return false; u.pm = (int)(Lx / nN); u.pn = (int)(Lx % nN); u.be = te[u.pm]; return true; }
    __device__ __forceinline__ unsigned row_byte_off(const pg8::Unit& u, int r) const { const int pos = 256 * u.pm - off[u.be] + r; const int t = pos < cnt[u.be] ? tok[(size_t)u.be * L + pos] : 0; return (unsigned)t * (unsigned)(D * 2); }
    __device__ __forceinline__ void a_ready(const pg8::Unit&) const {}
    __device__ __forceinline__ void done(const pg8::Unit&) const {} };
struct EpiGU { static constexpr bool PERM = true, AFTER_DRAIN = false; bf16_t* ACT;
    __device__ __forceinline__ void operator()(const f32x4 (&acc)[2][2][4][2], const pg8::Unit& u, int wr, int wc, int fr, int fq) const {
        const int row0 = u.pm * 256 + wr * 64 + fr, col0 = u.pn * 128 + wc * 32 + 8 * fq;
#pragma unroll
        for (int ai = 0; ai < 2; ++ai)
#pragma unroll
            for (int m = 0; m < 4; ++m) st_bf8(ACT + (size_t)(row0 + ai * 128 + m * 16) * DE + col0, silu4(acc[ai][0][m][0]) * acc[ai][1][m][0], silu4(acc[ai][0][m][1]) * acc[ai][1][m][1]);
    } };
struct FnYA { bf16_t* YA;
    static constexpr bool HAS_LOAD = false; typedef NoRegs R;
    __device__ __forceinline__ void apply8(int row, int col, f32x4 v0, f32x4 v1, const R&, const pg8::Unit&) const { st_bf8(YA + (size_t)row * D + col, v0, v1); } };
__device__ __forceinline__ void ph_moe_combine(const P& p, int l, MKLAS unsigned char* lds) {
    moe_tables(p, l, lds, false);
    const MKLAS int* off = (const MKLAS int*)(lds + MOE_TAB);
    const int tid_ = tid_fresh(), lane = tid_ & 63, wave = tid_ >> 6;
    const float* MOD = WSP(float, WS_MOD); const bf16_t* YA = WSP(bf16_t, WS_YA); bf16_t* H = WSP(bf16_t, WS_H);
    const int* AE = WSP(int, WS_AE); const int* APOS = WSP(int, WS_APOS); const float* AW = WSP(float, WS_AW);
    const bool last = (l == DEPTH - 1);
    const float* nw = last ? p.in[23] : p.in[6] + (l + 1) * D;
    for (int r = (last ? LC : 0) + blockIdx.x * NW + wave; r < L; r += gridDim.x * NW) {
        const int isc = r < LC ? 1 : 0;
        const float* g2 = MOD + (l * 2 + isc) * 6144 + 5 * 1024;
        float* xo = xrow_st(p, r);
        const int sa = off[AE[2 * r]] + APOS[2 * r], sb = off[AE[2 * r + 1]] + APOS[2 * r + 1]; const float wa = AW[2 * r], wb = AW[2 * r + 1];
        const u32x2* ya = (const u32x2*)(YA + (size_t)sa * D) + lane; const u32x2* yb = (const u32x2*)(YA + (size_t)sb * D) + lane;
        f32x4 v[4]; float ss = 0.f;
#pragma unroll
        for (int j = 0; j < 4; ++j) { const int c = 4 * (lane + 64 * j); const u32x2 a = ya[64 * j], b = yb[64 * j];
            const f32x4 y = (f32x4){wa * bflo(a.x) + wb * bflo(b.x), wa * bfhi(a.x) + wb * bfhi(b.x), wa * bflo(a.y) + wb * bflo(b.y), wa * bfhi(a.y) + wb * bfhi(b.y)};
            v[j] = *(const f32x4*)(xo + c) + *(const f32x4*)(g2 + c) * y;
            ss += (v[j].x * v[j].x + v[j].y * v[j].y) + (v[j].z * v[j].z + v[j].w * v[j].w); }
        const float rinv = 1.0f / sqrtf(wave_sum(ss) * (1.f / D) + EPS);
        if (last) {
#pragma unroll
            for (int j = 0; j < 4; ++j) { const int c = 4 * (lane + 64 * j); *(f32x4*)(xo + c) = v[j] * rinv * *(const f32x4*)(nw + c); }
        } else {
            const float* mod = MOD + ((l + 1) * 2 + isc) * 6144;
            u32x2* o = (u32x2*)(H + (size_t)r * D) + lane;
#pragma unroll
            for (int j = 0; j < 4; ++j) { const int c = 4 * (lane + 64 * j); *(f32x4*)(xo + c) = v[j];
                const f32x4 hh = v[j] * rinv * *(const f32x4*)(nw + c) * (*(const f32x4*)(mod + 1024 + c) + 1.0f) + *(const f32x4*)(mod + c);
                u32x2 q; q.x = cvt_pk_bf16(hh.x, hh.y); q.y = cvt_pk_bf16(hh.z, hh.w); o[64 * j] = q; }
        }
    }
}

constexpr int LDS_BYTES = 147456, LDS_CTL = LDS_CTL_OFF;
constexpr int NPH_LAYER = 12, NPH = 1 + DEPTH * NPH_LAYER;

__device__ __forceinline__ void ph_prologue(const P& p, MKLAS unsigned char* lds) {
    const int tid = tid_fresh(), b = blockIdx.x, G = gridDim.x;
    MKLAS float* s0 = (MKLAS float*)lds;
    MKLAS float* red = s0 + 2048;
    for (int i = tid; i < 1024; i += NT) { s0[i] = siluf(p.in[1][i]); s0[1024 + i] = siluf(p.in[3][i]); }
    __syncthreads();
    float* MOD = WSP(float, WS_MOD);
    for (int u = b; u < DEPTH * 96; u += G) {
        const int l = u / 96, n0 = (u % 96) * 64, c = tid & 63, ks = tid >> 6;
        const float* W = p.in[4] + (size_t)l * 1024 * 6144 + n0 + c;
        float a0 = 0.f, a1 = 0.f;
#pragma unroll 8
        for (int i = 0; i < 128; ++i) { const int k = ks * 128 + i; const float w = W[(size_t)k * 6144]; a0 += s0[k] * w; a1 += s0[1024 + k] * w; }
        red[(ks * 64 + c) * 2] = a0; red[(ks * 64 + c) * 2 + 1] = a1;
        __syncthreads();
        if (tid < 128) { const int cc = tid & 63, w = tid >> 6; float s = 0.f;
#pragma unroll
            for (int k2 = 0; k2 < 8; ++k2) s += red[(k2 * 64 + cc) * 2 + w];
            MOD[(l * 2 + w) * 6144 + n0 + cc] = s + p.in[5][l * 6144 + n0 + cc]; }
        __syncthreads();
    }
    if (b == G - 1) {
        float* LB = WSP(float, WS_LB);
        for (int idx = tid; idx < 2 * 512; idx += NT) { const int dir = idx >> 9, ch = idx & 511;
            float x[DEPTH], m = -3.0e38f;
#pragma unroll
            for (int l = 0; l < DEPTH; ++l) { x[l] = p.in[9][(dir * DEPTH + l) * 512 + ch]; m = fmaxf(m, x[l]); }
            float s = 0.f;
#pragma unroll
            for (int l = 0; l < DEPTH; ++l) { x[l] = expf(x[l] - m); s += x[l]; }
            float cum = 0.f; const float p0 = x[0] / s;
#pragma unroll
            for (int l = 0; l < DEPTH; ++l) { cum += x[l] / s; LB[(dir * DEPTH + l) * 512 + ch] = fminf(fmaxf(cum - p0, 0.f), 1.0f - 1e-6f); } }
    }
    if (b == (G > 1 ? G - 2 : 0)) {
        float* RT = WSP(float, WS_ROPE);
        for (int idx = tid; idx < 256 * 32; idx += NT) { const int pos = idx >> 5, i = idx & 31;
            double bp = 1.0; for (int q = 0; q < i; ++q) bp *= 0.7498942093324559;
            const float inv = (float)bp; const float ang = (float)pos * inv;
            const double a = (double)ang, n = rint(a * 0.15915494309189535), r = a - n * 6.283185307179586, r2 = r * r;
            double ts = r, tc = 1.0, sn = r, cs = 1.0;
            for (int k = 1; k <= 14; ++k) { tc *= -r2 / (double)((2 * k - 1) * (2 * k)); cs += tc; ts *= -r2 / (double)((2 * k) * (2 * k + 1)); sn += ts; }
            RT[idx * 2] = (float)cs; RT[idx * 2 + 1] = (float)sn; }
    }
    if (b == (G > 2 ? G - 3 : 0)) {
        float* LG = WSP(float, WS_LGAM);
        if (tid < DEPTH * 2 * 4) LG[tid] = -log1pf(expf(-p.in[11][tid]));
    }
    { float* WRT = WSP(float, WS_WRT);
        for (int idx = b * NT + tid; idx < DEPTH * 48 * 1024; idx += G * NT) { const int l = idx / (48 * 1024), n = (idx >> 10) % 48, k = idx & 1023;
            WRT[idx] = n < 32 ? p.in[18][((size_t)l * D + k) * NE + n] : (n < 36 ? p.in[16][((size_t)l * D + k) * 4 + (n - 32)] : 0.f); } }
    fill_convert<false>(p, 0, lds, (unsigned*)(p.ws + WS_CTL) + CW_CNT + 64 * 12, (volatile MKLAS int*)(lds + LDS_CTL + 8));
}


template <class F> __device__ __forceinline__ void ctx_gemm(MKLAS unsigned char* lds, const bf16_t* A, const bf16_t* Bt, int N, int K, const F& f) {
    const int tid = tid_fresh(), lane = tid & 63, w = __builtin_amdgcn_readfirstlane(tid >> 6), r16 = lane & 15, g = lane >> 4;
    const int br = w & 1, bc = (w >> 1) & 1, kh = w >> 2;
    MKLAS f32x4* red = (MKLAS f32x4*)lds;
    const int nitems = 4 * (N / 64), kspan = K / 2;
    for (int it = blockIdx.x; it < nitems; it += gridDim.x) {
        const int ir = it & 3, ic = it >> 2;
        const bf16_t* ap = A + (size_t)(64 * ir + 32 * br + r16) * K + kh * kspan + 8 * g;
        const bf16_t* bp = Bt + (size_t)(64 * ic + 32 * bc + r16) * K + kh * kspan + 8 * g;
        f32x4 acc[2][2];
#pragma unroll
        for (int i = 0; i < 2; ++i)
#pragma unroll
            for (int jn = 0; jn < 2; ++jn) acc[i][jn] = (f32x4){0.f, 0.f, 0.f, 0.f};
#pragma unroll 8
        for (int ks = 0; ks < kspan / 32; ++ks) {
            const bf16x8 a0 = *(const bf16x8*)(ap + 32 * ks), a1 = *(const bf16x8*)(ap + (size_t)16 * K + 32 * ks);
            const bf16x8 b0 = *(const bf16x8*)(bp + 32 * ks), b1 = *(const bf16x8*)(bp + (size_t)16 * K + 32 * ks);
            acc[0][0] = MFMA16(b0, a0, acc[0][0]); acc[0][1] = MFMA16(b1, a0, acc[0][1]); acc[1][0] = MFMA16(b0, a1, acc[1][0]); acc[1][1] = MFMA16(b1, a1, acc[1][1]);
        }
        if (kh) {
#pragma unroll
            for (int i = 0; i < 2; ++i)
#pragma unroll
                for (int jn = 0; jn < 2; ++jn) red[((w - 4) * 4 + i * 2 + jn) * 64 + lane] = acc[i][jn];
        }
        __syncthreads();
        if (!kh) { pg8::Unit u; u.pm = 0; u.pn = (64 * ic) >> 8; u.be = 0;
#pragma unroll
            for (int i = 0; i < 2; ++i)
#pragma unroll
                for (int jn = 0; jn < 2; ++jn) f(64 * ir + 32 * br + 16 * i + r16, 64 * ic + 32 * bc + 16 * jn + 4 * g, acc[i][jn] + red[(w * 4 + i * 2 + jn) * 64 + lane], u); }
        __syncthreads();
    }
}
struct LatentOrder : pg8::StaticOrder {
    __device__ __forceinline__ bool next(int i, pg8::Unit& u) const { if (!pg8::StaticOrder::next(i, u)) return false; u.pm += 1; return true; } };
template <class F> __device__ __forceinline__ void run_gemm_latent(MKLAS unsigned char* lds, const bf16_t* A, const bf16_t* Bt, int N, int K, const F& f) {
    pg8::Gemm g{A, Bt, L, N, K, 0}; LatentOrder S; S.init(T, N, (int)gridDim.x, (int)blockIdx.x);
    EpiGen<F> E{f};
    pg8::gemm_phase<EpiGen<F>, LatentOrder, false>(lds, g, S, E, nullptr);
}
template <class F> __device__ __forceinline__ void run_gemm(MKLAS unsigned char* lds, const bf16_t* A, const bf16_t* Bt, int M, int N, int K, const F& f) {
    pg8::Gemm g{A, Bt, M, N, K, 0}; pg8::StaticOrder S; S.init(M, N, (int)gridDim.x, (int)blockIdx.x);
    EpiGen<F> E{f};
    pg8::gemm_phase<EpiGen<F>, pg8::StaticOrder, false>(lds, g, S, E, nullptr);
}

#ifndef MK_MASK
#define MK_MASK 0xfffff
#endif
#define KON(j) ((MK_MASK >> (j)) & 1)
#define IN(k) (lo <= (k) && (k) < hi)
#ifndef MK_PROBE
#define MK_PROBE 0
#endif
#ifndef MK_PROBE_WORK
#define MK_PROBE_WORK 0u
#endif
#ifndef MK_PROBE_WAIT
#define MK_PROBE_WAIT 0u
#endif
#if MK_PROBE
#define PROBE_MARK(kind, iswait) do { if (blockIdx.x == 0 && threadIdx.x == 0) { const unsigned long long now_ = wall_clock64(); const unsigned long long d_ = now_ - *(volatile MKLAS unsigned long long*)(lctl + 4); \
        if ((((iswait) ? MK_PROBE_WAIT : MK_PROBE_WORK) >> (kind)) & 1u) *(volatile MKLAS unsigned long long*)(lctl + 6) += d_; *(volatile MKLAS unsigned long long*)(lctl + 4) = now_; } } while (0)
#else
#define PROBE_MARK(kind, iswait) do { } while (0)
#endif
#define SEAMK(k, kind) do { PROBE_MARK(kind, 0); if (IN(k) && IN((k) + 1)) { xcd_barrier(bar); } PROBE_MARK(kind, 1); } while (0)
template <int l> __device__ __forceinline__ void run_layer(const P& p, MKLAS unsigned char* lds, const XcdBarrier& bar, const int lo, const int hi, volatile MKLAS unsigned* lctl) {
    constexpr bool last = (l == DEPTH - 1);
    const int b = 1 + l * NPH_LAYER;
    unsigned* const ctl = (unsigned*)(p.ws + WS_CTL);
    volatile MKLAS int* const slot = (volatile MKLAS int*)(lctl + 2);
    if (KON(1) && IN(b + 0)) { if (l == 0) ph_hnorm(p, l); } SEAMK(b + 0, 1);
    if (KON(2) && IN(b + 1)) { FnA f{WSP(bf16_t, WS_QH), WSP(bf16_t, WS_VH), WSP(bf16_t, WS_RQ), WSP(bf16_t, WS_RK), WSP(bf16_t, WS_RV), WSP(float, WS_LF), WSP(float, WS_LB) + l * 512, WSP(float, WS_ROPE)};
        ctx_gemm(lds, WSP(bf16_t, WS_H), WSP(bf16_t, WS_WIN), NA, D, f);
        run_gemm_latent(lds, WSP(bf16_t, WS_H), WSP(bf16_t, WS_WIN), NA, D, f); } SEAMK(b + 1, 2);
    if (KON(3) && IN(b + 2)) { ph_scan_pass1(p, l, lds, ctl + CW_CNT + 64 * (l * 4 + 0), slot); } SEAMK(b + 2, 4);
    if (KON(3) && IN(b + 3)) { ph_scan_pass2(p, l); } SEAMK(b + 3, 5);
    if (KON(4) && IN(b + 4)) { ph_scan_pass3(p, l, lds); } SEAMK(b + 4, 7);
    if (KON(5) && IN(b + 5)) { FnB f{WSP(bf16_t, WS_OHG), WSP(bf16_t, WS_ORT), WSP(bf16_t, WS_GA), WSP(bf16_t, WS_GB)};
        if (last) run_gemm_latent(lds, WSP(bf16_t, WS_H), WSP(bf16_t, WS_WIN) + (size_t)NA * D, NB, D, f); else run_gemm(lds, WSP(bf16_t, WS_H), WSP(bf16_t, WS_WIN) + (size_t)NA * D, L, NB, D, f);
        fill_convert<true>(p, l, lds, ctl + CW_CNT + 64 * (8 + l * 2 + 0), slot); } SEAMK(b + 5, 8);
    if (KON(7) && IN(b + 6)) {
        { FnM1 f{WSP(bf16_t, WS_GA), WSP(bf16_t, WS_M1)};
          if (!last) ctx_gemm(lds, WSP(bf16_t, WS_OHG), WSP(bf16_t, WS_WOHG), D, 512, f);
          run_gemm_latent(lds, WSP(bf16_t, WS_OHG), WSP(bf16_t, WS_WOHG), D, 512, f); }
        { FnM2 f{WSP(bf16_t, WS_GB), WSP(bf16_t, WS_M1), WSP(bf16_t, WS_MB)};
          if (!last) ctx_gemm(lds, WSP(bf16_t, WS_ORT), WSP(bf16_t, WS_WORET), D, D, f);
          run_gemm_latent(lds, WSP(bf16_t, WS_ORT), WSP(bf16_t, WS_WORET), D, D, f); } } SEAMK(b + 6, 10);
    if (KON(8) && IN(b + 7)) { FnX f{l == 0 ? p.in[2] : WSP(float, WS_CTX), l == 0 ? p.in[0] : p.out, WSP(float, WS_CTX), p.out, WSP(float, WS_MOD) + l * 2 * 6144};
        if (!last) ctx_gemm(lds, WSP(bf16_t, WS_MB), WSP(bf16_t, WS_WOUT), D, D, f);
        run_gemm_latent(lds, WSP(bf16_t, WS_MB), WSP(bf16_t, WS_WOUT), D, D, f); } SEAMK(b + 7, 11);
    if (KON(9) && IN(b + 8)) { ph_router(p, l, lds, ctl + CW_ECNT + l * NE * 16); } SEAMK(b + 8, 12);
    if (KON(11) && IN(b + 9)) { moe_tables(p, l, lds, true);
        const MKLAS int* tb = (const MKLAS int*)(lds + MOE_TAB);
        MoeGatherOrder S{tb, tb + 64, tb + 96, WSP(int, WS_TOK), tb[NE + 1], 2, (int)gridDim.x, (int)blockIdx.x};
        pg8::Gemm g{WSP(bf16_t, WS_H), WSP(bf16_t, WS_WGU), XG_ROWS, 512, D, (size_t)512 * D * 2}; EpiGU E{WSP(bf16_t, WS_ACT)};
        pg8::gemm_phase<EpiGU, MoeGatherOrder, false>(lds, g, S, E, nullptr);
        if (!last) fill_convert<false>(p, l + 1, lds, ctl + CW_CNT + 64 * (8 + l * 2 + 1), slot); } SEAMK(b + 9, 14);
    if (KON(12) && IN(b + 10)) { const int* TE = WSP(int, WS_TILEE); MoeOrder S{TE, TE[255], 4, (int)gridDim.x, (int)blockIdx.x};
        pg8::Gemm g{WSP(bf16_t, WS_ACT), WSP(bf16_t, WS_WD), XG_ROWS, D, DE, (size_t)D * DE * 2}; EpiGen<FnYA> E{FnYA{WSP(bf16_t, WS_YA)}};
        pg8::gemm_phase<EpiGen<FnYA>, MoeOrder, false>(lds, g, S, E, nullptr); } SEAMK(b + 10, 15);
    if (KON(13) && IN(b + 11)) { ph_moe_combine(p, l, lds); } SEAMK(b + 11, 16);
}

__global__ void __launch_bounds__(NT, 2) fwd(P p) {
    extern __shared__ __attribute__((aligned(16))) unsigned char lds_raw[];
    MKLAS unsigned char* lds = (MKLAS unsigned char*)lds_raw;
    volatile MKLAS unsigned* lctl = (volatile MKLAS unsigned*)(lds + LDS_CTL);
    if (threadIdx.x < 8) lctl[threadIdx.x] = 0u;
    __syncthreads();
#if MK_PROBE
    if (blockIdx.x == 0 && threadIdx.x == 0) *(volatile MKLAS unsigned long long*)(lctl + 4) = wall_clock64();
#endif
    const int lo = p.ph_lo, hi = p.ph_hi;
    const bool multi = (hi - lo) > 1;
    XcdBarrier bar; bar.bar = (unsigned*)(p.ws + WS_CTL) + CW_BAR; bar.x = 0; bar.st = nullptr;
    if (multi) bar = xcd_barrier_post((unsigned*)(p.ws + WS_CTL) + CW_BAR, lctl);
    if (KON(0) && IN(0)) { ph_prologue(p, lds); } SEAMK(0, 0);
    run_layer<0>(p, lds, bar, lo, hi, lctl);
    run_layer<1>(p, lds, bar, lo, hi, lctl);
    static_assert(DEPTH == 2, "two layers written out");
#if MK_PROBE
    if (blockIdx.x == 0 && threadIdx.x == 0) { const unsigned long long t0_ = wall_clock64(), d_ = 4ull * *(volatile MKLAS unsigned long long*)(lctl + 6); while (wall_clock64() - t0_ < d_) __builtin_amdgcn_s_sleep(8); }
#endif
#undef IN
}
}

#ifndef MK_ONE_LAUNCH
#define MK_ONE_LAUNCH 1
#endif
extern "C" void kernel_launch(void* const* d_in, const int* in_sizes, int n_in, void* d_out, int out_size, void* d_ws, size_t ws_size, hipStream_t stream) {
    using namespace mk;
    static int grid = 0;
    if (grid == 0) {
        if (n_in != 24 || in_sizes[0] != T * D || out_size != T * D || ws_size < WS_END) { fprintf(stderr, "kernel_launch: unexpected shapes / workspace (n_in %d, ws %zu, need %zu); nothing launched\n", n_in, ws_size, (size_t)WS_END); grid = -1; return; }
        int dev = 0, cus = 0, per_cu = 0;
        if (hipGetDevice(&dev) != hipSuccess || hipDeviceGetAttribute(&cus, hipDeviceAttributeMultiprocessorCount, dev) != hipSuccess) { grid = -1; return; }
        if (hipFuncSetAttribute((const void*)fwd, hipFuncAttributeMaxDynamicSharedMemorySize, LDS_BYTES) != hipSuccess) { fprintf(stderr, "kernel_launch: hipFuncSetAttribute failed\n"); grid = -1; return; }
        if (hipOccupancyMaxActiveBlocksPerMultiprocessor(&per_cu, (const void*)fwd, NT, LDS_BYTES) != hipSuccess || per_cu < 1) { fprintf(stderr, "kernel_launch: occupancy query says %d\n", per_cu); (void)hipGetLastError(); per_cu = 1; }
        grid = cus;
    }
    if (grid < 0) return;
    if (hipMemsetAsync((char*)d_ws + WS_CTL, 0, CTL_BYTES, stream) != hipSuccess) return;
    P p{};
    for (int i = 0; i < 24; ++i) p.in[i] = (const float*)d_in[i];
    p.out = (float*)d_out; p.ws = (unsigned char*)d_ws;
#if MK_ONE_LAUNCH
    p.ph_lo = 0; p.ph_hi = NPH;
    hipLaunchKernelGGL(fwd, dim3(grid), dim3(NT), LDS_BYTES, stream, p);
#else
    for (int ph = 0; ph < NPH; ++ph) { p.ph_lo = ph; p.ph_hi = ph + 1; hipLaunchKernelGGL(fwd, dim3(grid), dim3(NT), LDS_BYTES, stream, p); }
#endif
}
```
